# Optimizing an MI355X kernel written in HIP

```python
import jax, jax.numpy as jnp
from jax import lax
import numpy as np

D_MODEL = 1024
BATCH = 4
SEQ = 8192
DEPTH = 2

CHUNK = 64
MEM_LEN = 256
EPS = 1e-6
NEG_INF = -1e30

A_Q_HEADS = 8
A_KV_HEADS = 2
A_HEAD_DIM = 64
A_WINDOW = 128
A_WIN_CHUNKS = A_WINDOW // CHUNK
A_WIDTH = A_Q_HEADS * A_HEAD_DIM

B_HEADS = 4
B_KEY_DIM = 128
B_VAL_DIM = 128
B_WIDTH = B_HEADS * B_VAL_DIM
ROT_BASE = 10000.0

C_WIDTH = D_MODEL
C_CONV = 3

X_HEADS = 4
X_HEAD_DIM = D_MODEL // X_HEADS

EVEN_SPLITS = (A_WIDTH,
               A_KV_HEADS * A_HEAD_DIM,
               A_KV_HEADS * A_HEAD_DIM,
               A_WIDTH,
               B_HEADS * B_KEY_DIM,
               B_HEADS * B_KEY_DIM,
               B_WIDTH,
               B_WIDTH)
EVEN_IN = sum(EVEN_SPLITS)
EVEN_SPLIT_POINTS = tuple(int(p) for p in np.cumsum(EVEN_SPLITS)[:-1])
MIX_WIDTH = A_WIDTH + B_WIDTH
ODD_IN = 4 * C_WIDTH
N_EVEN = (DEPTH + 1) // 2
N_ODD = DEPTH // 2

kernel_name = "hybrid_swa_retention_shortconv_memxattn"


def rmsnorm(x, g):
    xf = x.astype(jnp.float32)
    y = xf * lax.rsqrt(jnp.mean(xf * xf, axis=-1, keepdims=True) + EPS)
    return (y * g.astype(jnp.float32)).astype(x.dtype)


def swa_sink_attention(q, k, v, sink):
    b, s, _, d = q.shape
    n = s // CHUNK
    g = A_Q_HEADS // A_KV_HEADS
    nband = (A_WIN_CHUNKS + 1) * CHUNK
    qc = q.reshape(b, n, CHUNK, A_KV_HEADS, g, d)

    def band(t):
        tc = t.reshape(b, n, CHUNK, A_KV_HEADS, d)
        tp = jnp.pad(tc, ((0, 0), (A_WIN_CHUNKS, 0), (0, 0), (0, 0), (0, 0)))
        return jnp.concatenate([tp[:, j:j + n] for j in range(A_WIN_CHUNKS + 1)], axis=2)

    kb, vb = band(k), band(v)
    key_chunk = jnp.arange(n)[:, None] - A_WIN_CHUNKS + jnp.arange(nband)[None, :] // CHUNK
    valid = key_chunk >= 0
    scores = jnp.einsum('bnqhgd,bnkhd->bnhgqk', qc, kb).astype(jnp.float32) * (d ** -0.5)
    scores = jnp.where(valid[None, :, None, None, None, :], scores, NEG_INF)
    sink_logit = sink.astype(jnp.float32).reshape(1, 1, A_KV_HEADS, g, 1, 1)
    m = jnp.maximum(jnp.max(scores, axis=-1, keepdims=True), sink_logit)
    p = jnp.exp(scores - m)
    denom = jnp.sum(p, axis=-1, keepdims=True) + jnp.exp(sink_logit - m)
    p = (p / denom).astype(v.dtype)
    out = jnp.einsum('bnhgqk,bnkhd->bnqhgd', p, vb)
    return out.reshape(b, s, A_Q_HEADS * d)


def rotary(t, pos):
    d = t.shape[-1]
    inv = 1.0 / (ROT_BASE ** jnp.linspace(0.0, 1.0, d // 2, dtype=jnp.float32))
    ang = pos.astype(jnp.float32)[:, None] * inv[None, :]
    cos = jnp.cos(ang)[None, :, None, :].astype(t.dtype)
    sin = jnp.sin(ang)[None, :, None, :].astype(t.dtype)
    t1, t2 = t[..., :d // 2], t[..., d // 2:]
    return jnp.concatenate([t1 * cos - t2 * sin, t1 * sin + t2 * cos], axis=-1)


def retention(q, k, v):
    b, s, h, dk = q.shape
    dv = v.shape[-1]
    n = s // CHUNK
    dt = q.dtype
    pos = jnp.arange(s)
    q = rotary(q, pos)
    k = rotary(k, pos) * (dk ** -0.5)
    log_gamma = jnp.log1p(-jnp.exp2(-5.0 - jnp.arange(h, dtype=jnp.float32)))
    idx = jnp.arange(CHUNK, dtype=jnp.float32)
    intra = jnp.exp(log_gamma[:, None, None] * jnp.abs(idx[:, None] - idx[None, :]))
    k_decay = jnp.exp(log_gamma[:, None] * (CHUNK - 1 - idx)[None, :])
    q_decay = jnp.exp(log_gamma[:, None] * (idx + 1.0)[None, :])
    chunk_decay = jnp.exp(log_gamma * CHUNK).astype(dt)[None, :, None, None]

    qc = q.reshape(b, n, CHUNK, h, dk)
    kc = k.reshape(b, n, CHUNK, h, dk)
    vc = v.reshape(b, n, CHUNK, h, dv)
    sc = jnp.einsum('bnihd,bnjhd->bnhij', qc, kc) * intra.astype(dt)[None, None]
    o_intra = jnp.einsum('bnhij,bnjhe->bnihe', sc, vc)
    kv = jnp.einsum('bnjhd,bnjhe,hj->nbhde', kc, vc, k_decay.astype(dt))

    def step(state, kv_c):
        return state * chunk_decay + kv_c, state

    _, states = lax.scan(step, jnp.zeros((b, h, dk, dv), dt), kv)
    o_cross = jnp.einsum('bnihd,nbhde,hi->bnihe', qc, states, q_decay.astype(dt))
    o = (o_intra + o_cross).astype(jnp.float32)
    o = o * lax.rsqrt(jnp.mean(o * o, axis=-1, keepdims=True) + EPS)
    return o.astype(dt).reshape(b, s, h * dv)


def even_mixer(xn, w_in, sink, w_out):
    b, s, _ = xn.shape
    hcat = xn @ w_in
    aq, ak, av, ag, bq, bk, bv, bg = jnp.split(hcat, EVEN_SPLIT_POINTS, axis=-1)
    ya = swa_sink_attention(aq.reshape(b, s, A_Q_HEADS, A_HEAD_DIM),
                            ak.reshape(b, s, A_KV_HEADS, A_HEAD_DIM),
                            av.reshape(b, s, A_KV_HEADS, A_HEAD_DIM), sink)
    yb = retention(bq.reshape(b, s, B_HEADS, B_KEY_DIM),
                   bk.reshape(b, s, B_HEADS, B_KEY_DIM),
                   bv.reshape(b, s, B_HEADS, B_VAL_DIM))
    y = jnp.concatenate([ya * jax.nn.silu(ag), yb * jax.nn.silu(bg)], axis=-1)
    return y @ w_out


def conv_mixer(xn, w_in, conv_w, conv_b, w_out):
    s = xn.shape[1]
    gb, gc, u, gate = jnp.split(xn @ w_in, 4, axis=-1)
    z = gc * u
    zp = jnp.pad(z, ((0, 0), (C_CONV - 1, 0), (0, 0)))
    conv = conv_b
    for j in range(C_CONV):
        conv = conv + zp[:, j:j + s] * conv_w[j]
    y = gb * conv * jax.nn.silu(gate)
    return y @ w_out


def memory_cross_attention(xn, memn, wq, wkv, wo):
    b, s, _ = xn.shape
    q = (xn @ wq).reshape(b, s, X_HEADS, X_HEAD_DIM)
    k, v = jnp.split(memn @ wkv, 2, axis=-1)
    k = k.reshape(b, -1, X_HEADS, X_HEAD_DIM)
    v = v.reshape(b, -1, X_HEADS, X_HEAD_DIM)
    sc = jnp.einsum('bshd,bmhd->bhsm', q, k).astype(jnp.float32) * (X_HEAD_DIM ** -0.5)
    p = jax.nn.softmax(sc, axis=-1).astype(v.dtype)
    o = jnp.einsum('bhsm,bmhd->bshd', p, v).reshape(b, s, D_MODEL)
    return o @ wo


def setup_inputs(seed: int = 0) -> dict:
    key = jax.random.key(seed)
    ks = jax.random.split(key, 20)
    f32 = jnp.float32

    def w(k, shape, fan_in):
        return jax.random.normal(k, shape, f32) * (fan_in ** -0.5)

    def gain(k, shape):
        return 1.0 + 0.01 * jax.random.normal(k, shape, f32)

    return {
        "x": jax.random.normal(ks[0], (BATCH, SEQ, D_MODEL), f32),
        "mem": jax.random.normal(ks[1], (BATCH, MEM_LEN, D_MODEL), f32),
        "e_norm": gain(ks[2], (N_EVEN, D_MODEL)),
        "e_w_in": w(ks[3], (N_EVEN, D_MODEL, EVEN_IN), D_MODEL),
        "e_sink": 0.5 * jax.random.normal(ks[4], (N_EVEN, A_Q_HEADS), f32),
        "e_w_out": w(ks[5], (N_EVEN, MIX_WIDTH, D_MODEL), MIX_WIDTH),
        "o_norm": gain(ks[6], (N_ODD, D_MODEL)),
        "o_w_in": w(ks[7], (N_ODD, D_MODEL, ODD_IN), D_MODEL),
        "o_conv_w": w(ks[8], (N_ODD, C_CONV, C_WIDTH), C_CONV),
        "o_conv_b": 0.01 * jax.random.normal(ks[9], (N_ODD, C_WIDTH), f32),
        "o_w_out": w(ks[10], (N_ODD, C_WIDTH, D_MODEL), C_WIDTH),
        "c_norm": gain(ks[11], (DEPTH, D_MODEL)),
        "c_mem_norm": gain(ks[12], (DEPTH, D_MODEL)),
        "c_wq": w(ks[13], (DEPTH, D_MODEL, D_MODEL), D_MODEL),
        "c_wkv": w(ks[14], (DEPTH, D_MODEL, 2 * D_MODEL), D_MODEL),
        "c_wo": w(ks[15], (DEPTH, D_MODEL, D_MODEL), D_MODEL),
        "final_norm": gain(ks[16], (D_MODEL,)),
    }


def reference(x, mem, e_norm, e_w_in, e_sink, e_w_out, o_norm, o_w_in, o_conv_w, o_conv_b,
              o_w_out, c_norm, c_mem_norm, c_wq, c_wkv, c_wo, final_norm):
    for i in range(DEPTH):
        j = i // 2
        if i % 2 == 0:
            x = x + even_mixer(rmsnorm(x, e_norm[j]), e_w_in[j], e_sink[j], e_w_out[j])
        else:
            x = x + conv_mixer(rmsnorm(x, o_norm[j]), o_w_in[j], o_conv_w[j], o_conv_b[j], o_w_out[j])
        x = x + memory_cross_attention(rmsnorm(x, c_norm[i]), rmsnorm(mem, c_mem_norm[i]),
                                       c_wq[i], c_wkv[i], c_wo[i])
    return rmsnorm(x, final_norm)
```

```cpp
#include <hip/hip_runtime.h>
#include <hip/hip_cooperative_groups.h>
#include <cstdio>
#include <cstdint>
namespace cg = cooperative_groups;
namespace pg8 {
#define PG8_LAS __attribute__((address_space(3)))
typedef unsigned short bf16_t;
typedef short bf16x8 __attribute__((ext_vector_type(8)));
typedef float f32x4 __attribute__((ext_vector_type(4)));
typedef unsigned u32x4 __attribute__((ext_vector_type(4)));
constexpr int BM = 256, BK = 64, HALF = 128, HTB = HALF * BK * 2  , STAGE_BYTES = 8 * HTB, NXCD = 8, WGM = 8;

__host__ __device__ __forceinline__ int lds_byte(int r, int c) { const int st = (r >> 4) * 2 + (c >> 5), rr = r & 15, cc = c & 31, ob = rr * 64 + cc * 2; return st * 1024 + (ob ^ (((ob >> 9) & 1) << 5)); }
__host__ __device__ __forceinline__ void stage_rc(int b, int& R, int& C) { const int st = b / 1024, sb = b % 1024, swz = sb ^ (((sb >> 9) & 1) << 5); R = (st >> 1) * 16 + swz / 64; C = (st & 1) * 32 + (swz % 64) / 2; }
__host__ __device__ __forceinline__ int perm32(int rho) { const int n = rho >> 4, i = rho & 15; return 8 * (i >> 2) + 4 * n + (i & 3); }

struct Unit { int pm, pn; };
struct Gemm { const bf16_t* A; const bf16_t* Bt; int M, N, K; };

struct StaticOrder {
    int nM, nN, nwg, G, c;
    __host__ __device__ void init(int M, int N, int G_, int c_) { nM = M / BM; nN = N / BM; nwg = nM * nN; G = G_; c = c_; }
    __host__ __device__ bool next(int i, Unit& u) const {
        const long L = (long)i * G + c; if (L >= nwg) return false;
        int wgid = (int)L; { const int q = nwg / NXCD, r = nwg % NXCD, xcd = wgid % NXCD, off = wgid / NXCD; wgid = (xcd < r ? xcd * (q + 1) : r * (q + 1) + (xcd - r) * q) + off; }
        const int nig = WGM * nN, gid = wgid / nig, fm = gid * WGM, gsz = (nM - fm) < WGM ? (nM - fm) : WGM;
        u.pm = fm + ((wgid % nig) % gsz); u.pn = (wgid % nig) / gsz; return true;
    }
    __device__ __forceinline__ void a_ready(const Unit&) const {}
    __device__ __forceinline__ void done(const Unit&) const {}
};

typedef float f32x2 __attribute__((ext_vector_type(2))); typedef __bf16 bf16x2_t __attribute__((ext_vector_type(2)));
__device__ __forceinline__ unsigned cvt_pk_bf16(float lo, float hi) { const f32x2 v = {lo, hi}; const bf16x2_t b = __builtin_convertvector(v, bf16x2_t); return __builtin_bit_cast(unsigned, b); }
template <bool SCALE> struct EpiScaleBf16 {
    static constexpr bool PERM = true, AFTER_DRAIN = false;
    bf16_t* O; int ldc; const float* ssp;
    __device__ __forceinline__ void operator()(const f32x4 (&acc)[2][2][4][2], const Unit& u, int wr, int wc, int fr, int fq) const {
        const int row0 = u.pm * BM + wr * 64 + fr; const int col0 = u.pn * BM + wc * 32 + 8 * fq;
#pragma unroll
        for (int ai = 0; ai < 2; ++ai)
#pragma unroll
            for (int m = 0; m < 4; ++m) {
                const int row = row0 + ai * HALF + m * 16;
                float sc = 1.f;
                if (SCALE) { const f32x4* p = (const f32x4*)(ssp + (size_t)row * 16); const f32x4 a = p[0], b = p[1], c = p[2], d = p[3];
                    const float s = ((a[0] + a[1]) + (a[2] + a[3])) + ((b[0] + b[1]) + (b[2] + b[3])) + ((c[0] + c[1]) + (c[2] + c[3])) + ((d[0] + d[1]) + (d[2] + d[3]));
                    sc = 1.0f / sqrtf(s * (1.0f / 1024.0f) + 1e-6f); }
                bf16_t* rowp = O + (size_t)row * ldc + col0;
#pragma unroll
                for (int bj = 0; bj < 2; ++bj) { const f32x4 v0 = acc[ai][bj][m][0] * sc, v1 = acc[ai][bj][m][1] * sc;
                    u32x4 w; w.x = cvt_pk_bf16(v0[0], v0[1]); w.y = cvt_pk_bf16(v0[2], v0[3]); w.z = cvt_pk_bf16(v1[0], v1[1]); w.w = cvt_pk_bf16(v1[2], v1[3]);
                    *(u32x4*)(rowp + bj * HALF) = w; }
                if (m & 1) asm volatile("" ::: "memory");
            }
    }
};
struct EpiResidual {
    static constexpr bool PERM = true, AFTER_DRAIN = false;
    const float* base; float* out; bf16_t* xb; float* ssp; int ldc;
    __device__ __forceinline__ void operator()(const f32x4 (&acc)[2][2][4][2], const Unit& u, int wr, int wc, int fr, int fq) const {
        const int row0 = u.pm * BM + wr * 64 + fr; const int col0 = u.pn * BM + wc * 32 + 8 * fq;
#pragma unroll
        for (int ai = 0; ai < 2; ++ai)
#pragma unroll
            for (int m = 0; m < 4; ++m) {
                const int row = row0 + ai * HALF + m * 16;
                float ss = 0.f;
#pragma unroll
                for (int bj = 0; bj < 2; ++bj) { const size_t off = (size_t)row * ldc + col0 + bj * HALF;
                    const f32x4 b0 = *(const f32x4*)(base + off), b1 = *(const f32x4*)(base + off + 4);
                    const f32x4 o0 = b0 + acc[ai][bj][m][0], o1 = b1 + acc[ai][bj][m][1];
                    *(f32x4*)(out + off) = o0; *(f32x4*)(out + off + 4) = o1;
                    ss += ((o0[0] * o0[0] + o0[1] * o0[1]) + (o0[2] * o0[2] + o0[3] * o0[3])) + ((o1[0] * o1[0] + o1[1] * o1[1]) + (o1[2] * o1[2] + o1[3] * o1[3]));
                    if (xb) { u32x4 w; w.x = cvt_pk_bf16(o0[0], o0[1]); w.y = cvt_pk_bf16(o0[2], o0[3]); w.z = cvt_pk_bf16(o1[0], o1[1]); w.w = cvt_pk_bf16(o1[2], o1[3]);
                        *(u32x4*)(xb + off) = w; } }
                ss += __shfl_xor(ss, 16); ss += __shfl_xor(ss, 32);
                if (fq == 0) ssp[(size_t)row * 16 + u.pn * 4 + wc] = ss;
                asm volatile("" ::: "memory");
            }
    }
};
template <class Epi, class Sched, bool ALIGN_EPI = false, bool SP2 = false>
__device__ __forceinline__ void gemm_phase(PG8_LAS unsigned char* lds, const Gemm g, const Sched& S, const Epi& E) {
    int tid_ = threadIdx.x; asm volatile("" : "+v"(tid_));
    const int tid = tid_, wid = __builtin_amdgcn_readfirstlane(tid >> 6), lane = tid & 63, wr = wid >> 2, wc = wid & 3, fr = lane & 15, fq = lane >> 4;
    const int K = g.K, nt = K / BK;
    unsigned voffA[2], voffB[2];
#pragma unroll
    for (int i = 0; i < 2; ++i) { int R, C; stage_rc(tid * 16 + i * 8192, R, C); const int Rb = Epi::PERM ? ((R & ~31) + perm32(R & 31)) : R;
        voffA[i] = (unsigned)(R * K + C) * 2u; voffB[i] = (unsigned)(Rb * K + C) * 2u; }
    const size_t kstep = (size_t)(BK * 2);
    const size_t hstep = (size_t)HALF * K * 2;
    const size_t tstep = 2 * hstep;
    const unsigned ldsw = (unsigned)wid * 1024u;
    const int aoff = lds_byte(wr * 64 + fr, fq * 8), boff = lds_byte(wc * 32 + fr, fq * 8);
#define PG8_SA(b, h) (((b) * 2 + (h)) * HTB)
#define PG8_SB(b, h) ((4 + (b) * 2 + (h)) * HTB)
#define PG8_STAGE(bufoff, gbase, voff) do { _Pragma("unroll") for (int _i = 0; _i < 2; ++_i) \
        __builtin_amdgcn_global_load_lds((const unsigned*)((const char*)(gbase) + (voff)[_i]), (PG8_LAS unsigned*)(lds + (bufoff) + ldsw + _i * 8192), 16, 0, 0); } while (0)
#define PG8_LDA(dst, b, h) do { _Pragma("unroll") for (int m = 0; m < 4; ++m) _Pragma("unroll") for (int k = 0; k < 2; ++k) dst[m][k] = *(const PG8_LAS bf16x8*)(lds + PG8_SA(b, h) + aoff + m * 2048 + k * 1024); } while (0)
#define PG8_LDB(dst, b, h) do { _Pragma("unroll") for (int n = 0; n < 2; ++n) _Pragma("unroll") for (int k = 0; k < 2; ++k) dst[n][k] = *(const PG8_LAS bf16x8*)(lds + PG8_SB(b, h) + boff + n * 2048 + k * 1024); } while (0)
#define PG8_MMA(ai, bj, At, Bt) do { __builtin_amdgcn_s_setprio(1); _Pragma("unroll") for (int m = 0; m < 4; ++m) _Pragma("unroll") for (int n = 0; n < 2; ++n) _Pragma("unroll") for (int k = 0; k < 2; ++k) \
        acc[ai][bj][m][n] = __builtin_amdgcn_mfma_f32_16x16x32_bf16(Bt[n][k], At[m][k], acc[ai][bj][m][n], 0, 0, 0); __builtin_amdgcn_s_setprio(0); } while (0)
#define PG8_WAIT_V(n) asm volatile("s_waitcnt vmcnt(" #n ")" ::: "memory")
#define PG8_WAIT_L(n) asm volatile("s_waitcnt lgkmcnt(" #n ")" ::: "memory")
#define PG8_BAR __builtin_amdgcn_s_barrier()
#define PG8_SCHED __builtin_amdgcn_sched_barrier(0)
    Unit cur, nxt; int ui = 0;
    if (!S.next(0, cur)) return;
    f32x4 acc[2][2][4][2];
#pragma unroll
    for (int a = 0; a < 2; ++a)
#pragma unroll
        for (int b = 0; b < 2; ++b)
#pragma unroll
            for (int m = 0; m < 4; ++m)
#pragma unroll
                for (int n = 0; n < 2; ++n) acc[a][b][m][n] = (f32x4){0.f, 0.f, 0.f, 0.f};
    bf16x8 At[4][2], B0[2][2], B1[2][2];
    const char* cA = (const char*)g.A + (size_t)cur.pm * tstep; const char* cB = (const char*)g.Bt + (size_t)cur.pn * tstep;
    S.a_ready(cur);
    if constexpr (SP2) {
        PG8_STAGE(PG8_SB(0, 0), cB, voffB); PG8_STAGE(PG8_SB(0, 1), cB + hstep, voffB); PG8_STAGE(PG8_SA(0, 0), cA, voffA); PG8_STAGE(PG8_SA(0, 1), cA + hstep, voffA);
        if (wr == 1) PG8_BAR;
        PG8_WAIT_V(2); PG8_BAR;
        PG8_STAGE(PG8_SB(1, 0), cB + kstep, voffB); PG8_STAGE(PG8_SA(1, 0), cA + kstep, voffA); PG8_STAGE(PG8_SB(1, 1), cB + hstep + kstep, voffB);
        PG8_WAIT_V(6); PG8_BAR;
    } else {
        PG8_STAGE(PG8_SB(0, 0), cB, voffB); PG8_STAGE(PG8_SA(0, 0), cA, voffA); PG8_STAGE(PG8_SB(0, 1), cB + hstep, voffB); PG8_STAGE(PG8_SA(0, 1), cA + hstep, voffA);
        if (wr == 1) PG8_BAR;
        PG8_WAIT_V(4); PG8_BAR;
        PG8_STAGE(PG8_SB(1, 0), cB + kstep, voffB); PG8_STAGE(PG8_SA(1, 0), cA + kstep, voffA); PG8_STAGE(PG8_SB(1, 1), cB + hstep + kstep, voffB);
        PG8_WAIT_V(6); PG8_BAR;
    }
    for (;;) {
        const bool has_next = S.next(ui + 1, nxt);
        const char* nA = has_next ? (const char*)g.A + (size_t)nxt.pm * tstep : cA; const char* nB = has_next ? (const char*)g.Bt + (size_t)nxt.pn * tstep : cB;
        for (int t = 0; t < nt; t += 2) {
            const bool last = (t == nt - 2);
            const char* a1 = cA + (size_t)(t + 1) * kstep;
            const char* a2 = last ? nA : cA + (size_t)(t + 2) * kstep; const char* b2 = last ? nB : cB + (size_t)(t + 2) * kstep;
            const char* a3 = a2 + kstep; const char* b3 = b2 + kstep;
            if (last && has_next) S.a_ready(nxt);
            if constexpr (SP2) {
            PG8_LDB(B0, 0, 0); PG8_LDB(B1, 0, 1); PG8_SCHED; PG8_LDA(At, 0, 0); PG8_STAGE(PG8_SA(1, 1), a1 + hstep, voffA);
            PG8_WAIT_V(8); PG8_WAIT_L(0); PG8_BAR; PG8_MMA(0, 0, At, B0); PG8_MMA(0, 1, At, B1); PG8_BAR; PG8_SCHED;
            PG8_LDA(At, 0, 1); PG8_STAGE(PG8_SB(0, 0), b2, voffB); PG8_STAGE(PG8_SB(0, 1), b2 + hstep, voffB); PG8_STAGE(PG8_SA(0, 0), a2, voffA);
            PG8_WAIT_V(8); PG8_WAIT_L(0); PG8_BAR; PG8_MMA(1, 0, At, B0); PG8_MMA(1, 1, At, B1); PG8_BAR; PG8_SCHED;
            PG8_LDB(B0, 1, 0); PG8_LDB(B1, 1, 1); PG8_SCHED; PG8_LDA(At, 1, 0); PG8_STAGE(PG8_SA(0, 1), a2 + hstep, voffA);
            PG8_WAIT_V(8); PG8_WAIT_L(0); PG8_BAR; PG8_MMA(0, 0, At, B0); PG8_MMA(0, 1, At, B1); PG8_BAR; PG8_SCHED;
            PG8_LDA(At, 1, 1); PG8_STAGE(PG8_SB(1, 0), b3, voffB); PG8_STAGE(PG8_SB(1, 1), b3 + hstep, voffB); PG8_STAGE(PG8_SA(1, 0), a3, voffA);
            PG8_WAIT_V(8); PG8_WAIT_L(0); PG8_BAR; PG8_MMA(1, 0, At, B0); PG8_MMA(1, 1, At, B1); PG8_BAR; PG8_SCHED;
            } else {
            PG8_LDB(B0, 0, 0); PG8_SCHED; PG8_LDA(At, 0, 0); PG8_STAGE(PG8_SA(1, 1), a1 + hstep, voffA);
            PG8_WAIT_L(8); PG8_BAR; PG8_WAIT_L(0); PG8_MMA(0, 0, At, B0); PG8_BAR; PG8_SCHED;
            PG8_LDB(B1, 0, 1); PG8_STAGE(PG8_SB(0, 0), b2, voffB);
            PG8_BAR; PG8_WAIT_L(0); PG8_MMA(0, 1, At, B1); PG8_BAR;
            PG8_LDA(At, 0, 1); PG8_STAGE(PG8_SA(0, 0), a2, voffA);
            PG8_BAR; PG8_WAIT_L(0); PG8_MMA(1, 0, At, B0); PG8_BAR; PG8_SCHED;
            PG8_STAGE(PG8_SB(0, 1), b2 + hstep, voffB);
            PG8_WAIT_V(6); PG8_BAR; PG8_MMA(1, 1, At, B1); PG8_BAR;
            PG8_LDB(B0, 1, 0); PG8_SCHED; PG8_LDA(At, 1, 0); PG8_STAGE(PG8_SA(0, 1), a2 + hstep, voffA);
            PG8_WAIT_L(8); PG8_BAR; PG8_WAIT_L(0); PG8_MMA(0, 0, At, B0); PG8_BAR; PG8_SCHED;
            PG8_LDB(B1, 1, 1); PG8_STAGE(PG8_SB(1, 0), b3, voffB);
            PG8_BAR; PG8_WAIT_L(0); PG8_MMA(0, 1, At, B1); PG8_BAR;
            PG8_LDA(At, 1, 1); PG8_STAGE(PG8_SA(1, 0), a3, voffA);
            PG8_BAR; PG8_WAIT_L(0); PG8_MMA(1, 0, At, B0); PG8_BAR; PG8_SCHED;
            PG8_STAGE(PG8_SB(1, 1), b3 + hstep, voffB);
            PG8_WAIT_V(6); PG8_BAR; PG8_MMA(1, 1, At, B1); PG8_BAR;
            }
        }
        if constexpr (ALIGN_EPI) { if (wr == 0) PG8_BAR; }
        if constexpr (!Epi::AFTER_DRAIN) { E(acc, cur, wr, wc, fr, fq); S.done(cur); }
        if (!has_next) break;
#pragma unroll
        for (int a = 0; a < 2; ++a)
#pragma unroll
            for (int b = 0; b < 2; ++b)
#pragma unroll
                for (int m = 0; m < 4; ++m)
#pragma unroll
                    for (int n = 0; n < 2; ++n) acc[a][b][m][n] = (f32x4){0.f, 0.f, 0.f, 0.f};
        cur = nxt; cA = nA; cB = nB; ++ui;
        if constexpr (ALIGN_EPI) { if (wr == 1) PG8_BAR; }
    }
    PG8_WAIT_V(0);
    if constexpr (!ALIGN_EPI) { if (wr == 0) PG8_BAR; }
    PG8_BAR;
    if constexpr (Epi::AFTER_DRAIN) { E.fused(acc, cur, wr, wc, fr, fq, lds, wid, lane); S.done(cur); }
#undef PG8_SA
#undef PG8_SB
#undef PG8_STAGE
#undef PG8_LDA
#undef PG8_LDB
#undef PG8_MMA
#undef PG8_WAIT_V
#undef PG8_WAIT_L
#undef PG8_BAR
#undef PG8_SCHED
}
}

constexpr int D = 1024, BATCH = 4, SEQ = 8192, MTOK = BATCH * SEQ, NCH = SEQ / 64, MEMLEN = 256;
constexpr int EIN = 3328, OIN = 4096;
constexpr float EPS = 1e-6f;
constexpr int C_AQ = 0, C_AK = 512, C_AV = 640, C_AG = 768, C_BQ = 1280, C_BK = 1792, C_BV = 2304, C_BG = 2816;
constexpr int NWAVES = 8, NTHR = 512;
constexpr size_t MiB = 1u << 20;
constexpr size_t WS_WEIN = 1 * MiB, WS_WEOUT = 8 * MiB, WS_WOIN = 10 * MiB, WS_WOOUT = 18 * MiB, WS_WQ = 20 * MiB, WS_WKV = 24 * MiB, WS_WO = 32 * MiB;
constexpr size_t WS_MEMN = 36 * MiB, WS_KV = 40 * MiB, WS_ROT = 48 * MiB, WS_SSP = 52 * MiB;
constexpr size_t WS_XB = 56 * MiB;
constexpr size_t WS_BIG = 120 * MiB;
constexpr size_t WS_BUFA = 376 * MiB;
constexpr size_t WS_BUFB = 440 * MiB;
constexpr size_t WS_END = 504 * MiB;
constexpr int LDS_BYTES = 147456;

#define LAS __attribute__((address_space(3)))
typedef unsigned short bf16;
typedef short bf16x8 __attribute__((ext_vector_type(8)));
typedef short s16x4 __attribute__((ext_vector_type(4)));
typedef float f32x2 __attribute__((ext_vector_type(2)));
typedef float f32x4 __attribute__((ext_vector_type(4)));
typedef float f32x16 __attribute__((ext_vector_type(16)));
typedef unsigned u32x2 __attribute__((ext_vector_type(2)));
typedef unsigned u32x4 __attribute__((ext_vector_type(4)));

__device__ __forceinline__ unsigned pk2(float lo, float hi) { return pg8::cvt_pk_bf16(lo, hi); }
__device__ __forceinline__ float bflo(unsigned w) { return __uint_as_float(w << 16); }
__device__ __forceinline__ float bfhi(unsigned w) { return __uint_as_float(w & 0xffff0000u); }
__device__ __forceinline__ int crow(int r, int hi) { return (r & 3) + 8 * (r >> 2) + 4 * hi; }
__device__ __forceinline__ float wave_sum(float v) {
#pragma unroll
    for (int o = 1; o < 64; o <<= 1) v += __shfl_xor(v, o);
    return v;
}
__device__ __forceinline__ float silu(float x) { return x / (1.0f + __expf(-x)); }
__device__ __forceinline__ s16x4 trd(const LAS bf16* p) { return __builtin_bit_cast(s16x4, __builtin_amdgcn_ds_read_tr16_b64_v4i16((LAS s16x4*)p)); }
__device__ __forceinline__ bf16x8 tr_frag(const LAS bf16* T, int ld, int k0, int n0, int lane) {
    const int g4 = lane >> 4, li = lane & 15, q = li >> 2, p = li & 3, hi = g4 >> 1;
    const LAS bf16* a = T + (k0 + 4 * hi + q) * ld + n0 + 16 * (g4 & 1) + 4 * p;
    const s16x4 lo = trd(a), up = trd(a + 8 * ld);
    return (bf16x8){lo[0], lo[1], lo[2], lo[3], up[0], up[1], up[2], up[3]};
}
__device__ __forceinline__ bf16x8 pack8(float a0, float a1, float a2, float a3, float a4, float a5, float a6, float a7) {
    u32x4 w; w.x = pk2(a0, a1); w.y = pk2(a2, a3); w.z = pk2(a4, a5); w.w = pk2(a6, a7); return __builtin_bit_cast(bf16x8, w);
}
__device__ __forceinline__ int launder(int v) { asm volatile("" : "+v"(v)); return v; }
#define MFMA32(a, b, c) __builtin_amdgcn_mfma_f32_32x32x16_bf16((a), (b), (c), 0, 0, 0)

struct Args { const float* in[17]; float* out; unsigned char* ws; int ph_lo, ph_hi; };
struct Frame {
    LAS unsigned char* lds; int tid, lane, wave, G, bid;
    const float *x, *mem, *e_norm, *e_w_in, *e_sink, *e_w_out, *o_norm, *o_w_in, *o_conv_w, *o_conv_b, *o_w_out, *c_norm, *c_mem_norm, *c_wq, *c_wkv, *c_wo, *final_norm;
    float* out; unsigned char* ws;
};

__device__ __forceinline__ void p0_transpose_item(const float* W, const float* gain, int K, int N, bf16* WT, LAS float* scr, int item, int lane) {
    const int nblk = N / 32, kb = item / nblk, nb = item % nblk, k0 = 64 * kb, n0 = 32 * nb;
#pragma unroll 8
    for (int i = 0; i < 32; ++i) { const int kk = 2 * i + (lane >> 5); float w = W[(size_t)(k0 + kk) * N + n0 + (lane & 31)]; if (gain) w *= gain[k0 + kk]; scr[kk * 33 + (lane & 31)] = w; }
    asm volatile("s_waitcnt lgkmcnt(0)" ::: "memory");
    const int c = lane & 7;
#pragma unroll
    for (int j = 0; j < 4; ++j) { const int n = (lane >> 3) + 8 * j; const LAS float* s = scr + (8 * c) * 33 + n;
        u32x4 o; o.x = pk2(s[0 * 33], s[1 * 33]); o.y = pk2(s[2 * 33], s[3 * 33]); o.z = pk2(s[4 * 33], s[5 * 33]); o.w = pk2(s[6 * 33], s[7 * 33]);
        *(u32x4*)(WT + (size_t)(n0 + n) * K + k0 + 8 * c) = o; }
    asm volatile("s_waitcnt lgkmcnt(0)" ::: "memory");
}
__device__ __forceinline__ void p0_prologue(Frame& F) {
    LAS float* scr = (LAS float*)(F.lds + F.wave * 16384);
    const int gw = F.bid * NWAVES + F.wave, NGW = F.G * NWAVES, lane = F.lane;
    unsigned char* ws = F.ws;
    constexpr int I_EIN = 16 * (EIN / 32), I_SQ = 16 * 32, I_OIN = 16 * (OIN / 32), I_KV = 16 * 64;
    constexpr int NITEMS = I_EIN + I_SQ + I_OIN + I_SQ + 2 * I_SQ + 2 * I_KV + 2 * I_SQ;
    for (int it = gw; it < NITEMS; it += NGW) {
        int r = it;
        if (r < I_EIN) { p0_transpose_item(F.e_w_in, F.e_norm, D, EIN, (bf16*)(ws + WS_WEIN), scr, r, lane); continue; } r -= I_EIN;
        if (r < I_SQ) { p0_transpose_item(F.e_w_out, nullptr, D, D, (bf16*)(ws + WS_WEOUT), scr, r, lane); continue; } r -= I_SQ;
        if (r < I_OIN) { p0_transpose_item(F.o_w_in, F.o_norm, D, OIN, (bf16*)(ws + WS_WOIN), scr, r, lane); continue; } r -= I_OIN;
        if (r < I_SQ) { p0_transpose_item(F.o_w_out, nullptr, D, D, (bf16*)(ws + WS_WOOUT), scr, r, lane); continue; } r -= I_SQ;
        if (r < 2 * I_SQ) { const int l = r / I_SQ; p0_transpose_item(F.c_wq + (size_t)l * D * D, F.c_norm + l * D, D, D, (bf16*)(ws + WS_WQ) + (size_t)l * D * D, scr, r % I_SQ, lane); continue; } r -= 2 * I_SQ;
        if (r < 2 * I_KV) { const int l = r / I_KV; p0_transpose_item(F.c_wkv + (size_t)l * D * 2 * D, nullptr, D, 2 * D, (bf16*)(ws + WS_WKV) + (size_t)l * 2 * D * D, scr, r % I_KV, lane); continue; } r -= 2 * I_KV;
        { const int l = r / I_SQ; p0_transpose_item(F.c_wo + (size_t)l * D * D, nullptr, D, D, (bf16*)(ws + WS_WO) + (size_t)l * D * D, scr, r % I_SQ, lane); }
    }
    for (int it = gw; it < 2 * BATCH * MEMLEN; it += NGW) {
        const int l = it / (BATCH * MEMLEN), row = it % (BATCH * MEMLEN);
        const f32x4* xr = (const f32x4*)(F.mem + (size_t)row * D) + lane; const f32x4* gr = (const f32x4*)(F.c_mem_norm + l * D) + lane;
        f32x4 v[4]; float s = 0.f;
#pragma unroll
        for (int j = 0; j < 4; ++j) { v[j] = xr[64 * j]; s += (v[j][0] * v[j][0] + v[j][1] * v[j][1]) + (v[j][2] * v[j][2] + v[j][3] * v[j][3]); }
        const float rs = 1.0f / sqrtf(wave_sum(s) * (1.0f / D) + EPS);
        u32x2* o8 = (u32x2*)((bf16*)(ws + WS_MEMN) + (size_t)it * D) + lane;
#pragma unroll
        for (int j = 0; j < 4; ++j) { const f32x4 g = gr[64 * j]; u32x2 w; w.x = pk2(v[j][0] * rs * g[0], v[j][1] * rs * g[1]); w.y = pk2(v[j][2] * rs * g[2], v[j][3] * rs * g[3]); o8[64 * j] = w; }
    }
    for (int row = gw; row < MTOK; row += NGW) {
        const f32x4* xr = (const f32x4*)(F.x + (size_t)row * D) + lane;
        f32x4 v[4]; float s = 0.f;
#pragma unroll
        for (int j = 0; j < 4; ++j) { v[j] = xr[64 * j]; s += (v[j][0] * v[j][0] + v[j][1] * v[j][1]) + (v[j][2] * v[j][2] + v[j][3] * v[j][3]); }
        s = wave_sum(s);
        u32x2* o8 = (u32x2*)((bf16*)(ws + WS_XB) + (size_t)row * D) + lane;
#pragma unroll
        for (int j = 0; j < 4; ++j) { u32x2 w; w.x = pk2(v[j][0], v[j][1]); w.y = pk2(v[j][2], v[j][3]); o8[64 * j] = w; }
        if (lane < 16) ((float*)(ws + WS_SSP))[(size_t)row * 16 + lane] = (lane == 0) ? s : 0.f;
    }
    for (int e = F.bid * NTHR + F.tid; e < SEQ * 64; e += F.G * NTHR) {
        const int pos = e >> 6, j = e & 63;
        const float inv = 1.0f / exp2f(((float)j / 63.0f) * 13.287712379549449f);
        const float ang = (float)pos * inv;
        const double a = (double)ang, kk = rint(a * 0.63661977236758134308);
        const float r = (float)fma(-kk, 1.57079632679489661923, a), r2 = r * r;
        const float sn = r + r * r2 * (-1.6666654611e-1f + r2 * (8.3321608736e-3f + r2 * (-1.9515295891e-4f)));
        const float cs = 1.0f - 0.5f * r2 + r2 * r2 * (4.166664568298827e-2f + r2 * (-1.388731625493765e-3f + r2 * 2.443315711809948e-5f));
        const int q = ((int)kk) & 3;
        f32x2 o; o.x = (q == 0) ? cs : (q == 1) ? -sn : (q == 2) ? -cs : sn; o.y = (q == 0) ? sn : (q == 1) ? cs : (q == 2) ? -sn : -cs;
        ((f32x2*)(ws + WS_ROT))[e] = o;
    }
}

constexpr int AKS = 72;
__device__ __forceinline__ void swa_item(Frame& F, int item) {
    const int kvh = item & 1, c = (item >> 1) & (NCH - 1), b = item >> 8;
    const int c0 = c >= 2 ? c - 2 : 0, nch = c - c0 + 1;
    const int tid = launder(F.tid), lane = tid & 63, w = F.wave, r32 = lane & 31, hi = lane >> 5;
    LAS bf16* Ks = (LAS bf16*)F.lds; LAS bf16* Vs = Ks + 192 * AKS;
    const bf16* HC = (const bf16*)(F.ws + WS_BIG);
    const size_t rowbase = (size_t)b * SEQ;
    for (int p = tid; p < nch * 64 * 8; p += NTHR) { const int r = p >> 3, ch = p & 7; const bf16* src = HC + (rowbase + c0 * 64 + r) * EIN + kvh * 64 + ch * 8;
        const u32x4 kx = *(const u32x4*)(src + C_AK), vx = *(const u32x4*)(src + C_AV);
        *(LAS u32x4*)(Ks + r * AKS + ch * 8) = kx; *(LAS u32x4*)(Vs + r * AKS + ch * 8) = vx; }
    const int qh = kvh * 4 + (w >> 1);
    const size_t tok = rowbase + c * 64 + (w & 1) * 32 + r32;
    const bf16* qp = HC + tok * EIN + C_AQ + qh * 64 + hi * 8;
    bf16x8 qf[4];
#pragma unroll
    for (int s = 0; s < 4; ++s) qf[s] = *(const bf16x8*)(qp + 16 * s);
    __syncthreads();
    const int nkb = 2 * nch;
    f32x16 st[6];
#pragma unroll
    for (int kb = 0; kb < 6; ++kb) { st[kb] = (f32x16){};
        if (kb < nkb) {
#pragma unroll
            for (int s = 0; s < 4; ++s) { const bf16x8 a = *(const LAS bf16x8*)(Ks + (32 * kb + r32) * AKS + 16 * s + 8 * hi); st[kb] = MFMA32(a, qf[s], st[kb]); } } }
    float mx = -3.0e38f;
#pragma unroll
    for (int kb = 0; kb < 6; ++kb) if (kb < nkb) {
#pragma unroll
        for (int i = 0; i < 16; ++i) mx = fmaxf(mx, st[kb][i]); }
    mx = fmaxf(mx, __shfl_xor(mx, 32));
    const float sink = F.e_sink[qh];
    const float mref = fmaxf(mx * 0.125f, sink);
    const float L2E = 1.4426950408889634f;
    float sum = 0.f;
#pragma unroll
    for (int kb = 0; kb < 6; ++kb) if (kb < nkb) {
#pragma unroll
        for (int i = 0; i < 16; ++i) { const float p = exp2f((st[kb][i] * 0.125f - mref) * L2E); st[kb][i] = p; sum += p; } }
    sum += __shfl_xor(sum, 32);
    const float inv = 1.0f / (sum + exp2f((sink - mref) * L2E));
    f32x16 o[2]; o[0] = (f32x16){}; o[1] = (f32x16){};
#pragma unroll
    for (int kb = 0; kb < 6; ++kb) if (kb < nkb) {
#pragma unroll
        for (int s = 0; s < 2; ++s) {
            const bf16x8 pf = pack8(st[kb][8 * s + 0] * inv, st[kb][8 * s + 1] * inv, st[kb][8 * s + 2] * inv, st[kb][8 * s + 3] * inv, st[kb][8 * s + 4] * inv, st[kb][8 * s + 5] * inv, st[kb][8 * s + 6] * inv, st[kb][8 * s + 7] * inv);
#pragma unroll
            for (int db = 0; db < 2; ++db) { const bf16x8 vf = tr_frag(Vs, AKS, 32 * kb + 16 * s, 32 * db, lane); o[db] = MFMA32(vf, pf, o[db]); } } }
    const bf16* gp = HC + tok * EIN + C_AG + qh * 64;
    bf16* yp = (bf16*)(F.ws + WS_BUFA) + tok * D + qh * 64;
#pragma unroll
    for (int db = 0; db < 2; ++db)
#pragma unroll
        for (int gi = 0; gi < 4; ++gi) { const int d0 = 32 * db + 8 * gi + 4 * hi; const u32x2 g = *(const u32x2*)(gp + d0);
            u32x2 y; y.x = pk2(o[db][4 * gi + 0] * silu(bflo(g.x)), o[db][4 * gi + 1] * silu(bfhi(g.x))); y.y = pk2(o[db][4 * gi + 2] * silu(bflo(g.y)), o[db][4 * gi + 3] * silu(bfhi(g.y)));
            *(u32x2*)(yp + d0) = y; }
    __syncthreads();
}

constexpr int RKS = 136;
__device__ __forceinline__ float head_lg2(int h) { return log2f(1.0f - exp2f(-5.0f - (float)h)); }
__device__ __forceinline__ void ret1_item(Frame& F, int item) {
    const int h = item & 3, c = (item >> 2) & (NCH - 1), b = item >> 9;
    const int tid = launder(F.tid), lane = tid & 63, w = F.wave, r32 = lane & 31, hi = lane >> 5;
    LAS bf16* Qr = (LAS bf16*)F.lds; LAS bf16* Kr = Qr + 64 * RKS; LAS bf16* Vs = Kr + 64 * RKS; LAS bf16* Vd = Vs + 64 * RKS;
    bf16* HC = (bf16*)(F.ws + WS_BIG);
    const size_t rowbase = (size_t)b * SEQ + (size_t)c * 64;
    const float lg2 = head_lg2(h);
    {
        const int j = tid >> 3, pc = tid & 7;
        bf16* rowp = HC + (rowbase + j) * EIN;
        const u32x4 q1 = *(const u32x4*)(rowp + C_BQ + h * 128 + 8 * pc), q2 = *(const u32x4*)(rowp + C_BQ + h * 128 + 64 + 8 * pc);
        const u32x4 k1 = *(const u32x4*)(rowp + C_BK + h * 128 + 8 * pc), k2 = *(const u32x4*)(rowp + C_BK + h * 128 + 64 + 8 * pc);
        const u32x4 v1 = *(const u32x4*)(rowp + C_BV + h * 128 + 16 * pc), v2 = *(const u32x4*)(rowp + C_BV + h * 128 + 16 * pc + 8);
        const f32x4* rt = (const f32x4*)((const f32x2*)(F.ws + WS_ROT) + (size_t)(c * 64 + j) * 64 + 8 * pc);
        u32x4 qa, qb, ka, kb;
        const float ksc = 0.08838834764831845f;
#pragma unroll
        for (int e = 0; e < 4; ++e) { const f32x4 cs = rt[e];
            const float a0 = bflo(q1[e]), a1 = bfhi(q1[e]), b0 = bflo(q2[e]), b1 = bfhi(q2[e]);
            qa[e] = pk2(a0 * cs[0] - b0 * cs[1], a1 * cs[2] - b1 * cs[3]); qb[e] = pk2(a0 * cs[1] + b0 * cs[0], a1 * cs[3] + b1 * cs[2]);
            const float c0 = bflo(k1[e]), c1 = bfhi(k1[e]), d0 = bflo(k2[e]), d1 = bfhi(k2[e]);
            ka[e] = pk2((c0 * cs[0] - d0 * cs[1]) * ksc, (c1 * cs[2] - d1 * cs[3]) * ksc); kb[e] = pk2((c0 * cs[1] + d0 * cs[0]) * ksc, (c1 * cs[3] + d1 * cs[2]) * ksc); }
        *(LAS u32x4*)(Qr + j * RKS + 8 * pc) = qa; *(LAS u32x4*)(Qr + j * RKS + 64 + 8 * pc) = qb;
        *(LAS u32x4*)(Kr + j * RKS + 8 * pc) = ka; *(LAS u32x4*)(Kr + j * RKS + 64 + 8 * pc) = kb;
        *(u32x4*)(rowp + C_BQ + h * 128 + 8 * pc) = qa; *(u32x4*)(rowp + C_BQ + h * 128 + 64 + 8 * pc) = qb;
        *(LAS u32x4*)(Vs + j * RKS + 16 * pc) = v1; *(LAS u32x4*)(Vs + j * RKS + 16 * pc + 8) = v2;
        const float kd = exp2f(lg2 * (float)(63 - j));
        u32x4 w1, w2;
#pragma unroll
        for (int e = 0; e < 4; ++e) { w1[e] = pk2(bflo(v1[e]) * kd, bfhi(v1[e]) * kd); w2[e] = pk2(bflo(v2[e]) * kd, bfhi(v2[e]) * kd); }
        *(LAS u32x4*)(Vd + j * RKS + 16 * pc) = w1; *(LAS u32x4*)(Vd + j * RKS + 16 * pc + 8) = w2;
    }
    __syncthreads();
    const int ib = w & 1, db = w >> 1;
    f32x16 st[2];
#pragma unroll
    for (int jb = 0; jb < 2; ++jb) { st[jb] = (f32x16){};
#pragma unroll
        for (int s = 0; s < 8; ++s) { const bf16x8 a = *(const LAS bf16x8*)(Kr + (32 * jb + r32) * RKS + 16 * s + 8 * hi); const bf16x8 q = *(const LAS bf16x8*)(Qr + (32 * ib + r32) * RKS + 16 * s + 8 * hi);
            st[jb] = MFMA32(a, q, st[jb]); } }
    const int iloc = 32 * ib + r32;
#pragma unroll
    for (int jb = 0; jb < 2; ++jb)
#pragma unroll
        for (int i = 0; i < 16; ++i) { const int j = 32 * jb + crow(i, hi); const int dd = iloc > j ? iloc - j : j - iloc; st[jb][i] *= exp2f(lg2 * (float)dd); }
    f32x16 o = (f32x16){};
#pragma unroll
    for (int jb = 0; jb < 2; ++jb)
#pragma unroll
        for (int s = 0; s < 2; ++s) {
            const bf16x8 pf = pack8(st[jb][8 * s + 0], st[jb][8 * s + 1], st[jb][8 * s + 2], st[jb][8 * s + 3], st[jb][8 * s + 4], st[jb][8 * s + 5], st[jb][8 * s + 6], st[jb][8 * s + 7]);
            const bf16x8 vf = tr_frag(Vs, RKS, 32 * jb + 16 * s, 32 * db, lane);
            o = MFMA32(vf, pf, o); }
    {
        float* op = (float*)(F.ws + WS_XB) + (rowbase + iloc) * 512 + h * 128 + 32 * db + 4 * hi;
#pragma unroll
        for (int gi = 0; gi < 4; ++gi) *(f32x4*)(op + 8 * gi) = (f32x4){o[4 * gi], o[4 * gi + 1], o[4 * gi + 2], o[4 * gi + 3]};
    }
    const int rb = w >> 1;
    f32x16 kv[2]; kv[0] = (f32x16){}; kv[1] = (f32x16){};
#pragma unroll
    for (int s = 0; s < 4; ++s) { const bf16x8 af = tr_frag(Kr, RKS, 16 * s, 32 * rb, lane);
#pragma unroll
        for (int t = 0; t < 2; ++t) { const bf16x8 bf = tr_frag(Vd, RKS, 16 * s, 32 * (2 * (w & 1) + t), lane); kv[t] = MFMA32(af, bf, kv[t]); } }
    bf16* stp = (bf16*)(F.ws + WS_BUFB) + ((size_t)(b * NCH + c) * 4 + h) * 16384;
#pragma unroll
    for (int t = 0; t < 2; ++t) { const int dv = 32 * (2 * (w & 1) + t) + r32;
#pragma unroll
        for (int gi = 0; gi < 4; ++gi) { const int dk = 32 * rb + 8 * gi + 4 * hi; u32x2 y; y.x = pk2(kv[t][4 * gi], kv[t][4 * gi + 1]); y.y = pk2(kv[t][4 * gi + 2], kv[t][4 * gi + 3]);
            *(u32x2*)(stp + dv * 128 + dk) = y; } }
    __syncthreads();
}

__device__ __forceinline__ void scan_phase(Frame& F) {
    unsigned* ST = (unsigned*)(F.ws + WS_BUFB);
    for (int e = F.bid * NTHR + F.tid; e < BATCH * 4 * 8192; e += F.G * NTHR) {
        const int idx = e & 8191, h = (e >> 13) & 3, b = e >> 15;
        const float dec = exp2f(head_lg2(h) * 64.0f);
        unsigned* p = ST + ((size_t)(b * NCH) * 4 + h) * 8192 + idx;
        float s0 = 0.f, s1 = 0.f;
#pragma unroll 8
        for (int c = 0; c < NCH; ++c) { const unsigned kvw = p[(size_t)c * 4 * 8192]; p[(size_t)c * 4 * 8192] = pk2(s0, s1); s0 = s0 * dec + bflo(kvw); s1 = s1 * dec + bfhi(kvw); }
    }
}

__device__ __forceinline__ void ret2_item(Frame& F, int item) {
    const int h = item & 3, c = (item >> 2) & (NCH - 1), b = item >> 9;
    const int lane = launder(F.lane), w = F.wave, r32 = lane & 31, hi = lane >> 5;
    const int ib = w & 1, db = w >> 1, iloc = 32 * ib + r32;
    LAS float* part = (LAS float*)F.lds;
    const bf16* HC = (const bf16*)(F.ws + WS_BIG);
    const size_t tok = (size_t)b * SEQ + (size_t)c * 64 + iloc;
    const bf16* stp = (const bf16*)(F.ws + WS_BUFB) + ((size_t)(b * NCH + c) * 4 + h) * 16384 + (size_t)(32 * db + r32) * 128 + 8 * hi;
    const bf16* qp = HC + tok * EIN + C_BQ + h * 128 + 8 * hi;
    f32x16 oc = (f32x16){};
#pragma unroll
    for (int s = 0; s < 8; ++s) { const bf16x8 a = *(const bf16x8*)(stp + 16 * s); const bf16x8 q = *(const bf16x8*)(qp + 16 * s); oc = MFMA32(a, q, oc); }
    const float qdec = exp2f(head_lg2(h) * (float)(iloc + 1));
    const float* op = (const float*)(F.ws + WS_XB) + tok * 512 + h * 128 + 32 * db + 4 * hi;
    float ss = 0.f;
#pragma unroll
    for (int gi = 0; gi < 4; ++gi) { const f32x4 oi = *(const f32x4*)(op + 8 * gi);
#pragma unroll
        for (int e = 0; e < 4; ++e) { const float v = oi[e] + oc[4 * gi + e] * qdec; oc[4 * gi + e] = v; ss += v * v; } }
    ss += __shfl_xor(ss, 32);
    if (hi == 0) part[iloc * 4 + db] = ss;
    __syncthreads();
    const f32x4 pp = *(const LAS f32x4*)(part + iloc * 4);
    const float rs = 1.0f / sqrtf(((pp[0] + pp[1]) + (pp[2] + pp[3])) * (1.0f / 128.0f) + EPS);
    const bf16* gp = HC + tok * EIN + C_BG + h * 128 + 32 * db + 4 * hi;
    bf16* yp = (bf16*)(F.ws + WS_BUFA) + tok * D + 512 + h * 128 + 32 * db + 4 * hi;
#pragma unroll
    for (int gi = 0; gi < 4; ++gi) { const u32x2 g = *(const u32x2*)(gp + 8 * gi);
        u32x2 y; y.x = pk2(oc[4 * gi + 0] * rs * silu(bflo(g.x)), oc[4 * gi + 1] * rs * silu(bfhi(g.x))); y.y = pk2(oc[4 * gi + 2] * rs * silu(bflo(g.y)), oc[4 * gi + 3] * rs * silu(bfhi(g.y)));
        *(u32x2*)(yp + 8 * gi) = y; }
    __syncthreads();
}

constexpr int XKS = 264;
__device__ __forceinline__ void xattn_unit(Frame& F, int layer, int unit) {
    const int h = unit & 3, rt = unit >> 2, b = rt >> 5;
    const int tid = launder(F.tid), lane = tid & 63, w = F.wave, r32 = lane & 31, hi = lane >> 5;
    LAS bf16* buf = (LAS bf16*)F.lds;
    const bf16* Kg = (const bf16*)(F.ws + WS_KV) + ((size_t)layer * BATCH * MEMLEN + (size_t)b * MEMLEN) * 2048 + h * 256;
    const bf16* Vg = Kg + 1024;
    const size_t row = (size_t)rt * 256 + w * 32 + r32;
    const bf16* qp = (const bf16*)(F.ws + WS_BUFB) + row * D + h * 256 + 8 * hi;
    bf16x8 qf[16];
#pragma unroll
    for (int s = 0; s < 16; ++s) qf[s] = *(const bf16x8*)(qp + 16 * s);
    f32x16 st[8];
#pragma unroll
    for (int kblk = 0; kblk < 4; ++kblk) {
        __syncthreads();
#pragma unroll
        for (int i = 0; i < 4; ++i) { const int p = tid + i * NTHR, r = p >> 5, ch = p & 31; *(LAS u32x4*)(buf + r * XKS + ch * 8) = *(const u32x4*)(Kg + (size_t)(kblk * 64 + r) * 2048 + ch * 8); }
        __syncthreads();
#pragma unroll
        for (int kk = 0; kk < 2; ++kk) { f32x16 acc = (f32x16){};
#pragma unroll
            for (int s = 0; s < 16; ++s) { const bf16x8 a = *(const LAS bf16x8*)(buf + (32 * kk + r32) * XKS + 16 * s + 8 * hi); acc = MFMA32(a, qf[s], acc); }
            st[2 * kblk + kk] = acc; }
    }
    float mx = -3.0e38f;
#pragma unroll
    for (int kb = 0; kb < 8; ++kb)
#pragma unroll
        for (int i = 0; i < 16; ++i) mx = fmaxf(mx, st[kb][i]);
    mx = fmaxf(mx, __shfl_xor(mx, 32));
    const float SC = 0.0625f * 1.4426950408889634f;
    float sum = 0.f;
#pragma unroll
    for (int kb = 0; kb < 8; ++kb)
#pragma unroll
        for (int i = 0; i < 16; ++i) { const float p = exp2f((st[kb][i] - mx) * SC); st[kb][i] = p; sum += p; }
    sum += __shfl_xor(sum, 32);
    const float inv = 1.0f / sum;
    bf16x8 pw[8][2];
#pragma unroll
    for (int kb = 0; kb < 8; ++kb)
#pragma unroll
        for (int s = 0; s < 2; ++s) pw[kb][s] = pack8(st[kb][8 * s + 0] * inv, st[kb][8 * s + 1] * inv, st[kb][8 * s + 2] * inv, st[kb][8 * s + 3] * inv, st[kb][8 * s + 4] * inv, st[kb][8 * s + 5] * inv, st[kb][8 * s + 6] * inv, st[kb][8 * s + 7] * inv);
    f32x16 o[8];
#pragma unroll
    for (int db = 0; db < 8; ++db) o[db] = (f32x16){};
#pragma unroll
    for (int vblk = 0; vblk < 4; ++vblk) {
        __syncthreads();
#pragma unroll
        for (int i = 0; i < 4; ++i) { const int p = tid + i * NTHR, r = p >> 5, ch = p & 31; *(LAS u32x4*)(buf + r * XKS + ch * 8) = *(const u32x4*)(Vg + (size_t)(vblk * 64 + r) * 2048 + ch * 8); }
        __syncthreads();
#pragma unroll
        for (int kk = 0; kk < 2; ++kk)
#pragma unroll
            for (int s = 0; s < 2; ++s)
#pragma unroll
                for (int db = 0; db < 8; ++db) { const bf16x8 vf = tr_frag(buf, XKS, 32 * kk + 16 * s, 32 * db, lane); o[db] = MFMA32(vf, pw[2 * vblk + kk][s], o[db]); }
    }
    bf16* op = (bf16*)(F.ws + WS_BUFA) + row * D + h * 256 + 4 * hi;
#pragma unroll
    for (int db = 0; db < 8; ++db)
#pragma unroll
        for (int gi = 0; gi < 4; ++gi) { u32x2 y; y.x = pk2(o[db][4 * gi], o[db][4 * gi + 1]); y.y = pk2(o[db][4 * gi + 2], o[db][4 * gi + 3]); *(u32x2*)(op + 32 * db + 8 * gi) = y; }
    __syncthreads();
}

__device__ __forceinline__ void conv_phase(Frame& F) {
    const bf16* H4 = (const bf16*)(F.ws + WS_BIG); bf16* Y = (bf16*)(F.ws + WS_BUFA);
    const float* cw = F.o_conv_w; const float* cb = F.o_conv_b;
    for (int it = F.bid * NTHR + F.tid; it < (MTOK / 8) * 128; it += F.G * NTHR) {
        const int cgi = it & 127, tg = it >> 7, col = cgi * 8, t0 = tg * 8;
        float w0[8], w1[8], w2[8], bs[8];
#pragma unroll
        for (int e = 0; e < 8; ++e) { w0[e] = cw[col + e]; w1[e] = cw[D + col + e]; w2[e] = cw[2 * D + col + e]; bs[e] = cb[col + e]; }
        float zm2[8], zm1[8];
        const bool first = (t0 & (SEQ - 1)) == 0;
#pragma unroll
        for (int e = 0; e < 8; ++e) { zm2[e] = 0.f; zm1[e] = 0.f; }
        if (!first) {
            const bf16* r2 = H4 + (size_t)(t0 - 2) * OIN + col; const bf16* r1 = H4 + (size_t)(t0 - 1) * OIN + col;
            const u32x4 c2 = *(const u32x4*)(r2 + 1024), u2 = *(const u32x4*)(r2 + 2048), c1 = *(const u32x4*)(r1 + 1024), u1 = *(const u32x4*)(r1 + 2048);
#pragma unroll
            for (int e = 0; e < 4; ++e) { zm2[2 * e] = bflo(c2[e]) * bflo(u2[e]); zm2[2 * e + 1] = bfhi(c2[e]) * bfhi(u2[e]); zm1[2 * e] = bflo(c1[e]) * bflo(u1[e]); zm1[2 * e + 1] = bfhi(c1[e]) * bfhi(u1[e]); }
        }
#pragma unroll
        for (int tt = 0; tt < 8; ++tt) {
            const bf16* r = H4 + (size_t)(t0 + tt) * OIN + col;
            const u32x4 gb = *(const u32x4*)(r), gc = *(const u32x4*)(r + 1024), uu = *(const u32x4*)(r + 2048), gt = *(const u32x4*)(r + 3072);
            float z[8], y[8];
#pragma unroll
            for (int e = 0; e < 4; ++e) { z[2 * e] = bflo(gc[e]) * bflo(uu[e]); z[2 * e + 1] = bfhi(gc[e]) * bfhi(uu[e]); }
#pragma unroll
            for (int e = 0; e < 4; ++e) {
                const float cv0 = bs[2 * e] + zm2[2 * e] * w0[2 * e] + zm1[2 * e] * w1[2 * e] + z[2 * e] * w2[2 * e];
                const float cv1 = bs[2 * e + 1] + zm2[2 * e + 1] * w0[2 * e + 1] + zm1[2 * e + 1] * w1[2 * e + 1] + z[2 * e + 1] * w2[2 * e + 1];
                y[2 * e] = bflo(gb[e]) * cv0 * silu(bflo(gt[e])); y[2 * e + 1] = bfhi(gb[e]) * cv1 * silu(bfhi(gt[e])); }
            u32x4 o; o.x = pk2(y[0], y[1]); o.y = pk2(y[2], y[3]); o.z = pk2(y[4], y[5]); o.w = pk2(y[6], y[7]);
            *(u32x4*)(Y + (size_t)(t0 + tt) * D + col) = o;
#pragma unroll
            for (int e = 0; e < 8; ++e) { zm2[e] = zm1[e]; zm1[e] = z[e]; }
        }
    }
}

__device__ __forceinline__ void final_phase(Frame& F) {
    const int gw = F.bid * NWAVES + F.wave, NGW = F.G * NWAVES, lane = F.lane;
    const float* ssp = (const float*)(F.ws + WS_SSP);
    for (int row = gw; row < MTOK; row += NGW) {
        const f32x4* p = (const f32x4*)(ssp + (size_t)row * 16); const f32x4 a = p[0], b = p[1], c = p[2], d = p[3];
        const float s = ((a[0] + a[1]) + (a[2] + a[3])) + ((b[0] + b[1]) + (b[2] + b[3])) + ((c[0] + c[1]) + (c[2] + c[3])) + ((d[0] + d[1]) + (d[2] + d[3]));
        const float rs = 1.0f / sqrtf(s * (1.0f / D) + EPS);
        f32x4* xr = (f32x4*)(F.out + (size_t)row * D) + lane; const f32x4* gr = (const f32x4*)F.final_norm + lane;
#pragma unroll
        for (int j = 0; j < 4; ++j) { const f32x4 v = xr[64 * j], g = gr[64 * j]; xr[64 * j] = v * rs * g; }
    }
}

#ifndef MK_SPLIT
#define MK_SPLIT 0
#define PROBE_HI NPHASE
#define PD(off, rows, ld, f32, acc) hipLaunchKernelGGL(probe_dump, dim3(2048), dim3(256), 0, stream, (const void*)((unsigned char*)d_ws + (off)), rows, ld, (float*)d_out, f32, acc)
#define PROBE_DUMP
#endif
constexpr int NPHASE = 16;
__global__ void __launch_bounds__(NTHR, 2) fwd_megakernel(Args args) {
    extern __shared__ __attribute__((aligned(16))) unsigned char lds_raw[];
    cg::grid_group grid = cg::this_grid();
    Frame F;
    F.lds = (LAS unsigned char*)lds_raw; F.tid = threadIdx.x; F.lane = F.tid & 63; F.wave = __builtin_amdgcn_readfirstlane(F.tid >> 6); F.G = gridDim.x; F.bid = blockIdx.x;
    F.x = args.in[0]; F.mem = args.in[1]; F.e_norm = args.in[2]; F.e_w_in = args.in[3]; F.e_sink = args.in[4]; F.e_w_out = args.in[5]; F.o_norm = args.in[6]; F.o_w_in = args.in[7];
    F.o_conv_w = args.in[8]; F.o_conv_b = args.in[9]; F.o_w_out = args.in[10]; F.c_norm = args.in[11]; F.c_mem_norm = args.in[12]; F.c_wq = args.in[13]; F.c_wkv = args.in[14]; F.c_wo = args.in[15]; F.final_norm = args.in[16];
    F.out = args.out; F.ws = args.ws;
    unsigned char* ws = args.ws;
    const int lo = args.ph_lo, hi = args.ph_hi;
#define IN(k) (lo <= (k) && (k) < hi)
#define SEAM(k) do { if (IN(k) && IN((k) + 1)) { asm volatile("s_waitcnt vmcnt(0) lgkmcnt(0)" ::: "memory"); grid.sync(); __builtin_amdgcn_fence(__ATOMIC_ACQUIRE, "agent"); asm volatile("s_waitcnt vmcnt(0)" ::: "memory"); } } while (0)
    typedef pg8::EpiScaleBf16<true> EpiS; typedef pg8::EpiScaleBf16<false> EpiN;
    bf16* XB = (bf16*)(ws + WS_XB); float* SSP = (float*)(ws + WS_SSP); bf16* BIG = (bf16*)(ws + WS_BIG); bf16* BUFA = (bf16*)(ws + WS_BUFA); bf16* BUFB = (bf16*)(ws + WS_BUFB);

    if (IN(0)) { p0_prologue(F); } SEAM(0);
    if (IN(1)) {
        { pg8::Gemm g{XB, (const bf16*)(ws + WS_WEIN), MTOK, EIN, D}; pg8::StaticOrder S; S.init(MTOK, EIN, F.G, F.bid); EpiS E{BIG, EIN, SSP};
          pg8::gemm_phase<EpiS, pg8::StaticOrder, true, true>(F.lds, g, S, E); }
#pragma unroll 1
        for (int l = 0; l < 2; ++l) { pg8::Gemm g{(const bf16*)(ws + WS_MEMN) + (size_t)l * BATCH * MEMLEN * D, (const bf16*)(ws + WS_WKV) + (size_t)l * 2 * D * D, BATCH * MEMLEN, 2 * D, D};
          pg8::StaticOrder S; S.init(BATCH * MEMLEN, 2 * D, F.G, (F.bid + F.G - (F.G / 2 + 32 * l) % F.G) % F.G); EpiN E{(bf16*)(ws + WS_KV) + (size_t)l * BATCH * MEMLEN * 2 * D, 2 * D, nullptr};
          pg8::gemm_phase<EpiN, pg8::StaticOrder, true, true>(F.lds, g, S, E); }
    } SEAM(1);
    if (IN(2)) {
        for (int it = F.bid; it < BATCH * NCH * 4; it += F.G) ret1_item(F, it);
        for (int it = F.bid; it < BATCH * NCH * 2; it += F.G) swa_item(F, it);
    } SEAM(2);
    if (IN(3)) { scan_phase(F); } SEAM(3);
    if (IN(4)) { for (int it = F.bid; it < BATCH * NCH * 4; it += F.G) ret2_item(F, it); } SEAM(4);
    if (IN(5)) {
        pg8::Gemm g{BUFA, (const bf16*)(ws + WS_WEOUT), MTOK, D, D}; pg8::StaticOrder S; S.init(MTOK, D, F.G, F.bid); pg8::EpiResidual E{F.x, F.out, XB, SSP, D};
        pg8::gemm_phase<pg8::EpiResidual, pg8::StaticOrder, true, true>(F.lds, g, S, E);
    } SEAM(5);
#pragma unroll
    for (int l = 0; l < 2; ++l) {
        const int pb = (l == 0) ? 6 : 12;
        if (IN(pb)) {
            pg8::Gemm g{XB, (const bf16*)(ws + WS_WQ) + (size_t)l * D * D, MTOK, D, D}; pg8::StaticOrder S; S.init(MTOK, D, F.G, F.bid); EpiS E{BUFB, D, SSP};
            pg8::gemm_phase<EpiS, pg8::StaticOrder, true, true>(F.lds, g, S, E);
        } SEAM(pb);
        if (IN(pb + 1)) { for (int it = F.bid; it < (MTOK / 256) * 4; it += F.G) xattn_unit(F, l, it); } SEAM(pb + 1);
        if (IN(pb + 2)) {
            pg8::Gemm g{BUFA, (const bf16*)(ws + WS_WO) + (size_t)l * D * D, MTOK, D, D}; pg8::StaticOrder S; S.init(MTOK, D, F.G, F.bid); pg8::EpiResidual E{F.out, F.out, (l == 0) ? XB : nullptr, SSP, D};
            pg8::gemm_phase<pg8::EpiResidual, pg8::StaticOrder, true, true>(F.lds, g, S, E);
        } SEAM(pb + 2);
        if (l == 0) {
            if (IN(9)) {
                pg8::Gemm g{XB, (const bf16*)(ws + WS_WOIN), MTOK, OIN, D}; pg8::StaticOrder S; S.init(MTOK, OIN, F.G, F.bid); EpiS E{BIG, OIN, SSP};
                pg8::gemm_phase<EpiS, pg8::StaticOrder, true, true>(F.lds, g, S, E);
            } SEAM(9);
            if (IN(10)) { conv_phase(F); } SEAM(10);
            if (IN(11)) {
                pg8::Gemm g{BUFA, (const bf16*)(ws + WS_WOOUT), MTOK, D, D}; pg8::StaticOrder S; S.init(MTOK, D, F.G, F.bid); pg8::EpiResidual E{F.out, F.out, XB, SSP, D};
                pg8::gemm_phase<pg8::EpiResidual, pg8::StaticOrder, true, true>(F.lds, g, S, E);
            } SEAM(11);
        }
    }
    if (IN(15)) { final_phase(F); }
#undef IN
#undef SEAM
}

__global__ void probe_dump(const void* buf, int rows, int ld, float* out, int isf32, int accum) {
    for (size_t i = (size_t)blockIdx.x * blockDim.x + threadIdx.x; i < (size_t)MTOK * D; i += (size_t)gridDim.x * blockDim.x) {
        const int r = (int)(i >> 10), c = (int)(i & 1023); float s = accum ? out[i] : 0.f;
        for (int j = 0; c + 1024 * j < ld; ++j) { const size_t e = (size_t)(r % rows) * ld + c + 1024 * j; s += isf32 ? ((const float*)buf)[e] : __uint_as_float((unsigned)((const bf16*)buf)[e] << 16); }
        out[i] = s; }
}
extern "C" void kernel_launch(void* const* d_in, const int* in_sizes, int n_in, void* d_out, int out_size, void* d_ws, size_t ws_size, hipStream_t stream) {
    static int grid = 0;
    if (grid == 0) {
        if (n_in != 17 || out_size != MTOK * D || ws_size < WS_END) { fprintf(stderr, "kernel_launch: unexpected shapes (n_in %d out %d ws %zu)\n", n_in, out_size, ws_size); grid = -1; return; }
        int dev = 0, cus = 0, per_cu = 0;
        hipGetDevice(&dev); hipDeviceGetAttribute(&cus, hipDeviceAttributeMultiprocessorCount, dev);
        if (hipFuncSetAttribute((const void*)fwd_megakernel, hipFuncAttributeMaxDynamicSharedMemorySize, LDS_BYTES) != hipSuccess) { fprintf(stderr, "kernel_launch: hipFuncSetAttribute failed\n"); grid = -1; return; }
        if (hipOccupancyMaxActiveBlocksPerMultiprocessor(&per_cu, (const void*)fwd_megakernel, NTHR, LDS_BYTES) != hipSuccess || per_cu < 1) { fprintf(stderr, "kernel_launch: occupancy query says %d\n", per_cu); per_cu = 1; }
        (void)hipGetLastError();
        grid = cus;
    }
    if (grid < 0) return;
    Args a{};
    for (int i = 0; i < 17; ++i) a.in[i] = (const float*)d_in[i];
    a.out = (float*)d_out; a.ws = (unsigned char*)d_ws;
#if MK_SPLIT
    for (int p = 0; p < PROBE_HI; ++p) { a.ph_lo = p; a.ph_hi = p + 1; hipLaunchKernelGGL(fwd_megakernel, dim3(grid), dim3(NTHR), LDS_BYTES, stream, a); }
    PROBE_DUMP;
#else
    a.ph_lo = 0; a.ph_hi = NPHASE;
    void* kargs[] = {&a};
    hipError_t e = hipLaunchCooperativeKernel((const void*)fwd_megakernel, dim3(grid), dim3(NTHR), kargs, LDS_BYTES, stream);
    if (e != hipSuccess) fprintf(stderr, "kernel_launch: cooperative launch failed: %s (grid %d)\n", hipGetErrorString(e), grid);
#endif
}
```

```cpp
#include <hip/hip_runtime.h>
#include <hip/hip_cooperative_groups.h>
#include <cstdio>
#include <cstdint>
namespace cg = cooperative_groups;
namespace pg8 {
#define PG8_LAS __attribute__((address_space(3)))
typedef unsigned short bf16_t;
typedef short bf16x8 __attribute__((ext_vector_type(8)));
typedef float f32x4 __attribute__((ext_vector_type(4)));
typedef unsigned u32x4 __attribute__((ext_vector_type(4)));
constexpr int BM = 256, BK = 64, HALF = 128, HTB = HALF * BK * 2  , STAGE_BYTES = 8 * HTB, NXCD = 8, WGM = 8;

__host__ __device__ __forceinline__ int lds_byte(int r, int c) { const int st = (r >> 4) * 2 + (c >> 5), rr = r & 15, cc = c & 31, ob = rr * 64 + cc * 2; return st * 1024 + (ob ^ (((ob >> 9) & 1) << 5)); }
__host__ __device__ __forceinline__ void stage_rc(int b, int& R, int& C) { const int st = b / 1024, sb = b % 1024, swz = sb ^ (((sb >> 9) & 1) << 5); R = (st >> 1) * 16 + swz / 64; C = (st & 1) * 32 + (swz % 64) / 2; }
__host__ __device__ __forceinline__ int perm32(int rho) { const int n = rho >> 4, i = rho & 15; return 8 * (i >> 2) + 4 * n + (i & 3); }

struct Unit { int pm, pn; };
struct Gemm { const bf16_t* A; const bf16_t* Bt; int M, N, K; };

struct StaticOrder {
    int nM, nN, nwg, G, c;
    __host__ __device__ void init(int M, int N, int G_, int c_) { nM = M / BM; nN = N / BM; nwg = nM * nN; G = G_; c = c_; }
    __host__ __device__ bool next(int i, Unit& u) const {
        const long L = (long)i * G + c; if (L >= nwg) return false;
        int wgid = (int)L; { const int q = nwg / NXCD, r = nwg % NXCD, xcd = wgid % NXCD, off = wgid / NXCD; wgid = (xcd < r ? xcd * (q + 1) : r * (q + 1) + (xcd - r) * q) + off; }
        const int nig = WGM * nN, gid = wgid / nig, fm = gid * WGM, gsz = (nM - fm) < WGM ? (nM - fm) : WGM;
        u.pm = fm + ((wgid % nig) % gsz); u.pn = (wgid % nig) / gsz; return true;
    }
    __device__ __forceinline__ void a_ready(const Unit&) const {}
    __device__ __forceinline__ void done(const Unit&) const {}
};

typedef float f32x2 __attribute__((ext_vector_type(2))); typedef __bf16 bf16x2_t __attribute__((ext_vector_type(2)));
__device__ __forceinline__ unsigned cvt_pk_bf16(float lo, float hi) { const f32x2 v = {lo, hi}; const bf16x2_t b = __builtin_convertvector(v, bf16x2_t); return __builtin_bit_cast(unsigned, b); }
template <bool SCALE> struct EpiScaleBf16 {
    static constexpr bool PERM = true, AFTER_DRAIN = false;
    bf16_t* O; int ldc; const float* ssp;
    __device__ __forceinline__ void operator()(const f32x4 (&acc)[2][2][4][2], const Unit& u, int wr, int wc, int fr, int fq) const {
        const int row0 = u.pm * BM + wr * 64 + fr; const int col0 = u.pn * BM + wc * 32 + 8 * fq;
#pragma unroll
        for (int ai = 0; ai < 2; ++ai)
#pragma unroll
            for (int m = 0; m < 4; ++m) {
                const int row = row0 + ai * HALF + m * 16;
                float sc = 1.f;
                if (SCALE) { const f32x4* p = (const f32x4*)(ssp + (size_t)row * 16); const f32x4 a = p[0], b = p[1], c = p[2], d = p[3];
                    const float s = ((a[0] + a[1]) + (a[2] + a[3])) + ((b[0] + b[1]) + (b[2] + b[3])) + ((c[0] + c[1]) + (c[2] + c[3])) + ((d[0] + d[1]) + (d[2] + d[3]));
                    sc = 1.0f / sqrtf(s * (1.0f / 1024.0f) + 1e-6f); }
                bf16_t* rowp = O + (size_t)row * ldc + col0;
#pragma unroll
                for (int bj = 0; bj < 2; ++bj) { const f32x4 v0 = acc[ai][bj][m][0] * sc, v1 = acc[ai][bj][m][1] * sc;
                    u32x4 w; w.x = cvt_pk_bf16(v0[0], v0[1]); w.y = cvt_pk_bf16(v0[2], v0[3]); w.z = cvt_pk_bf16(v1[0], v1[1]); w.w = cvt_pk_bf16(v1[2], v1[3]);
                    *(u32x4*)(rowp + bj * HALF) = w; }
                if (m & 1) asm volatile("" ::: "memory");
            }
    }
};
template <bool BASE_F32, bool OUT_F32> struct EpiResidual {
    static constexpr bool PERM = true, AFTER_DRAIN = false;
    const void* base; void* out; float* ssp; int ldc;
    __device__ __forceinline__ void operator()(const f32x4 (&acc)[2][2][4][2], const Unit& u, int wr, int wc, int fr, int fq) const {
        const int row0 = u.pm * BM + wr * 64 + fr; const int col0 = u.pn * BM + wc * 32 + 8 * fq;
#pragma unroll
        for (int ai = 0; ai < 2; ++ai)
#pragma unroll
            for (int m = 0; m < 4; ++m) {
                const int row = row0 + ai * HALF + m * 16;
                float ss = 0.f;
#pragma unroll
                for (int bj = 0; bj < 2; ++bj) { const size_t off = (size_t)row * ldc + col0 + bj * HALF;
                    f32x4 b0, b1;
                    if (BASE_F32) { b0 = *(const f32x4*)((const float*)base + off); b1 = *(const f32x4*)((const float*)base + off + 4); }
                    else { const u32x4 w = *(const u32x4*)((const bf16_t*)base + off);
                        b0 = (f32x4){__uint_as_float(w.x << 16), __uint_as_float(w.x & 0xffff0000u), __uint_as_float(w.y << 16), __uint_as_float(w.y & 0xffff0000u)};
                        b1 = (f32x4){__uint_as_float(w.z << 16), __uint_as_float(w.z & 0xffff0000u), __uint_as_float(w.w << 16), __uint_as_float(w.w & 0xffff0000u)}; }
                    const f32x4 o0 = b0 + acc[ai][bj][m][0], o1 = b1 + acc[ai][bj][m][1];
                    ss += ((o0[0] * o0[0] + o0[1] * o0[1]) + (o0[2] * o0[2] + o0[3] * o0[3])) + ((o1[0] * o1[0] + o1[1] * o1[1]) + (o1[2] * o1[2] + o1[3] * o1[3]));
                    if (OUT_F32) { *(f32x4*)((float*)out + off) = o0; *(f32x4*)((float*)out + off + 4) = o1; }
                    else { u32x4 w; w.x = cvt_pk_bf16(o0[0], o0[1]); w.y = cvt_pk_bf16(o0[2], o0[3]); w.z = cvt_pk_bf16(o1[0], o1[1]); w.w = cvt_pk_bf16(o1[2], o1[3]);
                        *(u32x4*)((bf16_t*)out + off) = w; } }
                ss += __shfl_xor(ss, 16); ss += __shfl_xor(ss, 32);
                if (fq == 0) ssp[(size_t)row * 16 + u.pn * 4 + wc] = ss;
                asm volatile("" ::: "memory");
            }
    }
};
template <class Epi, class Sched, bool ALIGN_EPI = false, bool SP2 = false>
__device__ __forceinline__ void gemm_phase(PG8_LAS unsigned char* lds, const Gemm g, const Sched& S, const Epi& E) {
    int tid_ = threadIdx.x; asm volatile("" : "+v"(tid_));
    const int tid = tid_, wid = __builtin_amdgcn_readfirstlane(tid >> 6), lane = tid & 63, wr = wid >> 2, wc = wid & 3, fr = lane & 15, fq = lane >> 4;
    const int K = g.K, nt = K / BK;
    unsigned voffA[2], voffB[2];
#pragma unroll
    for (int i = 0; i < 2; ++i) { int R, C; stage_rc(tid * 16 + i * 8192, R, C); const int Rb = Epi::PERM ? ((R & ~31) + perm32(R & 31)) : R;
        voffA[i] = (unsigned)(R * K + C) * 2u; voffB[i] = (unsigned)(Rb * K + C) * 2u; }
    const size_t kstep = (size_t)(BK * 2);
    const size_t hstep = (size_t)HALF * K * 2;
    const size_t tstep = 2 * hstep;
    const unsigned ldsw = (unsigned)wid * 1024u;
    const int aoff = lds_byte(wr * 64 + fr, fq * 8), boff = lds_byte(wc * 32 + fr, fq * 8);
#define PG8_SA(b, h) (((b) * 2 + (h)) * HTB)
#define PG8_SB(b, h) ((4 + (b) * 2 + (h)) * HTB)
#define PG8_STAGE(bufoff, gbase, voff) do { _Pragma("unroll") for (int _i = 0; _i < 2; ++_i) \
        __builtin_amdgcn_global_load_lds((const unsigned*)((const char*)(gbase) + (voff)[_i]), (PG8_LAS unsigned*)(lds + (bufoff) + ldsw + _i * 8192), 16, 0, 0); } while (0)
#define PG8_LDA(dst, b, h) do { _Pragma("unroll") for (int m = 0; m < 4; ++m) _Pragma("unroll") for (int k = 0; k < 2; ++k) dst[m][k] = *(const PG8_LAS bf16x8*)(lds + PG8_SA(b, h) + aoff + m * 2048 + k * 1024); } while (0)
#define PG8_LDB(dst, b, h) do { _Pragma("unroll") for (int n = 0; n < 2; ++n) _Pragma("unroll") for (int k = 0; k < 2; ++k) dst[n][k] = *(const PG8_LAS bf16x8*)(lds + PG8_SB(b, h) + boff + n * 2048 + k * 1024); } while (0)
#define PG8_MMA(ai, bj, At, Bt) do { __builtin_amdgcn_s_setprio(1); _Pragma("unroll") for (int m = 0; m < 4; ++m) _Pragma("unroll") for (int n = 0; n < 2; ++n) _Pragma("unroll") for (int k = 0; k < 2; ++k) \
        acc[ai][bj][m][n] = __builtin_amdgcn_mfma_f32_16x16x32_bf16(Bt[n][k], At[m][k], acc[ai][bj][m][n], 0, 0, 0); __builtin_amdgcn_s_setprio(0); } while (0)
#define PG8_WAIT_V(n) asm volatile("s_waitcnt vmcnt(" #n ")" ::: "memory")
#define PG8_WAIT_L(n) asm volatile("s_waitcnt lgkmcnt(" #n ")" ::: "memory")
#define PG8_BAR __builtin_amdgcn_s_barrier()
#define PG8_SCHED __builtin_amdgcn_sched_barrier(0)
    Unit cur, nxt; int ui = 0;
    if (!S.next(0, cur)) return;
    f32x4 acc[2][2][4][2];
#pragma unroll
    for (int a = 0; a < 2; ++a)
#pragma unroll
        for (int b = 0; b < 2; ++b)
#pragma unroll
            for (int m = 0; m < 4; ++m)
#pragma unroll
                for (int n = 0; n < 2; ++n) acc[a][b][m][n] = (f32x4){0.f, 0.f, 0.f, 0.f};
    bf16x8 At[4][2], B0[2][2], B1[2][2];
    const char* cA = (const char*)g.A + (size_t)cur.pm * tstep; const char* cB = (const char*)g.Bt + (size_t)cur.pn * tstep;
    S.a_ready(cur);
    if constexpr (SP2) {
        PG8_STAGE(PG8_SB(0, 0), cB, voffB); PG8_STAGE(PG8_SB(0, 1), cB + hstep, voffB); PG8_STAGE(PG8_SA(0, 0), cA, voffA); PG8_STAGE(PG8_SA(0, 1), cA + hstep, voffA);
        if (wr == 1) PG8_BAR;
        PG8_WAIT_V(2); PG8_BAR;
        PG8_STAGE(PG8_SB(1, 0), cB + kstep, voffB); PG8_STAGE(PG8_SA(1, 0), cA + kstep, voffA); PG8_STAGE(PG8_SB(1, 1), cB + hstep + kstep, voffB);
        PG8_WAIT_V(6); PG8_BAR;
    } else {
        PG8_STAGE(PG8_SB(0, 0), cB, voffB); PG8_STAGE(PG8_SA(0, 0), cA, voffA); PG8_STAGE(PG8_SB(0, 1), cB + hstep, voffB); PG8_STAGE(PG8_SA(0, 1), cA + hstep, voffA);
        if (wr == 1) PG8_BAR;
        PG8_WAIT_V(4); PG8_BAR;
        PG8_STAGE(PG8_SB(1, 0), cB + kstep, voffB); PG8_STAGE(PG8_SA(1, 0), cA + kstep, voffA); PG8_STAGE(PG8_SB(1, 1), cB + hstep + kstep, voffB);
        PG8_WAIT_V(6); PG8_BAR;
    }
    for (;;) {
        const bool has_next = S.next(ui + 1, nxt);
        const char* nA = has_next ? (const char*)g.A + (size_t)nxt.pm * tstep : cA; const char* nB = has_next ? (const char*)g.Bt + (size_t)nxt.pn * tstep : cB;
        for (int t = 0; t < nt; t += 2) {
            const bool last = (t == nt - 2);
            const char* a1 = cA + (size_t)(t + 1) * kstep;
            const char* a2 = last ? nA : cA + (size_t)(t + 2) * kstep; const char* b2 = last ? nB : cB + (size_t)(t + 2) * kstep;
            const char* a3 = a2 + kstep; const char* b3 = b2 + kstep;
            if (last && has_next) S.a_ready(nxt);
            if constexpr (SP2) {
            PG8_LDB(B0, 0, 0); PG8_LDB(B1, 0, 1); PG8_SCHED; PG8_LDA(At, 0, 0); PG8_STAGE(PG8_SA(1, 1), a1 + hstep, voffA);
            PG8_WAIT_V(8); PG8_WAIT_L(0); PG8_BAR; PG8_MMA(0, 0, At, B0); PG8_MMA(0, 1, At, B1); PG8_BAR; PG8_SCHED;
            PG8_LDA(At, 0, 1); PG8_STAGE(PG8_SB(0, 0), b2, voffB); PG8_STAGE(PG8_SB(0, 1), b2 + hstep, voffB); PG8_STAGE(PG8_SA(0, 0), a2, voffA);
            PG8_WAIT_V(8); PG8_WAIT_L(0); PG8_BAR; PG8_MMA(1, 0, At, B0); PG8_MMA(1, 1, At, B1); PG8_BAR; PG8_SCHED;
            PG8_LDB(B0, 1, 0); PG8_LDB(B1, 1, 1); PG8_SCHED; PG8_LDA(At, 1, 0); PG8_STAGE(PG8_SA(0, 1), a2 + hstep, voffA);
            PG8_WAIT_V(8); PG8_WAIT_L(0); PG8_BAR; PG8_MMA(0, 0, At, B0); PG8_MMA(0, 1, At, B1); PG8_BAR; PG8_SCHED;
            PG8_LDA(At, 1, 1); PG8_STAGE(PG8_SB(1, 0), b3, voffB); PG8_STAGE(PG8_SB(1, 1), b3 + hstep, voffB); PG8_STAGE(PG8_SA(1, 0), a3, voffA);
            PG8_WAIT_V(8); PG8_WAIT_L(0); PG8_BAR; PG8_MMA(1, 0, At, B0); PG8_MMA(1, 1, At, B1); PG8_BAR; PG8_SCHED;
            } else {
            PG8_LDB(B0, 0, 0); PG8_SCHED; PG8_LDA(At, 0, 0); PG8_STAGE(PG8_SA(1, 1), a1 + hstep, voffA);
            PG8_WAIT_L(8); PG8_BAR; PG8_WAIT_L(0); PG8_MMA(0, 0, At, B0); PG8_BAR; PG8_SCHED;
            PG8_LDB(B1, 0, 1); PG8_STAGE(PG8_SB(0, 0), b2, voffB);
            PG8_BAR; PG8_WAIT_L(0); PG8_MMA(0, 1, At, B1); PG8_BAR;
            PG8_LDA(At, 0, 1); PG8_STAGE(PG8_SA(0, 0), a2, voffA);
            PG8_BAR; PG8_WAIT_L(0); PG8_MMA(1, 0, At, B0); PG8_BAR; PG8_SCHED;
            PG8_STAGE(PG8_SB(0, 1), b2 + hstep, voffB);
            PG8_WAIT_V(6); PG8_BAR; PG8_MMA(1, 1, At, B1); PG8_BAR;
            PG8_LDB(B0, 1, 0); PG8_SCHED; PG8_LDA(At, 1, 0); PG8_STAGE(PG8_SA(0, 1), a2 + hstep, voffA);
            PG8_WAIT_L(8); PG8_BAR; PG8_WAIT_L(0); PG8_MMA(0, 0, At, B0); PG8_BAR; PG8_SCHED;
            PG8_LDB(B1, 1, 1); PG8_STAGE(PG8_SB(1, 0), b3, voffB);
            PG8_BAR; PG8_WAIT_L(0); PG8_MMA(0, 1, At, B1); PG8_BAR;
            PG8_LDA(At, 1, 1); PG8_STAGE(PG8_SA(1, 0), a3, voffA);
            PG8_BAR; PG8_WAIT_L(0); PG8_MMA(1, 0, At, B0); PG8_BAR; PG8_SCHED;
            PG8_STAGE(PG8_SB(1, 1), b3 + hstep, voffB);
            PG8_WAIT_V(6); PG8_BAR; PG8_MMA(1, 1, At, B1); PG8_BAR;
            }
        }
        if constexpr (ALIGN_EPI) { if (wr == 0) PG8_BAR; }
        if constexpr (!Epi::AFTER_DRAIN) { E(acc, cur, wr, wc, fr, fq); S.done(cur); }
        if (!has_next) break;
#pragma unroll
        for (int a = 0; a < 2; ++a)
#pragma unroll
            for (int b = 0; b < 2; ++b)
#pragma unroll
                for (int m = 0; m < 4; ++m)
#pragma unroll
                    for (int n = 0; n < 2; ++n) acc[a][b][m][n] = (f32x4){0.f, 0.f, 0.f, 0.f};
        cur = nxt; cA = nA; cB = nB; ++ui;
        if constexpr (ALIGN_EPI) { if (wr == 1) PG8_BAR; }
    }
    PG8_WAIT_V(0);
    if constexpr (!ALIGN_EPI) { if (wr == 0) PG8_BAR; }
    PG8_BAR;
    if constexpr (Epi::AFTER_DRAIN) { E.fused(acc, cur, wr, wc, fr, fq, lds, wid, lane); S.done(cur); }
#undef PG8_SA
#undef PG8_SB
#undef PG8_STAGE
#undef PG8_LDA
#undef PG8_LDB
#undef PG8_MMA
#undef PG8_WAIT_V
#undef PG8_WAIT_L
#undef PG8_BAR
#undef PG8_SCHED
}
}

constexpr int D = 1024, BATCH = 4, SEQ = 8192, MTOK = BATCH * SEQ, NCH = SEQ / 64, MEMLEN = 256;
constexpr int EIN = 3328, OIN = 4096;
constexpr float EPS = 1e-6f;
constexpr int C_AQ = 0, C_AK = 512, C_AV = 640, C_AG = 768, C_BQ = 1280, C_BK = 1792, C_BV = 2304, C_BG = 2816;
constexpr int NWAVES = 8, NTHR = 512;
constexpr size_t MiB = 1u << 20;
constexpr size_t WS_WEIN = 1 * MiB, WS_WEOUT = 8 * MiB, WS_WOIN = 10 * MiB, WS_WOOUT = 18 * MiB, WS_WQ = 20 * MiB, WS_WKV = 24 * MiB, WS_WO = 32 * MiB;
constexpr size_t WS_MEMN = 36 * MiB, WS_KV = 40 * MiB, WS_ROT = 48 * MiB, WS_SSP = 52 * MiB;
constexpr size_t WS_XB = 56 * MiB;
constexpr size_t WS_BIG = 120 * MiB;
constexpr size_t WS_BUFA = 376 * MiB;
constexpr size_t WS_BUFB = 440 * MiB;
constexpr size_t WS_END = 504 * MiB;
constexpr int LDS_BYTES = 147456;

#define LAS __attribute__((address_space(3)))
typedef unsigned short bf16;
typedef short bf16x8 __attribute__((ext_vector_type(8)));
typedef short s16x4 __attribute__((ext_vector_type(4)));
typedef float f32x2 __attribute__((ext_vector_type(2)));
typedef float f32x4 __attribute__((ext_vector_type(4)));
typedef float f32x16 __attribute__((ext_vector_type(16)));
typedef unsigned u32x2 __attribute__((ext_vector_type(2)));
typedef unsigned u32x4 __attribute__((ext_vector_type(4)));

__device__ __forceinline__ unsigned pk2(float lo, float hi) { return pg8::cvt_pk_bf16(lo, hi); }
__device__ __forceinline__ float bflo(unsigned w) { return __uint_as_float(w << 16); }
__device__ __forceinline__ float bfhi(unsigned w) { return __uint_as_float(w & 0xffff0000u); }
__device__ __forceinline__ int crow(int r, int hi) { return (r & 3) + 8 * (r >> 2) + 4 * hi; }
__device__ __forceinline__ float wave_sum(float v) {
#pragma unroll
    for (int o = 1; o < 64; o <<= 1) v += __shfl_xor(v, o);
    return v;
}
__device__ __forceinline__ float silu(float x) { return x / (1.0f + __expf(-x)); }
__device__ __forceinline__ s16x4 trd(const LAS bf16* p) { return __builtin_bit_cast(s16x4, __builtin_amdgcn_ds_read_tr16_b64_v4i16((LAS s16x4*)p)); }
__device__ __forceinline__ bf16x8 tr_frag(const LAS bf16* T, int ld, int k0, int n0, int lane) {
    const int g4 = lane >> 4, li = lane & 15, q = li >> 2, p = li & 3, hi = g4 >> 1;
    const LAS bf16* a = T + (k0 + 4 * hi + q) * ld + n0 + 16 * (g4 & 1) + 4 * p;
    const s16x4 lo = trd(a), up = trd(a + 8 * ld);
    return (bf16x8){lo[0], lo[1], lo[2], lo[3], up[0], up[1], up[2], up[3]};
}
__device__ __forceinline__ bf16x8 pack8(float a0, float a1, float a2, float a3, float a4, float a5, float a6, float a7) {
    u32x4 w; w.x = pk2(a0, a1); w.y = pk2(a2, a3); w.z = pk2(a4, a5); w.w = pk2(a6, a7); return __builtin_bit_cast(bf16x8, w);
}
__device__ __forceinline__ int launder(int v) { asm volatile("" : "+v"(v)); return v; }
#define MFMA32(a, b, c) __builtin_amdgcn_mfma_f32_32x32x16_bf16((a), (b), (c), 0, 0, 0)

struct Args { const float* in[17]; float* out; unsigned char* ws; int ph_lo, ph_hi; };
struct Frame {
    LAS unsigned char* lds; int tid, lane, wave, G, bid;
    const float *x, *mem, *e_norm, *e_w_in, *e_sink, *e_w_out, *o_norm, *o_w_in, *o_conv_w, *o_conv_b, *o_w_out, *c_norm, *c_mem_norm, *c_wq, *c_wkv, *c_wo, *final_norm;
    float* out; unsigned char* ws;
};

__device__ __forceinline__ void p0_transpose_item(const float* W, const float* gain, int K, int N, bf16* WT, LAS float* scr, int item, int lane) {
    const int nblk = N / 32, kb = item / nblk, nb = item % nblk, k0 = 64 * kb, n0 = 32 * nb;
#pragma unroll 8
    for (int i = 0; i < 32; ++i) { const int kk = 2 * i + (lane >> 5); float w = W[(size_t)(k0 + kk) * N + n0 + (lane & 31)]; if (gain) w *= gain[k0 + kk]; scr[kk * 33 + (lane & 31)] = w; }
    asm volatile("s_waitcnt lgkmcnt(0)" ::: "memory");
    const int c = lane & 7;
#pragma unroll
    for (int j = 0; j < 4; ++j) { const int n = (lane >> 3) + 8 * j; const LAS float* s = scr + (8 * c) * 33 + n;
        u32x4 o; o.x = pk2(s[0 * 33], s[1 * 33]); o.y = pk2(s[2 * 33], s[3 * 33]); o.z = pk2(s[4 * 33], s[5 * 33]); o.w = pk2(s[6 * 33], s[7 * 33]);
        *(u32x4*)(WT + (size_t)(n0 + n) * K + k0 + 8 * c) = o; }
    asm volatile("s_waitcnt lgkmcnt(0)" ::: "memory");
}
__device__ __forceinline__ void p0_prologue(Frame& F) {
    LAS float* scr = (LAS float*)(F.lds + F.wave * 16384);
    const int gw = F.bid * NWAVES + F.wave, NGW = F.G * NWAVES, lane = F.lane;
    unsigned char* ws = F.ws;
    constexpr int I_EIN = 16 * (EIN / 32), I_SQ = 16 * 32, I_OIN = 16 * (OIN / 32), I_KV = 16 * 64;
    constexpr int NITEMS = I_EIN + I_SQ + I_OIN + I_SQ + 2 * I_SQ + 2 * I_KV + 2 * I_SQ;
    for (int it = gw; it < NITEMS; it += NGW) {
        int r = it;
        if (r < I_EIN) { p0_transpose_item(F.e_w_in, F.e_norm, D, EIN, (bf16*)(ws + WS_WEIN), scr, r, lane); continue; } r -= I_EIN;
        if (r < I_SQ) { p0_transpose_item(F.e_w_out, nullptr, D, D, (bf16*)(ws + WS_WEOUT), scr, r, lane); continue; } r -= I_SQ;
        if (r < I_OIN) { p0_transpose_item(F.o_w_in, F.o_norm, D, OIN, (bf16*)(ws + WS_WOIN), scr, r, lane); continue; } r -= I_OIN;
        if (r < I_SQ) { p0_transpose_item(F.o_w_out, nullptr, D, D, (bf16*)(ws + WS_WOOUT), scr, r, lane); continue; } r -= I_SQ;
        if (r < 2 * I_SQ) { const int l = r / I_SQ; p0_transpose_item(F.c_wq + (size_t)l * D * D, F.c_norm + l * D, D, D, (bf16*)(ws + WS_WQ) + (size_t)l * D * D, scr, r % I_SQ, lane); continue; } r -= 2 * I_SQ;
        if (r < 2 * I_KV) { const int l = r / I_KV; p0_transpose_item(F.c_wkv + (size_t)l * D * 2 * D, nullptr, D, 2 * D, (bf16*)(ws + WS_WKV) + (size_t)l * 2 * D * D, scr, r % I_KV, lane); continue; } r -= 2 * I_KV;
        { const int l = r / I_SQ; p0_transpose_item(F.c_wo + (size_t)l * D * D, nullptr, D, D, (bf16*)(ws + WS_WO) + (size_t)l * D * D, scr, r % I_SQ, lane); }
    }
    for (int it = gw; it < 2 * BATCH * MEMLEN; it += NGW) {
        const int l = it / (BATCH * MEMLEN), row = it % (BATCH * MEMLEN);
        const f32x4* xr = (const f32x4*)(F.mem + (size_t)row * D) + lane; const f32x4* gr = (const f32x4*)(F.c_mem_norm + l * D) + lane;
        f32x4 v[4]; float s = 0.f;
#pragma unroll
        for (int j = 0; j < 4; ++j) { v[j] = xr[64 * j]; s += (v[j][0] * v[j][0] + v[j][1] * v[j][1]) + (v[j][2] * v[j][2] + v[j][3] * v[j][3]); }
        const float rs = 1.0f / sqrtf(wave_sum(s) * (1.0f / D) + EPS);
        u32x2* o8 = (u32x2*)((bf16*)(ws + WS_MEMN) + (size_t)it * D) + lane;
#pragma unroll
        for (int j = 0; j < 4; ++j) { const f32x4 g = gr[64 * j]; u32x2 w; w.x = pk2(v[j][0] * rs * g[0], v[j][1] * rs * g[1]); w.y = pk2(v[j][2] * rs * g[2], v[j][3] * rs * g[3]); o8[64 * j] = w; }
    }
    for (int row = gw; row < MTOK; row += NGW) {
        const f32x4* xr = (const f32x4*)(F.x + (size_t)row * D) + lane;
        f32x4 v[4]; float s = 0.f;
#pragma unroll
        for (int j = 0; j < 4; ++j) { v[j] = xr[64 * j]; s += (v[j][0] * v[j][0] + v[j][1] * v[j][1]) + (v[j][2] * v[j][2] + v[j][3] * v[j][3]); }
        s = wave_sum(s);
        u32x2* o8 = (u32x2*)((bf16*)(ws + WS_XB) + (size_t)row * D) + lane;
#pragma unroll
        for (int j = 0; j < 4; ++j) { u32x2 w; w.x = pk2(v[j][0], v[j][1]); w.y = pk2(v[j][2], v[j][3]); o8[64 * j] = w; }
        if (lane < 16) ((float*)(ws + WS_SSP))[(size_t)row * 16 + lane] = (lane == 0) ? s : 0.f;
    }
    for (int e = F.bid * NTHR + F.tid; e < SEQ * 64; e += F.G * NTHR) {
        const int pos = e >> 6, j = e & 63;
        const float inv = 1.0f / exp2f(((float)j / 63.0f) * 13.287712379549449f);
        const float ang = (float)pos * inv;
        const double a = (double)ang, kk = rint(a * 0.63661977236758134308);
        const float r = (float)fma(-kk, 1.57079632679489661923, a), r2 = r * r;
        const float sn = r + r * r2 * (-1.6666654611e-1f + r2 * (8.3321608736e-3f + r2 * (-1.9515295891e-4f)));
        const float cs = 1.0f - 0.5f * r2 + r2 * r2 * (4.166664568298827e-2f + r2 * (-1.388731625493765e-3f + r2 * 2.443315711809948e-5f));
        const int q = ((int)kk) & 3;
        f32x2 o; o.x = (q == 0) ? cs : (q == 1) ? -sn : (q == 2) ? -cs : sn; o.y = (q == 0) ? sn : (q == 1) ? cs : (q == 2) ? -sn : -cs;
        ((f32x2*)(ws + WS_ROT))[e] = o;
    }
}

constexpr int AKS = 72;
__device__ __forceinline__ void swa_item(Frame& F, int item) {
    const int kvh = item & 1, c = (item >> 1) & (NCH - 1), b = item >> 8;
    const int c0 = c >= 2 ? c - 2 : 0, nch = c - c0 + 1;
    const int tid = launder(F.tid), lane = tid & 63, w = F.wave, r32 = lane & 31, hi = lane >> 5;
    LAS bf16* Ks = (LAS bf16*)F.lds; LAS bf16* Vs = Ks + 192 * AKS;
    const bf16* HC = (const bf16*)(F.ws + WS_BIG);
    const size_t rowbase = (size_t)b * SEQ;
    for (int p = tid; p < nch * 64 * 8; p += NTHR) { const int r = p >> 3, ch = p & 7; const bf16* src = HC + (rowbase + c0 * 64 + r) * EIN + kvh * 64 + ch * 8;
        const u32x4 kx = *(const u32x4*)(src + C_AK), vx = *(const u32x4*)(src + C_AV);
        *(LAS u32x4*)(Ks + r * AKS + ch * 8) = kx; *(LAS u32x4*)(Vs + r * AKS + ch * 8) = vx; }
    const int qh = kvh * 4 + (w >> 1);
    const size_t tok = rowbase + c * 64 + (w & 1) * 32 + r32;
    const bf16* qp = HC + tok * EIN + C_AQ + qh * 64 + hi * 8;
    bf16x8 qf[4];
#pragma unroll
    for (int s = 0; s < 4; ++s) qf[s] = *(const bf16x8*)(qp + 16 * s);
    __syncthreads();
    const int nkb = 2 * nch;
    f32x16 st[6];
#pragma unroll
    for (int kb = 0; kb < 6; ++kb) { st[kb] = (f32x16){};
        if (kb < nkb) {
#pragma unroll
            for (int s = 0; s < 4; ++s) { const bf16x8 a = *(const LAS bf16x8*)(Ks + (32 * kb + r32) * AKS + 16 * s + 8 * hi); st[kb] = MFMA32(a, qf[s], st[kb]); } } }
    float mx = -3.0e38f;
#pragma unroll
    for (int kb = 0; kb < 6; ++kb) if (kb < nkb) {
#pragma unroll
        for (int i = 0; i < 16; ++i) mx = fmaxf(mx, st[kb][i]); }
    mx = fmaxf(mx, __shfl_xor(mx, 32));
    const float sink = F.e_sink[qh];
    const float mref = fmaxf(mx * 0.125f, sink);
    const float L2E = 1.4426950408889634f;
    float sum = 0.f;
#pragma unroll
    for (int kb = 0; kb < 6; ++kb) if (kb < nkb) {
#pragma unroll
        for (int i = 0; i < 16; ++i) { const float p = exp2f((st[kb][i] * 0.125f - mref) * L2E); st[kb][i] = p; sum += p; } }
    sum += __shfl_xor(sum, 32);
    const float inv = 1.0f / (sum + exp2f((sink - mref) * L2E));
    f32x16 o[2]; o[0] = (f32x16){}; o[1] = (f32x16){};
#pragma unroll
    for (int kb = 0; kb < 6; ++kb) if (kb < nkb) {
#pragma unroll
        for (int s = 0; s < 2; ++s) {
            const bf16x8 pf = pack8(st[kb][8 * s + 0] * inv, st[kb][8 * s + 1] * inv, st[kb][8 * s + 2] * inv, st[kb][8 * s + 3] * inv, st[kb][8 * s + 4] * inv, st[kb][8 * s + 5] * inv, st[kb][8 * s + 6] * inv, st[kb][8 * s + 7] * inv);
#pragma unroll
            for (int db = 0; db < 2; ++db) { const bf16x8 vf = tr_frag(Vs, AKS, 32 * kb + 16 * s, 32 * db, lane); o[db] = MFMA32(vf, pf, o[db]); } } }
    const bf16* gp = HC + tok * EIN + C_AG + qh * 64;
    bf16* yp = (bf16*)(F.ws + WS_BUFA) + tok * D + qh * 64;
#pragma unroll
    for (int db = 0; db < 2; ++db)
#pragma unroll
        for (int gi = 0; gi < 4; ++gi) { const int d0 = 32 * db + 8 * gi + 4 * hi; const u32x2 g = *(const u32x2*)(gp + d0);
            u32x2 y; y.x = pk2(o[db][4 * gi + 0] * silu(bflo(g.x)), o[db][4 * gi + 1] * silu(bfhi(g.x))); y.y = pk2(o[db][4 * gi + 2] * silu(bflo(g.y)), o[db][4 * gi + 3] * silu(bfhi(g.y)));
            *(u32x2*)(yp + d0) = y; }
    __syncthreads();
}

constexpr int RKS = 136;
__device__ __forceinline__ float head_lg2(int h) { return log2f(1.0f - exp2f(-5.0f - (float)h)); }
__device__ __forceinline__ void ret1_item(Frame& F, int item) {
    const int h = item & 3, c = (item >> 2) & (NCH - 1), b = item >> 9;
    const int tid = launder(F.tid), lane = tid & 63, w = F.wave, r32 = lane & 31, hi = lane >> 5;
    LAS bf16* Qr = (LAS bf16*)F.lds; LAS bf16* Kr = Qr + 64 * RKS; LAS bf16* Vs = Kr + 64 * RKS; LAS bf16* Vd = Vs + 64 * RKS;
    bf16* HC = (bf16*)(F.ws + WS_BIG);
    const size_t rowbase = (size_t)b * SEQ + (size_t)c * 64;
    const float lg2 = head_lg2(h);
    {
        const int j = tid >> 3, pc = tid & 7;
        bf16* rowp = HC + (rowbase + j) * EIN;
        const u32x4 q1 = *(const u32x4*)(rowp + C_BQ + h * 128 + 8 * pc), q2 = *(const u32x4*)(rowp + C_BQ + h * 128 + 64 + 8 * pc);
        const u32x4 k1 = *(const u32x4*)(rowp + C_BK + h * 128 + 8 * pc), k2 = *(const u32x4*)(rowp + C_BK + h * 128 + 64 + 8 * pc);
        const u32x4 v1 = *(const u32x4*)(rowp + C_BV + h * 128 + 16 * pc), v2 = *(const u32x4*)(rowp + C_BV + h * 128 + 16 * pc + 8);
        const f32x4* rt = (const f32x4*)((const f32x2*)(F.ws + WS_ROT) + (size_t)(c * 64 + j) * 64 + 8 * pc);
        u32x4 qa, qb, ka, kb;
        const float ksc = 0.08838834764831845f;
#pragma unroll
        for (int e = 0; e < 4; ++e) { const f32x4 cs = rt[e];
            const float a0 = bflo(q1[e]), a1 = bfhi(q1[e]), b0 = bflo(q2[e]), b1 = bfhi(q2[e]);
            qa[e] = pk2(a0 * cs[0] - b0 * cs[1], a1 * cs[2] - b1 * cs[3]); qb[e] = pk2(a0 * cs[1] + b0 * cs[0], a1 * cs[3] + b1 * cs[2]);
            const float c0 = bflo(k1[e]), c1 = bfhi(k1[e]), d0 = bflo(k2[e]), d1 = bfhi(k2[e]);
            ka[e] = pk2((c0 * cs[0] - d0 * cs[1]) * ksc, (c1 * cs[2] - d1 * cs[3]) * ksc); kb[e] = pk2((c0 * cs[1] + d0 * cs[0]) * ksc, (c1 * cs[3] + d1 * cs[2]) * ksc); }
        *(LAS u32x4*)(Qr + j * RKS + 8 * pc) = qa; *(LAS u32x4*)(Qr + j * RKS + 64 + 8 * pc) = qb;
        *(LAS u32x4*)(Kr + j * RKS + 8 * pc) = ka; *(LAS u32x4*)(Kr + j * RKS + 64 + 8 * pc) = kb;
        *(u32x4*)(rowp + C_BQ + h * 128 + 8 * pc) = qa; *(u32x4*)(rowp + C_BQ + h * 128 + 64 + 8 * pc) = qb;
        *(LAS u32x4*)(Vs + j * RKS + 16 * pc) = v1; *(LAS u32x4*)(Vs + j * RKS + 16 * pc + 8) = v2;
        const float kd = exp2f(lg2 * (float)(63 - j));
        u32x4 w1, w2;
#pragma unroll
        for (int e = 0; e < 4; ++e) { w1[e] = pk2(bflo(v1[e]) * kd, bfhi(v1[e]) * kd); w2[e] = pk2(bflo(v2[e]) * kd, bfhi(v2[e]) * kd); }
        *(LAS u32x4*)(Vd + j * RKS + 16 * pc) = w1; *(LAS u32x4*)(Vd + j * RKS + 16 * pc + 8) = w2;
    }
    __syncthreads();
    const int ib = w & 1, db = w >> 1;
    f32x16 st[2];
#pragma unroll
    for (int jb = 0; jb < 2; ++jb) { st[jb] = (f32x16){};
#pragma unroll
        for (int s = 0; s < 8; ++s) { const bf16x8 a = *(const LAS bf16x8*)(Kr + (32 * jb + r32) * RKS + 16 * s + 8 * hi); const bf16x8 q = *(const LAS bf16x8*)(Qr + (32 * ib + r32) * RKS + 16 * s + 8 * hi);
            st[jb] = MFMA32(a, q, st[jb]); } }
    const int iloc = 32 * ib + r32;
#pragma unroll
    for (int jb = 0; jb < 2; ++jb)
#pragma unroll
        for (int i = 0; i < 16; ++i) { const int j = 32 * jb + crow(i, hi); const int dd = iloc > j ? iloc - j : j - iloc; st[jb][i] *= exp2f(lg2 * (float)dd); }
    f32x16 o = (f32x16){};
#pragma unroll
    for (int jb = 0; jb < 2; ++jb)
#pragma unroll
        for (int s = 0; s < 2; ++s) {
            const bf16x8 pf = pack8(st[jb][8 * s + 0], st[jb][8 * s + 1], st[jb][8 * s + 2], st[jb][8 * s + 3], st[jb][8 * s + 4], st[jb][8 * s + 5], st[jb][8 * s + 6], st[jb][8 * s + 7]);
            const bf16x8 vf = tr_frag(Vs, RKS, 32 * jb + 16 * s, 32 * db, lane);
            o = MFMA32(vf, pf, o); }
    {
        float* op = (float*)(F.ws + WS_XB) + (rowbase + iloc) * 512 + h * 128 + 32 * db + 4 * hi;
#pragma unroll
        for (int gi = 0; gi < 4; ++gi) *(f32x4*)(op + 8 * gi) = (f32x4){o[4 * gi], o[4 * gi + 1], o[4 * gi + 2], o[4 * gi + 3]};
    }
    const int rb = w >> 1;
    f32x16 kv[2]; kv[0] = (f32x16){}; kv[1] = (f32x16){};
#pragma unroll
    for (int s = 0; s < 4; ++s) { const bf16x8 af = tr_frag(Kr, RKS, 16 * s, 32 * rb, lane);
#pragma unroll
        for (int t = 0; t < 2; ++t) { const bf16x8 bf = tr_frag(Vd, RKS, 16 * s, 32 * (2 * (w & 1) + t), lane); kv[t] = MFMA32(af, bf, kv[t]); } }
    bf16* stp = (bf16*)(F.ws + WS_BUFB) + ((size_t)(b * NCH + c) * 4 + h) * 16384;
#pragma unroll
    for (int t = 0; t < 2; ++t) { const int dv = 32 * (2 * (w & 1) + t) + r32;
#pragma unroll
        for (int gi = 0; gi < 4; ++gi) { const int dk = 32 * rb + 8 * gi + 4 * hi; u32x2 y; y.x = pk2(kv[t][4 * gi], kv[t][4 * gi + 1]); y.y = pk2(kv[t][4 * gi + 2], kv[t][4 * gi + 3]);
            *(u32x2*)(stp + dv * 128 + dk) = y; } }
    __syncthreads();
}

__device__ __forceinline__ void scan_phase(Frame& F) {
    unsigned* ST = (unsigned*)(F.ws + WS_BUFB);
    for (int e = F.bid * NTHR + F.tid; e < BATCH * 4 * 8192; e += F.G * NTHR) {
        const int idx = e & 8191, h = (e >> 13) & 3, b = e >> 15;
        const float dec = exp2f(head_lg2(h) * 64.0f);
        unsigned* p = ST + ((size_t)(b * NCH) * 4 + h) * 8192 + idx;
        float s0 = 0.f, s1 = 0.f;
#pragma unroll 8
        for (int c = 0; c < NCH; ++c) { const unsigned kvw = p[(size_t)c * 4 * 8192]; p[(size_t)c * 4 * 8192] = pk2(s0, s1); s0 = s0 * dec + bflo(kvw); s1 = s1 * dec + bfhi(kvw); }
    }
}

__device__ __forceinline__ void ret2_item(Frame& F, int item) {
    const int h = item & 3, c = (item >> 2) & (NCH - 1), b = item >> 9;
    const int lane = launder(F.lane), w = F.wave, r32 = lane & 31, hi = lane >> 5;
    const int ib = w & 1, db = w >> 1, iloc = 32 * ib + r32;
    LAS float* part = (LAS float*)F.lds;
    const bf16* HC = (const bf16*)(F.ws + WS_BIG);
    const size_t tok = (size_t)b * SEQ + (size_t)c * 64 + iloc;
    const bf16* stp = (const bf16*)(F.ws + WS_BUFB) + ((size_t)(b * NCH + c) * 4 + h) * 16384 + (size_t)(32 * db + r32) * 128 + 8 * hi;
    const bf16* qp = HC + tok * EIN + C_BQ + h * 128 + 8 * hi;
    f32x16 oc = (f32x16){};
#pragma unroll
    for (int s = 0; s < 8; ++s) { const bf16x8 a = *(const bf16x8*)(stp + 16 * s); const bf16x8 q = *(const bf16x8*)(qp + 16 * s); oc = MFMA32(a, q, oc); }
    const float qdec = exp2f(head_lg2(h) * (float)(iloc + 1));
    const float* op = (const float*)(F.ws + WS_XB) + tok * 512 + h * 128 + 32 * db + 4 * hi;
    float ss = 0.f;
#pragma unroll
    for (int gi = 0; gi < 4; ++gi) { const f32x4 oi = *(const f32x4*)(op + 8 * gi);
#pragma unroll
        for (int e = 0; e < 4; ++e) { const float v = oi[e] + oc[4 * gi + e] * qdec; oc[4 * gi + e] = v; ss += v * v; } }
    ss += __shfl_xor(ss, 32);
    if (hi == 0) part[iloc * 4 + db] = ss;
    __syncthreads();
    const f32x4 pp = *(const LAS f32x4*)(part + iloc * 4);
    const float rs = 1.0f / sqrtf(((pp[0] + pp[1]) + (pp[2] + pp[3])) * (1.0f / 128.0f) + EPS);
    const bf16* gp = HC + tok * EIN + C_BG + h * 128 + 32 * db + 4 * hi;
    bf16* yp = (bf16*)(F.ws + WS_BUFA) + tok * D + 512 + h * 128 + 32 * db + 4 * hi;
#pragma unroll
    for (int gi = 0; gi < 4; ++gi) { const u32x2 g = *(const u32x2*)(gp + 8 * gi);
        u32x2 y; y.x = pk2(oc[4 * gi + 0] * rs * silu(bflo(g.x)), oc[4 * gi + 1] * rs * silu(bfhi(g.x))); y.y = pk2(oc[4 * gi + 2] * rs * silu(bflo(g.y)), oc[4 * gi + 3] * rs * silu(bfhi(g.y)));
        *(u32x2*)(yp + 8 * gi) = y; }
    __syncthreads();
}

constexpr int XKS = 264;
__device__ __forceinline__ void xattn_unit(Frame& F, int layer, int unit) {
    const int h = unit & 3, rt = unit >> 2, b = rt >> 5;
    const int tid = launder(F.tid), lane = tid & 63, w = F.wave, r32 = lane & 31, hi = lane >> 5;
    LAS bf16* buf = (LAS bf16*)F.lds;
    const bf16* Kg = (const bf16*)(F.ws + WS_KV) + ((size_t)layer * BATCH * MEMLEN + (size_t)b * MEMLEN) * 2048 + h * 256;
    const bf16* Vg = Kg + 1024;
    const size_t row = (size_t)rt * 256 + w * 32 + r32;
    const bf16* qp = (const bf16*)(F.ws + WS_BUFB) + row * D + h * 256 + 8 * hi;
    bf16x8 qf[16];
#pragma unroll
    for (int s = 0; s < 16; ++s) qf[s] = *(const bf16x8*)(qp + 16 * s);
    f32x16 st[8];
#pragma unroll
    for (int kblk = 0; kblk < 4; ++kblk) {
        __syncthreads();
#pragma unroll
        for (int i = 0; i < 4; ++i) { const int p = tid + i * NTHR, r = p >> 5, ch = p & 31; *(LAS u32x4*)(buf + r * XKS + ch * 8) = *(const u32x4*)(Kg + (size_t)(kblk * 64 + r) * 2048 + ch * 8); }
        __syncthreads();
#pragma unroll
        for (int kk = 0; kk < 2; ++kk) { f32x16 acc = (f32x16){};
#pragma unroll
            for (int s = 0; s < 16; ++s) { const bf16x8 a = *(const LAS bf16x8*)(buf + (32 * kk + r32) * XKS + 16 * s + 8 * hi); acc = MFMA32(a, qf[s], acc); }
            st[2 * kblk + kk] = acc; }
    }
    float mx = -3.0e38f;
#pragma unroll
    for (int kb = 0; kb < 8; ++kb)
#pragma unroll
        for (int i = 0; i < 16; ++i) mx = fmaxf(mx, st[kb][i]);
    mx = fmaxf(mx, __shfl_xor(mx, 32));
    const float SC = 0.0625f * 1.4426950408889634f;
    float sum = 0.f;
#pragma unroll
    for (int kb = 0; kb < 8; ++kb)
#pragma unroll
        for (int i = 0; i < 16; ++i) { const float p = exp2f((st[kb][i] - mx) * SC); st[kb][i] = p; sum += p; }
    sum += __shfl_xor(sum, 32);
    const float inv = 1.0f / sum;
    bf16x8 pw[8][2];
#pragma unroll
    for (int kb = 0; kb < 8; ++kb)
#pragma unroll
        for (int s = 0; s < 2; ++s) pw[kb][s] = pack8(st[kb][8 * s + 0] * inv, st[kb][8 * s + 1] * inv, st[kb][8 * s + 2] * inv, st[kb][8 * s + 3] * inv, st[kb][8 * s + 4] * inv, st[kb][8 * s + 5] * inv, st[kb][8 * s + 6] * inv, st[kb][8 * s + 7] * inv);
    f32x16 o[8];
#pragma unroll
    for (int db = 0; db < 8; ++db) o[db] = (f32x16){};
#pragma unroll
    for (int vblk = 0; vblk < 4; ++vblk) {
        __syncthreads();
#pragma unroll
        for (int i = 0; i < 4; ++i) { const int p = tid + i * NTHR, r = p >> 5, ch = p & 31; *(LAS u32x4*)(buf + r * XKS + ch * 8) = *(const u32x4*)(Vg + (size_t)(vblk * 64 + r) * 2048 + ch * 8); }
        __syncthreads();
#pragma unroll
        for (int kk = 0; kk < 2; ++kk)
#pragma unroll
            for (int s = 0; s < 2; ++s)
#pragma unroll
                for (int db = 0; db < 8; ++db) { const bf16x8 vf = tr_frag(buf, XKS, 32 * kk + 16 * s, 32 * db, lane); o[db] = MFMA32(vf, pw[2 * vblk + kk][s], o[db]); }
    }
    bf16* op = (bf16*)(F.ws + WS_BUFA) + row * D + h * 256 + 4 * hi;
#pragma unroll
    for (int db = 0; db < 8; ++db)
#pragma unroll
        for (int gi = 0; gi < 4; ++gi) { u32x2 y; y.x = pk2(o[db][4 * gi], o[db][4 * gi + 1]); y.y = pk2(o[db][4 * gi + 2], o[db][4 * gi + 3]); *(u32x2*)(op + 32 * db + 8 * gi) = y; }
    __syncthreads();
}

__device__ __forceinline__ void conv_phase(Frame& F) {
    const bf16* H4 = (const bf16*)(F.ws + WS_BIG); bf16* Y = (bf16*)(F.ws + WS_BUFA);
    const float* cw = F.o_conv_w; const float* cb = F.o_conv_b;
    for (int it = F.bid * NTHR + F.tid; it < (MTOK / 8) * 128; it += F.G * NTHR) {
        const int cgi = it & 127, tg = it >> 7, col = cgi * 8, t0 = tg * 8;
        float w0[8], w1[8], w2[8], bs[8];
#pragma unroll
        for (int e = 0; e < 8; ++e) { w0[e] = cw[col + e]; w1[e] = cw[D + col + e]; w2[e] = cw[2 * D + col + e]; bs[e] = cb[col + e]; }
        float zm2[8], zm1[8];
        const bool first = (t0 & (SEQ - 1)) == 0;
#pragma unroll
        for (int e = 0; e < 8; ++e) { zm2[e] = 0.f; zm1[e] = 0.f; }
        if (!first) {
            const bf16* r2 = H4 + (size_t)(t0 - 2) * OIN + col; const bf16* r1 = H4 + (size_t)(t0 - 1) * OIN + col;
            const u32x4 c2 = *(const u32x4*)(r2 + 1024), u2 = *(const u32x4*)(r2 + 2048), c1 = *(const u32x4*)(r1 + 1024), u1 = *(const u32x4*)(r1 + 2048);
#pragma unroll
            for (int e = 0; e < 4; ++e) { zm2[2 * e] = bflo(c2[e]) * bflo(u2[e]); zm2[2 * e + 1] = bfhi(c2[e]) * bfhi(u2[e]); zm1[2 * e] = bflo(c1[e]) * bflo(u1[e]); zm1[2 * e + 1] = bfhi(c1[e]) * bfhi(u1[e]); }
        }
#pragma unroll
        for (int tt = 0; tt < 8; ++tt) {
            const bf16* r = H4 + (size_t)(t0 + tt) * OIN + col;
            const u32x4 gb = *(const u32x4*)(r), gc = *(const u32x4*)(r + 1024), uu = *(const u32x4*)(r + 2048), gt = *(const u32x4*)(r + 3072);
            float z[8], y[8];
#pragma unroll
            for (int e = 0; e < 4; ++e) { z[2 * e] = bflo(gc[e]) * bflo(uu[e]); z[2 * e + 1] = bfhi(gc[e]) * bfhi(uu[e]); }
#pragma unroll
            for (int e = 0; e < 4; ++e) {
                const float cv0 = bs[2 * e] + zm2[2 * e] * w0[2 * e] + zm1[2 * e] * w1[2 * e] + z[2 * e] * w2[2 * e];
                const float cv1 = bs[2 * e + 1] + zm2[2 * e + 1] * w0[2 * e + 1] + zm1[2 * e + 1] * w1[2 * e + 1] + z[2 * e + 1] * w2[2 * e + 1];
                y[2 * e] = bflo(gb[e]) * cv0 * silu(bflo(gt[e])); y[2 * e + 1] = bfhi(gb[e]) * cv1 * silu(bfhi(gt[e])); }
            u32x4 o; o.x = pk2(y[0], y[1]); o.y = pk2(y[2], y[3]); o.z = pk2(y[4], y[5]); o.w = pk2(y[6], y[7]);
            *(u32x4*)(Y + (size_t)(t0 + tt) * D + col) = o;
#pragma unroll
            for (int e = 0; e < 8; ++e) { zm2[e] = zm1[e]; zm1[e] = z[e]; }
        }
    }
}

__device__ __forceinline__ void final_phase(Frame& F) {
    const int gw = F.bid * NWAVES + F.wave, NGW = F.G * NWAVES, lane = F.lane;
    const float* ssp = (const float*)(F.ws + WS_SSP);
    for (int row = gw; row < MTOK; row += NGW) {
        const f32x4* p = (const f32x4*)(ssp + (size_t)row * 16); const f32x4 a = p[0], b = p[1], c = p[2], d = p[3];
        const float s = ((a[0] + a[1]) + (a[2] + a[3])) + ((b[0] + b[1]) + (b[2] + b[3])) + ((c[0] + c[1]) + (c[2] + c[3])) + ((d[0] + d[1]) + (d[2] + d[3]));
        const float rs = 1.0f / sqrtf(s * (1.0f / D) + EPS);
        f32x4* xr = (f32x4*)(F.out + (size_t)row * D) + lane; const f32x4* gr = (const f32x4*)F.final_norm + lane;
#pragma unroll
        for (int j = 0; j < 4; ++j) { const f32x4 v = xr[64 * j], g = gr[64 * j]; xr[64 * j] = v * rs * g; }
    }
}

#ifndef TS_PROBE
#define TS_PROBE 0
#endif
#define TS_A_HI 5
#define TS_A_LO 2
#define TS_B_HI 1
#define TS_B_LO 0
#ifndef DUP_MASK
#define DUP_MASK 0
#endif
#define REP(k) _Pragma("unroll 1") for (int rep_ = 0; rep_ < ((((DUP_MASK) >> (k)) & 1) + 1); ++rep_)
#ifndef MK_SPLIT
#define MK_SPLIT 0
#endif
constexpr int NPHASE = 16;
__global__ void __launch_bounds__(NTHR, 2) fwd_megakernel(Args args) {
    extern __shared__ __attribute__((aligned(16))) unsigned char lds_raw[];
    cg::grid_group grid = cg::this_grid();
    Frame F;
    F.lds = (LAS unsigned char*)lds_raw; F.tid = threadIdx.x; F.lane = F.tid & 63; F.wave = __builtin_amdgcn_readfirstlane(F.tid >> 6); F.G = gridDim.x; F.bid = blockIdx.x;
    F.x = args.in[0]; F.mem = args.in[1]; F.e_norm = args.in[2]; F.e_w_in = args.in[3]; F.e_sink = args.in[4]; F.e_w_out = args.in[5]; F.o_norm = args.in[6]; F.o_w_in = args.in[7];
    F.o_conv_w = args.in[8]; F.o_conv_b = args.in[9]; F.o_w_out = args.in[10]; F.c_norm = args.in[11]; F.c_mem_norm = args.in[12]; F.c_wq = args.in[13]; F.c_wkv = args.in[14]; F.c_wo = args.in[15]; F.final_norm = args.in[16];
    F.out = args.out; F.ws = args.ws;
    unsigned char* ws = args.ws;
    const int lo = args.ph_lo, hi = args.ph_hi;
#define IN(k) (lo <= (k) && (k) < hi)
#define SEAM(k) do { if (IN(k) && IN((k) + 1)) { asm volatile("s_waitcnt vmcnt(0) lgkmcnt(0)" ::: "memory"); grid.sync(); __builtin_amdgcn_fence(__ATOMIC_ACQUIRE, "agent"); asm volatile("s_waitcnt vmcnt(0)" ::: "memory"); } STAMP((k) + 1); } while (0)
    typedef pg8::EpiScaleBf16<true> EpiS; typedef pg8::EpiScaleBf16<false> EpiN;
    bf16* XB = (bf16*)(ws + WS_XB); float* SSP = (float*)(ws + WS_SSP); bf16* BIG = (bf16*)(ws + WS_BIG); bf16* BUFA = (bf16*)(ws + WS_BUFA); bf16* BUFB = (bf16*)(ws + WS_BUFB);

#if TS_PROBE
#define STAMP(i) do { if (blockIdx.x == 0 && threadIdx.x == 0) ((unsigned long long*)ws)[i] = __builtin_amdgcn_s_memrealtime(); } while (0)
#else
#define STAMP(i) do { } while (0)
#endif
    STAMP(0);
    REP(0) {
    if (IN(0)) { p0_prologue(F); } SEAM(0); }
    REP(1) {
    if (IN(1)) {
        { pg8::Gemm g{XB, (const bf16*)(ws + WS_WEIN), MTOK, EIN, D}; pg8::StaticOrder S; S.init(MTOK, EIN, F.G, F.bid); EpiS E{BIG, EIN, SSP};
          pg8::gemm_phase<EpiS, pg8::StaticOrder, true, true>(F.lds, g, S, E); }
#pragma unroll 1
        for (int l = 0; l < 2; ++l) { pg8::Gemm g{(const bf16*)(ws + WS_MEMN) + (size_t)l * BATCH * MEMLEN * D, (const bf16*)(ws + WS_WKV) + (size_t)l * 2 * D * D, BATCH * MEMLEN, 2 * D, D};
          pg8::StaticOrder S; S.init(BATCH * MEMLEN, 2 * D, F.G, (F.bid + F.G - (F.G / 2 + 32 * l) % F.G) % F.G); EpiN E{(bf16*)(ws + WS_KV) + (size_t)l * BATCH * MEMLEN * 2 * D, 2 * D, nullptr};
          pg8::gemm_phase<EpiN, pg8::StaticOrder, true, true>(F.lds, g, S, E); }
    } SEAM(1); }
    REP(2) {
    if (IN(2)) {
        for (int it = F.bid; it < BATCH * NCH * 4; it += F.G) ret1_item(F, it);
        for (int it = F.bid; it < BATCH * NCH * 2; it += F.G) swa_item(F, it);
    } SEAM(2); }
    REP(3) {
    if (IN(3)) { scan_phase(F); } SEAM(3); }
    REP(4) {
    if (IN(4)) { for (int it = F.bid; it < BATCH * NCH * 4; it += F.G) ret2_item(F, it); } SEAM(4); }
    REP(5) {
    if (IN(5)) {
        pg8::Gemm g{BUFA, (const bf16*)(ws + WS_WEOUT), MTOK, D, D}; pg8::StaticOrder S; S.init(MTOK, D, F.G, F.bid); typedef pg8::EpiResidual<true, false> EpiR0; EpiR0 E{F.x, XB, SSP, D};
        pg8::gemm_phase<EpiR0, pg8::StaticOrder, true, true>(F.lds, g, S, E);
    } SEAM(5); }
#pragma unroll
    for (int l = 0; l < 2; ++l) {
        const int pb = (l == 0) ? 6 : 12;
        REP(pb) {
        if (IN(pb)) {
            pg8::Gemm g{XB, (const bf16*)(ws + WS_WQ) + (size_t)l * D * D, MTOK, D, D}; pg8::StaticOrder S; S.init(MTOK, D, F.G, F.bid); EpiS E{BUFB, D, SSP};
            pg8::gemm_phase<EpiS, pg8::StaticOrder, true, true>(F.lds, g, S, E);
        } SEAM(pb); }
        REP(pb + 1) {
        if (IN(pb + 1)) { for (int it = F.bid; it < (MTOK / 256) * 4; it += F.G) xattn_unit(F, l, it); } SEAM(pb + 1); }
        REP(pb + 2) {
        if (IN(pb + 2)) {
            pg8::Gemm g{BUFA, (const bf16*)(ws + WS_WO) + (size_t)l * D * D, MTOK, D, D}; pg8::StaticOrder S; S.init(MTOK, D, F.G, F.bid); if (l == 0) { typedef pg8::EpiResidual<false, false> EpiR1; EpiR1 E{XB, XB, SSP, D}; pg8::gemm_phase<EpiR1, pg8::StaticOrder, true, true>(F.lds, g, S, E); }
            else { typedef pg8::EpiResidual<false, true> EpiR2; EpiR2 E{XB, F.out, SSP, D}; pg8::gemm_phase<EpiR2, pg8::StaticOrder, true, true>(F.lds, g, S, E); }
        } SEAM(pb + 2); }
        if (l == 0) {
            REP(9) {
            if (IN(9)) {
                pg8::Gemm g{XB, (const bf16*)(ws + WS_WOIN), MTOK, OIN, D}; pg8::StaticOrder S; S.init(MTOK, OIN, F.G, F.bid); EpiS E{BIG, OIN, SSP};
                pg8::gemm_phase<EpiS, pg8::StaticOrder, true, true>(F.lds, g, S, E);
            } SEAM(9); }
            REP(10) {
            if (IN(10)) { conv_phase(F); } SEAM(10); }
            REP(11) {
            if (IN(11)) {
                pg8::Gemm g{BUFA, (const bf16*)(ws + WS_WOOUT), MTOK, D, D}; pg8::StaticOrder S; S.init(MTOK, D, F.G, F.bid); typedef pg8::EpiResidual<false, false> EpiR1; EpiR1 E{XB, XB, SSP, D};
                pg8::gemm_phase<EpiR1, pg8::StaticOrder, true, true>(F.lds, g, S, E);
            } SEAM(11); }
        }
    }
    if (IN(15)) { final_phase(F); }
#if TS_PROBE
    __syncthreads();
    if (blockIdx.x == 0 && threadIdx.x == 0) { const unsigned long long* ts = (const unsigned long long*)ws;
        const float ta = (float)(ts[TS_A_HI] - ts[TS_A_LO]) * 0.01f, tb = (float)(ts[TS_B_HI] - ts[TS_B_LO]) * 0.01f;
        F.out[0] = ta; for (int i = 1; i <= 1000; ++i) F.out[i] = tb; }
#endif
#undef IN
#undef SEAM
}

extern "C" void kernel_launch(void* const* d_in, const int* in_sizes, int n_in, void* d_out, int out_size, void* d_ws, size_t ws_size, hipStream_t stream) {
    static int grid = 0;
    if (grid == 0) {
        if (n_in != 17 || out_size != MTOK * D || ws_size < WS_END) { fprintf(stderr, "kernel_launch: unexpected shapes (n_in %d out %d ws %zu)\n", n_in, out_size, ws_size); grid = -1; return; }
        int dev = 0, cus = 0, per_cu = 0;
        hipGetDevice(&dev); hipDeviceGetAttribute(&cus, hipDeviceAttributeMultiprocessorCount, dev);
        if (hipFuncSetAttribute((const void*)fwd_megakernel, hipFuncAttributeMaxDynamicSharedMemorySize, LDS_BYTES) != hipSuccess) { fprintf(stderr, "kernel_launch: hipFuncSetAttribute failed\n"); grid = -1; return; }
        if (hipOccupancyMaxActiveBlocksPerMultiprocessor(&per_cu, (const void*)fwd_megakernel, NTHR, LDS_BYTES) != hipSuccess || per_cu < 1) { fprintf(stderr, "kernel_launch: occupancy query says %d\n", per_cu); per_cu = 1; }
        (void)hipGetLastError();
        grid = cus;
    }
    if (grid < 0) return;
    Args a{};
    for (int i = 0; i < 17; ++i) a.in[i] = (const float*)d_in[i];
    a.out = (float*)d_out; a.ws = (unsigned char*)d_ws;
#if MK_SPLIT
    for (int p = 0; p < NPHASE; ++p) { a.ph_lo = p; a.ph_hi = p + 1; hipLaunchKernelGGL(fwd_megakernel, dim3(grid), dim3(NTHR), LDS_BYTES, stream, a); }
#else
    a.ph_lo = 0; a.ph_hi = NPHASE;
    void* kargs[] = {&a};
    hipError_t e = hipLaunchCooperativeKernel((const void*)fwd_megakernel, dim3(grid), dim3(NTHR), kargs, LDS_BYTES, stream);
    if (e != hipSuccess) fprintf(stderr, "kernel_launch: cooperative launch failed: %s (grid %d)\n", hipGetErrorString(e), grid);
#endif
}
```

```cpp
#include <hip/hip_runtime.h>
#include <hip/hip_cooperative_groups.h>
#include <cstdio>
#include <cstdint>
namespace cg = cooperative_groups;
namespace pg8 {
#define PG8_LAS __attribute__((address_space(3)))
typedef unsigned short bf16_t;
typedef short bf16x8 __attribute__((ext_vector_type(8)));
typedef float f32x4 __attribute__((ext_vector_type(4)));
typedef unsigned u32x4 __attribute__((ext_vector_type(4)));
constexpr int BM = 256, BK = 64, HALF = 128, HTB = HALF * BK * 2  , STAGE_BYTES = 8 * HTB, NXCD = 8, WGM = 8;

__host__ __device__ __forceinline__ int lds_byte(int r, int c) { const int st = (r >> 4) * 2 + (c >> 5), rr = r & 15, cc = c & 31, ob = rr * 64 + cc * 2; return st * 1024 + (ob ^ (((ob >> 9) & 1) << 5)); }
__host__ __device__ __forceinline__ void stage_rc(int b, int& R, int& C) { const int st = b / 1024, sb = b % 1024, swz = sb ^ (((sb >> 9) & 1) << 5); R = (st >> 1) * 16 + swz / 64; C = (st & 1) * 32 + (swz % 64) / 2; }
__host__ __device__ __forceinline__ int perm32(int rho) { const int n = rho >> 4, i = rho & 15; return 8 * (i >> 2) + 4 * n + (i & 3); }

struct Unit { int pm, pn, idx; };
struct Gemm { const bf16_t* A; const bf16_t* Bt; int M, N, K; };

struct StaticOrder {
    int nM, nN, nwg, G, c;
    __host__ __device__ void init(int M, int N, int G_, int c_) { nM = M / BM; nN = N / BM; nwg = nM * nN; G = G_; c = c_; }
    __host__ __device__ bool next(int i, Unit& u) const {
        const long L = (long)i * G + c; if (L >= nwg) return false;
        int wgid = (int)L; { const int q = nwg / NXCD, r = nwg % NXCD, xcd = wgid % NXCD, off = wgid / NXCD; wgid = (xcd < r ? xcd * (q + 1) : r * (q + 1) + (xcd - r) * q) + off; }
        const int nig = WGM * nN, gid = wgid / nig, fm = gid * WGM, gsz = (nM - fm) < WGM ? (nM - fm) : WGM;
        u.pm = fm + ((wgid % nig) % gsz); u.pn = (wgid % nig) / gsz; u.idx = i; return true;
    }
    __device__ __forceinline__ void a_ready(const Unit&) const {}
    __device__ __forceinline__ void done(const Unit&) const {}
};

typedef float f32x2 __attribute__((ext_vector_type(2))); typedef __bf16 bf16x2_t __attribute__((ext_vector_type(2)));
__device__ __forceinline__ unsigned cvt_pk_bf16(float lo, float hi) { const f32x2 v = {lo, hi}; const bf16x2_t b = __builtin_convertvector(v, bf16x2_t); return __builtin_bit_cast(unsigned, b); }
template <bool SCALE> struct EpiScaleBf16 {
    static constexpr bool PERM = true, AFTER_DRAIN = false;
    bf16_t* O; int ldc; const PG8_LAS float* rs;
    __device__ __forceinline__ void operator()(const f32x4 (&acc)[2][2][4][2], const Unit& u, int wr, int wc, int fr, int fq) const {
        const int rl0 = wr * 64 + fr; const int col0 = u.pn * BM + wc * 32 + 8 * fq;
#pragma unroll
        for (int ai = 0; ai < 2; ++ai)
#pragma unroll
            for (int m = 0; m < 4; ++m) {
                const float sc = SCALE ? rs[256 * u.idx + rl0 + ai * HALF + m * 16] : 1.f;
                bf16_t* rowp = O + (size_t)(u.pm * BM + rl0 + ai * HALF + m * 16) * ldc + col0;
#pragma unroll
                for (int bj = 0; bj < 2; ++bj) { const f32x4 v0 = acc[ai][bj][m][0] * sc, v1 = acc[ai][bj][m][1] * sc;
                    u32x4 w; w.x = cvt_pk_bf16(v0[0], v0[1]); w.y = cvt_pk_bf16(v0[2], v0[3]); w.z = cvt_pk_bf16(v1[0], v1[1]); w.w = cvt_pk_bf16(v1[2], v1[3]);
                    *(u32x4*)(rowp + bj * HALF) = w; }
            }
    }
};
template <class Sched> __device__ __forceinline__ void rs_prepass(PG8_LAS float* rs, const Sched& S, const float* ssp, int tid) {
    Unit u;
    for (int i = 0; S.next(i, u); ++i)
        if (tid < 256) { const f32x4* p = (const f32x4*)(ssp + (size_t)(u.pm * BM + tid) * 16); const f32x4 a = p[0], b = p[1], c = p[2], d = p[3];
            const float s = ((a[0] + a[1]) + (a[2] + a[3])) + ((b[0] + b[1]) + (b[2] + b[3])) + ((c[0] + c[1]) + (c[2] + c[3])) + ((d[0] + d[1]) + (d[2] + d[3]));
            rs[256 * i + tid] = 1.0f / sqrtf(s * (1.0f / 1024.0f) + 1e-6f); }
    __syncthreads();
}
template <bool BASE_F32, bool OUT_F32> struct EpiResidual {
    static constexpr bool PERM = true, AFTER_DRAIN = false;
    const void* base; void* out; float* ssp; int ldc;
    __device__ __forceinline__ void operator()(const f32x4 (&acc)[2][2][4][2], const Unit& u, int wr, int wc, int fr, int fq) const {
        const int row0 = u.pm * BM + wr * 64 + fr; const int col0 = u.pn * BM + wc * 32 + 8 * fq;
#pragma unroll
        for (int ai = 0; ai < 2; ++ai)
#pragma unroll
          for (int mh = 0; mh < 2; ++mh) {
            u32x4 pb[2][2]; f32x4 fb[2][2][2];
#pragma unroll
            for (int m2 = 0; m2 < 2; ++m2)
#pragma unroll
                for (int bj = 0; bj < 2; ++bj) { const size_t off = (size_t)(row0 + ai * HALF + (2 * mh + m2) * 16) * ldc + col0 + bj * HALF;
                    if (BASE_F32) { fb[m2][bj][0] = *(const f32x4*)((const float*)base + off); fb[m2][bj][1] = *(const f32x4*)((const float*)base + off + 4); }
                    else pb[m2][bj] = *(const u32x4*)((const bf16_t*)base + off); }
#pragma unroll
            for (int m2 = 0; m2 < 2; ++m2) {
                const int m = 2 * mh + m2, row = row0 + ai * HALF + m * 16;
                float ss = 0.f;
#pragma unroll
                for (int bj = 0; bj < 2; ++bj) { const size_t off = (size_t)row * ldc + col0 + bj * HALF;
                    f32x4 b0, b1;
                    if (BASE_F32) { b0 = fb[m2][bj][0]; b1 = fb[m2][bj][1]; }
                    else { const u32x4 w = pb[m2][bj];
                        b0 = (f32x4){__uint_as_float(w.x << 16), __uint_as_float(w.x & 0xffff0000u), __uint_as_float(w.y << 16), __uint_as_float(w.y & 0xffff0000u)};
                        b1 = (f32x4){__uint_as_float(w.z << 16), __uint_as_float(w.z & 0xffff0000u), __uint_as_float(w.w << 16), __uint_as_float(w.w & 0xffff0000u)}; }
                    const f32x4 o0 = b0 + acc[ai][bj][m][0], o1 = b1 + acc[ai][bj][m][1];
                    ss += ((o0[0] * o0[0] + o0[1] * o0[1]) + (o0[2] * o0[2] + o0[3] * o0[3])) + ((o1[0] * o1[0] + o1[1] * o1[1]) + (o1[2] * o1[2] + o1[3] * o1[3]));
                    if (OUT_F32) { *(f32x4*)((float*)out + off) = o0; *(f32x4*)((float*)out + off + 4) = o1; }
                    else { u32x4 w; w.x = cvt_pk_bf16(o0[0], o0[1]); w.y = cvt_pk_bf16(o0[2], o0[3]); w.z = cvt_pk_bf16(o1[0], o1[1]); w.w = cvt_pk_bf16(o1[2], o1[3]);
                        *(u32x4*)((bf16_t*)out + off) = w; } }
                ss += __shfl_xor(ss, 16); ss += __shfl_xor(ss, 32);
                if (fq == 0) ssp[(size_t)row * 16 + u.pn * 4 + wc] = ss;
            }
            asm volatile("" ::: "memory");
          }
    }
};
template <class Epi, class Sched, bool ALIGN_EPI = false, bool SP2 = false>
__device__ __forceinline__ void gemm_phase(PG8_LAS unsigned char* lds, const Gemm g, const Sched& S, const Epi& E) {
    int tid_ = threadIdx.x; asm volatile("" : "+v"(tid_));
    const int tid = tid_, wid = __builtin_amdgcn_readfirstlane(tid >> 6), lane = tid & 63, wr = wid >> 2, wc = wid & 3, fr = lane & 15, fq = lane >> 4;
    const int K = g.K, nt = K / BK;
    unsigned voffA[2], voffB[2];
#pragma unroll
    for (int i = 0; i < 2; ++i) { int R, C; stage_rc(tid * 16 + i * 8192, R, C); const int Rb = Epi::PERM ? ((R & ~31) + perm32(R & 31)) : R;
        voffA[i] = (unsigned)(R * K + C) * 2u; voffB[i] = (unsigned)(Rb * K + C) * 2u; }
    const size_t kstep = (size_t)(BK * 2);
    const size_t hstep = (size_t)HALF * K * 2;
    const size_t tstep = 2 * hstep;
    const unsigned ldsw = (unsigned)wid * 1024u;
    const int aoff = lds_byte(wr * 64 + fr, fq * 8), boff = lds_byte(wc * 32 + fr, fq * 8);
#define PG8_SA(b, h) (((b) * 2 + (h)) * HTB)
#define PG8_SB(b, h) ((4 + (b) * 2 + (h)) * HTB)
#define PG8_STAGE(bufoff, gbase, voff) do { _Pragma("unroll") for (int _i = 0; _i < 2; ++_i) \
        __builtin_amdgcn_global_load_lds((const unsigned*)((const char*)(gbase) + (voff)[_i]), (PG8_LAS unsigned*)(lds + (bufoff) + ldsw + _i * 8192), 16, 0, 0); } while (0)
#define PG8_LDA(dst, b, h) do { _Pragma("unroll") for (int m = 0; m < 4; ++m) _Pragma("unroll") for (int k = 0; k < 2; ++k) dst[m][k] = *(const PG8_LAS bf16x8*)(lds + PG8_SA(b, h) + aoff + m * 2048 + k * 1024); } while (0)
#define PG8_LDB(dst, b, h) do { _Pragma("unroll") for (int n = 0; n < 2; ++n) _Pragma("unroll") for (int k = 0; k < 2; ++k) dst[n][k] = *(const PG8_LAS bf16x8*)(lds + PG8_SB(b, h) + boff + n * 2048 + k * 1024); } while (0)
#define PG8_MMA(ai, bj, At, Bt) do { __builtin_amdgcn_s_setprio(1); _Pragma("unroll") for (int m = 0; m < 4; ++m) _Pragma("unroll") for (int n = 0; n < 2; ++n) _Pragma("unroll") for (int k = 0; k < 2; ++k) \
        acc[ai][bj][m][n] = __builtin_amdgcn_mfma_f32_16x16x32_bf16(Bt[n][k], At[m][k], acc[ai][bj][m][n], 0, 0, 0); __builtin_amdgcn_s_setprio(0); } while (0)
#define PG8_WAIT_V(n) asm volatile("s_waitcnt vmcnt(" #n ")" ::: "memory")
#define PG8_WAIT_L(n) asm volatile("s_waitcnt lgkmcnt(" #n ")" ::: "memory")
#define PG8_BAR __builtin_amdgcn_s_barrier()
#define PG8_SCHED __builtin_amdgcn_sched_barrier(0)
    Unit cur, nxt; int ui = 0;
    if (!S.next(0, cur)) return;
    f32x4 acc[2][2][4][2];
#pragma unroll
    for (int a = 0; a < 2; ++a)
#pragma unroll
        for (int b = 0; b < 2; ++b)
#pragma unroll
            for (int m = 0; m < 4; ++m)
#pragma unroll
                for (int n = 0; n < 2; ++n) acc[a][b][m][n] = (f32x4){0.f, 0.f, 0.f, 0.f};
    bf16x8 At[4][2], B0[2][2], B1[2][2];
    const char* cA = (const char*)g.A + (size_t)cur.pm * tstep; const char* cB = (const char*)g.Bt + (size_t)cur.pn * tstep;
    S.a_ready(cur);
    if constexpr (SP2) {
        PG8_STAGE(PG8_SB(0, 0), cB, voffB); PG8_STAGE(PG8_SB(0, 1), cB + hstep, voffB); PG8_STAGE(PG8_SA(0, 0), cA, voffA); PG8_STAGE(PG8_SA(0, 1), cA + hstep, voffA);
        if (wr == 1) PG8_BAR;
        PG8_WAIT_V(2); PG8_BAR;
        PG8_STAGE(PG8_SB(1, 0), cB + kstep, voffB); PG8_STAGE(PG8_SA(1, 0), cA + kstep, voffA); PG8_STAGE(PG8_SB(1, 1), cB + hstep + kstep, voffB);
        PG8_WAIT_V(6); PG8_BAR;
    } else {
        PG8_STAGE(PG8_SB(0, 0), cB, voffB); PG8_STAGE(PG8_SA(0, 0), cA, voffA); PG8_STAGE(PG8_SB(0, 1), cB + hstep, voffB); PG8_STAGE(PG8_SA(0, 1), cA + hstep, voffA);
        if (wr == 1) PG8_BAR;
        PG8_WAIT_V(4); PG8_BAR;
        PG8_STAGE(PG8_SB(1, 0), cB + kstep, voffB); PG8_STAGE(PG8_SA(1, 0), cA + kstep, voffA); PG8_STAGE(PG8_SB(1, 1), cB + hstep + kstep, voffB);
        PG8_WAIT_V(6); PG8_BAR;
    }
    for (;;) {
        const bool has_next = S.next(ui + 1, nxt);
        const char* nA = has_next ? (const char*)g.A + (size_t)nxt.pm * tstep : cA; const char* nB = has_next ? (const char*)g.Bt + (size_t)nxt.pn * tstep : cB;
        for (int t = 0; t < nt; t += 2) {
            const bool last = (t == nt - 2);
            const char* a1 = cA + (size_t)(t + 1) * kstep;
            const char* a2 = last ? nA : cA + (size_t)(t + 2) * kstep; const char* b2 = last ? nB : cB + (size_t)(t + 2) * kstep;
            const char* a3 = a2 + kstep; const char* b3 = b2 + kstep;
            if (last && has_next) S.a_ready(nxt);
            if constexpr (SP2) {
            PG8_LDB(B0, 0, 0); PG8_LDB(B1, 0, 1); PG8_SCHED; PG8_LDA(At, 0, 0); PG8_STAGE(PG8_SA(1, 1), a1 + hstep, voffA);
            PG8_WAIT_V(8); PG8_WAIT_L(0); PG8_BAR; PG8_MMA(0, 0, At, B0); PG8_MMA(0, 1, At, B1); PG8_BAR; PG8_SCHED;
            PG8_LDA(At, 0, 1); PG8_STAGE(PG8_SB(0, 0), b2, voffB); PG8_STAGE(PG8_SB(0, 1), b2 + hstep, voffB); PG8_STAGE(PG8_SA(0, 0), a2, voffA);
            PG8_WAIT_V(8); PG8_WAIT_L(0); PG8_BAR; PG8_MMA(1, 0, At, B0); PG8_MMA(1, 1, At, B1); PG8_BAR; PG8_SCHED;
            PG8_LDB(B0, 1, 0); PG8_LDB(B1, 1, 1); PG8_SCHED; PG8_LDA(At, 1, 0); PG8_STAGE(PG8_SA(0, 1), a2 + hstep, voffA);
            PG8_WAIT_V(8); PG8_WAIT_L(0); PG8_BAR; PG8_MMA(0, 0, At, B0); PG8_MMA(0, 1, At, B1); PG8_BAR; PG8_SCHED;
            PG8_LDA(At, 1, 1); PG8_STAGE(PG8_SB(1, 0), b3, voffB); PG8_STAGE(PG8_SB(1, 1), b3 + hstep, voffB); PG8_STAGE(PG8_SA(1, 0), a3, voffA);
            PG8_WAIT_V(8); PG8_WAIT_L(0); PG8_BAR; PG8_MMA(1, 0, At, B0); PG8_MMA(1, 1, At, B1); PG8_BAR; PG8_SCHED;
            } else {
            PG8_LDB(B0, 0, 0); PG8_SCHED; PG8_LDA(At, 0, 0); PG8_STAGE(PG8_SA(1, 1), a1 + hstep, voffA);
            PG8_WAIT_L(8); PG8_BAR; PG8_WAIT_L(0); PG8_MMA(0, 0, At, B0); PG8_BAR; PG8_SCHED;
            PG8_LDB(B1, 0, 1); PG8_STAGE(PG8_SB(0, 0), b2, voffB);
            PG8_BAR; PG8_WAIT_L(0); PG8_MMA(0, 1, At, B1); PG8_BAR;
            PG8_LDA(At, 0, 1); PG8_STAGE(PG8_SA(0, 0), a2, voffA);
            PG8_BAR; PG8_WAIT_L(0); PG8_MMA(1, 0, At, B0); PG8_BAR; PG8_SCHED;
            PG8_STAGE(PG8_SB(0, 1), b2 + hstep, voffB);
            PG8_WAIT_V(6); PG8_BAR; PG8_MMA(1, 1, At, B1); PG8_BAR;
            PG8_LDB(B0, 1, 0); PG8_SCHED; PG8_LDA(At, 1, 0); PG8_STAGE(PG8_SA(0, 1), a2 + hstep, voffA);
            PG8_WAIT_L(8); PG8_BAR; PG8_WAIT_L(0); PG8_MMA(0, 0, At, B0); PG8_BAR; PG8_SCHED;
            PG8_LDB(B1, 1, 1); PG8_STAGE(PG8_SB(1, 0), b3, voffB);
            PG8_BAR; PG8_WAIT_L(0); PG8_MMA(0, 1, At, B1); PG8_BAR;
            PG8_LDA(At, 1, 1); PG8_STAGE(PG8_SA(1, 0), a3, voffA);
            PG8_BAR; PG8_WAIT_L(0); PG8_MMA(1, 0, At, B0); PG8_BAR; PG8_SCHED;
            PG8_STAGE(PG8_SB(1, 1), b3 + hstep, voffB);
            PG8_WAIT_V(6); PG8_BAR; PG8_MMA(1, 1, At, B1); PG8_BAR;
            }
        }
        if constexpr (ALIGN_EPI) { if (wr == 0) PG8_BAR; }
        if constexpr (!Epi::AFTER_DRAIN) { E(acc, cur, wr, wc, fr, fq); S.done(cur); }
        if (!has_next) break;
#pragma unroll
        for (int a = 0; a < 2; ++a)
#pragma unroll
            for (int b = 0; b < 2; ++b)
#pragma unroll
                for (int m = 0; m < 4; ++m)
#pragma unroll
                    for (int n = 0; n < 2; ++n) acc[a][b][m][n] = (f32x4){0.f, 0.f, 0.f, 0.f};
        cur = nxt; cA = nA; cB = nB; ++ui;
        if constexpr (ALIGN_EPI) { if (wr == 1) PG8_BAR; }
    }
    PG8_WAIT_V(0);
    if constexpr (!ALIGN_EPI) { if (wr == 0) PG8_BAR; }
    PG8_BAR;
    if constexpr (Epi::AFTER_DRAIN) { E.fused(acc, cur, wr, wc, fr, fq, lds, wid, lane); S.done(cur); }
#undef PG8_SA
#undef PG8_SB
#undef PG8_STAGE
#undef PG8_LDA
#undef PG8_LDB
#undef PG8_MMA
#undef PG8_WAIT_V
#undef PG8_WAIT_L
#undef PG8_BAR
#undef PG8_SCHED
}
}

constexpr int D = 1024, BATCH = 4, SEQ = 8192, MTOK = BATCH * SEQ, NCH = SEQ / 64, MEMLEN = 256;
constexpr int EIN = 3328, OIN = 4096;
constexpr float EPS = 1e-6f;
constexpr int C_AQ = 0, C_AK = 512, C_AV = 640, C_AG = 768, C_BQ = 1280, C_BK = 1792, C_BV = 2304, C_BG = 2816;
constexpr int NWAVES = 8, NTHR = 512;
constexpr size_t MiB = 1u << 20;
constexpr size_t WS_WEIN = 1 * MiB, WS_WEOUT = 8 * MiB, WS_WOIN = 10 * MiB, WS_WOOUT = 18 * MiB, WS_WQ = 20 * MiB, WS_WKV = 24 * MiB, WS_WO = 32 * MiB;
constexpr size_t WS_MEMN = 36 * MiB, WS_KV = 40 * MiB, WS_ROT = 48 * MiB, WS_SSP = 52 * MiB;
constexpr size_t WS_XB = 56 * MiB;
constexpr size_t WS_BIG = 120 * MiB;
constexpr size_t WS_BUFA = 376 * MiB;
constexpr size_t WS_BUFB = 440 * MiB;
constexpr size_t WS_END = 504 * MiB;
constexpr int LDS_BYTES = 147456;

#define LAS __attribute__((address_space(3)))
typedef unsigned short bf16;
typedef short bf16x8 __attribute__((ext_vector_type(8)));
typedef short s16x4 __attribute__((ext_vector_type(4)));
typedef float f32x2 __attribute__((ext_vector_type(2)));
typedef float f32x4 __attribute__((ext_vector_type(4)));
typedef float f32x16 __attribute__((ext_vector_type(16)));
typedef unsigned u32x2 __attribute__((ext_vector_type(2)));
typedef unsigned u32x4 __attribute__((ext_vector_type(4)));

__device__ __forceinline__ unsigned pk2(float lo, float hi) { return pg8::cvt_pk_bf16(lo, hi); }
__device__ __forceinline__ float bflo(unsigned w) { return __uint_as_float(w << 16); }
__device__ __forceinline__ float bfhi(unsigned w) { return __uint_as_float(w & 0xffff0000u); }
__device__ __forceinline__ int crow(int r, int hi) { return (r & 3) + 8 * (r >> 2) + 4 * hi; }
__device__ __forceinline__ float wave_sum(float v) {
#pragma unroll
    for (int o = 1; o < 64; o <<= 1) v += __shfl_xor(v, o);
    return v;
}
__device__ __forceinline__ float silu(float x) { return x / (1.0f + __expf(-x)); }
__device__ __forceinline__ s16x4 trd(const LAS bf16* p) { return __builtin_bit_cast(s16x4, __builtin_amdgcn_ds_read_tr16_b64_v4i16((LAS s16x4*)p)); }
__device__ __forceinline__ bf16x8 tr_frag(const LAS bf16* T, int ld, int k0, int n0, int lane) {
    const int g4 = lane >> 4, li = lane & 15, q = li >> 2, p = li & 3, hi = g4 >> 1;
    const LAS bf16* a = T + (k0 + 4 * hi + q) * ld + n0 + 16 * (g4 & 1) + 4 * p;
    const s16x4 lo = trd(a), up = trd(a + 8 * ld);
    return (bf16x8){lo[0], lo[1], lo[2], lo[3], up[0], up[1], up[2], up[3]};
}
__device__ __forceinline__ bf16x8 pack8(float a0, float a1, float a2, float a3, float a4, float a5, float a6, float a7) {
    u32x4 w; w.x = pk2(a0, a1); w.y = pk2(a2, a3); w.z = pk2(a4, a5); w.w = pk2(a6, a7); return __builtin_bit_cast(bf16x8, w);
}
__device__ __forceinline__ int launder(int v) { asm volatile("" : "+v"(v)); return v; }
#define MFMA32(a, b, c) __builtin_amdgcn_mfma_f32_32x32x16_bf16((a), (b), (c), 0, 0, 0)

#define XB_TMO      128
#define XB_XCNT(j)  (256  + 64 * (j))
#define XB_XSUB(j)  (1280 + 64 * (j))
#define XB_XGEN(j)  (2304 + 64 * (j))
#define XB_TOP      3328
#define XB_TOPGEN   3392
#define XCD_BAR_WORDS 3456
#define XB_SPIN_CAP (1u << 18)

__device__ __forceinline__ unsigned xb_ld(unsigned* p)              { return __hip_atomic_load(p, __ATOMIC_RELAXED, __HIP_MEMORY_SCOPE_AGENT); }
__device__ __forceinline__ unsigned xb_add(unsigned* p, unsigned v) { return __hip_atomic_fetch_add(p, v, __ATOMIC_RELAXED, __HIP_MEMORY_SCOPE_AGENT); }
__device__ __forceinline__ unsigned xb_xcc_id() { return (unsigned)__builtin_amdgcn_s_getreg((3 << 11) | 20) & 0xFu; }
#define XB_SPIN(cond, bar) do { unsigned _sp = 0; while (cond) { __builtin_amdgcn_s_sleep(1); \
    if ((++_sp & 255u) == 0u) { if (xb_ld(&(bar)[XB_TMO])) break; if (_sp > XB_SPIN_CAP) { atomicAdd(&(bar)[XB_TMO], 1u); break; } } } } while (0)

struct XcdBarrier {
    unsigned* bar; unsigned x;
    volatile LAS unsigned* st;
};

__device__ __forceinline__ XcdBarrier xcd_barrier_post(unsigned* bar, volatile LAS unsigned* st) {
    XcdBarrier b; b.bar = bar; b.x = xb_xcc_id(); b.st = st;
    if (threadIdx.x == 0) (void)xb_add(&bar[XB_XCNT(b.x)], 1u);
    return b;
}
__device__ __forceinline__ void xcd_barrier_complete(unsigned* bar, unsigned x, unsigned& nloc, unsigned& nx) {
    const unsigned G = gridDim.x * gridDim.y * gridDim.z;
    unsigned sum, cnt, mine, sp = 0u;
    for (;;) {
        sum = 0u; cnt = 0u; mine = 0u;
#pragma unroll
        for (unsigned j = 0; j < 16; ++j) { const unsigned c = xb_ld(&bar[XB_XCNT(j)]); sum += c; cnt += (c > 0u) ? 1u : 0u; mine = (j == x) ? c : mine; }
        if (sum == G) break;
        __builtin_amdgcn_s_sleep(1);
        if ((++sp & 255u) == 0u) { if (xb_ld(&bar[XB_TMO])) break; if (sp > XB_SPIN_CAP) { atomicAdd(&bar[XB_TMO], 1u); break; } }
    }
    nloc = mine > 0u ? mine : 1u; nx = cnt > 0u ? cnt : 1u;
}

__device__ __forceinline__ void xcd_barrier(const XcdBarrier& b) {
    asm volatile("s_waitcnt vmcnt(0)" ::: "memory");
    __syncthreads();
    if (threadIdx.x == 0) {
        unsigned* bar = b.bar;
        __builtin_amdgcn_s_waitcnt(0);
        unsigned nloc = b.st[0], nx = b.st[1];
        if (nloc == 0u) { xcd_barrier_complete(bar, b.x, nloc, nx); b.st[0] = nloc; b.st[1] = nx; }
        const unsigned old = xb_add(&bar[XB_XSUB(b.x)], 1u);
        const unsigned gen = old / nloc;
        if (old + 1u == (gen + 1u) * nloc) {
            __builtin_amdgcn_fence(__ATOMIC_RELEASE, "agent");
            asm volatile("s_waitcnt vmcnt(0)" ::: "memory");
            const unsigned og = xb_add(&bar[XB_TOP], 1u);
            const unsigned tg = og / nx;
            if (og + 1u == (tg + 1u) * nx) xb_add(&bar[XB_TOPGEN], 1u);
            else XB_SPIN(xb_ld(&bar[XB_TOPGEN]) == tg, bar);
            __builtin_amdgcn_fence(__ATOMIC_ACQUIRE, "agent");
            xb_add(&bar[XB_XGEN(b.x)], 1u);
            asm volatile("s_waitcnt vmcnt(0)" ::: "memory");
        } else {
            XB_SPIN(xb_ld(&bar[XB_XGEN(b.x)]) == gen, bar);
            __builtin_amdgcn_fence(__ATOMIC_ACQUIRE, "agent");
            asm volatile("s_waitcnt vmcnt(0)" ::: "memory");
        }
    }
    __syncthreads();
}

constexpr int XB_WS_OFF = 4096, XB_LDS_OFF = 147200;
struct Args { const float* in[17]; float* out; unsigned char* ws; int ph_lo, ph_hi; };
struct Frame {
    LAS unsigned char* lds; int tid, lane, wave, G, bid;
    const float *x, *mem, *e_norm, *e_w_in, *e_sink, *e_w_out, *o_norm, *o_w_in, *o_conv_w, *o_conv_b, *o_w_out, *c_norm, *c_mem_norm, *c_wq, *c_wkv, *c_wo, *final_norm;
    float* out; unsigned char* ws;
};

__device__ __forceinline__ void p0_transpose_item(const float* W, const float* gain, int K, int N, bf16* WT, LAS float* scr, int item, int lane) {
    const int nblk = N / 32, kb = item / nblk, nb = item % nblk, k0 = 64 * kb, n0 = 32 * nb;
#pragma unroll 8
    for (int i = 0; i < 32; ++i) { const int kk = 2 * i + (lane >> 5); float w = W[(size_t)(k0 + kk) * N + n0 + (lane & 31)]; if (gain) w *= gain[k0 + kk]; scr[kk * 33 + (lane & 31)] = w; }
    asm volatile("s_waitcnt lgkmcnt(0)" ::: "memory");
    const int c = lane & 7;
#pragma unroll
    for (int j = 0; j < 4; ++j) { const int n = (lane >> 3) + 8 * j; const LAS float* s = scr + (8 * c) * 33 + n;
        u32x4 o; o.x = pk2(s[0 * 33], s[1 * 33]); o.y = pk2(s[2 * 33], s[3 * 33]); o.z = pk2(s[4 * 33], s[5 * 33]); o.w = pk2(s[6 * 33], s[7 * 33]);
        *(u32x4*)(WT + (size_t)(n0 + n) * K + k0 + 8 * c) = o; }
    asm volatile("s_waitcnt lgkmcnt(0)" ::: "memory");
}
__device__ __forceinline__ void p0_prologue(Frame& F) {
    LAS float* scr = (LAS float*)(F.lds + F.wave * 16384);
    const int gw = F.bid * NWAVES + F.wave, NGW = F.G * NWAVES, lane = F.lane;
    unsigned char* ws = F.ws;
    constexpr int I_EIN = 16 * (EIN / 32), I_SQ = 16 * 32, I_OIN = 16 * (OIN / 32), I_KV = 16 * 64;
    constexpr int NITEMS = I_EIN + I_SQ + I_OIN + I_SQ + 2 * I_SQ + 2 * I_KV + 2 * I_SQ;
    for (int it = gw; it < NITEMS; it += NGW) {
        int r = it;
        if (r < I_EIN) { p0_transpose_item(F.e_w_in, F.e_norm, D, EIN, (bf16*)(ws + WS_WEIN), scr, r, lane); continue; } r -= I_EIN;
        if (r < I_SQ) { p0_transpose_item(F.e_w_out, nullptr, D, D, (bf16*)(ws + WS_WEOUT), scr, r, lane); continue; } r -= I_SQ;
        if (r < I_OIN) { p0_transpose_item(F.o_w_in, F.o_norm, D, OIN, (bf16*)(ws + WS_WOIN), scr, r, lane); continue; } r -= I_OIN;
        if (r < I_SQ) { p0_transpose_item(F.o_w_out, nullptr, D, D, (bf16*)(ws + WS_WOOUT), scr, r, lane); continue; } r -= I_SQ;
        if (r < 2 * I_SQ) { const int l = r / I_SQ; p0_transpose_item(F.c_wq + (size_t)l * D * D, F.c_norm + l * D, D, D, (bf16*)(ws + WS_WQ) + (size_t)l * D * D, scr, r % I_SQ, lane); continue; } r -= 2 * I_SQ;
        if (r < 2 * I_KV) { const int l = r / I_KV; p0_transpose_item(F.c_wkv + (size_t)l * D * 2 * D, nullptr, D, 2 * D, (bf16*)(ws + WS_WKV) + (size_t)l * 2 * D * D, scr, r % I_KV, lane); continue; } r -= 2 * I_KV;
        { const int l = r / I_SQ; p0_transpose_item(F.c_wo + (size_t)l * D * D, nullptr, D, D, (bf16*)(ws + WS_WO) + (size_t)l * D * D, scr, r % I_SQ, lane); }
    }
    for (int it = gw; it < 2 * BATCH * MEMLEN; it += NGW) {
        const int l = it / (BATCH * MEMLEN), row = it % (BATCH * MEMLEN);
        const f32x4* xr = (const f32x4*)(F.mem + (size_t)row * D) + lane; const f32x4* gr = (const f32x4*)(F.c_mem_norm + l * D) + lane;
        f32x4 v[4]; float s = 0.f;
#pragma unroll
        for (int j = 0; j < 4; ++j) { v[j] = xr[64 * j]; s += (v[j][0] * v[j][0] + v[j][1] * v[j][1]) + (v[j][2] * v[j][2] + v[j][3] * v[j][3]); }
        const float rs = 1.0f / sqrtf(wave_sum(s) * (1.0f / D) + EPS);
        u32x2* o8 = (u32x2*)((bf16*)(ws + WS_MEMN) + (size_t)it * D) + lane;
#pragma unroll
        for (int j = 0; j < 4; ++j) { const f32x4 g = gr[64 * j]; u32x2 w; w.x = pk2(v[j][0] * rs * g[0], v[j][1] * rs * g[1]); w.y = pk2(v[j][2] * rs * g[2], v[j][3] * rs * g[3]); o8[64 * j] = w; }
    }
    for (int row = gw; row < MTOK; row += NGW) {
        const f32x4* xr = (const f32x4*)(F.x + (size_t)row * D) + lane;
        f32x4 v[4]; float s = 0.f;
#pragma unroll
        for (int j = 0; j < 4; ++j) { v[j] = xr[64 * j]; s += (v[j][0] * v[j][0] + v[j][1] * v[j][1]) + (v[j][2] * v[j][2] + v[j][3] * v[j][3]); }
        s = wave_sum(s);
        u32x2* o8 = (u32x2*)((bf16*)(ws + WS_XB) + (size_t)row * D) + lane;
#pragma unroll
        for (int j = 0; j < 4; ++j) { u32x2 w; w.x = pk2(v[j][0], v[j][1]); w.y = pk2(v[j][2], v[j][3]); o8[64 * j] = w; }
        if (lane < 16) ((float*)(ws + WS_SSP))[(size_t)row * 16 + lane] = (lane == 0) ? s : 0.f;
    }
    for (int e = F.bid * NTHR + launder(F.tid); e < SEQ * 64; e += F.G * NTHR) {
        const int pos = e >> 6, j = e & 63;
        const float inv = 1.0f / exp2f(((float)j / 63.0f) * 13.287712379549449f);
        const float ang = (float)pos * inv;
        const double a = (double)ang, kk = rint(a * 0.63661977236758134308);
        const float r = (float)fma(-kk, 1.57079632679489661923, a), r2 = r * r;
        const float sn = r + r * r2 * (-1.6666654611e-1f + r2 * (8.3321608736e-3f + r2 * (-1.9515295891e-4f)));
        const float cs = 1.0f - 0.5f * r2 + r2 * r2 * (4.166664568298827e-2f + r2 * (-1.388731625493765e-3f + r2 * 2.443315711809948e-5f));
        const int q = ((int)kk) & 3;
        f32x2 o; o.x = (q == 0) ? cs : (q == 1) ? -sn : (q == 2) ? -cs : sn; o.y = (q == 0) ? sn : (q == 1) ? cs : (q == 2) ? -sn : -cs;
        ((f32x2*)(ws + WS_ROT))[e] = o;
    }
}

constexpr int AKS = 72;
__device__ __forceinline__ void swa_item(Frame& F, int item) {
    const int kvh = item & 1, c = (item >> 1) & (NCH - 1), b = item >> 8;
    const int c0 = c >= 2 ? c - 2 : 0, nch = c - c0 + 1;
    const int tid = launder(F.tid), lane = tid & 63, w = F.wave, r32 = lane & 31, hi = lane >> 5;
    LAS bf16* Ks = (LAS bf16*)F.lds; LAS bf16* Vs = Ks + 192 * AKS;
    const bf16* HC = (const bf16*)(F.ws + WS_BIG);
    const size_t rowbase = (size_t)b * SEQ;
    for (int p = tid; p < nch * 64 * 8; p += NTHR) { const int r = p >> 3, ch = p & 7; const bf16* src = HC + (rowbase + c0 * 64 + r) * EIN + kvh * 64 + ch * 8;
        const u32x4 kx = *(const u32x4*)(src + C_AK), vx = *(const u32x4*)(src + C_AV);
        *(LAS u32x4*)(Ks + r * AKS + ch * 8) = kx; *(LAS u32x4*)(Vs + r * AKS + ch * 8) = vx; }
    const int qh = kvh * 4 + (w >> 1);
    const size_t tok = rowbase + c * 64 + (w & 1) * 32 + r32;
    const bf16* qp = HC + tok * EIN + C_AQ + qh * 64 + hi * 8;
    bf16x8 qf[4];
#pragma unroll
    for (int s = 0; s < 4; ++s) qf[s] = *(const bf16x8*)(qp + 16 * s);
    __syncthreads();
    const int nkb = 2 * nch;
    f32x16 st[6];
#pragma unroll
    for (int kb = 0; kb < 6; ++kb) { st[kb] = (f32x16){};
        if (kb < nkb) {
#pragma unroll
            for (int s = 0; s < 4; ++s) { const bf16x8 a = *(const LAS bf16x8*)(Ks + (32 * kb + r32) * AKS + 16 * s + 8 * hi); st[kb] = MFMA32(a, qf[s], st[kb]); } } }
    float mx = -3.0e38f;
#pragma unroll
    for (int kb = 0; kb < 6; ++kb) if (kb < nkb) {
#pragma unroll
        for (int i = 0; i < 16; ++i) mx = fmaxf(mx, st[kb][i]); }
    mx = fmaxf(mx, __shfl_xor(mx, 32));
    const float sink = F.e_sink[qh];
    const float mref = fmaxf(mx * 0.125f, sink);
    const float L2E = 1.4426950408889634f;
    float sum = 0.f;
#pragma unroll
    for (int kb = 0; kb < 6; ++kb) if (kb < nkb) {
#pragma unroll
        for (int i = 0; i < 16; ++i) { const float p = exp2f((st[kb][i] * 0.125f - mref) * L2E); st[kb][i] = p; sum += p; } }
    sum += __shfl_xor(sum, 32);
    const float inv = 1.0f / (sum + exp2f((sink - mref) * L2E));
    f32x16 o[2]; o[0] = (f32x16){}; o[1] = (f32x16){};
#pragma unroll
    for (int kb = 0; kb < 6; ++kb) if (kb < nkb) {
#pragma unroll
        for (int s = 0; s < 2; ++s) {
            const bf16x8 pf = pack8(st[kb][8 * s + 0] * inv, st[kb][8 * s + 1] * inv, st[kb][8 * s + 2] * inv, st[kb][8 * s + 3] * inv, st[kb][8 * s + 4] * inv, st[kb][8 * s + 5] * inv, st[kb][8 * s + 6] * inv, st[kb][8 * s + 7] * inv);
#pragma unroll
            for (int db = 0; db < 2; ++db) { const bf16x8 vf = tr_frag(Vs, AKS, 32 * kb + 16 * s, 32 * db, lane); o[db] = MFMA32(vf, pf, o[db]); } } }
    const bf16* gp = HC + tok * EIN + C_AG + qh * 64;
    bf16* yp = (bf16*)(F.ws + WS_BUFA) + tok * D + qh * 64;
#pragma unroll
    for (int db = 0; db < 2; ++db)
#pragma unroll
        for (int gi = 0; gi < 4; ++gi) { const int d0 = 32 * db + 8 * gi + 4 * hi; const u32x2 g = *(const u32x2*)(gp + d0);
            u32x2 y; y.x = pk2(o[db][4 * gi + 0] * silu(bflo(g.x)), o[db][4 * gi + 1] * silu(bfhi(g.x))); y.y = pk2(o[db][4 * gi + 2] * silu(bflo(g.y)), o[db][4 * gi + 3] * silu(bfhi(g.y)));
            *(u32x2*)(yp + d0) = y; }
    __syncthreads();
}

constexpr int RKS = 136;
__device__ __forceinline__ float head_lg2(int h) { return log2f(1.0f - exp2f(-5.0f - (float)h)); }
__device__ __forceinline__ void ret1_item(Frame& F, int item) {
    const int h = item & 3, c = (item >> 2) & (NCH - 1), b = item >> 9;
    const int tid = launder(F.tid), lane = tid & 63, w = F.wave, r32 = lane & 31, hi = lane >> 5;
    LAS bf16* Qr = (LAS bf16*)F.lds; LAS bf16* Kr = Qr + 64 * RKS; LAS bf16* Vs = Kr + 64 * RKS; LAS bf16* Vd = Vs + 64 * RKS;
    bf16* HC = (bf16*)(F.ws + WS_BIG);
    const size_t rowbase = (size_t)b * SEQ + (size_t)c * 64;
    const float lg2 = head_lg2(h);
    {
        const int j = tid >> 3, pc = tid & 7;
        bf16* rowp = HC + (rowbase + j) * EIN;
        const u32x4 q1 = *(const u32x4*)(rowp + C_BQ + h * 128 + 8 * pc), q2 = *(const u32x4*)(rowp + C_BQ + h * 128 + 64 + 8 * pc);
        const u32x4 k1 = *(const u32x4*)(rowp + C_BK + h * 128 + 8 * pc), k2 = *(const u32x4*)(rowp + C_BK + h * 128 + 64 + 8 * pc);
        const u32x4 v1 = *(const u32x4*)(rowp + C_BV + h * 128 + 16 * pc), v2 = *(const u32x4*)(rowp + C_BV + h * 128 + 16 * pc + 8);
        const f32x4* rt = (const f32x4*)((const f32x2*)(F.ws + WS_ROT) + (size_t)(c * 64 + j) * 64 + 8 * pc);
        u32x4 qa, qb, ka, kb;
        const float ksc = 0.08838834764831845f;
#pragma unroll
        for (int e = 0; e < 4; ++e) { const f32x4 cs = rt[e];
            const float a0 = bflo(q1[e]), a1 = bfhi(q1[e]), b0 = bflo(q2[e]), b1 = bfhi(q2[e]);
            qa[e] = pk2(a0 * cs[0] - b0 * cs[1], a1 * cs[2] - b1 * cs[3]); qb[e] = pk2(a0 * cs[1] + b0 * cs[0], a1 * cs[3] + b1 * cs[2]);
            const float c0 = bflo(k1[e]), c1 = bfhi(k1[e]), d0 = bflo(k2[e]), d1 = bfhi(k2[e]);
            ka[e] = pk2((c0 * cs[0] - d0 * cs[1]) * ksc, (c1 * cs[2] - d1 * cs[3]) * ksc); kb[e] = pk2((c0 * cs[1] + d0 * cs[0]) * ksc, (c1 * cs[3] + d1 * cs[2]) * ksc); }
        *(LAS u32x4*)(Qr + j * RKS + 8 * pc) = qa; *(LAS u32x4*)(Qr + j * RKS + 64 + 8 * pc) = qb;
        *(LAS u32x4*)(Kr + j * RKS + 8 * pc) = ka; *(LAS u32x4*)(Kr + j * RKS + 64 + 8 * pc) = kb;
        *(u32x4*)(rowp + C_BQ + h * 128 + 8 * pc) = qa; *(u32x4*)(rowp + C_BQ + h * 128 + 64 + 8 * pc) = qb;
        *(LAS u32x4*)(Vs + j * RKS + 16 * pc) = v1; *(LAS u32x4*)(Vs + j * RKS + 16 * pc + 8) = v2;
        const float kd = exp2f(lg2 * (float)(63 - j));
        u32x4 w1, w2;
#pragma unroll
        for (int e = 0; e < 4; ++e) { w1[e] = pk2(bflo(v1[e]) * kd, bfhi(v1[e]) * kd); w2[e] = pk2(bflo(v2[e]) * kd, bfhi(v2[e]) * kd); }
        *(LAS u32x4*)(Vd + j * RKS + 16 * pc) = w1; *(LAS u32x4*)(Vd + j * RKS + 16 * pc + 8) = w2;
    }
    __syncthreads();
    const int ib = w & 1, db = w >> 1;
    f32x16 st[2];
#pragma unroll
    for (int jb = 0; jb < 2; ++jb) { st[jb] = (f32x16){};
#pragma unroll
        for (int s = 0; s < 8; ++s) { const bf16x8 a = *(const LAS bf16x8*)(Kr + (32 * jb + r32) * RKS + 16 * s + 8 * hi); const bf16x8 q = *(const LAS bf16x8*)(Qr + (32 * ib + r32) * RKS + 16 * s + 8 * hi);
            st[jb] = MFMA32(a, q, st[jb]); } }
    const int iloc = 32 * ib + r32;
#pragma unroll
    for (int jb = 0; jb < 2; ++jb)
#pragma unroll
        for (int i = 0; i < 16; ++i) { const int j = 32 * jb + crow(i, hi); const int dd = iloc > j ? iloc - j : j - iloc; st[jb][i] *= exp2f(lg2 * (float)dd); }
    f32x16 o = (f32x16){};
#pragma unroll
    for (int jb = 0; jb < 2; ++jb)
#pragma unroll
        for (int s = 0; s < 2; ++s) {
            const bf16x8 pf = pack8(st[jb][8 * s + 0], st[jb][8 * s + 1], st[jb][8 * s + 2], st[jb][8 * s + 3], st[jb][8 * s + 4], st[jb][8 * s + 5], st[jb][8 * s + 6], st[jb][8 * s + 7]);
            const bf16x8 vf = tr_frag(Vs, RKS, 32 * jb + 16 * s, 32 * db, lane);
            o = MFMA32(vf, pf, o); }
    {
        float* op = (float*)(F.ws + WS_XB) + (rowbase + iloc) * 512 + h * 128 + 32 * db + 4 * hi;
#pragma unroll
        for (int gi = 0; gi < 4; ++gi) *(f32x4*)(op + 8 * gi) = (f32x4){o[4 * gi], o[4 * gi + 1], o[4 * gi + 2], o[4 * gi + 3]};
    }
    const int rb = w >> 1;
    f32x16 kv[2]; kv[0] = (f32x16){}; kv[1] = (f32x16){};
#pragma unroll
    for (int s = 0; s < 4; ++s) { const bf16x8 af = tr_frag(Kr, RKS, 16 * s, 32 * rb, lane);
#pragma unroll
        for (int t = 0; t < 2; ++t) { const bf16x8 bf = tr_frag(Vd, RKS, 16 * s, 32 * (2 * (w & 1) + t), lane); kv[t] = MFMA32(af, bf, kv[t]); } }
    bf16* stp = (bf16*)(F.ws + WS_BUFB) + ((size_t)(b * NCH + c) * 4 + h) * 16384;
#pragma unroll
    for (int t = 0; t < 2; ++t) { const int dv = 32 * (2 * (w & 1) + t) + r32;
#pragma unroll
        for (int gi = 0; gi < 4; ++gi) { const int dk = 32 * rb + 8 * gi + 4 * hi; u32x2 y; y.x = pk2(kv[t][4 * gi], kv[t][4 * gi + 1]); y.y = pk2(kv[t][4 * gi + 2], kv[t][4 * gi + 3]);
            *(u32x2*)(stp + dv * 128 + dk) = y; } }
    __syncthreads();
}

__device__ __forceinline__ void scan_phase(Frame& F) {
    unsigned* ST = (unsigned*)(F.ws + WS_BUFB);
    for (int e = F.bid * NTHR + launder(F.tid); e < BATCH * 4 * 8192; e += F.G * NTHR) {
        const int idx = e & 8191, h = (e >> 13) & 3, b = e >> 15;
        const float dec = exp2f(head_lg2(h) * 64.0f);
        unsigned* p = ST + ((size_t)(b * NCH) * 4 + h) * 8192 + idx;
        float s0 = 0.f, s1 = 0.f;
#pragma unroll 8
        for (int c = 0; c < NCH; ++c) { const unsigned kvw = p[(size_t)c * 4 * 8192]; p[(size_t)c * 4 * 8192] = pk2(s0, s1); s0 = s0 * dec + bflo(kvw); s1 = s1 * dec + bfhi(kvw); }
    }
}

__device__ __forceinline__ void ret2_item(Frame& F, int item) {
    const int h = item & 3, c = (item >> 2) & (NCH - 1), b = item >> 9;
    const int lane = launder(F.lane), w = F.wave, r32 = lane & 31, hi = lane >> 5;
    const int ib = w & 1, db = w >> 1, iloc = 32 * ib + r32;
    LAS float* part = (LAS float*)F.lds;
    const bf16* HC = (const bf16*)(F.ws + WS_BIG);
    const size_t tok = (size_t)b * SEQ + (size_t)c * 64 + iloc;
    const bf16* stp = (const bf16*)(F.ws + WS_BUFB) + ((size_t)(b * NCH + c) * 4 + h) * 16384 + (size_t)(32 * db + r32) * 128 + 8 * hi;
    const bf16* qp = HC + tok * EIN + C_BQ + h * 128 + 8 * hi;
    f32x16 oc = (f32x16){};
#pragma unroll
    for (int s = 0; s < 8; ++s) { const bf16x8 a = *(const bf16x8*)(stp + 16 * s); const bf16x8 q = *(const bf16x8*)(qp + 16 * s); oc = MFMA32(a, q, oc); }
    const float qdec = exp2f(head_lg2(h) * (float)(iloc + 1));
    const float* op = (const float*)(F.ws + WS_XB) + tok * 512 + h * 128 + 32 * db + 4 * hi;
    float ss = 0.f;
#pragma unroll
    for (int gi = 0; gi < 4; ++gi) { const f32x4 oi = *(const f32x4*)(op + 8 * gi);
#pragma unroll
        for (int e = 0; e < 4; ++e) { const float v = oi[e] + oc[4 * gi + e] * qdec; oc[4 * gi + e] = v; ss += v * v; } }
    ss += __shfl_xor(ss, 32);
    if (hi == 0) part[iloc * 4 + db] = ss;
    __syncthreads();
    const f32x4 pp = *(const LAS f32x4*)(part + iloc * 4);
    const float rs = 1.0f / sqrtf(((pp[0] + pp[1]) + (pp[2] + pp[3])) * (1.0f / 128.0f) + EPS);
    const bf16* gp = HC + tok * EIN + C_BG + h * 128 + 32 * db + 4 * hi;
    bf16* yp = (bf16*)(F.ws + WS_BUFA) + tok * D + 512 + h * 128 + 32 * db + 4 * hi;
#pragma unroll
    for (int gi = 0; gi < 4; ++gi) { const u32x2 g = *(const u32x2*)(gp + 8 * gi);
        u32x2 y; y.x = pk2(oc[4 * gi + 0] * rs * silu(bflo(g.x)), oc[4 * gi + 1] * rs * silu(bfhi(g.x))); y.y = pk2(oc[4 * gi + 2] * rs * silu(bflo(g.y)), oc[4 * gi + 3] * rs * silu(bfhi(g.y)));
        *(u32x2*)(yp + 8 * gi) = y; }
    __syncthreads();
}

constexpr int XKS = 264;
__device__ __forceinline__ void xattn_unit(Frame& F, int layer, int unit) {
    const int h = unit & 3, rt = unit >> 2, b = rt >> 5;
    const int tid = launder(F.tid), lane = tid & 63, w = F.wave, r32 = lane & 31, hi = lane >> 5;
    LAS bf16* buf = (LAS bf16*)F.lds;
    const bf16* Kg = (const bf16*)(F.ws + WS_KV) + ((size_t)layer * BATCH * MEMLEN + (size_t)b * MEMLEN) * 2048 + h * 256;
    const bf16* Vg = Kg + 1024;
    const size_t row = (size_t)rt * 256 + w * 32 + r32;
    const bf16* qp = (const bf16*)(F.ws + WS_BUFB) + row * D + h * 256 + 8 * hi;
    bf16x8 qf[8];
    LAS bf16* qs = (LAS bf16*)(F.lds + 36864) + w * (32 * 136) + r32 * 136 + 8 * hi;
#pragma unroll
    for (int s = 0; s < 8; ++s) qf[s] = *(const bf16x8*)(qp + 16 * s);
#pragma unroll
    for (int s = 0; s < 8; ++s) { const bf16x8 t = *(const bf16x8*)(qp + 128 + 16 * s); *(LAS bf16x8*)(qs + 16 * s) = t; }
    f32x16 st[8];
#pragma unroll
    for (int kblk = 0; kblk < 4; ++kblk) {
        __syncthreads();
#pragma unroll
        for (int i = 0; i < 4; ++i) { const int p = tid + i * NTHR, r = p >> 5, ch = p & 31; *(LAS u32x4*)(buf + r * XKS + ch * 8) = *(const u32x4*)(Kg + (size_t)(kblk * 64 + r) * 2048 + ch * 8); }
        __syncthreads();
#pragma unroll
        for (int kk = 0; kk < 2; ++kk) { f32x16 acc = (f32x16){};
#pragma unroll
            for (int s = 0; s < 8; ++s) { const bf16x8 a = *(const LAS bf16x8*)(buf + (32 * kk + r32) * XKS + 16 * s + 8 * hi); acc = MFMA32(a, qf[s], acc); }
#pragma unroll
            for (int s = 0; s < 8; ++s) { const bf16x8 a = *(const LAS bf16x8*)(buf + (32 * kk + r32) * XKS + 128 + 16 * s + 8 * hi); const bf16x8 q = *(const LAS bf16x8*)(qs + 16 * s); acc = MFMA32(a, q, acc); }
            st[2 * kblk + kk] = acc; }
    }
    float mx = -3.0e38f;
#pragma unroll
    for (int kb = 0; kb < 8; ++kb)
#pragma unroll
        for (int i = 0; i < 16; ++i) mx = fmaxf(mx, st[kb][i]);
    mx = fmaxf(mx, __shfl_xor(mx, 32));
    const float SC = 0.0625f * 1.4426950408889634f;
    float sum = 0.f;
#pragma unroll
    for (int kb = 0; kb < 8; ++kb)
#pragma unroll
        for (int i = 0; i < 16; ++i) { const float p = exp2f((st[kb][i] - mx) * SC); st[kb][i] = p; sum += p; }
    sum += __shfl_xor(sum, 32);
    const float inv = 1.0f / sum;
    bf16x8 pw[8][2];
#pragma unroll
    for (int kb = 0; kb < 8; ++kb)
#pragma unroll
        for (int s = 0; s < 2; ++s) pw[kb][s] = pack8(st[kb][8 * s + 0] * inv, st[kb][8 * s + 1] * inv, st[kb][8 * s + 2] * inv, st[kb][8 * s + 3] * inv, st[kb][8 * s + 4] * inv, st[kb][8 * s + 5] * inv, st[kb][8 * s + 6] * inv, st[kb][8 * s + 7] * inv);
    f32x16 o[8];
#pragma unroll
    for (int db = 0; db < 8; ++db) o[db] = (f32x16){};
#pragma unroll
    for (int vblk = 0; vblk < 4; ++vblk) {
        __syncthreads();
#pragma unroll
        for (int i = 0; i < 4; ++i) { const int p = tid + i * NTHR, r = p >> 5, ch = p & 31; *(LAS u32x4*)(buf + r * XKS + ch * 8) = *(const u32x4*)(Vg + (size_t)(vblk * 64 + r) * 2048 + ch * 8); }
        __syncthreads();
#pragma unroll
        for (int kk = 0; kk < 2; ++kk)
#pragma unroll
            for (int s = 0; s < 2; ++s)
#pragma unroll
                for (int db = 0; db < 8; ++db) { const bf16x8 vf = tr_frag(buf, XKS, 32 * kk + 16 * s, 32 * db, lane); o[db] = MFMA32(vf, pw[2 * vblk + kk][s], o[db]); }
    }
    bf16* op = (bf16*)(F.ws + WS_BUFA) + row * D + h * 256 + 4 * hi;
#pragma unroll
    for (int db = 0; db < 8; ++db)
#pragma unroll
        for (int gi = 0; gi < 4; ++gi) { u32x2 y; y.x = pk2(o[db][4 * gi], o[db][4 * gi + 1]); y.y = pk2(o[db][4 * gi + 2], o[db][4 * gi + 3]); *(u32x2*)(op + 32 * db + 8 * gi) = y; }
    __syncthreads();
}

__device__ __forceinline__ void conv_phase(Frame& F) {
    const bf16* H4 = (const bf16*)(F.ws + WS_BIG); bf16* Y = (bf16*)(F.ws + WS_BUFA);
    const float* cw = F.o_conv_w; const float* cb = F.o_conv_b;
    for (int it = F.bid * NTHR + launder(F.tid); it < (MTOK / 8) * 128; it += F.G * NTHR) {
        const int cgi = it & 127, tg = it >> 7, col = cgi * 8, t0 = tg * 8;
        float w0[8], w1[8], w2[8], bs[8];
#pragma unroll
        for (int e = 0; e < 8; ++e) { w0[e] = cw[col + e]; w1[e] = cw[D + col + e]; w2[e] = cw[2 * D + col + e]; bs[e] = cb[col + e]; }
        float zm2[8], zm1[8];
        const bool first = (t0 & (SEQ - 1)) == 0;
#pragma unroll
        for (int e = 0; e < 8; ++e) { zm2[e] = 0.f; zm1[e] = 0.f; }
        if (!first) {
            const bf16* r2 = H4 + (size_t)(t0 - 2) * OIN + col; const bf16* r1 = H4 + (size_t)(t0 - 1) * OIN + col;
            const u32x4 c2 = *(const u32x4*)(r2 + 1024), u2 = *(const u32x4*)(r2 + 2048), c1 = *(const u32x4*)(r1 + 1024), u1 = *(const u32x4*)(r1 + 2048);
#pragma unroll
            for (int e = 0; e < 4; ++e) { zm2[2 * e] = bflo(c2[e]) * bflo(u2[e]); zm2[2 * e + 1] = bfhi(c2[e]) * bfhi(u2[e]); zm1[2 * e] = bflo(c1[e]) * bflo(u1[e]); zm1[2 * e + 1] = bfhi(c1[e]) * bfhi(u1[e]); }
        }
#pragma unroll
        for (int tt = 0; tt < 8; ++tt) {
            const bf16* r = H4 + (size_t)(t0 + tt) * OIN + col;
            const u32x4 gb = *(const u32x4*)(r), gc = *(const u32x4*)(r + 1024), uu = *(const u32x4*)(r + 2048), gt = *(const u32x4*)(r + 3072);
            float z[8], y[8];
#pragma unroll
            for (int e = 0; e < 4; ++e) { z[2 * e] = bflo(gc[e]) * bflo(uu[e]); z[2 * e + 1] = bfhi(gc[e]) * bfhi(uu[e]); }
#pragma unroll
            for (int e = 0; e < 4; ++e) {
                const float cv0 = bs[2 * e] + zm2[2 * e] * w0[2 * e] + zm1[2 * e] * w1[2 * e] + z[2 * e] * w2[2 * e];
                const float cv1 = bs[2 * e + 1] + zm2[2 * e + 1] * w0[2 * e + 1] + zm1[2 * e + 1] * w1[2 * e + 1] + z[2 * e + 1] * w2[2 * e + 1];
                y[2 * e] = bflo(gb[e]) * cv0 * silu(bflo(gt[e])); y[2 * e + 1] = bfhi(gb[e]) * cv1 * silu(bfhi(gt[e])); }
            u32x4 o; o.x = pk2(y[0], y[1]); o.y = pk2(y[2], y[3]); o.z = pk2(y[4], y[5]); o.w = pk2(y[6], y[7]);
            *(u32x4*)(Y + (size_t)(t0 + tt) * D + col) = o;
#pragma unroll
            for (int e = 0; e < 8; ++e) { zm2[e] = zm1[e]; zm1[e] = z[e]; }
        }
    }
}

__device__ __forceinline__ void final_phase(Frame& F) {
    const int gw = F.bid * NWAVES + F.wave, NGW = F.G * NWAVES, lane = F.lane;
    const float* ssp = (const float*)(F.ws + WS_SSP);
    for (int row = gw; row < MTOK; row += NGW) {
        const f32x4* p = (const f32x4*)(ssp + (size_t)row * 16); const f32x4 a = p[0], b = p[1], c = p[2], d = p[3];
        const float s = ((a[0] + a[1]) + (a[2] + a[3])) + ((b[0] + b[1]) + (b[2] + b[3])) + ((c[0] + c[1]) + (c[2] + c[3])) + ((d[0] + d[1]) + (d[2] + d[3]));
        const float rs = 1.0f / sqrtf(s * (1.0f / D) + EPS);
        f32x4* xr = (f32x4*)(F.out + (size_t)row * D) + lane; const f32x4* gr = (const f32x4*)F.final_norm + lane;
#pragma unroll
        for (int j = 0; j < 4; ++j) { const f32x4 v = xr[64 * j], g = gr[64 * j]; xr[64 * j] = v * rs * g; }
    }
}

#ifndef TS_PROBE
#define TS_PROBE 0
#endif
#define TS_A_HI 5
#define TS_A_LO 2
#define TS_B_HI 1
#define TS_B_LO 0
#ifndef DUP_MASK
#define DUP_MASK 0
#endif
#define REP(k) _Pragma("unroll 1") for (int rep_ = 0; rep_ < ((((DUP_MASK) >> (k)) & 1) + 1); ++rep_)
#ifndef MK_SPLIT
#define MK_SPLIT 0
#endif
constexpr int NPHASE = 16;
__global__ void __launch_bounds__(NTHR, 2) fwd_megakernel(Args args) {
    extern __shared__ __attribute__((aligned(16))) unsigned char lds_raw[];
    cg::grid_group grid = cg::this_grid();
    Frame F;
    F.lds = (LAS unsigned char*)lds_raw; F.tid = threadIdx.x; F.lane = F.tid & 63; F.wave = __builtin_amdgcn_readfirstlane(F.tid >> 6); F.G = gridDim.x; F.bid = blockIdx.x;
    F.x = args.in[0]; F.mem = args.in[1]; F.e_norm = args.in[2]; F.e_w_in = args.in[3]; F.e_sink = args.in[4]; F.e_w_out = args.in[5]; F.o_norm = args.in[6]; F.o_w_in = args.in[7];
    F.o_conv_w = args.in[8]; F.o_conv_b = args.in[9]; F.o_w_out = args.in[10]; F.c_norm = args.in[11]; F.c_mem_norm = args.in[12]; F.c_wq = args.in[13]; F.c_wkv = args.in[14]; F.c_wo = args.in[15]; F.final_norm = args.in[16];
    F.out = args.out; F.ws = args.ws;
    unsigned char* ws = args.ws;
    if (F.tid < 2) ((LAS unsigned*)(F.lds + XB_LDS_OFF))[F.tid] = 0u;
    __syncthreads();
    const XcdBarrier xbar = xcd_barrier_post((unsigned*)(args.ws + XB_WS_OFF), (volatile LAS unsigned*)(F.lds + XB_LDS_OFF));
    const int lo = args.ph_lo, hi = args.ph_hi;
#define IN(k) (lo <= (k) && (k) < hi)
#define SEAM(k) do { if (IN(k) && IN((k) + 1)) { if ((k) == 0) { asm volatile("s_waitcnt vmcnt(0) lgkmcnt(0)" ::: "memory"); grid.sync(); __builtin_amdgcn_fence(__ATOMIC_ACQUIRE, "agent"); asm volatile("s_waitcnt vmcnt(0)" ::: "memory"); } else xcd_barrier(xbar); } STAMP((k) + 1); } while (0)
    typedef pg8::EpiScaleBf16<true> EpiS; typedef pg8::EpiScaleBf16<false> EpiN;
    bf16* XB = (bf16*)(ws + WS_XB); float* SSP = (float*)(ws + WS_SSP); bf16* BIG = (bf16*)(ws + WS_BIG); bf16* BUFA = (bf16*)(ws + WS_BUFA); bf16* BUFB = (bf16*)(ws + WS_BUFB);

#if TS_PROBE
#define STAMP(i) do { if (blockIdx.x == 0 && threadIdx.x == 0) ((unsigned long long*)ws)[i] = __builtin_amdgcn_s_memrealtime(); } while (0)
#else
#define STAMP(i) do { } while (0)
#endif
    STAMP(0);
    REP(0) {
    if (IN(0)) { p0_prologue(F); } SEAM(0); }
    REP(1) {
    if (IN(1)) {
        { pg8::Gemm g{XB, (const bf16*)(ws + WS_WEIN), MTOK, EIN, D}; pg8::StaticOrder S; S.init(MTOK, EIN, F.G, F.bid); pg8::rs_prepass((LAS float*)(F.lds + 131072), S, SSP, F.tid); EpiS E{BIG, EIN, (const LAS float*)(F.lds + 131072)};
          pg8::gemm_phase<EpiS, pg8::StaticOrder, true, true>(F.lds, g, S, E); }
#pragma unroll 1
        for (int l = 0; l < 2; ++l) { pg8::Gemm g{(const bf16*)(ws + WS_MEMN) + (size_t)l * BATCH * MEMLEN * D, (const bf16*)(ws + WS_WKV) + (size_t)l * 2 * D * D, BATCH * MEMLEN, 2 * D, D};
          pg8::StaticOrder S; S.init(BATCH * MEMLEN, 2 * D, F.G, (F.bid + F.G - (F.G / 2 + 32 * l) % F.G) % F.G); EpiN E{(bf16*)(ws + WS_KV) + (size_t)l * BATCH * MEMLEN * 2 * D, 2 * D, nullptr};
          pg8::gemm_phase<EpiN, pg8::StaticOrder, true, true>(F.lds, g, S, E); }
    } SEAM(1); }
    REP(2) {
    if (IN(2)) {
        for (int it = F.bid; it < BATCH * NCH * 4; it += F.G) ret1_item(F, it);
        for (int it = F.bid; it < BATCH * NCH * 2; it += F.G) swa_item(F, it);
    } SEAM(2); }
    REP(3) {
    if (IN(3)) { scan_phase(F); } SEAM(3); }
    REP(4) {
    if (IN(4)) { for (int it = F.bid; it < BATCH * NCH * 4; it += F.G) ret2_item(F, it); } SEAM(4); }
    REP(5) {
    if (IN(5)) {
        pg8::Gemm g{BUFA, (const bf16*)(ws + WS_WEOUT), MTOK, D, D}; pg8::StaticOrder S; S.init(MTOK, D, F.G, F.bid); typedef pg8::EpiResidual<true, false> EpiR0; EpiR0 E{F.x, XB, SSP, D};
        pg8::gemm_phase<EpiR0, pg8::StaticOrder, true, true>(F.lds, g, S, E);
    } SEAM(5); }
#pragma unroll
    for (int l = 0; l < 2; ++l) {
        const int pb = (l == 0) ? 6 : 12;
        REP(pb) {
        if (IN(pb)) {
            pg8::Gemm g{XB, (const bf16*)(ws + WS_WQ) + (size_t)l * D * D, MTOK, D, D}; pg8::StaticOrder S; S.init(MTOK, D, F.G, F.bid); pg8::rs_prepass((LAS float*)(F.lds + 131072), S, SSP, F.tid); EpiS E{BUFB, D, (const LAS float*)(F.lds + 131072)};
            pg8::gemm_phase<EpiS, pg8::StaticOrder, true, true>(F.lds, g, S, E);
        } SEAM(pb); }
        REP(pb + 1) {
        if (IN(pb + 1)) { for (int it = F.bid; it < (MTOK / 256) * 4; it += F.G) xattn_unit(F, l, it); } SEAM(pb + 1); }
        REP(pb + 2) {
        if (IN(pb + 2)) {
            pg8::Gemm g{BUFA, (const bf16*)(ws + WS_WO) + (size_t)l * D * D, MTOK, D, D}; pg8::StaticOrder S; S.init(MTOK, D, F.G, F.bid); if (l == 0) { typedef pg8::EpiResidual<false, false> EpiR1; EpiR1 E{XB, XB, SSP, D}; pg8::gemm_phase<EpiR1, pg8::StaticOrder, true, true>(F.lds, g, S, E); }
            else { typedef pg8::EpiResidual<false, true> EpiR2; EpiR2 E{XB, F.out, SSP, D}; pg8::gemm_phase<EpiR2, pg8::StaticOrder, true, true>(F.lds, g, S, E); }
        } SEAM(pb + 2); }
        if (l == 0) {
            REP(9) {
            if (IN(9)) {
                pg8::Gemm g{XB, (const bf16*)(ws + WS_WOIN), MTOK, OIN, D}; pg8::StaticOrder S; S.init(MTOK, OIN, F.G, F.bid); pg8::rs_prepass((LAS float*)(F.lds + 131072), S, SSP, F.tid); EpiS E{BIG, OIN, (const LAS float*)(F.lds + 131072)};
                pg8::gemm_phase<EpiS, pg8::StaticOrder, true, true>(F.lds, g, S, E);
            } SEAM(9); }
            REP(10) {
            if (IN(10)) { conv_phase(F); } SEAM(10); }
            REP(11) {
            if (IN(11)) {
                pg8::Gemm g{BUFA, (const bf16*)(ws + WS_WOOUT), MTOK, D, D}; pg8::StaticOrder S; S.init(MTOK, D, F.G, F.bid); typedef pg8::EpiResidual<false, false> EpiR1; EpiR1 E{XB, XB, SSP, D};
                pg8::gemm_phase<EpiR1, pg8::StaticOrder, true, true>(F.lds, g, S, E);
            } SEAM(11); }
        }
    }
    if (IN(15)) { final_phase(F); }
#if TS_PROBE
    __syncthreads();
    if (blockIdx.x == 0 && threadIdx.x == 0) { const unsigned long long* ts = (const unsigned long long*)ws;
        const float ta = (float)(ts[TS_A_HI] - ts[TS_A_LO]) * 0.01f, tb = (float)(ts[TS_B_HI] - ts[TS_B_LO]) * 0.01f;
        F.out[0] = ta; for (int i = 1; i <= 1000; ++i) F.out[i] = tb; }
#endif
#undef IN
#undef SEAM
}

extern "C" void kernel_launch(void* const* d_in, const int* in_sizes, int n_in, void* d_out, int out_size, void* d_ws, size_t ws_size, hipStream_t stream) {
    static int grid = 0;
    if (grid == 0) {
        if (n_in != 17 || out_size != MTOK * D || ws_size < WS_END) { fprintf(stderr, "kernel_launch: unexpected shapes (n_in %d out %d ws %zu)\n", n_in, out_size, ws_size); grid = -1; return; }
        int dev = 0, cus = 0, per_cu = 0;
        hipGetDevice(&dev); hipDeviceGetAttribute(&cus, hipDeviceAttributeMultiprocessorCount, dev);
        if (hipFuncSetAttribute((const void*)fwd_megakernel, hipFuncAttributeMaxDynamicSharedMemorySize, LDS_BYTES) != hipSuccess) { fprintf(stderr, "kernel_launch: hipFuncSetAttribute failed\n"); grid = -1; return; }
        if (hipOccupancyMaxActiveBlocksPerMultiprocessor(&per_cu, (const void*)fwd_megakernel, NTHR, LDS_BYTES) != hipSuccess || per_cu < 1) { fprintf(stderr, "kernel_launch: occupancy query says %d\n", per_cu); per_cu = 1; }
        (void)hipGetLastError();
        grid = cus;
    }
    if (grid < 0) return;
    if (hipMemsetAsync(d_ws, 0, 65536, stream) != hipSuccess) { fprintf(stderr, "kernel_launch: hipMemsetAsync failed\n"); return; }
    Args a{};
    for (int i = 0; i < 17; ++i) a.in[i] = (const float*)d_in[i];
    a.out = (float*)d_out; a.ws = (unsigned char*)d_ws;
#if MK_SPLIT
    for (int p = 0; p < NPHASE; ++p) { a.ph_lo = p; a.ph_hi = p + 1; hipLaunchKernelGGL(fwd_megakernel, dim3(grid), dim3(NTHR), LDS_BYTES, stream, a); }
#else
    a.ph_lo = 0; a.ph_hi = NPHASE;
    void* kargs[] = {&a};
    hipError_t e = hipLaunchCooperativeKernel((const void*)fwd_megakernel, dim3(grid), dim3(NTHR), kargs, LDS_BYTES, stream);
    if (e != hipSuccess) fprintf(stderr, "kernel_launch: cooperative launch failed: %s (grid %d)\n", hipGetErrorString(e), grid);
#endif
}
```

```cpp
#include <hip/hip_runtime.h>
#include <hip/hip_cooperative_groups.h>
#include <cstdio>
#include <cstdint>
namespace cg = cooperative_groups;
__device__ __forceinline__ int mk_lane() { int l = (int)__builtin_amdgcn_mbcnt_hi(~0u, __builtin_amdgcn_mbcnt_lo(~0u, 0u)); asm volatile("" : "+v"(l)); return l; }
namespace pg8 {
#define PG8_LAS __attribute__((address_space(3)))
typedef unsigned short bf16_t;
typedef short bf16x8 __attribute__((ext_vector_type(8)));
typedef float f32x4 __attribute__((ext_vector_type(4)));
typedef unsigned u32x4 __attribute__((ext_vector_type(4)));
constexpr int BM = 256, BK = 64, HALF = 128, HTB = HALF * BK * 2  , STAGE_BYTES = 8 * HTB, NXCD = 8, WGM = 8;

__host__ __device__ __forceinline__ int lds_byte(int r, int c) { const int st = (r >> 4) * 2 + (c >> 5), rr = r & 15, cc = c & 31, ob = rr * 64 + cc * 2; return st * 1024 + (ob ^ (((ob >> 9) & 1) << 5)); }
__host__ __device__ __forceinline__ void stage_rc(int b, int& R, int& C) { const int st = b / 1024, sb = b % 1024, swz = sb ^ (((sb >> 9) & 1) << 5); R = (st >> 1) * 16 + swz / 64; C = (st & 1) * 32 + (swz % 64) / 2; }
__host__ __device__ __forceinline__ int perm32(int rho) { const int n = rho >> 4, i = rho & 15; return 8 * (i >> 2) + 4 * n + (i & 3); }

struct Unit { int pm, pn, idx; };
struct Gemm { const bf16_t* A; const bf16_t* Bt; int M, N, K; };

struct StaticOrder {
    int nM, nN, nwg, G, c;
    __host__ __device__ void init(int M, int N, int G_, int c_) { nM = M / BM; nN = N / BM; nwg = nM * nN; G = G_; c = c_; }
    __host__ __device__ bool next(int i, Unit& u) const {
        const long L = (long)i * G + c; if (L >= nwg) return false;
        int wgid = (int)L; { const int q = nwg / NXCD, r = nwg % NXCD, xcd = wgid % NXCD, off = wgid / NXCD; wgid = (xcd < r ? xcd * (q + 1) : r * (q + 1) + (xcd - r) * q) + off; }
        const int nig = WGM * nN, gid = wgid / nig, fm = gid * WGM, gsz = (nM - fm) < WGM ? (nM - fm) : WGM;
        u.pm = fm + ((wgid % nig) % gsz); u.pn = (wgid % nig) / gsz; u.idx = i; return true;
    }
    __device__ __forceinline__ void a_ready(const Unit&) const {}
    __device__ __forceinline__ void done(const Unit&) const {}
};

typedef float f32x2 __attribute__((ext_vector_type(2))); typedef __bf16 bf16x2_t __attribute__((ext_vector_type(2)));
__device__ __forceinline__ unsigned cvt_pk_bf16(float lo, float hi) { const f32x2 v = {lo, hi}; const bf16x2_t b = __builtin_convertvector(v, bf16x2_t); return __builtin_bit_cast(unsigned, b); }
template <bool SCALE> struct EpiScaleBf16 {
    static constexpr bool PERM = true, AFTER_DRAIN = false;
    bf16_t* O; int ldc; const PG8_LAS float* rs;
    __device__ __forceinline__ void operator()(const f32x4 (&acc)[2][2][4][2], const Unit& u, int wr, int wc, int fr, int fq) const {
        const int rl0 = wr * 64 + fr; const int col0 = u.pn * BM + wc * 32 + 8 * fq;
#pragma unroll
        for (int ai = 0; ai < 2; ++ai)
#pragma unroll
            for (int m = 0; m < 4; ++m) {
                const float sc = SCALE ? rs[256 * u.idx + rl0 + ai * HALF + m * 16] : 1.f;
                bf16_t* rowp = O + (size_t)(u.pm * BM + rl0 + ai * HALF + m * 16) * ldc + col0;
#pragma unroll
                for (int bj = 0; bj < 2; ++bj) { const f32x4 v0 = acc[ai][bj][m][0] * sc, v1 = acc[ai][bj][m][1] * sc;
                    u32x4 w; w.x = cvt_pk_bf16(v0[0], v0[1]); w.y = cvt_pk_bf16(v0[2], v0[3]); w.z = cvt_pk_bf16(v1[0], v1[1]); w.w = cvt_pk_bf16(v1[2], v1[3]);
                    *(u32x4*)(rowp + bj * HALF) = w; }
            }
    }
};
template <class Sched> __device__ __forceinline__ void rs_prepass(PG8_LAS float* rs, const Sched& S, const float* ssp, int tid) {
    Unit u;
    for (int i = 0; S.next(i, u); ++i)
        if (tid < 256) { const f32x4* p = (const f32x4*)(ssp + (size_t)(u.pm * BM + tid) * 16); const f32x4 a = p[0], b = p[1], c = p[2], d = p[3];
            const float s = ((a[0] + a[1]) + (a[2] + a[3])) + ((b[0] + b[1]) + (b[2] + b[3])) + ((c[0] + c[1]) + (c[2] + c[3])) + ((d[0] + d[1]) + (d[2] + d[3]));
            rs[256 * i + tid] = 1.0f / sqrtf(s * (1.0f / 1024.0f) + 1e-6f); }
    __syncthreads();
}
template <bool BASE_F32, bool OUT_F32> struct EpiResidual {
    static constexpr bool PERM = true, AFTER_DRAIN = false;
    const void* base; void* out; float* ssp; int ldc;
    __device__ __forceinline__ void operator()(const f32x4 (&acc)[2][2][4][2], const Unit& u, int wr, int wc, int fr, int fq) const {
        const int row0 = u.pm * BM + wr * 64 + fr; const int col0 = u.pn * BM + wc * 32 + 8 * fq;
#pragma unroll
        for (int ai = 0; ai < 2; ++ai)
#pragma unroll
          for (int mh = 0; mh < 2; ++mh) {
            u32x4 pb[2][2]; f32x4 fb[2][2][2];
#pragma unroll
            for (int m2 = 0; m2 < 2; ++m2)
#pragma unroll
                for (int bj = 0; bj < 2; ++bj) { const size_t off = (size_t)(row0 + ai * HALF + (2 * mh + m2) * 16) * ldc + col0 + bj * HALF;
                    if (BASE_F32) { fb[m2][bj][0] = *(const f32x4*)((const float*)base + off); fb[m2][bj][1] = *(const f32x4*)((const float*)base + off + 4); }
                    else pb[m2][bj] = *(const u32x4*)((const bf16_t*)base + off); }
#pragma unroll
            for (int m2 = 0; m2 < 2; ++m2) {
                const int m = 2 * mh + m2, row = row0 + ai * HALF + m * 16;
                float ss = 0.f;
#pragma unroll
                for (int bj = 0; bj < 2; ++bj) { const size_t off = (size_t)row * ldc + col0 + bj * HALF;
                    f32x4 b0, b1;
                    if (BASE_F32) { b0 = fb[m2][bj][0]; b1 = fb[m2][bj][1]; }
                    else { const u32x4 w = pb[m2][bj];
                        b0 = (f32x4){__uint_as_float(w.x << 16), __uint_as_float(w.x & 0xffff0000u), __uint_as_float(w.y << 16), __uint_as_float(w.y & 0xffff0000u)};
                        b1 = (f32x4){__uint_as_float(w.z << 16), __uint_as_float(w.z & 0xffff0000u), __uint_as_float(w.w << 16), __uint_as_float(w.w & 0xffff0000u)}; }
                    const f32x4 o0 = b0 + acc[ai][bj][m][0], o1 = b1 + acc[ai][bj][m][1];
                    ss += ((o0[0] * o0[0] + o0[1] * o0[1]) + (o0[2] * o0[2] + o0[3] * o0[3])) + ((o1[0] * o1[0] + o1[1] * o1[1]) + (o1[2] * o1[2] + o1[3] * o1[3]));
                    if (OUT_F32) { *(f32x4*)((float*)out + off) = o0; *(f32x4*)((float*)out + off + 4) = o1; }
                    else { u32x4 w; w.x = cvt_pk_bf16(o0[0], o0[1]); w.y = cvt_pk_bf16(o0[2], o0[3]); w.z = cvt_pk_bf16(o1[0], o1[1]); w.w = cvt_pk_bf16(o1[2], o1[3]);
                        *(u32x4*)((bf16_t*)out + off) = w; } }
                ss += __shfl_xor(ss, 16); ss += __shfl_xor(ss, 32);
                if (fq == 0) ssp[(size_t)row * 16 + u.pn * 4 + wc] = ss;
            }
            asm volatile("" ::: "memory");
          }
    }
};
template <class Epi, class Sched, bool ALIGN_EPI = false, bool SP2 = false>
__device__ __forceinline__ void gemm_phase(PG8_LAS unsigned char* lds, const Gemm g, const Sched& S, const Epi& E, const int wave_in) {
    int tid_ = wave_in * 64 + mk_lane(); asm volatile("" : "+v"(tid_));
    const int tid = tid_, wid = __builtin_amdgcn_readfirstlane(tid >> 6), lane = tid & 63, wr = wid >> 2, wc = wid & 3, fr = lane & 15, fq = lane >> 4;
    const int K = g.K, nt = K / BK;
    unsigned voffA[2], voffB[2];
#pragma unroll
    for (int i = 0; i < 2; ++i) { int R, C; stage_rc(tid * 16 + i * 8192, R, C); const int Rb = Epi::PERM ? ((R & ~31) + perm32(R & 31)) : R;
        voffA[i] = (unsigned)(R * K + C) * 2u; voffB[i] = (unsigned)(Rb * K + C) * 2u; }
    const size_t kstep = (size_t)(BK * 2);
    const size_t hstep = (size_t)HALF * K * 2;
    const size_t tstep = 2 * hstep;
    const unsigned ldsw = (unsigned)wid * 1024u;
    const int aoff = lds_byte(wr * 64 + fr, fq * 8), boff = lds_byte(wc * 32 + fr, fq * 8);
#define PG8_SA(b, h) (((b) * 2 + (h)) * HTB)
#define PG8_SB(b, h) ((4 + (b) * 2 + (h)) * HTB)
#define PG8_STAGE(bufoff, gbase, voff) do { _Pragma("unroll") for (int _i = 0; _i < 2; ++_i) \
        __builtin_amdgcn_global_load_lds((const unsigned*)((const char*)(gbase) + (voff)[_i]), (PG8_LAS unsigned*)(lds + (bufoff) + ldsw + _i * 8192), 16, 0, 0); } while (0)
#define PG8_LDA(dst, b, h) do { _Pragma("unroll") for (int m = 0; m < 4; ++m) _Pragma("unroll") for (int k = 0; k < 2; ++k) dst[m][k] = *(const PG8_LAS bf16x8*)(lds + PG8_SA(b, h) + aoff + m * 2048 + k * 1024); } while (0)
#define PG8_LDB(dst, b, h) do { _Pragma("unroll") for (int n = 0; n < 2; ++n) _Pragma("unroll") for (int k = 0; k < 2; ++k) dst[n][k] = *(const PG8_LAS bf16x8*)(lds + PG8_SB(b, h) + boff + n * 2048 + k * 1024); } while (0)
#define PG8_MMA(ai, bj, At, Bt) do { __builtin_amdgcn_s_setprio(1); _Pragma("unroll") for (int m = 0; m < 4; ++m) _Pragma("unroll") for (int n = 0; n < 2; ++n) _Pragma("unroll") for (int k = 0; k < 2; ++k) \
        acc[ai][bj][m][n] = __builtin_amdgcn_mfma_f32_16x16x32_bf16(Bt[n][k], At[m][k], acc[ai][bj][m][n], 0, 0, 0); __builtin_amdgcn_s_setprio(0); } while (0)
#define PG8_WAIT_V(n) asm volatile("s_waitcnt vmcnt(" #n ")" ::: "memory")
#define PG8_WAIT_L(n) asm volatile("s_waitcnt lgkmcnt(" #n ")" ::: "memory")
#define PG8_BAR __builtin_amdgcn_s_barrier()
#define PG8_SCHED __builtin_amdgcn_sched_barrier(0)
    Unit cur, nxt; int ui = 0;
    if (!S.next(0, cur)) return;
    f32x4 acc[2][2][4][2];
#pragma unroll
    for (int a = 0; a < 2; ++a)
#pragma unroll
        for (int b = 0; b < 2; ++b)
#pragma unroll
            for (int m = 0; m < 4; ++m)
#pragma unroll
                for (int n = 0; n < 2; ++n) acc[a][b][m][n] = (f32x4){0.f, 0.f, 0.f, 0.f};
    bf16x8 At[4][2], B0[2][2], B1[2][2];
    const char* cA = (const char*)g.A + (size_t)cur.pm * tstep; const char* cB = (const char*)g.Bt + (size_t)cur.pn * tstep;
    S.a_ready(cur);
    if constexpr (SP2) {
        PG8_STAGE(PG8_SB(0, 0), cB, voffB); PG8_STAGE(PG8_SB(0, 1), cB + hstep, voffB); PG8_STAGE(PG8_SA(0, 0), cA, voffA); PG8_STAGE(PG8_SA(0, 1), cA + hstep, voffA);
        if (wr == 1) PG8_BAR;
        PG8_WAIT_V(2); PG8_BAR;
        PG8_STAGE(PG8_SB(1, 0), cB + kstep, voffB); PG8_STAGE(PG8_SA(1, 0), cA + kstep, voffA); PG8_STAGE(PG8_SB(1, 1), cB + hstep + kstep, voffB);
        PG8_WAIT_V(6); PG8_BAR;
    } else {
        PG8_STAGE(PG8_SB(0, 0), cB, voffB); PG8_STAGE(PG8_SA(0, 0), cA, voffA); PG8_STAGE(PG8_SB(0, 1), cB + hstep, voffB); PG8_STAGE(PG8_SA(0, 1), cA + hstep, voffA);
        if (wr == 1) PG8_BAR;
        PG8_WAIT_V(4); PG8_BAR;
        PG8_STAGE(PG8_SB(1, 0), cB + kstep, voffB); PG8_STAGE(PG8_SA(1, 0), cA + kstep, voffA); PG8_STAGE(PG8_SB(1, 1), cB + hstep + kstep, voffB);
        PG8_WAIT_V(6); PG8_BAR;
    }
    for (;;) {
        const bool has_next = S.next(ui + 1, nxt);
        const char* nA = has_next ? (const char*)g.A + (size_t)nxt.pm * tstep : cA; const char* nB = has_next ? (const char*)g.Bt + (size_t)nxt.pn * tstep : cB;
        for (int t = 0; t < nt; t += 2) {
            const bool last = (t == nt - 2);
            const char* a1 = cA + (size_t)(t + 1) * kstep;
            const char* a2 = last ? nA : cA + (size_t)(t + 2) * kstep; const char* b2 = last ? nB : cB + (size_t)(t + 2) * kstep;
            const char* a3 = a2 + kstep; const char* b3 = b2 + kstep;
            if (last && has_next) S.a_ready(nxt);
            if constexpr (SP2) {
            PG8_LDB(B0, 0, 0); PG8_LDB(B1, 0, 1); PG8_SCHED; PG8_LDA(At, 0, 0); PG8_STAGE(PG8_SA(1, 1), a1 + hstep, voffA);
            PG8_WAIT_V(8); PG8_WAIT_L(0); PG8_BAR; PG8_MMA(0, 0, At, B0); PG8_MMA(0, 1, At, B1); PG8_BAR; PG8_SCHED;
            PG8_LDA(At, 0, 1); PG8_STAGE(PG8_SB(0, 0), b2, voffB); PG8_STAGE(PG8_SB(0, 1), b2 + hstep, voffB); PG8_STAGE(PG8_SA(0, 0), a2, voffA);
            PG8_WAIT_V(8); PG8_WAIT_L(0); PG8_BAR; PG8_MMA(1, 0, At, B0); PG8_MMA(1, 1, At, B1); PG8_BAR; PG8_SCHED;
            PG8_LDB(B0, 1, 0); PG8_LDB(B1, 1, 1); PG8_SCHED; PG8_LDA(At, 1, 0); PG8_STAGE(PG8_SA(0, 1), a2 + hstep, voffA);
            PG8_WAIT_V(8); PG8_WAIT_L(0); PG8_BAR; PG8_MMA(0, 0, At, B0); PG8_MMA(0, 1, At, B1); PG8_BAR; PG8_SCHED;
            PG8_LDA(At, 1, 1); PG8_STAGE(PG8_SB(1, 0), b3, voffB); PG8_STAGE(PG8_SB(1, 1), b3 + hstep, voffB); PG8_STAGE(PG8_SA(1, 0), a3, voffA);
            PG8_WAIT_V(8); PG8_WAIT_L(0); PG8_BAR; PG8_MMA(1, 0, At, B0); PG8_MMA(1, 1, At, B1); PG8_BAR; PG8_SCHED;
            } else {
            PG8_LDB(B0, 0, 0); PG8_SCHED; PG8_LDA(At, 0, 0); PG8_STAGE(PG8_SA(1, 1), a1 + hstep, voffA);
            PG8_WAIT_L(8); PG8_BAR; PG8_WAIT_L(0); PG8_MMA(0, 0, At, B0); PG8_BAR; PG8_SCHED;
            PG8_LDB(B1, 0, 1); PG8_STAGE(PG8_SB(0, 0), b2, voffB);
            PG8_BAR; PG8_WAIT_L(0); PG8_MMA(0, 1, At, B1); PG8_BAR;
            PG8_LDA(At, 0, 1); PG8_STAGE(PG8_SA(0, 0), a2, voffA);
            PG8_BAR; PG8_WAIT_L(0); PG8_MMA(1, 0, At, B0); PG8_BAR; PG8_SCHED;
            PG8_STAGE(PG8_SB(0, 1), b2 + hstep, voffB);
            PG8_WAIT_V(6); PG8_BAR; PG8_MMA(1, 1, At, B1); PG8_BAR;
            PG8_LDB(B0, 1, 0); PG8_SCHED; PG8_LDA(At, 1, 0); PG8_STAGE(PG8_SA(0, 1), a2 + hstep, voffA);
            PG8_WAIT_L(8); PG8_BAR; PG8_WAIT_L(0); PG8_MMA(0, 0, At, B0); PG8_BAR; PG8_SCHED;
            PG8_LDB(B1, 1, 1); PG8_STAGE(PG8_SB(1, 0), b3, voffB);
            PG8_BAR; PG8_WAIT_L(0); PG8_MMA(0, 1, At, B1); PG8_BAR;
            PG8_LDA(At, 1, 1); PG8_STAGE(PG8_SA(1, 0), a3, voffA);
            PG8_BAR; PG8_WAIT_L(0); PG8_MMA(1, 0, At, B0); PG8_BAR; PG8_SCHED;
            PG8_STAGE(PG8_SB(1, 1), b3 + hstep, voffB);
            PG8_WAIT_V(6); PG8_BAR; PG8_MMA(1, 1, At, B1); PG8_BAR;
            }
        }
        if constexpr (ALIGN_EPI) { if (wr == 0) PG8_BAR; }
        if constexpr (!Epi::AFTER_DRAIN) { E(acc, cur, wr, wc, fr, fq); S.done(cur); }
        if (!has_next) break;
#pragma unroll
        for (int a = 0; a < 2; ++a)
#pragma unroll
            for (int b = 0; b < 2; ++b)
#pragma unroll
                for (int m = 0; m < 4; ++m)
#pragma unroll
                    for (int n = 0; n < 2; ++n) acc[a][b][m][n] = (f32x4){0.f, 0.f, 0.f, 0.f};
        cur = nxt; cA = nA; cB = nB; ++ui;
        if constexpr (ALIGN_EPI) { if (wr == 1) PG8_BAR; }
    }
    PG8_WAIT_V(0);
    if constexpr (!ALIGN_EPI) { if (wr == 0) PG8_BAR; }
    PG8_BAR;
    if constexpr (Epi::AFTER_DRAIN) { E.fused(acc, cur, wr, wc, fr, fq, lds, wid, lane); S.done(cur); }
#undef PG8_SA
#undef PG8_SB
#undef PG8_STAGE
#undef PG8_LDA
#undef PG8_LDB
#undef PG8_MMA
#undef PG8_WAIT_V
#undef PG8_WAIT_L
#undef PG8_BAR
#undef PG8_SCHED
}
}

constexpr int D = 1024, BATCH = 4, SEQ = 8192, MTOK = BATCH * SEQ, NCH = SEQ / 64, MEMLEN = 256;
constexpr int EIN = 3328, OIN = 4096;
constexpr float EPS = 1e-6f;
constexpr int C_AQ = 0, C_AK = 512, C_AV = 640, C_AG = 768, C_BQ = 1280, C_BK = 1792, C_BV = 2304, C_BG = 2816;
constexpr int NWAVES = 8, NTHR = 512;
constexpr size_t MiB = 1u << 20;
constexpr size_t WS_WEIN = 1 * MiB, WS_WEOUT = 8 * MiB, WS_WOIN = 10 * MiB, WS_WOOUT = 18 * MiB, WS_WQ = 20 * MiB, WS_WKV = 24 * MiB, WS_WO = 32 * MiB;
constexpr size_t WS_MEMN = 36 * MiB, WS_KV = 40 * MiB, WS_ROT = 48 * MiB, WS_SSP = 52 * MiB;
constexpr size_t WS_XB = 56 * MiB;
constexpr size_t WS_BIG = 120 * MiB;
constexpr size_t WS_BUFA = 376 * MiB;
constexpr size_t WS_BUFB = 440 * MiB;
constexpr size_t WS_END = 504 * MiB;
constexpr int LDS_BYTES = 147456;

#define LAS __attribute__((address_space(3)))
typedef unsigned short bf16;
typedef short bf16x8 __attribute__((ext_vector_type(8)));
typedef short s16x4 __attribute__((ext_vector_type(4)));
typedef float f32x2 __attribute__((ext_vector_type(2)));
typedef float f32x4 __attribute__((ext_vector_type(4)));
typedef float f32x16 __attribute__((ext_vector_type(16)));
typedef unsigned u32x2 __attribute__((ext_vector_type(2)));
typedef unsigned u32x4 __attribute__((ext_vector_type(4)));

__device__ __forceinline__ unsigned pk2(float lo, float hi) { return pg8::cvt_pk_bf16(lo, hi); }
__device__ __forceinline__ float bflo(unsigned w) { return __uint_as_float(w << 16); }
__device__ __forceinline__ float bfhi(unsigned w) { return __uint_as_float(w & 0xffff0000u); }
__device__ __forceinline__ int crow(int r, int hi) { return (r & 3) + 8 * (r >> 2) + 4 * hi; }
__device__ __forceinline__ float wave_sum(float v) {
#pragma unroll
    for (int o = 1; o < 64; o <<= 1) v += __shfl_xor(v, o);
    return v;
}
__device__ __forceinline__ float silu(float x) { return x / (1.0f + __expf(-x)); }
__device__ __forceinline__ s16x4 trd(const LAS bf16* p) { return __builtin_bit_cast(s16x4, __builtin_amdgcn_ds_read_tr16_b64_v4i16((LAS s16x4*)p)); }
__device__ __forceinline__ bf16x8 tr_frag(const LAS bf16* T, int ld, int k0, int n0, int lane) {
    const int g4 = lane >> 4, li = lane & 15, q = li >> 2, p = li & 3, hi = g4 >> 1;
    const LAS bf16* a = T + (k0 + 4 * hi + q) * ld + n0 + 16 * (g4 & 1) + 4 * p;
    const s16x4 lo = trd(a), up = trd(a + 8 * ld);
    return (bf16x8){lo[0], lo[1], lo[2], lo[3], up[0], up[1], up[2], up[3]};
}
__device__ __forceinline__ bf16x8 pack8(float a0, float a1, float a2, float a3, float a4, float a5, float a6, float a7) {
    u32x4 w; w.x = pk2(a0, a1); w.y = pk2(a2, a3); w.z = pk2(a4, a5); w.w = pk2(a6, a7); return __builtin_bit_cast(bf16x8, w);
}
__device__ __forceinline__ int launder(int v) { asm volatile("" : "+v"(v)); return v; }
#define MFMA32(a, b, c) __builtin_amdgcn_mfma_f32_32x32x16_bf16((a), (b), (c), 0, 0, 0)

#define XB_TMO      128
#define XB_XCNT(j)  (256  + 64 * (j))
#define XB_XSUB(j)  (1280 + 64 * (j))
#define XB_XGEN(j)  (2304 + 64 * (j))
#define XB_TOP      3328
#define XB_TOPGEN   3392
#define XCD_BAR_WORDS 3456
#define XB_SPIN_CAP (1u << 18)

__device__ __forceinline__ unsigned xb_ld(unsigned* p)              { return __hip_atomic_load(p, __ATOMIC_RELAXED, __HIP_MEMORY_SCOPE_AGENT); }
__device__ __forceinline__ unsigned xb_add(unsigned* p, unsigned v) { return __hip_atomic_fetch_add(p, v, __ATOMIC_RELAXED, __HIP_MEMORY_SCOPE_AGENT); }
__device__ __forceinline__ unsigned xb_xcc_id() { return (unsigned)__builtin_amdgcn_s_getreg((3 << 11) | 20) & 0xFu; }
#define XB_SPIN(cond, bar) do { unsigned _sp = 0; while (cond) { __builtin_amdgcn_s_sleep(1); \
    if ((++_sp & 255u) == 0u) { if (xb_ld(&(bar)[XB_TMO])) break; if (_sp > XB_SPIN_CAP) { atomicAdd(&(bar)[XB_TMO], 1u); break; } } } } while (0)

struct XcdBarrier {
    unsigned* bar; unsigned x; int wv;
    volatile LAS unsigned* st;
};

__device__ __forceinline__ XcdBarrier xcd_barrier_post(unsigned* bar, volatile LAS unsigned* st, int wv) {
    XcdBarrier b; b.bar = bar; b.x = xb_xcc_id(); b.st = st; b.wv = wv;
    if (wv == 0 && mk_lane() == 0) (void)xb_add(&bar[XB_XCNT(b.x)], 1u);
    return b;
}
__device__ __forceinline__ void xcd_barrier_complete(unsigned* bar, unsigned x, unsigned& nloc, unsigned& nx) {
    const unsigned G = gridDim.x * gridDim.y * gridDim.z;
    unsigned sum, cnt, mine, sp = 0u;
    for (;;) {
        sum = 0u; cnt = 0u; mine = 0u;
#pragma unroll
        for (unsigned j = 0; j < 16; ++j) { const unsigned c = xb_ld(&bar[XB_XCNT(j)]); sum += c; cnt += (c > 0u) ? 1u : 0u; mine = (j == x) ? c : mine; }
        if (sum == G) break;
        __builtin_amdgcn_s_sleep(1);
        if ((++sp & 255u) == 0u) { if (xb_ld(&bar[XB_TMO])) break; if (sp > XB_SPIN_CAP) { atomicAdd(&bar[XB_TMO], 1u); break; } }
    }
    nloc = mine > 0u ? mine : 1u; nx = cnt > 0u ? cnt : 1u;
}

__device__ __forceinline__ void xcd_barrier(const XcdBarrier& b) {
    asm volatile("s_waitcnt vmcnt(0)" ::: "memory");
    __syncthreads();
    if (b.wv == 0 && mk_lane() == 0) {
        unsigned* bar = b.bar;
        __builtin_amdgcn_s_waitcnt(0);
        unsigned nloc = b.st[0], nx = b.st[1];
        if (nloc == 0u) { xcd_barrier_complete(bar, b.x, nloc, nx); b.st[0] = nloc; b.st[1] = nx; }
        const unsigned old = xb_add(&bar[XB_XSUB(b.x)], 1u);
        const unsigned gen = old / nloc;
        if (old + 1u == (gen + 1u) * nloc) {
            __builtin_amdgcn_fence(__ATOMIC_RELEASE, "agent");
            asm volatile("s_waitcnt vmcnt(0)" ::: "memory");
            const unsigned og = xb_add(&bar[XB_TOP], 1u);
            const unsigned tg = og / nx;
            if (og + 1u == (tg + 1u) * nx) xb_add(&bar[XB_TOPGEN], 1u);
            else XB_SPIN(xb_ld(&bar[XB_TOPGEN]) == tg, bar);
            __builtin_amdgcn_fence(__ATOMIC_ACQUIRE, "agent");
            xb_add(&bar[XB_XGEN(b.x)], 1u);
            asm volatile("s_waitcnt vmcnt(0)" ::: "memory");
        } else {
            XB_SPIN(xb_ld(&bar[XB_XGEN(b.x)]) == gen, bar);
            __builtin_amdgcn_fence(__ATOMIC_ACQUIRE, "agent");
            asm volatile("s_waitcnt vmcnt(0)" ::: "memory");
        }
    }
    __syncthreads();
}

constexpr int XB_WS_OFF = 4096, XB_LDS_OFF = 147200;
struct Args { const float* in[17]; float* out; unsigned char* ws; int ph_lo, ph_hi; };
struct Frame {
    LAS unsigned char* lds; int wave, G, bid;
    const Args* ap;
};

__device__ __forceinline__ void p0_transpose_item(const float* W, const float* gain, int K, int N, bf16* WT, LAS float* scr, int item, int lane) {
    const int nblk = N / 32, kb = item / nblk, nb = item % nblk, k0 = 64 * kb, n0 = 32 * nb;
#pragma unroll 8
    for (int i = 0; i < 32; ++i) { const int kk = 2 * i + (lane >> 5); float w = W[(size_t)(k0 + kk) * N + n0 + (lane & 31)]; if (gain) w *= gain[k0 + kk]; scr[kk * 33 + (lane & 31)] = w; }
    asm volatile("s_waitcnt lgkmcnt(0)" ::: "memory");
    const int c = lane & 7;
#pragma unroll
    for (int j = 0; j < 4; ++j) { const int n = (lane >> 3) + 8 * j; const LAS float* s = scr + (8 * c) * 33 + n;
        u32x4 o; o.x = pk2(s[0 * 33], s[1 * 33]); o.y = pk2(s[2 * 33], s[3 * 33]); o.z = pk2(s[4 * 33], s[5 * 33]); o.w = pk2(s[6 * 33], s[7 * 33]);
        *(u32x4*)(WT + (size_t)(n0 + n) * K + k0 + 8 * c) = o; }
    asm volatile("s_waitcnt lgkmcnt(0)" ::: "memory");
}
__device__ __forceinline__ void p0_prologue(Frame& F) {
    LAS float* scr = (LAS float*)(F.lds + F.wave * 16384);
    const int gw = F.bid * NWAVES + F.wave, NGW = F.G * NWAVES, lane = mk_lane();
    unsigned char* ws = F.ap->ws;
    constexpr int I_EIN = 16 * (EIN / 32), I_SQ = 16 * 32, I_OIN = 16 * (OIN / 32), I_KV = 16 * 64;
    constexpr int NITEMS = I_EIN + I_SQ + I_OIN + I_SQ + 2 * I_SQ + 2 * I_KV + 2 * I_SQ;
    for (int it = gw; it < NITEMS; it += NGW) {
        int r = it;
        if (r < I_EIN) { p0_transpose_item(F.ap->in[3], F.ap->in[2], D, EIN, (bf16*)(ws + WS_WEIN), scr, r, lane); continue; } r -= I_EIN;
        if (r < I_SQ) { p0_transpose_item(F.ap->in[5], nullptr, D, D, (bf16*)(ws + WS_WEOUT), scr, r, lane); continue; } r -= I_SQ;
        if (r < I_OIN) { p0_transpose_item(F.ap->in[7], F.ap->in[6], D, OIN, (bf16*)(ws + WS_WOIN), scr, r, lane); continue; } r -= I_OIN;
        if (r < I_SQ) { p0_transpose_item(F.ap->in[10], nullptr, D, D, (bf16*)(ws + WS_WOOUT), scr, r, lane); continue; } r -= I_SQ;
        if (r < 2 * I_SQ) { const int l = r / I_SQ; p0_transpose_item(F.ap->in[13] + (size_t)l * D * D, F.ap->in[11] + l * D, D, D, (bf16*)(ws + WS_WQ) + (size_t)l * D * D, scr, r % I_SQ, lane); continue; } r -= 2 * I_SQ;
        if (r < 2 * I_KV) { const int l = r / I_KV; p0_transpose_item(F.ap->in[14] + (size_t)l * D * 2 * D, nullptr, D, 2 * D, (bf16*)(ws + WS_WKV) + (size_t)l * 2 * D * D, scr, r % I_KV, lane); continue; } r -= 2 * I_KV;
        { const int l = r / I_SQ; p0_transpose_item(F.ap->in[15] + (size_t)l * D * D, nullptr, D, D, (bf16*)(ws + WS_WO) + (size_t)l * D * D, scr, r % I_SQ, lane); }
    }
    for (int it = gw; it < 2 * BATCH * MEMLEN; it += NGW) {
        const int l = it / (BATCH * MEMLEN), row = it % (BATCH * MEMLEN);
        const f32x4* xr = (const f32x4*)(F.ap->in[1] + (size_t)row * D) + lane; const f32x4* gr = (const f32x4*)(F.ap->in[12] + l * D) + lane;
        f32x4 v[4]; float s = 0.f;
#pragma unroll
        for (int j = 0; j < 4; ++j) { v[j] = xr[64 * j]; s += (v[j][0] * v[j][0] + v[j][1] * v[j][1]) + (v[j][2] * v[j][2] + v[j][3] * v[j][3]); }
        const float rs = 1.0f / sqrtf(wave_sum(s) * (1.0f / D) + EPS);
        u32x2* o8 = (u32x2*)((bf16*)(ws + WS_MEMN) + (size_t)it * D) + lane;
#pragma unroll
        for (int j = 0; j < 4; ++j) { const f32x4 g = gr[64 * j]; u32x2 w; w.x = pk2(v[j][0] * rs * g[0], v[j][1] * rs * g[1]); w.y = pk2(v[j][2] * rs * g[2], v[j][3] * rs * g[3]); o8[64 * j] = w; }
    }
    for (int row = gw; row < MTOK; row += NGW) {
        const f32x4* xr = (const f32x4*)(F.ap->in[0] + (size_t)row * D) + lane;
        f32x4 v[4]; float s = 0.f;
#pragma unroll
        for (int j = 0; j < 4; ++j) { v[j] = xr[64 * j]; s += (v[j][0] * v[j][0] + v[j][1] * v[j][1]) + (v[j][2] * v[j][2] + v[j][3] * v[j][3]); }
        s = wave_sum(s);
        u32x2* o8 = (u32x2*)((bf16*)(ws + WS_XB) + (size_t)row * D) + lane;
#pragma unroll
        for (int j = 0; j < 4; ++j) { u32x2 w; w.x = pk2(v[j][0], v[j][1]); w.y = pk2(v[j][2], v[j][3]); o8[64 * j] = w; }
        if (lane < 16) ((float*)(ws + WS_SSP))[(size_t)row * 16 + lane] = (lane == 0) ? s : 0.f;
    }
    for (int e = F.bid * NTHR + launder((F.wave * 64 + mk_lane())); e < SEQ * 64; e += F.G * NTHR) {
        const int pos = e >> 6, j = e & 63;
        const float inv = 1.0f / exp2f(((float)j / 63.0f) * 13.287712379549449f);
        const float ang = (float)pos * inv;
        const double a = (double)ang, kk = rint(a * 0.63661977236758134308);
        const float r = (float)fma(-kk, 1.57079632679489661923, a), r2 = r * r;
        const float sn = r + r * r2 * (-1.6666654611e-1f + r2 * (8.3321608736e-3f + r2 * (-1.9515295891e-4f)));
        const float cs = 1.0f - 0.5f * r2 + r2 * r2 * (4.166664568298827e-2f + r2 * (-1.388731625493765e-3f + r2 * 2.443315711809948e-5f));
        const int q = ((int)kk) & 3;
        f32x2 o; o.x = (q == 0) ? cs : (q == 1) ? -sn : (q == 2) ? -cs : sn; o.y = (q == 0) ? sn : (q == 1) ? cs : (q == 2) ? -sn : -cs;
        ((f32x2*)(ws + WS_ROT))[e] = o;
    }
}

constexpr int AKS = 72;
__device__ __forceinline__ void swa_item(Frame& F, int item) {
    const int kvh = item & 1, c = (item >> 1) & (NCH - 1), b = item >> 8;
    const int c0 = c >= 2 ? c - 2 : 0, nch = c - c0 + 1;
    const int tid = launder((F.wave * 64 + mk_lane())), lane = tid & 63, w = F.wave, r32 = lane & 31, hi = lane >> 5;
    LAS bf16* Ks = (LAS bf16*)F.lds; LAS bf16* Vs = Ks + 192 * AKS;
    const bf16* HC = (const bf16*)(F.ap->ws + WS_BIG);
    const size_t rowbase = (size_t)b * SEQ;
    for (int p = tid; p < nch * 64 * 8; p += NTHR) { const int r = p >> 3, ch = p & 7; const bf16* src = HC + (rowbase + c0 * 64 + r) * EIN + kvh * 64 + ch * 8;
        const u32x4 kx = *(const u32x4*)(src + C_AK), vx = *(const u32x4*)(src + C_AV);
        *(LAS u32x4*)(Ks + r * AKS + ch * 8) = kx; *(LAS u32x4*)(Vs + r * AKS + ch * 8) = vx; }
    const int qh = kvh * 4 + (w >> 1);
    const size_t tok = rowbase + c * 64 + (w & 1) * 32 + r32;
    const bf16* qp = HC + tok * EIN + C_AQ + qh * 64 + hi * 8;
    bf16x8 qf[4];
#pragma unroll
    for (int s = 0; s < 4; ++s) qf[s] = *(const bf16x8*)(qp + 16 * s);
    __syncthreads();
    const int nkb = 2 * nch;
    f32x16 st[6];
#pragma unroll
    for (int kb = 0; kb < 6; ++kb) { st[kb] = (f32x16){};
        if (kb < nkb) {
#pragma unroll
            for (int s = 0; s < 4; ++s) { const bf16x8 a = *(const LAS bf16x8*)(Ks + (32 * kb + r32) * AKS + 16 * s + 8 * hi); st[kb] = MFMA32(a, qf[s], st[kb]); } } }
    float mx = -3.0e38f;
#pragma unroll
    for (int kb = 0; kb < 6; ++kb) if (kb < nkb) {
#pragma unroll
        for (int i = 0; i < 16; ++i) mx = fmaxf(mx, st[kb][i]); }
    mx = fmaxf(mx, __shfl_xor(mx, 32));
    const float sink = F.ap->in[4][qh];
    const float mref = fmaxf(mx * 0.125f, sink);
    const float L2E = 1.4426950408889634f;
    float sum = 0.f;
#pragma unroll
    for (int kb = 0; kb < 6; ++kb) if (kb < nkb) {
#pragma unroll
        for (int i = 0; i < 16; ++i) { const float p = exp2f((st[kb][i] * 0.125f - mref) * L2E); st[kb][i] = p; sum += p; } }
    sum += __shfl_xor(sum, 32);
    const float inv = 1.0f / (sum + exp2f((sink - mref) * L2E));
    f32x16 o[2]; o[0] = (f32x16){}; o[1] = (f32x16){};
#pragma unroll
    for (int kb = 0; kb < 6; ++kb) if (kb < nkb) {
#pragma unroll
        for (int s = 0; s < 2; ++s) {
            const bf16x8 pf = pack8(st[kb][8 * s + 0] * inv, st[kb][8 * s + 1] * inv, st[kb][8 * s + 2] * inv, st[kb][8 * s + 3] * inv, st[kb][8 * s + 4] * inv, st[kb][8 * s + 5] * inv, st[kb][8 * s + 6] * inv, st[kb][8 * s + 7] * inv);
#pragma unroll
            for (int db = 0; db < 2; ++db) { const bf16x8 vf = tr_frag(Vs, AKS, 32 * kb + 16 * s, 32 * db, lane); o[db] = MFMA32(vf, pf, o[db]); } } }
    const bf16* gp = HC + tok * EIN + C_AG + qh * 64;
    bf16* yp = (bf16*)(F.ap->ws + WS_BUFA) + tok * D + qh * 64;
#pragma unroll
    for (int db = 0; db < 2; ++db)
#pragma unroll
        for (int gi = 0; gi < 4; ++gi) { const int d0 = 32 * db + 8 * gi + 4 * hi; const u32x2 g = *(const u32x2*)(gp + d0);
            u32x2 y; y.x = pk2(o[db][4 * gi + 0] * silu(bflo(g.x)), o[db][4 * gi + 1] * silu(bfhi(g.x))); y.y = pk2(o[db][4 * gi + 2] * silu(bflo(g.y)), o[db][4 * gi + 3] * silu(bfhi(g.y)));
            *(u32x2*)(yp + d0) = y; }
    __syncthreads();
}

constexpr int RKS = 136;
__device__ __forceinline__ float head_lg2(int h) { return log2f(1.0f - exp2f(-5.0f - (float)h)); }
__device__ __forceinline__ void ret1_item(Frame& F, int item) {
    const int h = item & 3, c = (item >> 2) & (NCH - 1), b = item >> 9;
    const int tid = launder((F.wave * 64 + mk_lane())), lane = tid & 63, w = F.wave, r32 = lane & 31, hi = lane >> 5;
    LAS bf16* Qr = (LAS bf16*)F.lds; LAS bf16* Kr = Qr + 64 * RKS; LAS bf16* Vs = Kr + 64 * RKS; LAS bf16* Vd = Vs + 64 * RKS;
    bf16* HC = (bf16*)(F.ap->ws + WS_BIG);
    const size_t rowbase = (size_t)b * SEQ + (size_t)c * 64;
    const float lg2 = head_lg2(h);
    {
        const int j = tid >> 3, pc = tid & 7;
        bf16* rowp = HC + (rowbase + j) * EIN;
        const u32x4 q1 = *(const u32x4*)(rowp + C_BQ + h * 128 + 8 * pc), q2 = *(const u32x4*)(rowp + C_BQ + h * 128 + 64 + 8 * pc);
        const u32x4 k1 = *(const u32x4*)(rowp + C_BK + h * 128 + 8 * pc), k2 = *(const u32x4*)(rowp + C_BK + h * 128 + 64 + 8 * pc);
        const u32x4 v1 = *(const u32x4*)(rowp + C_BV + h * 128 + 16 * pc), v2 = *(const u32x4*)(rowp + C_BV + h * 128 + 16 * pc + 8);
        const f32x4* rt = (const f32x4*)((const f32x2*)(F.ap->ws + WS_ROT) + (size_t)(c * 64 + j) * 64 + 8 * pc);
        u32x4 qa, qb, ka, kb;
        const float ksc = 0.08838834764831845f;
#pragma unroll
        for (int e = 0; e < 4; ++e) { const f32x4 cs = rt[e];
            const float a0 = bflo(q1[e]), a1 = bfhi(q1[e]), b0 = bflo(q2[e]), b1 = bfhi(q2[e]);
            qa[e] = pk2(a0 * cs[0] - b0 * cs[1], a1 * cs[2] - b1 * cs[3]); qb[e] = pk2(a0 * cs[1] + b0 * cs[0], a1 * cs[3] + b1 * cs[2]);
            const float c0 = bflo(k1[e]), c1 = bfhi(k1[e]), d0 = bflo(k2[e]), d1 = bfhi(k2[e]);
            ka[e] = pk2((c0 * cs[0] - d0 * cs[1]) * ksc, (c1 * cs[2] - d1 * cs[3]) * ksc); kb[e] = pk2((c0 * cs[1] + d0 * cs[0]) * ksc, (c1 * cs[3] + d1 * cs[2]) * ksc); }
        *(LAS u32x4*)(Qr + j * RKS + 8 * pc) = qa; *(LAS u32x4*)(Qr + j * RKS + 64 + 8 * pc) = qb;
        *(LAS u32x4*)(Kr + j * RKS + 8 * pc) = ka; *(LAS u32x4*)(Kr + j * RKS + 64 + 8 * pc) = kb;
        *(u32x4*)(rowp + C_BQ + h * 128 + 8 * pc) = qa; *(u32x4*)(rowp + C_BQ + h * 128 + 64 + 8 * pc) = qb;
        *(LAS u32x4*)(Vs + j * RKS + 16 * pc) = v1; *(LAS u32x4*)(Vs + j * RKS + 16 * pc + 8) = v2;
        const float kd = exp2f(lg2 * (float)(63 - j));
        u32x4 w1, w2;
#pragma unroll
        for (int e = 0; e < 4; ++e) { w1[e] = pk2(bflo(v1[e]) * kd, bfhi(v1[e]) * kd); w2[e] = pk2(bflo(v2[e]) * kd, bfhi(v2[e]) * kd); }
        *(LAS u32x4*)(Vd + j * RKS + 16 * pc) = w1; *(LAS u32x4*)(Vd + j * RKS + 16 * pc + 8) = w2;
    }
    __syncthreads();
    const int ib = w & 1, db = w >> 1;
    f32x16 st[2];
#pragma unroll
    for (int jb = 0; jb < 2; ++jb) { st[jb] = (f32x16){};
#pragma unroll
        for (int s = 0; s < 8; ++s) { const bf16x8 a = *(const LAS bf16x8*)(Kr + (32 * jb + r32) * RKS + 16 * s + 8 * hi); const bf16x8 q = *(const LAS bf16x8*)(Qr + (32 * ib + r32) * RKS + 16 * s + 8 * hi);
            st[jb] = MFMA32(a, q, st[jb]); } }
    const int iloc = 32 * ib + r32;
#pragma unroll
    for (int jb = 0; jb < 2; ++jb)
#pragma unroll
        for (int i = 0; i < 16; ++i) { const int j = 32 * jb + crow(i, hi); const int dd = iloc > j ? iloc - j : j - iloc; st[jb][i] *= exp2f(lg2 * (float)dd); }
    f32x16 o = (f32x16){};
#pragma unroll
    for (int jb = 0; jb < 2; ++jb)
#pragma unroll
        for (int s = 0; s < 2; ++s) {
            const bf16x8 pf = pack8(st[jb][8 * s + 0], st[jb][8 * s + 1], st[jb][8 * s + 2], st[jb][8 * s + 3], st[jb][8 * s + 4], st[jb][8 * s + 5], st[jb][8 * s + 6], st[jb][8 * s + 7]);
            const bf16x8 vf = tr_frag(Vs, RKS, 32 * jb + 16 * s, 32 * db, lane);
            o = MFMA32(vf, pf, o); }
    {
        float* op = (float*)(F.ap->ws + WS_XB) + (rowbase + iloc) * 512 + h * 128 + 32 * db + 4 * hi;
#pragma unroll
        for (int gi = 0; gi < 4; ++gi) *(f32x4*)(op + 8 * gi) = (f32x4){o[4 * gi], o[4 * gi + 1], o[4 * gi + 2], o[4 * gi + 3]};
    }
    const int rb = w >> 1;
    f32x16 kv[2]; kv[0] = (f32x16){}; kv[1] = (f32x16){};
#pragma unroll
    for (int s = 0; s < 4; ++s) { const bf16x8 af = tr_frag(Kr, RKS, 16 * s, 32 * rb, lane);
#pragma unroll
        for (int t = 0; t < 2; ++t) { const bf16x8 bf = tr_frag(Vd, RKS, 16 * s, 32 * (2 * (w & 1) + t), lane); kv[t] = MFMA32(af, bf, kv[t]); } }
    bf16* stp = (bf16*)(F.ap->ws + WS_BUFB) + ((size_t)(b * NCH + c) * 4 + h) * 16384;
#pragma unroll
    for (int t = 0; t < 2; ++t) { const int dv = 32 * (2 * (w & 1) + t) + r32;
#pragma unroll
        for (int gi = 0; gi < 4; ++gi) { const int dk = 32 * rb + 8 * gi + 4 * hi; u32x2 y; y.x = pk2(kv[t][4 * gi], kv[t][4 * gi + 1]); y.y = pk2(kv[t][4 * gi + 2], kv[t][4 * gi + 3]);
            *(u32x2*)(stp + dv * 128 + dk) = y; } }
    __syncthreads();
}

__device__ __forceinline__ void scan_phase(Frame& F) {
    unsigned* ST = (unsigned*)(F.ap->ws + WS_BUFB);
    for (int e = F.bid * NTHR + launder((F.wave * 64 + mk_lane())); e < BATCH * 4 * 8192; e += F.G * NTHR) {
        const int idx = e & 8191, h = (e >> 13) & 3, b = e >> 15;
        const float dec = exp2f(head_lg2(h) * 64.0f);
        unsigned* p = ST + ((size_t)(b * NCH) * 4 + h) * 8192 + idx;
        float s0 = 0.f, s1 = 0.f;
#pragma unroll 8
        for (int c = 0; c < NCH; ++c) { const unsigned kvw = p[(size_t)c * 4 * 8192]; p[(size_t)c * 4 * 8192] = pk2(s0, s1); s0 = s0 * dec + bflo(kvw); s1 = s1 * dec + bfhi(kvw); }
    }
}

__device__ __forceinline__ void ret2_item(Frame& F, int item) {
    const int h = item & 3, c = (item >> 2) & (NCH - 1), b = item >> 9;
    const int lane = launder(mk_lane()), w = F.wave, r32 = lane & 31, hi = lane >> 5;
    const int ib = w & 1, db = w >> 1, iloc = 32 * ib + r32;
    LAS float* part = (LAS float*)F.lds;
    const bf16* HC = (const bf16*)(F.ap->ws + WS_BIG);
    const size_t tok = (size_t)b * SEQ + (size_t)c * 64 + iloc;
    const bf16* stp = (const bf16*)(F.ap->ws + WS_BUFB) + ((size_t)(b * NCH + c) * 4 + h) * 16384 + (size_t)(32 * db + r32) * 128 + 8 * hi;
    const bf16* qp = HC + tok * EIN + C_BQ + h * 128 + 8 * hi;
    f32x16 oc = (f32x16){};
#pragma unroll
    for (int s = 0; s < 8; ++s) { const bf16x8 a = *(const bf16x8*)(stp + 16 * s); const bf16x8 q = *(const bf16x8*)(qp + 16 * s); oc = MFMA32(a, q, oc); }
    const float qdec = exp2f(head_lg2(h) * (float)(iloc + 1));
    const float* op = (const float*)(F.ap->ws + WS_XB) + tok * 512 + h * 128 + 32 * db + 4 * hi;
    float ss = 0.f;
#pragma unroll
    for (int gi = 0; gi < 4; ++gi) { const f32x4 oi = *(const f32x4*)(op + 8 * gi);
#pragma unroll
        for (int e = 0; e < 4; ++e) { const float v = oi[e] + oc[4 * gi + e] * qdec; oc[4 * gi + e] = v; ss += v * v; } }
    ss += __shfl_xor(ss, 32);
    if (hi == 0) part[iloc * 4 + db] = ss;
    __syncthreads();
    const f32x4 pp = *(const LAS f32x4*)(part + iloc * 4);
    const float rs = 1.0f / sqrtf(((pp[0] + pp[1]) + (pp[2] + pp[3])) * (1.0f / 128.0f) + EPS);
    const bf16* gp = HC + tok * EIN + C_BG + h * 128 + 32 * db + 4 * hi;
    bf16* yp = (bf16*)(F.ap->ws + WS_BUFA) + tok * D + 512 + h * 128 + 32 * db + 4 * hi;
#pragma unroll
    for (int gi = 0; gi < 4; ++gi) { const u32x2 g = *(const u32x2*)(gp + 8 * gi);
        u32x2 y; y.x = pk2(oc[4 * gi + 0] * rs * silu(bflo(g.x)), oc[4 * gi + 1] * rs * silu(bfhi(g.x))); y.y = pk2(oc[4 * gi + 2] * rs * silu(bflo(g.y)), oc[4 * gi + 3] * rs * silu(bfhi(g.y)));
        *(u32x2*)(yp + 8 * gi) = y; }
    __syncthreads();
}

constexpr int XKS = 264;
__device__ __forceinline__ void xattn_unit(Frame& F, int layer, int unit) {
    const int h = unit & 3, rt = unit >> 2, b = rt >> 5;
    const int tid = launder((F.wave * 64 + mk_lane())), lane = tid & 63, w = F.wave, r32 = lane & 31, hi = lane >> 5;
    LAS bf16* buf0 = (LAS bf16*)F.lds; LAS bf16* buf1 = buf0 + 64 * XKS;
    const bf16* Kg = (const bf16*)(F.ap->ws + WS_KV) + ((size_t)layer * BATCH * MEMLEN + (size_t)b * MEMLEN) * 2048 + h * 256;
    const size_t row = (size_t)rt * 256 + w * 32 + r32;
    const bf16* qp = (const bf16*)(F.ap->ws + WS_BUFB) + row * D + h * 256 + 8 * hi;
    const bf16* gsrc = Kg + (size_t)(tid >> 5) * 2048 + (tid & 31) * 8;
    const int ldst = (tid >> 5) * XKS + (tid & 31) * 8;
    u32x4 pf[4];
#define XLOAD(blk) do { _Pragma("unroll") for (int i_ = 0; i_ < 4; ++i_) pf[i_] = *(const u32x4*)(gsrc + (size_t)((((blk) & 3) * 64 + 16 * i_) * 2048 + ((blk) >= 4 ? 1024 : 0))); } while (0)
#define XSTORE(bufp) do { _Pragma("unroll") for (int i_ = 0; i_ < 4; ++i_) *(LAS u32x4*)((bufp) + ldst + 16 * i_ * XKS) = pf[i_]; } while (0)
    __syncthreads();
    XLOAD(0);
    bf16x8 qf[8];
    LAS bf16* qs = (LAS bf16*)(F.lds + 69632) + w * (32 * 136) + r32 * 136 + 8 * hi;
#pragma unroll
    for (int s = 0; s < 8; ++s) qf[s] = *(const bf16x8*)(qp + 16 * s);
#pragma unroll
    for (int s = 0; s < 8; ++s) { const bf16x8 t = *(const bf16x8*)(qp + 128 + 16 * s); *(LAS bf16x8*)(qs + 16 * s) = t; }
    XSTORE(buf0);
    XLOAD(1);
    __syncthreads();
    f32x16 st[8];
#pragma unroll
    for (int kblk = 0; kblk < 4; ++kblk) {
        const LAS bf16* cur = (kblk & 1) ? buf1 : buf0; LAS bf16* nxt = (kblk & 1) ? buf0 : buf1;
#pragma unroll
        for (int kk = 0; kk < 2; ++kk) { f32x16 acc = (f32x16){};
#pragma unroll
            for (int s = 0; s < 8; ++s) { const bf16x8 a = *(const LAS bf16x8*)(cur + (32 * kk + r32) * XKS + 16 * s + 8 * hi); acc = MFMA32(a, qf[s], acc); }
#pragma unroll
            for (int s = 0; s < 8; ++s) { const bf16x8 a = *(const LAS bf16x8*)(cur + (32 * kk + r32) * XKS + 128 + 16 * s + 8 * hi); const bf16x8 q = *(const LAS bf16x8*)(qs + 16 * s); acc = MFMA32(a, q, acc); }
            st[2 * kblk + kk] = acc; }
        XSTORE(nxt);
        XLOAD(kblk + 2);
        __syncthreads();
    }
    float mx = -3.0e38f;
#pragma unroll
    for (int kb = 0; kb < 8; ++kb)
#pragma unroll
        for (int i = 0; i < 16; ++i) mx = fmaxf(mx, st[kb][i]);
    mx = fmaxf(mx, __shfl_xor(mx, 32));
    const float SC = 0.0625f * 1.4426950408889634f;
    float sum = 0.f;
#pragma unroll
    for (int kb = 0; kb < 8; ++kb)
#pragma unroll
        for (int i = 0; i < 16; ++i) { const float p = exp2f((st[kb][i] - mx) * SC); st[kb][i] = p; sum += p; }
    sum += __shfl_xor(sum, 32);
    const float inv = 1.0f / sum;
    bf16x8 pw[8][2];
#pragma unroll
    for (int kb = 0; kb < 8; ++kb)
#pragma unroll
        for (int s = 0; s < 2; ++s) pw[kb][s] = pack8(st[kb][8 * s + 0] * inv, st[kb][8 * s + 1] * inv, st[kb][8 * s + 2] * inv, st[kb][8 * s + 3] * inv, st[kb][8 * s + 4] * inv, st[kb][8 * s + 5] * inv, st[kb][8 * s + 6] * inv, st[kb][8 * s + 7] * inv);
    f32x16 o[8];
#pragma unroll
    for (int db = 0; db < 8; ++db) o[db] = (f32x16){};
#pragma unroll
    for (int vblk = 0; vblk < 4; ++vblk) {
        const LAS bf16* cur = (vblk & 1) ? buf1 : buf0; LAS bf16* nxt = (vblk & 1) ? buf0 : buf1;
#pragma unroll
        for (int kk = 0; kk < 2; ++kk)
#pragma unroll
            for (int s = 0; s < 2; ++s)
#pragma unroll
                for (int db = 0; db < 8; ++db) { const bf16x8 vf = tr_frag(cur, XKS, 32 * kk + 16 * s, 32 * db, lane); o[db] = MFMA32(vf, pw[2 * vblk + kk][s], o[db]); }
        if (vblk < 3) XSTORE(nxt);
        if (vblk < 2) XLOAD(vblk + 6);
        __syncthreads();
    }
#undef XLOAD
#undef XSTORE
    bf16* op = (bf16*)(F.ap->ws + WS_BUFA) + row * D + h * 256 + 4 * hi;
#pragma unroll
    for (int db = 0; db < 8; ++db)
#pragma unroll
        for (int gi = 0; gi < 4; ++gi) { u32x2 y; y.x = pk2(o[db][4 * gi], o[db][4 * gi + 1]); y.y = pk2(o[db][4 * gi + 2], o[db][4 * gi + 3]); *(u32x2*)(op + 32 * db + 8 * gi) = y; }
}

__device__ __forceinline__ void conv_phase(Frame& F) {
    const bf16* H4 = (const bf16*)(F.ap->ws + WS_BIG); bf16* Y = (bf16*)(F.ap->ws + WS_BUFA);
    const float* cw = F.ap->in[8]; const float* cb = F.ap->in[9];
    for (int it = F.bid * NTHR + launder((F.wave * 64 + mk_lane())); it < (MTOK / 8) * 128; it += F.G * NTHR) {
        const int cgi = it & 127, tg = it >> 7, col = cgi * 8, t0 = tg * 8;
        float w0[8], w1[8], w2[8], bs[8];
#pragma unroll
        for (int e = 0; e < 8; ++e) { w0[e] = cw[col + e]; w1[e] = cw[D + col + e]; w2[e] = cw[2 * D + col + e]; bs[e] = cb[col + e]; }
        float zm2[8], zm1[8];
        const bool first = (t0 & (SEQ - 1)) == 0;
#pragma unroll
        for (int e = 0; e < 8; ++e) { zm2[e] = 0.f; zm1[e] = 0.f; }
        if (!first) {
            const bf16* r2 = H4 + (size_t)(t0 - 2) * OIN + col; const bf16* r1 = H4 + (size_t)(t0 - 1) * OIN + col;
            const u32x4 c2 = *(const u32x4*)(r2 + 1024), u2 = *(const u32x4*)(r2 + 2048), c1 = *(const u32x4*)(r1 + 1024), u1 = *(const u32x4*)(r1 + 2048);
#pragma unroll
            for (int e = 0; e < 4; ++e) { zm2[2 * e] = bflo(c2[e]) * bflo(u2[e]); zm2[2 * e + 1] = bfhi(c2[e]) * bfhi(u2[e]); zm1[2 * e] = bflo(c1[e]) * bflo(u1[e]); zm1[2 * e + 1] = bfhi(c1[e]) * bfhi(u1[e]); }
        }
#pragma unroll
        for (int tt = 0; tt < 8; ++tt) {
            const bf16* r = H4 + (size_t)(t0 + tt) * OIN + col;
            const u32x4 gb = *(const u32x4*)(r), gc = *(const u32x4*)(r + 1024), uu = *(const u32x4*)(r + 2048), gt = *(const u32x4*)(r + 3072);
            float z[8], y[8];
#pragma unroll
            for (int e = 0; e < 4; ++e) { z[2 * e] = bflo(gc[e]) * bflo(uu[e]); z[2 * e + 1] = bfhi(gc[e]) * bfhi(uu[e]); }
#pragma unroll
            for (int e = 0; e < 4; ++e) {
                const float cv0 = bs[2 * e] + zm2[2 * e] * w0[2 * e] + zm1[2 * e] * w1[2 * e] + z[2 * e] * w2[2 * e];
                const float cv1 = bs[2 * e + 1] + zm2[2 * e + 1] * w0[2 * e + 1] + zm1[2 * e + 1] * w1[2 * e + 1] + z[2 * e + 1] * w2[2 * e + 1];
                y[2 * e] = bflo(gb[e]) * cv0 * silu(bflo(gt[e])); y[2 * e + 1] = bfhi(gb[e]) * cv1 * silu(bfhi(gt[e])); }
            u32x4 o; o.x = pk2(y[0], y[1]); o.y = pk2(y[2], y[3]); o.z = pk2(y[4], y[5]); o.w = pk2(y[6], y[7]);
            *(u32x4*)(Y + (size_t)(t0 + tt) * D + col) = o;
#pragma unroll
            for (int e = 0; e < 8; ++e) { zm2[e] = zm1[e]; zm1[e] = z[e]; }
        }
    }
}

__device__ __forceinline__ void final_phase(Frame& F) {
    const int gw = F.bid * NWAVES + F.wave, NGW = F.G * NWAVES, lane = mk_lane();
    const float* ssp = (const float*)(F.ap->ws + WS_SSP);
    for (int row = gw; row < MTOK; row += NGW) {
        const f32x4* p = (const f32x4*)(ssp + (size_t)row * 16); const f32x4 a = p[0], b = p[1], c = p[2], d = p[3];
        const float s = ((a[0] + a[1]) + (a[2] + a[3])) + ((b[0] + b[1]) + (b[2] + b[3])) + ((c[0] + c[1]) + (c[2] + c[3])) + ((d[0] + d[1]) + (d[2] + d[3]));
        const float rs = 1.0f / sqrtf(s * (1.0f / D) + EPS);
        f32x4* xr = (f32x4*)(F.ap->out + (size_t)row * D) + lane; const f32x4* gr = (const f32x4*)F.ap->in[16] + lane;
#pragma unroll
        for (int j = 0; j < 4; ++j) { const f32x4 v = xr[64 * j], g = gr[64 * j]; xr[64 * j] = v * rs * g; }
    }
}

#ifndef TS_PROBE
#define TS_PROBE 0
#endif
#define TS_A_HI 5
#define TS_A_LO 2
#define TS_B_HI 1
#define TS_B_LO 0
#ifndef DUP_MASK
#define DUP_MASK 0
#endif
#define REP(k) _Pragma("unroll 1") for (int rep_ = 0; rep_ < ((((DUP_MASK) >> (k)) & 1) + 1); ++rep_)
#ifndef MK_SPLIT
#define MK_SPLIT 0
#endif
constexpr int NPHASE = 16;
__global__ void __launch_bounds__(NTHR, 2) fwd_megakernel(Args args) {
    extern __shared__ __attribute__((aligned(16))) unsigned char lds_raw[];
    cg::grid_group grid = cg::this_grid();
    Frame F;
    F.lds = (LAS unsigned char*)lds_raw; F.wave = __builtin_amdgcn_readfirstlane((int)threadIdx.x >> 6); F.G = gridDim.x; F.bid = blockIdx.x;
    F.ap = (const Args*)__builtin_amdgcn_kernarg_segment_ptr();
    if ((F.wave * 64 + mk_lane()) < 2) ((LAS unsigned*)(F.lds + XB_LDS_OFF))[(F.wave * 64 + mk_lane())] = 0u;
    __syncthreads();
    const XcdBarrier xbar = xcd_barrier_post((unsigned*)(args.ws + XB_WS_OFF), (volatile LAS unsigned*)(F.lds + XB_LDS_OFF), F.wave);
    const int lo = args.ph_lo, hi = args.ph_hi;
    if (hi > NPHASE) grid.sync();
#define IN(k) (lo <= (k) && (k) < hi)
#define SEAM(k) do { if (IN(k) && IN((k) + 1)) xcd_barrier(xbar); STAMP((k) + 1); } while (0)
    typedef pg8::EpiScaleBf16<true> EpiS; typedef pg8::EpiScaleBf16<false> EpiN;
#define ws (F.ap->ws)
#define XB ((bf16*)(ws + WS_XB))
#define SSP ((float*)(ws + WS_SSP))
#define BIG ((bf16*)(ws + WS_BIG))
#define BUFA ((bf16*)(ws + WS_BUFA))
#define BUFB ((bf16*)(ws + WS_BUFB))

#if TS_PROBE
#define STAMP(i) do { if (blockIdx.x == 0 && threadIdx.x == 0) ((unsigned long long*)ws)[i] = __builtin_amdgcn_s_memrealtime(); } while (0)
#else
#define STAMP(i) do { } while (0)
#endif
    STAMP(0);
    REP(0) {
    if (IN(0)) { p0_prologue(F); } SEAM(0); }
    REP(1) {
    if (IN(1)) {
        { pg8::Gemm g{XB, (const bf16*)(ws + WS_WEIN), MTOK, EIN, D}; pg8::StaticOrder S; S.init(MTOK, EIN, F.G, F.bid); pg8::rs_prepass((LAS float*)(F.lds + 131072), S, SSP, (F.wave * 64 + mk_lane())); EpiS E{BIG, EIN, (const LAS float*)(F.lds + 131072)};
          pg8::gemm_phase<EpiS, pg8::StaticOrder, true, true>(F.lds, g, S, E, F.wave); }
#pragma unroll 1
        for (int l = 0; l < 2; ++l) { pg8::Gemm g{(const bf16*)(ws + WS_MEMN) + (size_t)l * BATCH * MEMLEN * D, (const bf16*)(ws + WS_WKV) + (size_t)l * 2 * D * D, BATCH * MEMLEN, 2 * D, D};
          pg8::StaticOrder S; S.init(BATCH * MEMLEN, 2 * D, F.G, (F.bid + F.G - (F.G / 2 + 32 * l) % F.G) % F.G); EpiN E{(bf16*)(ws + WS_KV) + (size_t)l * BATCH * MEMLEN * 2 * D, 2 * D, nullptr};
          pg8::gemm_phase<EpiN, pg8::StaticOrder, true, true>(F.lds, g, S, E, F.wave); }
    } SEAM(1); }
    REP(2) {
    if (IN(2)) {
        for (int it = F.bid; it < BATCH * NCH * 4; it += F.G) ret1_item(F, it);
        for (int it = F.bid; it < BATCH * NCH * 2; it += F.G) swa_item(F, it);
    } SEAM(2); }
    REP(3) {
    if (IN(3)) { scan_phase(F); } SEAM(3); }
    REP(4) {
    if (IN(4)) { for (int it = F.bid; it < BATCH * NCH * 4; it += F.G) ret2_item(F, it); } SEAM(4); }
    REP(5) {
    if (IN(5)) {
        pg8::Gemm g{BUFA, (const bf16*)(ws + WS_WEOUT), MTOK, D, D}; pg8::StaticOrder S; S.init(MTOK, D, F.G, F.bid); typedef pg8::EpiResidual<true, false> EpiR0; EpiR0 E{F.ap->in[0], XB, SSP, D};
        pg8::gemm_phase<EpiR0, pg8::StaticOrder, true, true>(F.lds, g, S, E, F.wave);
    } SEAM(5); }
#pragma unroll
    for (int l = 0; l < 2; ++l) {
        const int pb = (l == 0) ? 6 : 12;
        REP(pb) {
        if (IN(pb)) {
            pg8::Gemm g{XB, (const bf16*)(ws + WS_WQ) + (size_t)l * D * D, MTOK, D, D}; pg8::StaticOrder S; S.init(MTOK, D, F.G, F.bid); pg8::rs_prepass((LAS float*)(F.lds + 131072), S, SSP, (F.wave * 64 + mk_lane())); EpiS E{BUFB, D, (const LAS float*)(F.lds + 131072)};
            pg8::gemm_phase<EpiS, pg8::StaticOrder, true, true>(F.lds, g, S, E, F.wave);
        } SEAM(pb); }
        REP(pb + 1) {
        if (IN(pb + 1)) { for (int it = F.bid; it < (MTOK / 256) * 4; it += F.G) xattn_unit(F, l, it); } SEAM(pb + 1); }
        REP(pb + 2) {
        if (IN(pb + 2)) {
            pg8::Gemm g{BUFA, (const bf16*)(ws + WS_WO) + (size_t)l * D * D, MTOK, D, D}; pg8::StaticOrder S; S.init(MTOK, D, F.G, F.bid); if (l == 0) { typedef pg8::EpiResidual<false, false> EpiR1; EpiR1 E{XB, XB, SSP, D}; pg8::gemm_phase<EpiR1, pg8::StaticOrder, true, true>(F.lds, g, S, E, F.wave); }
            else { typedef pg8::EpiResidual<false, true> EpiR2; EpiR2 E{XB, F.ap->out, SSP, D}; pg8::gemm_phase<EpiR2, pg8::StaticOrder, true, true>(F.lds, g, S, E, F.wave); }
        } SEAM(pb + 2); }
        if (l == 0) {
            REP(9) {
            if (IN(9)) {
                pg8::Gemm g{XB, (const bf16*)(ws + WS_WOIN), MTOK, OIN, D}; pg8::StaticOrder S; S.init(MTOK, OIN, F.G, F.bid); pg8::rs_prepass((LAS float*)(F.lds + 131072), S, SSP, (F.wave * 64 + mk_lane())); EpiS E{BIG, OIN, (const LAS float*)(F.lds + 131072)};
                pg8::gemm_phase<EpiS, pg8::StaticOrder, true, true>(F.lds, g, S, E, F.wave);
            } SEAM(9); }
            REP(10) {
            if (IN(10)) { conv_phase(F); } SEAM(10); }
            REP(11) {
            if (IN(11)) {
                pg8::Gemm g{BUFA, (const bf16*)(ws + WS_WOOUT), MTOK, D, D}; pg8::StaticOrder S; S.init(MTOK, D, F.G, F.bid); typedef pg8::EpiResidual<false, false> EpiR1; EpiR1 E{XB, XB, SSP, D};
                pg8::gemm_phase<EpiR1, pg8::StaticOrder, true, true>(F.lds, g, S, E, F.wave);
            } SEAM(11); }
        }
    }
    if (IN(15)) { final_phase(F); }
#if TS_PROBE
    __syncthreads();
    if (blockIdx.x == 0 && threadIdx.x == 0) { const unsigned long long* ts = (const unsigned long long*)ws;
        const float ta = (float)(ts[TS_A_HI] - ts[TS_A_LO]) * 0.01f, tb = (float)(ts[TS_B_HI] - ts[TS_B_LO]) * 0.01f;
        F.ap->out[0] = ta; for (int i = 1; i <= 1000; ++i) F.ap->out[i] = tb; }
#endif
#undef IN
#undef SEAM
#undef ws
#undef XB
#undef SSP
#undef BIG
#undef BUFA
#undef BUFB
}

extern "C" void kernel_launch(void* const* d_in, const int* in_sizes, int n_in, void* d_out, int out_size, void* d_ws, size_t ws_size, hipStream_t stream) {
    static int grid = 0;
    if (grid == 0) {
        if (n_in != 17 || out_size != MTOK * D || ws_size < WS_END) { fprintf(stderr, "kernel_launch: unexpected shapes (n_in %d out %d ws %zu)\n", n_in, out_size, ws_size); grid = -1; return; }
        int dev = 0, cus = 0, per_cu = 0;
        hipGetDevice(&dev); hipDeviceGetAttribute(&cus, hipDeviceAttributeMultiprocessorCount, dev);
        if (hipFuncSetAttribute((const void*)fwd_megakernel, hipFuncAttributeMaxDynamicSharedMemorySize, LDS_BYTES) != hipSuccess) { fprintf(stderr, "kernel_launch: hipFuncSetAttribute failed\n"); grid = -1; return; }
        if (hipOccupancyMaxActiveBlocksPerMultiprocessor(&per_cu, (const void*)fwd_megakernel, NTHR, LDS_BYTES) != hipSuccess || per_cu < 1) { fprintf(stderr, "kernel_launch: occupancy query says %d\n", per_cu); per_cu = 1; }
        (void)hipGetLastError();
        grid = cus;
    }
    if (grid < 0) return;
    if (hipMemsetAsync(d_ws, 0, 65536, stream) != hipSuccess) { fprintf(stderr, "kernel_launch: hipMemsetAsync failed\n"); return; }
    Args a{};
    for (int i = 0; i < 17; ++i) a.in[i] = (const float*)d_in[i];
    a.out = (float*)d_out; a.ws = (unsigned char*)d_ws;
#if MK_SPLIT
    for (int p = 0; p < NPHASE; ++p) { a.ph_lo = p; a.ph_hi = p + 1; hipLaunchKernelGGL(fwd_megakernel, dim3(grid), dim3(NTHR), LDS_BYTES, stream, a); }
#else
    a.ph_lo = 0; a.ph_hi = NPHASE;
    void* kargs[] = {&a};
    hipError_t e = hipLaunchCooperativeKernel((const void*)fwd_megakernel, dim3(grid), dim3(NTHR), kargs, LDS_BYTES, stream);
    if (e != hipSuccess) fprintf(stderr, "kernel_launch: cooperative launch failed: %s (grid %d)\n", hipGetErrorString(e), grid);
#endif
}
```

```cpp
#include <hip/hip_runtime.h>
#include <hip/hip_cooperative_groups.h>
#include <cstdio>
#include <cstdint>
namespace cg = cooperative_groups;
__device__ __forceinline__ int mk_lane() { int l = (int)__builtin_amdgcn_mbcnt_hi(~0u, __builtin_amdgcn_mbcnt_lo(~0u, 0u)); asm volatile("" : "+v"(l)); return l; }
namespace pg8 {
#define PG8_LAS __attribute__((address_space(3)))
typedef unsigned short bf16_t;
typedef short bf16x8 __attribute__((ext_vector_type(8)));
typedef float f32x4 __attribute__((ext_vector_type(4)));
typedef unsigned u32x4 __attribute__((ext_vector_type(4)));
constexpr int BM = 256, BK = 64, HALF = 128, HTB = HALF * BK * 2  , STAGE_BYTES = 8 * HTB, NXCD = 8, WGM = 8;

__host__ __device__ __forceinline__ int lds_byte(int r, int c) { const int st = (r >> 4) * 2 + (c >> 5), rr = r & 15, cc = c & 31, ob = rr * 64 + cc * 2; return st * 1024 + (ob ^ (((ob >> 9) & 1) << 5)); }
__host__ __device__ __forceinline__ void stage_rc(int b, int& R, int& C) { const int st = b / 1024, sb = b % 1024, swz = sb ^ (((sb >> 9) & 1) << 5); R = (st >> 1) * 16 + swz / 64; C = (st & 1) * 32 + (swz % 64) / 2; }
__host__ __device__ __forceinline__ int perm32(int rho) { const int n = rho >> 4, i = rho & 15; return 8 * (i >> 2) + 4 * n + (i & 3); }

struct Unit { int pm, pn, idx; };
struct Gemm { const bf16_t* A; const bf16_t* Bt; int M, N, K; };

struct StaticOrder {
    int nM, nN, nwg, G, c;
    __host__ __device__ void init(int M, int N, int G_, int c_) { nM = M / BM; nN = N / BM; nwg = nM * nN; G = G_; c = c_; }
    __host__ __device__ bool next(int i, Unit& u) const {
        const long L = (long)i * G + c; if (L >= nwg) return false;
        int wgid = (int)L; { const int q = nwg / NXCD, r = nwg % NXCD, xcd = wgid % NXCD, off = wgid / NXCD; wgid = (xcd < r ? xcd * (q + 1) : r * (q + 1) + (xcd - r) * q) + off; }
        const int nig = WGM * nN, gid = wgid / nig, fm = gid * WGM, gsz = (nM - fm) < WGM ? (nM - fm) : WGM;
        u.pm = fm + ((wgid % nig) % gsz); u.pn = (wgid % nig) / gsz; u.idx = i; return true;
    }
    __device__ __forceinline__ void a_ready(const Unit&) const {}
    __device__ __forceinline__ void done(const Unit&) const {}
};

typedef float f32x2 __attribute__((ext_vector_type(2))); typedef __bf16 bf16x2_t __attribute__((ext_vector_type(2)));
__device__ __forceinline__ unsigned cvt_pk_bf16(float lo, float hi) { const f32x2 v = {lo, hi}; const bf16x2_t b = __builtin_convertvector(v, bf16x2_t); return __builtin_bit_cast(unsigned, b); }
template <bool SCALE> struct EpiScaleBf16 {
    static constexpr bool PERM = true, AFTER_DRAIN = false;
    bf16_t* O; int ldc; const PG8_LAS float* rs;
    __device__ __forceinline__ void operator()(const f32x4 (&acc)[2][2][4][2], const Unit& u, int wr, int wc, int fr, int fq) const {
        const int rl0 = wr * 64 + fr; const int col0 = u.pn * BM + wc * 32 + 8 * fq;
#pragma unroll
        for (int ai = 0; ai < 2; ++ai)
#pragma unroll
            for (int m = 0; m < 4; ++m) {
                const float sc = SCALE ? rs[256 * u.idx + rl0 + ai * HALF + m * 16] : 1.f;
                bf16_t* rowp = O + (size_t)(u.pm * BM + rl0 + ai * HALF + m * 16) * ldc + col0;
#pragma unroll
                for (int bj = 0; bj < 2; ++bj) { const f32x4 v0 = acc[ai][bj][m][0] * sc, v1 = acc[ai][bj][m][1] * sc;
                    u32x4 w; w.x = cvt_pk_bf16(v0[0], v0[1]); w.y = cvt_pk_bf16(v0[2], v0[3]); w.z = cvt_pk_bf16(v1[0], v1[1]); w.w = cvt_pk_bf16(v1[2], v1[3]);
                    *(u32x4*)(rowp + bj * HALF) = w; }
            }
    }
};
template <class Sched> __device__ __forceinline__ void rs_prepass(PG8_LAS float* rs, const Sched& S, const float* ssp, int tid) {
    Unit u;
    for (int i = 0; S.next(i, u); ++i)
        if (tid < 256) { const f32x4* p = (const f32x4*)(ssp + (size_t)(u.pm * BM + tid) * 16); const f32x4 a = p[0], b = p[1], c = p[2], d = p[3];
            const float s = ((a[0] + a[1]) + (a[2] + a[3])) + ((b[0] + b[1]) + (b[2] + b[3])) + ((c[0] + c[1]) + (c[2] + c[3])) + ((d[0] + d[1]) + (d[2] + d[3]));
            rs[256 * i + tid] = 1.0f / sqrtf(s * (1.0f / 1024.0f) + 1e-6f); }
    __syncthreads();
}
template <bool BASE_F32, bool OUT_F32> struct EpiResidual {
    static constexpr bool PERM = true, AFTER_DRAIN = false;
    const void* base; void* out; float* ssp; int ldc;
    __device__ __forceinline__ void operator()(const f32x4 (&acc)[2][2][4][2], const Unit& u, int wr, int wc, int fr, int fq) const {
        const int row0 = u.pm * BM + wr * 64 + fr; const int col0 = u.pn * BM + wc * 32 + 8 * fq;
#pragma unroll
        for (int ai = 0; ai < 2; ++ai)
#pragma unroll
          for (int mh = 0; mh < 2; ++mh) {
            u32x4 pb[2][2]; f32x4 fb[2][2][2];
#pragma unroll
            for (int m2 = 0; m2 < 2; ++m2)
#pragma unroll
                for (int bj = 0; bj < 2; ++bj) { const size_t off = (size_t)(row0 + ai * HALF + (2 * mh + m2) * 16) * ldc + col0 + bj * HALF;
                    if (BASE_F32) { fb[m2][bj][0] = *(const f32x4*)((const float*)base + off); fb[m2][bj][1] = *(const f32x4*)((const float*)base + off + 4); }
                    else pb[m2][bj] = *(const u32x4*)((const bf16_t*)base + off); }
#pragma unroll
            for (int m2 = 0; m2 < 2; ++m2) {
                const int m = 2 * mh + m2, row = row0 + ai * HALF + m * 16;
                float ss = 0.f;
#pragma unroll
                for (int bj = 0; bj < 2; ++bj) { const size_t off = (size_t)row * ldc + col0 + bj * HALF;
                    f32x4 b0, b1;
                    if (BASE_F32) { b0 = fb[m2][bj][0]; b1 = fb[m2][bj][1]; }
                    else { const u32x4 w = pb[m2][bj];
                        b0 = (f32x4){__uint_as_float(w.x << 16), __uint_as_float(w.x & 0xffff0000u), __uint_as_float(w.y << 16), __uint_as_float(w.y & 0xffff0000u)};
                        b1 = (f32x4){__uint_as_float(w.z << 16), __uint_as_float(w.z & 0xffff0000u), __uint_as_float(w.w << 16), __uint_as_float(w.w & 0xffff0000u)}; }
                    const f32x4 o0 = b0 + acc[ai][bj][m][0], o1 = b1 + acc[ai][bj][m][1];
                    ss += ((o0[0] * o0[0] + o0[1] * o0[1]) + (o0[2] * o0[2] + o0[3] * o0[3])) + ((o1[0] * o1[0] + o1[1] * o1[1]) + (o1[2] * o1[2] + o1[3] * o1[3]));
                    if (OUT_F32) { *(f32x4*)((float*)out + off) = o0; *(f32x4*)((float*)out + off + 4) = o1; }
                    else { u32x4 w; w.x = cvt_pk_bf16(o0[0], o0[1]); w.y = cvt_pk_bf16(o0[2], o0[3]); w.z = cvt_pk_bf16(o1[0], o1[1]); w.w = cvt_pk_bf16(o1[2], o1[3]);
                        *(u32x4*)((bf16_t*)out + off) = w; } }
                ss += __shfl_xor(ss, 16); ss += __shfl_xor(ss, 32);
                if (fq == 0) ssp[(size_t)row * 16 + u.pn * 4 + wc] = ss;
            }
            asm volatile("" ::: "memory");
          }
    }
};
template <class Epi, class Sched, bool ALIGN_EPI = false, bool SP2 = false>
__device__ __forceinline__ void gemm_phase(PG8_LAS unsigned char* lds, const Gemm g, const Sched& S, const Epi& E, const int wave_in) {
    int tid_ = wave_in * 64 + mk_lane(); asm volatile("" : "+v"(tid_));
    const int tid = tid_, wid = __builtin_amdgcn_readfirstlane(tid >> 6), lane = tid & 63, wr = wid >> 2, wc = wid & 3, fr = lane & 15, fq = lane >> 4;
    const int K = g.K, nt = K / BK;
    unsigned voffA[2], voffB[2];
#pragma unroll
    for (int i = 0; i < 2; ++i) { int R, C; stage_rc(tid * 16 + i * 8192, R, C); const int Rb = Epi::PERM ? ((R & ~31) + perm32(R & 31)) : R;
        voffA[i] = (unsigned)(R * K + C) * 2u; voffB[i] = (unsigned)(Rb * K + C) * 2u; }
    const size_t kstep = (size_t)(BK * 2);
    const size_t hstep = (size_t)HALF * K * 2;
    const size_t tstep = 2 * hstep;
    const unsigned ldsw = (unsigned)wid * 1024u;
    const int aoff = lds_byte(wr * 64 + fr, fq * 8), boff = lds_byte(wc * 32 + fr, fq * 8);
#define PG8_SA(b, h) (((b) * 2 + (h)) * HTB)
#define PG8_SB(b, h) ((4 + (b) * 2 + (h)) * HTB)
#define PG8_STAGE(bufoff, gbase, voff) do { _Pragma("unroll") for (int _i = 0; _i < 2; ++_i) \
        __builtin_amdgcn_global_load_lds((const unsigned*)((const char*)(gbase) + (voff)[_i]), (PG8_LAS unsigned*)(lds + (bufoff) + ldsw + _i * 8192), 16, 0, 0); } while (0)
#define PG8_LDA(dst, b, h) do { _Pragma("unroll") for (int m = 0; m < 4; ++m) _Pragma("unroll") for (int k = 0; k < 2; ++k) dst[m][k] = *(const PG8_LAS bf16x8*)(lds + PG8_SA(b, h) + aoff + m * 2048 + k * 1024); } while (0)
#define PG8_LDB(dst, b, h) do { _Pragma("unroll") for (int n = 0; n < 2; ++n) _Pragma("unroll") for (int k = 0; k < 2; ++k) dst[n][k] = *(const PG8_LAS bf16x8*)(lds + PG8_SB(b, h) + boff + n * 2048 + k * 1024); } while (0)
#define PG8_MMA(ai, bj, At, Bt) do { __builtin_amdgcn_s_setprio(1); _Pragma("unroll") for (int m = 0; m < 4; ++m) _Pragma("unroll") for (int n = 0; n < 2; ++n) _Pragma("unroll") for (int k = 0; k < 2; ++k) \
        acc[ai][bj][m][n] = __builtin_amdgcn_mfma_f32_16x16x32_bf16(Bt[n][k], At[m][k], acc[ai][bj][m][n], 0, 0, 0); __builtin_amdgcn_s_setprio(0); } while (0)
#define PG8_WAIT_V(n) asm volatile("s_waitcnt vmcnt(" #n ")" ::: "memory")
#define PG8_WAIT_L(n) asm volatile("s_waitcnt lgkmcnt(" #n ")" ::: "memory")
#define PG8_BAR __builtin_amdgcn_s_barrier()
#define PG8_SCHED __builtin_amdgcn_sched_barrier(0)
    Unit cur, nxt; int ui = 0;
    if (!S.next(0, cur)) return;
    f32x4 acc[2][2][4][2];
#pragma unroll
    for (int a = 0; a < 2; ++a)
#pragma unroll
        for (int b = 0; b < 2; ++b)
#pragma unroll
            for (int m = 0; m < 4; ++m)
#pragma unroll
                for (int n = 0; n < 2; ++n) acc[a][b][m][n] = (f32x4){0.f, 0.f, 0.f, 0.f};
    bf16x8 At[4][2], B0[2][2], B1[2][2];
    const char* cA = (const char*)g.A + (size_t)cur.pm * tstep; const char* cB = (const char*)g.Bt + (size_t)cur.pn * tstep;
    S.a_ready(cur);
    if constexpr (SP2) {
        PG8_STAGE(PG8_SB(0, 0), cB, voffB); PG8_STAGE(PG8_SB(0, 1), cB + hstep, voffB); PG8_STAGE(PG8_SA(0, 0), cA, voffA); PG8_STAGE(PG8_SA(0, 1), cA + hstep, voffA);
        if (wr == 1) PG8_BAR;
        PG8_WAIT_V(2); PG8_BAR;
        PG8_STAGE(PG8_SB(1, 0), cB + kstep, voffB); PG8_STAGE(PG8_SA(1, 0), cA + kstep, voffA); PG8_STAGE(PG8_SB(1, 1), cB + hstep + kstep, voffB);
        PG8_WAIT_V(6); PG8_BAR;
    } else {
        PG8_STAGE(PG8_SB(0, 0), cB, voffB); PG8_STAGE(PG8_SA(0, 0), cA, voffA); PG8_STAGE(PG8_SB(0, 1), cB + hstep, voffB); PG8_STAGE(PG8_SA(0, 1), cA + hstep, voffA);
        if (wr == 1) PG8_BAR;
        PG8_WAIT_V(4); PG8_BAR;
        PG8_STAGE(PG8_SB(1, 0), cB + kstep, voffB); PG8_STAGE(PG8_SA(1, 0), cA + kstep, voffA); PG8_STAGE(PG8_SB(1, 1), cB + hstep + kstep, voffB);
        PG8_WAIT_V(6); PG8_BAR;
    }
    for (;;) {
        const bool has_next = S.next(ui + 1, nxt);
        const char* nA = has_next ? (const char*)g.A + (size_t)nxt.pm * tstep : cA; const char* nB = has_next ? (const char*)g.Bt + (size_t)nxt.pn * tstep : cB;
        for (int t = 0; t < nt; t += 2) {
            const bool last = (t == nt - 2);
            const char* a1 = cA + (size_t)(t + 1) * kstep;
            const char* a2 = last ? nA : cA + (size_t)(t + 2) * kstep; const char* b2 = last ? nB : cB + (size_t)(t + 2) * kstep;
            const char* a3 = a2 + kstep; const char* b3 = b2 + kstep;
            if (last && has_next) S.a_ready(nxt);
            if constexpr (SP2) {
            PG8_LDB(B0, 0, 0); PG8_LDB(B1, 0, 1); PG8_SCHED; PG8_LDA(At, 0, 0); PG8_STAGE(PG8_SA(1, 1), a1 + hstep, voffA);
            PG8_WAIT_V(8); PG8_WAIT_L(0); PG8_BAR; PG8_MMA(0, 0, At, B0); PG8_MMA(0, 1, At, B1); PG8_BAR; PG8_SCHED;
            PG8_LDA(At, 0, 1); PG8_STAGE(PG8_SB(0, 0), b2, voffB); PG8_STAGE(PG8_SB(0, 1), b2 + hstep, voffB); PG8_STAGE(PG8_SA(0, 0), a2, voffA);
            PG8_WAIT_V(8); PG8_WAIT_L(0); PG8_BAR; PG8_MMA(1, 0, At, B0); PG8_MMA(1, 1, At, B1); PG8_BAR; PG8_SCHED;
            PG8_LDB(B0, 1, 0); PG8_LDB(B1, 1, 1); PG8_SCHED; PG8_LDA(At, 1, 0); PG8_STAGE(PG8_SA(0, 1), a2 + hstep, voffA);
            PG8_WAIT_V(8); PG8_WAIT_L(0); PG8_BAR; PG8_MMA(0, 0, At, B0); PG8_MMA(0, 1, At, B1); PG8_BAR; PG8_SCHED;
            PG8_LDA(At, 1, 1); PG8_STAGE(PG8_SB(1, 0), b3, voffB); PG8_STAGE(PG8_SB(1, 1), b3 + hstep, voffB); PG8_STAGE(PG8_SA(1, 0), a3, voffA);
            PG8_WAIT_V(8); PG8_WAIT_L(0); PG8_BAR; PG8_MMA(1, 0, At, B0); PG8_MMA(1, 1, At, B1); PG8_BAR; PG8_SCHED;
            } else {
            PG8_LDB(B0, 0, 0); PG8_SCHED; PG8_LDA(At, 0, 0); PG8_STAGE(PG8_SA(1, 1), a1 + hstep, voffA);
            PG8_WAIT_L(8); PG8_BAR; PG8_WAIT_L(0); PG8_MMA(0, 0, At, B0); PG8_BAR; PG8_SCHED;
            PG8_LDB(B1, 0, 1); PG8_STAGE(PG8_SB(0, 0), b2, voffB);
            PG8_BAR; PG8_WAIT_L(0); PG8_MMA(0, 1, At, B1); PG8_BAR;
            PG8_LDA(At, 0, 1); PG8_STAGE(PG8_SA(0, 0), a2, voffA);
            PG8_BAR; PG8_WAIT_L(0); PG8_MMA(1, 0, At, B0); PG8_BAR; PG8_SCHED;
            PG8_STAGE(PG8_SB(0, 1), b2 + hstep, voffB);
            PG8_WAIT_V(6); PG8_BAR; PG8_MMA(1, 1, At, B1); PG8_BAR;
            PG8_LDB(B0, 1, 0); PG8_SCHED; PG8_LDA(At, 1, 0); PG8_STAGE(PG8_SA(0, 1), a2 + hstep, voffA);
            PG8_WAIT_L(8); PG8_BAR; PG8_WAIT_L(0); PG8_MMA(0, 0, At, B0); PG8_BAR; PG8_SCHED;
            PG8_LDB(B1, 1, 1); PG8_STAGE(PG8_SB(1, 0), b3, voffB);
            PG8_BAR; PG8_WAIT_L(0); PG8_MMA(0, 1, At, B1); PG8_BAR;
            PG8_LDA(At, 1, 1); PG8_STAGE(PG8_SA(1, 0), a3, voffA);
            PG8_BAR; PG8_WAIT_L(0); PG8_MMA(1, 0, At, B0); PG8_BAR; PG8_SCHED;
            PG8_STAGE(PG8_SB(1, 1), b3 + hstep, voffB);
            PG8_WAIT_V(6); PG8_BAR; PG8_MMA(1, 1, At, B1); PG8_BAR;
            }
        }
        if constexpr (ALIGN_EPI) { if (wr == 0) PG8_BAR; }
        if constexpr (!Epi::AFTER_DRAIN) { E(acc, cur, wr, wc, fr, fq); S.done(cur); }
        if (!has_next) break;
#pragma unroll
        for (int a = 0; a < 2; ++a)
#pragma unroll
            for (int b = 0; b < 2; ++b)
#pragma unroll
                for (int m = 0; m < 4; ++m)
#pragma unroll
                    for (int n = 0; n < 2; ++n) acc[a][b][m][n] = (f32x4){0.f, 0.f, 0.f, 0.f};
        cur = nxt; cA = nA; cB = nB; ++ui;
        if constexpr (ALIGN_EPI) { if (wr == 1) PG8_BAR; }
    }
    PG8_WAIT_V(0);
    if constexpr (!ALIGN_EPI) { if (wr == 0) PG8_BAR; }
    PG8_BAR;
    if constexpr (Epi::AFTER_DRAIN) { E.fused(acc, cur, wr, wc, fr, fq, lds, wid, lane); S.done(cur); }
#undef PG8_SA
#undef PG8_SB
#undef PG8_STAGE
#undef PG8_LDA
#undef PG8_LDB
#undef PG8_MMA
#undef PG8_WAIT_V
#undef PG8_WAIT_L
#undef PG8_BAR
#undef PG8_SCHED
}
}

constexpr int D = 1024, BATCH = 4, SEQ = 8192, MTOK = BATCH * SEQ, NCH = SEQ / 64, MEMLEN = 256;
constexpr int EIN = 3328, OIN = 4096;
constexpr float EPS = 1e-6f;
constexpr int C_AQ = 0, C_AK = 512, C_AV = 640, C_AG = 768, C_BQ = 1280, C_BK = 1792, C_BV = 2304, C_BG = 2816;
constexpr int NWAVES = 8, NTHR = 512;
constexpr size_t MiB = 1u << 20;
constexpr size_t WS_WEIN = 1 * MiB, WS_WEOUT = 8 * MiB, WS_WOIN = 10 * MiB, WS_WOOUT = 18 * MiB, WS_WQ = 20 * MiB, WS_WKV = 24 * MiB, WS_WO = 32 * MiB;
constexpr size_t WS_MEMN = 36 * MiB, WS_KV = 40 * MiB, WS_ROT = 48 * MiB, WS_SSP = 52 * MiB;
constexpr size_t WS_XB = 56 * MiB;
constexpr size_t WS_BIG = 120 * MiB;
constexpr size_t WS_BUFA = 376 * MiB;
constexpr size_t WS_BUFB = 440 * MiB;
constexpr size_t WS_END = 504 * MiB;
constexpr int LDS_BYTES = 147456;

#define LAS __attribute__((address_space(3)))
typedef unsigned short bf16;
typedef short bf16x8 __attribute__((ext_vector_type(8)));
typedef short s16x4 __attribute__((ext_vector_type(4)));
typedef float f32x2 __attribute__((ext_vector_type(2)));
typedef float f32x4 __attribute__((ext_vector_type(4)));
typedef float f32x16 __attribute__((ext_vector_type(16)));
typedef unsigned u32x2 __attribute__((ext_vector_type(2)));
typedef unsigned u32x4 __attribute__((ext_vector_type(4)));

__device__ __forceinline__ unsigned pk2(float lo, float hi) { return pg8::cvt_pk_bf16(lo, hi); }
__device__ __forceinline__ float bflo(unsigned w) { return __uint_as_float(w << 16); }
__device__ __forceinline__ float bfhi(unsigned w) { return __uint_as_float(w & 0xffff0000u); }
__device__ __forceinline__ int crow(int r, int hi) { return (r & 3) + 8 * (r >> 2) + 4 * hi; }
__device__ __forceinline__ float wave_sum(float v) {
#pragma unroll
    for (int o = 1; o < 64; o <<= 1) v += __shfl_xor(v, o);
    return v;
}
__device__ __forceinline__ float silu(float x) { return x / (1.0f + __expf(-x)); }
__device__ __forceinline__ s16x4 trd(const LAS bf16* p) { return __builtin_bit_cast(s16x4, __builtin_amdgcn_ds_read_tr16_b64_v4i16((LAS s16x4*)p)); }
__device__ __forceinline__ bf16x8 tr_frag(const LAS bf16* T, int ld, int k0, int n0, int lane) {
    const int g4 = lane >> 4, li = lane & 15, q = li >> 2, p = li & 3, hi = g4 >> 1;
    const LAS bf16* a = T + (k0 + 4 * hi + q) * ld + n0 + 16 * (g4 & 1) + 4 * p;
    const s16x4 lo = trd(a), up = trd(a + 8 * ld);
    return (bf16x8){lo[0], lo[1], lo[2], lo[3], up[0], up[1], up[2], up[3]};
}
__device__ __forceinline__ bf16x8 pack8(float a0, float a1, float a2, float a3, float a4, float a5, float a6, float a7) {
    u32x4 w; w.x = pk2(a0, a1); w.y = pk2(a2, a3); w.z = pk2(a4, a5); w.w = pk2(a6, a7); return __builtin_bit_cast(bf16x8, w);
}
__device__ __forceinline__ int launder(int v) { asm volatile("" : "+v"(v)); return v; }
#define MFMA32(a, b, c) __builtin_amdgcn_mfma_f32_32x32x16_bf16((a), (b), (c), 0, 0, 0)

#define XB_TMO      128
#define XB_XCNT(j)  (256  + 64 * (j))
#define XB_XSUB(j)  (1280 + 64 * (j))
#define XB_XGEN(j)  (2304 + 64 * (j))
#define XB_TOP      3328
#define XB_TOPGEN   3392
#define XCD_BAR_WORDS 3456
#define XB_SPIN_CAP (1u << 18)

__device__ __forceinline__ unsigned xb_ld(unsigned* p)              { return __hip_atomic_load(p, __ATOMIC_RELAXED, __HIP_MEMORY_SCOPE_AGENT); }
__device__ __forceinline__ unsigned xb_add(unsigned* p, unsigned v) { return __hip_atomic_fetch_add(p, v, __ATOMIC_RELAXED, __HIP_MEMORY_SCOPE_AGENT); }
__device__ __forceinline__ unsigned xb_xcc_id() { return (unsigned)__builtin_amdgcn_s_getreg((3 << 11) | 20) & 0xFu; }
#define XB_SPIN(cond, bar) do { unsigned _sp = 0; while (cond) { __builtin_amdgcn_s_sleep(1); \
    if ((++_sp & 255u) == 0u) { if (xb_ld(&(bar)[XB_TMO])) break; if (_sp > XB_SPIN_CAP) { atomicAdd(&(bar)[XB_TMO], 1u); break; } } } } while (0)

struct XcdBarrier {
    unsigned* bar; unsigned x; int wv;
    volatile LAS unsigned* st;
};

__device__ __forceinline__ XcdBarrier xcd_barrier_post(unsigned* bar, volatile LAS unsigned* st, int wv) {
    XcdBarrier b; b.bar = bar; b.x = xb_xcc_id(); b.st = st; b.wv = wv;
    if (wv == 0 && mk_lane() == 0) (void)xb_add(&bar[XB_XCNT(b.x)], 1u);
    return b;
}
__device__ __forceinline__ void xcd_barrier_complete(unsigned* bar, unsigned x, unsigned& nloc, unsigned& nx) {
    const unsigned G = gridDim.x * gridDim.y * gridDim.z;
    unsigned sum, cnt, mine, sp = 0u;
    for (;;) {
        sum = 0u; cnt = 0u; mine = 0u;
#pragma unroll
        for (unsigned j = 0; j < 16; ++j) { const unsigned c = xb_ld(&bar[XB_XCNT(j)]); sum += c; cnt += (c > 0u) ? 1u : 0u; mine = (j == x) ? c : mine; }
        if (sum == G) break;
        __builtin_amdgcn_s_sleep(1);
        if ((++sp & 255u) == 0u) { if (xb_ld(&bar[XB_TMO])) break; if (sp > XB_SPIN_CAP) { atomicAdd(&bar[XB_TMO], 1u); break; } }
    }
    nloc = mine > 0u ? mine : 1u; nx = cnt > 0u ? cnt : 1u;
}

__device__ __forceinline__ void xcd_barrier(const XcdBarrier& b) {
    asm volatile("s_waitcnt vmcnt(0)" ::: "memory");
    __syncthreads();
    if (b.wv == 0 && mk_lane() == 0) {
        unsigned* bar = b.bar;
        __builtin_amdgcn_s_waitcnt(0);
        unsigned nloc = b.st[0], nx = b.st[1];
        if (nloc == 0u) { xcd_barrier_complete(bar, b.x, nloc, nx); b.st[0] = nloc; b.st[1] = nx; }
        const unsigned old = xb_add(&bar[XB_XSUB(b.x)], 1u);
        const unsigned gen = old / nloc;
        if (old + 1u == (gen + 1u) * nloc) {
            __builtin_amdgcn_fence(__ATOMIC_RELEASE, "agent");
            asm volatile("s_waitcnt vmcnt(0)" ::: "memory");
            const unsigned og = xb_add(&bar[XB_TOP], 1u);
            const unsigned tg = og / nx;
            if (og + 1u == (tg + 1u) * nx) xb_add(&bar[XB_TOPGEN], 1u);
            else XB_SPIN(xb_ld(&bar[XB_TOPGEN]) == tg, bar);
            __builtin_amdgcn_fence(__ATOMIC_ACQUIRE, "agent");
            xb_add(&bar[XB_XGEN(b.x)], 1u);
            asm volatile("s_waitcnt vmcnt(0)" ::: "memory");
        } else {
            XB_SPIN(xb_ld(&bar[XB_XGEN(b.x)]) == gen, bar);
            __builtin_amdgcn_fence(__ATOMIC_ACQUIRE, "agent");
            asm volatile("s_waitcnt vmcnt(0)" ::: "memory");
        }
    }
    __syncthreads();
}

constexpr int XB_WS_OFF = 4096, XB_LDS_OFF = 147200;
struct Args { const float* in[17]; float* out; unsigned char* ws; int ph_lo, ph_hi; };
struct Frame {
    LAS unsigned char* lds; int wave, G, bid;
    const Args* ap;
};

__device__ __forceinline__ void p0_transpose_item(const float* W, const float* gain, int K, int N, bf16* WT, LAS float* scr, int item, int lane) {
    const int nblk = N / 32, kb = item / nblk, nb = item % nblk, k0 = 64 * kb, n0 = 32 * nb;
#pragma unroll 8
    for (int i = 0; i < 32; ++i) { const int kk = 2 * i + (lane >> 5); float w = W[(size_t)(k0 + kk) * N + n0 + (lane & 31)]; if (gain) w *= gain[k0 + kk]; scr[kk * 33 + (lane & 31)] = w; }
    asm volatile("s_waitcnt lgkmcnt(0)" ::: "memory");
    const int c = lane & 7;
#pragma unroll
    for (int j = 0; j < 4; ++j) { const int n = (lane >> 3) + 8 * j; const LAS float* s = scr + (8 * c) * 33 + n;
        u32x4 o; o.x = pk2(s[0 * 33], s[1 * 33]); o.y = pk2(s[2 * 33], s[3 * 33]); o.z = pk2(s[4 * 33], s[5 * 33]); o.w = pk2(s[6 * 33], s[7 * 33]);
        *(u32x4*)(WT + (size_t)(n0 + n) * K + k0 + 8 * c) = o; }
    asm volatile("s_waitcnt lgkmcnt(0)" ::: "memory");
}
__device__ __forceinline__ void p0_prologue(Frame& F) {
    LAS float* scr = (LAS float*)(F.lds + F.wave * 16384);
    const int gw = F.bid * NWAVES + F.wave, NGW = F.G * NWAVES, lane = mk_lane();
    unsigned char* ws = F.ap->ws;
    constexpr int I_EIN = 16 * (EIN / 32), I_SQ = 16 * 32, I_OIN = 16 * (OIN / 32), I_KV = 16 * 64;
    constexpr int NITEMS = I_EIN + I_SQ + I_OIN + I_SQ + 2 * I_SQ + 2 * I_KV + 2 * I_SQ;
    for (int it = gw; it < NITEMS; it += NGW) {
        int r = it;
        if (r < I_EIN) { p0_transpose_item(F.ap->in[3], F.ap->in[2], D, EIN, (bf16*)(ws + WS_WEIN), scr, r, lane); continue; } r -= I_EIN;
        if (r < I_SQ) { p0_transpose_item(F.ap->in[5], nullptr, D, D, (bf16*)(ws + WS_WEOUT), scr, r, lane); continue; } r -= I_SQ;
        if (r < I_OIN) { p0_transpose_item(F.ap->in[7], F.ap->in[6], D, OIN, (bf16*)(ws + WS_WOIN), scr, r, lane); continue; } r -= I_OIN;
        if (r < I_SQ) { p0_transpose_item(F.ap->in[10], nullptr, D, D, (bf16*)(ws + WS_WOOUT), scr, r, lane); continue; } r -= I_SQ;
        if (r < 2 * I_SQ) { const int l = r / I_SQ; p0_transpose_item(F.ap->in[13] + (size_t)l * D * D, F.ap->in[11] + l * D, D, D, (bf16*)(ws + WS_WQ) + (size_t)l * D * D, scr, r % I_SQ, lane); continue; } r -= 2 * I_SQ;
        if (r < 2 * I_KV) { const int l = r / I_KV; p0_transpose_item(F.ap->in[14] + (size_t)l * D * 2 * D, nullptr, D, 2 * D, (bf16*)(ws + WS_WKV) + (size_t)l * 2 * D * D, scr, r % I_KV, lane); continue; } r -= 2 * I_KV;
        { const int l = r / I_SQ; p0_transpose_item(F.ap->in[15] + (size_t)l * D * D, nullptr, D, D, (bf16*)(ws + WS_WO) + (size_t)l * D * D, scr, r % I_SQ, lane); }
    }
    for (int it = gw; it < 2 * BATCH * MEMLEN; it += NGW) {
        const int l = it / (BATCH * MEMLEN), row = it % (BATCH * MEMLEN);
        const f32x4* xr = (const f32x4*)(F.ap->in[1] + (size_t)row * D) + lane; const f32x4* gr = (const f32x4*)(F.ap->in[12] + l * D) + lane;
        f32x4 v[4]; float s = 0.f;
#pragma unroll
        for (int j = 0; j < 4; ++j) { v[j] = xr[64 * j]; s += (v[j][0] * v[j][0] + v[j][1] * v[j][1]) + (v[j][2] * v[j][2] + v[j][3] * v[j][3]); }
        const float rs = 1.0f / sqrtf(wave_sum(s) * (1.0f / D) + EPS);
        u32x2* o8 = (u32x2*)((bf16*)(ws + WS_MEMN) + (size_t)it * D) + lane;
#pragma unroll
        for (int j = 0; j < 4; ++j) { const f32x4 g = gr[64 * j]; u32x2 w; w.x = pk2(v[j][0] * rs * g[0], v[j][1] * rs * g[1]); w.y = pk2(v[j][2] * rs * g[2], v[j][3] * rs * g[3]); o8[64 * j] = w; }
    }
    for (int row = gw; row < MTOK; row += NGW) {
        const f32x4* xr = (const f32x4*)(F.ap->in[0] + (size_t)row * D) + lane;
        f32x4 v[4]; float s = 0.f;
#pragma unroll
        for (int j = 0; j < 4; ++j) { v[j] = xr[64 * j]; s += (v[j][0] * v[j][0] + v[j][1] * v[j][1]) + (v[j][2] * v[j][2] + v[j][3] * v[j][3]); }
        s = wave_sum(s);
        u32x2* o8 = (u32x2*)((bf16*)(ws + WS_XB) + (size_t)row * D) + lane;
#pragma unroll
        for (int j = 0; j < 4; ++j) { u32x2 w; w.x = pk2(v[j][0], v[j][1]); w.y = pk2(v[j][2], v[j][3]); o8[64 * j] = w; }
        if (lane < 16) ((float*)(ws + WS_SSP))[(size_t)row * 16 + lane] = (lane == 0) ? s : 0.f;
    }
    for (int e = F.bid * NTHR + launder((F.wave * 64 + mk_lane())); e < SEQ * 64; e += F.G * NTHR) {
        const int pos = e >> 6, j = e & 63;
        const float inv = 1.0f / exp2f(((float)j / 63.0f) * 13.287712379549449f);
        const float ang = (float)pos * inv;
        const double a = (double)ang, kk = rint(a * 0.63661977236758134308);
        const float r = (float)fma(-kk, 1.57079632679489661923, a), r2 = r * r;
        const float sn = r + r * r2 * (-1.6666654611e-1f + r2 * (8.3321608736e-3f + r2 * (-1.9515295891e-4f)));
        const float cs = 1.0f - 0.5f * r2 + r2 * r2 * (4.166664568298827e-2f + r2 * (-1.388731625493765e-3f + r2 * 2.443315711809948e-5f));
        const int q = ((int)kk) & 3;
        f32x2 o; o.x = (q == 0) ? cs : (q == 1) ? -sn : (q == 2) ? -cs : sn; o.y = (q == 0) ? sn : (q == 1) ? cs : (q == 2) ? -sn : -cs;
        ((f32x2*)(ws + WS_ROT))[e] = o;
    }
}

constexpr int AKS = 72;
__device__ __forceinline__ void swa_item(Frame& F, int item) {
    const int kvh = item & 1, c = (item >> 1) & (NCH - 1), b = item >> 8;
    const int c0 = c >= 2 ? c - 2 : 0, nch = c - c0 + 1;
    const int tid = launder((F.wave * 64 + mk_lane())), lane = tid & 63, w = F.wave, r32 = lane & 31, hi = lane >> 5;
    LAS bf16* Ks = (LAS bf16*)F.lds; LAS bf16* Vs = Ks + 192 * AKS;
    const bf16* HC = (const bf16*)(F.ap->ws + WS_BIG);
    const size_t rowbase = (size_t)b * SEQ;
    for (int p = tid; p < nch * 64 * 8; p += NTHR) { const int r = p >> 3, ch = p & 7; const bf16* src = HC + (rowbase + c0 * 64 + r) * EIN + kvh * 64 + ch * 8;
        const u32x4 kx = *(const u32x4*)(src + C_AK), vx = *(const u32x4*)(src + C_AV);
        *(LAS u32x4*)(Ks + r * AKS + ch * 8) = kx; *(LAS u32x4*)(Vs + r * AKS + ch * 8) = vx; }
    const int qh = kvh * 4 + (w >> 1);
    const size_t tok = rowbase + c * 64 + (w & 1) * 32 + r32;
    const bf16* qp = HC + tok * EIN + C_AQ + qh * 64 + hi * 8;
    bf16x8 qf[4];
#pragma unroll
    for (int s = 0; s < 4; ++s) qf[s] = *(const bf16x8*)(qp + 16 * s);
    __syncthreads();
    const int nkb = 2 * nch;
    f32x16 st[6];
#pragma unroll
    for (int kb = 0; kb < 6; ++kb) { st[kb] = (f32x16){};
        if (kb < nkb) {
#pragma unroll
            for (int s = 0; s < 4; ++s) { const bf16x8 a = *(const LAS bf16x8*)(Ks + (32 * kb + r32) * AKS + 16 * s + 8 * hi); st[kb] = MFMA32(a, qf[s], st[kb]); } } }
    float mx = -3.0e38f;
#pragma unroll
    for (int kb = 0; kb < 6; ++kb) if (kb < nkb) {
#pragma unroll
        for (int i = 0; i < 16; ++i) mx = fmaxf(mx, st[kb][i]); }
    mx = fmaxf(mx, __shfl_xor(mx, 32));
    const float sink = F.ap->in[4][qh];
    const float mref = fmaxf(mx * 0.125f, sink);
    const float L2E = 1.4426950408889634f;
    float sum = 0.f;
#pragma unroll
    for (int kb = 0; kb < 6; ++kb) if (kb < nkb) {
#pragma unroll
        for (int i = 0; i < 16; ++i) { const float p = exp2f((st[kb][i] * 0.125f - mref) * L2E); st[kb][i] = p; sum += p; } }
    sum += __shfl_xor(sum, 32);
    const float inv = 1.0f / (sum + exp2f((sink - mref) * L2E));
    f32x16 o[2]; o[0] = (f32x16){}; o[1] = (f32x16){};
#pragma unroll
    for (int kb = 0; kb < 6; ++kb) if (kb < nkb) {
#pragma unroll
        for (int s = 0; s < 2; ++s) {
            const bf16x8 pf = pack8(st[kb][8 * s + 0] * inv, st[kb][8 * s + 1] * inv, st[kb][8 * s + 2] * inv, st[kb][8 * s + 3] * inv, st[kb][8 * s + 4] * inv, st[kb][8 * s + 5] * inv, st[kb][8 * s + 6] * inv, st[kb][8 * s + 7] * inv);
#pragma unroll
            for (int db = 0; db < 2; ++db) { const bf16x8 vf = tr_frag(Vs, AKS, 32 * kb + 16 * s, 32 * db, lane); o[db] = MFMA32(vf, pf, o[db]); } } }
    const bf16* gp = HC + tok * EIN + C_AG + qh * 64;
    bf16* yp = (bf16*)(F.ap->ws + WS_BUFA) + tok * D + qh * 64;
#pragma unroll
    for (int db = 0; db < 2; ++db)
#pragma unroll
        for (int gi = 0; gi < 4; ++gi) { const int d0 = 32 * db + 8 * gi + 4 * hi; const u32x2 g = *(const u32x2*)(gp + d0);
            u32x2 y; y.x = pk2(o[db][4 * gi + 0] * silu(bflo(g.x)), o[db][4 * gi + 1] * silu(bfhi(g.x))); y.y = pk2(o[db][4 * gi + 2] * silu(bflo(g.y)), o[db][4 * gi + 3] * silu(bfhi(g.y)));
            *(u32x2*)(yp + d0) = y; }
    __syncthreads();
}

constexpr int RKS = 136;
__device__ __forceinline__ float head_lg2(int h) { return log2f(1.0f - exp2f(-5.0f - (float)h)); }
__device__ __forceinline__ void ret1_item(Frame& F, int item) {
    const int h = item & 3, c = (item >> 2) & (NCH - 1), b = item >> 9;
    const int tid = launder((F.wave * 64 + mk_lane())), lane = tid & 63, w = F.wave, r32 = lane & 31, hi = lane >> 5;
    LAS bf16* Qr = (LAS bf16*)F.lds; LAS bf16* Kr = Qr + 64 * RKS; LAS bf16* Vs = Kr + 64 * RKS; LAS bf16* Vd = Vs + 64 * RKS;
    bf16* HC = (bf16*)(F.ap->ws + WS_BIG);
    const size_t rowbase = (size_t)b * SEQ + (size_t)c * 64;
    const float lg2 = head_lg2(h);
    {
        const int j = tid >> 3, pc = tid & 7;
        bf16* rowp = HC + (rowbase + j) * EIN;
        const u32x4 q1 = *(const u32x4*)(rowp + C_BQ + h * 128 + 8 * pc), q2 = *(const u32x4*)(rowp + C_BQ + h * 128 + 64 + 8 * pc);
        const u32x4 k1 = *(const u32x4*)(rowp + C_BK + h * 128 + 8 * pc), k2 = *(const u32x4*)(rowp + C_BK + h * 128 + 64 + 8 * pc);
        const u32x4 v1 = *(const u32x4*)(rowp + C_BV + h * 128 + 16 * pc), v2 = *(const u32x4*)(rowp + C_BV + h * 128 + 16 * pc + 8);
        const f32x4* rt = (const f32x4*)((const f32x2*)(F.ap->ws + WS_ROT) + (size_t)(c * 64 + j) * 64 + 8 * pc);
        u32x4 qa, qb, ka, kb;
        const float ksc = 0.08838834764831845f;
#pragma unroll
        for (int e = 0; e < 4; ++e) { const f32x4 cs = rt[e];
            const float a0 = bflo(q1[e]), a1 = bfhi(q1[e]), b0 = bflo(q2[e]), b1 = bfhi(q2[e]);
            qa[e] = pk2(a0 * cs[0] - b0 * cs[1], a1 * cs[2] - b1 * cs[3]); qb[e] = pk2(a0 * cs[1] + b0 * cs[0], a1 * cs[3] + b1 * cs[2]);
            const float c0 = bflo(k1[e]), c1 = bfhi(k1[e]), d0 = bflo(k2[e]), d1 = bfhi(k2[e]);
            ka[e] = pk2((c0 * cs[0] - d0 * cs[1]) * ksc, (c1 * cs[2] - d1 * cs[3]) * ksc); kb[e] = pk2((c0 * cs[1] + d0 * cs[0]) * ksc, (c1 * cs[3] + d1 * cs[2]) * ksc); }
        *(LAS u32x4*)(Qr + j * RKS + 8 * pc) = qa; *(LAS u32x4*)(Qr + j * RKS + 64 + 8 * pc) = qb;
        *(LAS u32x4*)(Kr + j * RKS + 8 * pc) = ka; *(LAS u32x4*)(Kr + j * RKS + 64 + 8 * pc) = kb;
        { bf16* yq = (bf16*)(F.ap->ws + WS_BUFA) + (rowbase + j) * D + 512 + h * 128 + 8 * pc; *(u32x4*)yq = qa; *(u32x4*)(yq + 64) = qb; }
        *(LAS u32x4*)(Vs + j * RKS + 16 * pc) = v1; *(LAS u32x4*)(Vs + j * RKS + 16 * pc + 8) = v2;
        const float kd = exp2f(lg2 * (float)(63 - j));
        u32x4 w1, w2;
#pragma unroll
        for (int e = 0; e < 4; ++e) { w1[e] = pk2(bflo(v1[e]) * kd, bfhi(v1[e]) * kd); w2[e] = pk2(bflo(v2[e]) * kd, bfhi(v2[e]) * kd); }
        *(LAS u32x4*)(Vd + j * RKS + 16 * pc) = w1; *(LAS u32x4*)(Vd + j * RKS + 16 * pc + 8) = w2;
    }
    __syncthreads();
    const int ib = w & 1, db = w >> 1;
    f32x16 st[2];
#pragma unroll
    for (int jb = 0; jb < 2; ++jb) { st[jb] = (f32x16){};
#pragma unroll
        for (int s = 0; s < 8; ++s) { const bf16x8 a = *(const LAS bf16x8*)(Kr + (32 * jb + r32) * RKS + 16 * s + 8 * hi); const bf16x8 q = *(const LAS bf16x8*)(Qr + (32 * ib + r32) * RKS + 16 * s + 8 * hi);
            st[jb] = MFMA32(a, q, st[jb]); } }
    const int iloc = 32 * ib + r32;
#pragma unroll
    for (int jb = 0; jb < 2; ++jb)
#pragma unroll
        for (int i = 0; i < 16; ++i) { const int j = 32 * jb + crow(i, hi); const int dd = iloc > j ? iloc - j : j - iloc; st[jb][i] *= exp2f(lg2 * (float)dd); }
    f32x16 o = (f32x16){};
#pragma unroll
    for (int jb = 0; jb < 2; ++jb)
#pragma unroll
        for (int s = 0; s < 2; ++s) {
            const bf16x8 pf = pack8(st[jb][8 * s + 0], st[jb][8 * s + 1], st[jb][8 * s + 2], st[jb][8 * s + 3], st[jb][8 * s + 4], st[jb][8 * s + 5], st[jb][8 * s + 6], st[jb][8 * s + 7]);
            const bf16x8 vf = tr_frag(Vs, RKS, 32 * jb + 16 * s, 32 * db, lane);
            o = MFMA32(vf, pf, o); }
    {
        float* op = (float*)(F.ap->ws + WS_XB) + (rowbase + iloc) * 512 + h * 128 + 32 * db + 4 * hi;
#pragma unroll
        for (int gi = 0; gi < 4; ++gi) *(f32x4*)(op + 8 * gi) = (f32x4){o[4 * gi], o[4 * gi + 1], o[4 * gi + 2], o[4 * gi + 3]};
    }
    const int rb = w >> 1;
    f32x16 kv[2]; kv[0] = (f32x16){}; kv[1] = (f32x16){};
#pragma unroll
    for (int s = 0; s < 4; ++s) { const bf16x8 af = tr_frag(Kr, RKS, 16 * s, 32 * rb, lane);
#pragma unroll
        for (int t = 0; t < 2; ++t) { const bf16x8 bf = tr_frag(Vd, RKS, 16 * s, 32 * (2 * (w & 1) + t), lane); kv[t] = MFMA32(af, bf, kv[t]); } }
    bf16* stp = (bf16*)(F.ap->ws + WS_BUFB) + ((size_t)(b * NCH + c) * 4 + h) * 16384;
#pragma unroll
    for (int t = 0; t < 2; ++t) { const int dv = 32 * (2 * (w & 1) + t) + r32;
#pragma unroll
        for (int gi = 0; gi < 4; ++gi) { const int dk = 32 * rb + 8 * gi + 4 * hi; u32x2 y; y.x = pk2(kv[t][4 * gi], kv[t][4 * gi + 1]); y.y = pk2(kv[t][4 * gi + 2], kv[t][4 * gi + 3]);
            *(u32x2*)(stp + dv * 128 + dk) = y; } }
    __syncthreads();
}

__device__ __forceinline__ void scan_phase(Frame& F) {
    unsigned* ST = (unsigned*)(F.ap->ws + WS_BUFB);
    for (int e = F.bid * NTHR + launder((F.wave * 64 + mk_lane())); e < BATCH * 4 * 8192; e += F.G * NTHR) {
        const int idx = e & 8191, h = (e >> 13) & 3, b = e >> 15;
        const float dec = exp2f(head_lg2(h) * 64.0f);
        unsigned* p = ST + ((size_t)(b * NCH) * 4 + h) * 8192 + idx;
        float s0 = 0.f, s1 = 0.f;
        unsigned ka[32], kb[32];
#define SCAN_LD(dst, c0) do { _Pragma("unroll") for (int j = 0; j < 32; ++j) dst[j] = p[(size_t)((c0) + j) * 4 * 8192]; } while (0)
#define SCAN_UP(src, c0) do { _Pragma("unroll") for (int j = 0; j < 32; ++j) { p[(size_t)((c0) + j) * 4 * 8192] = pk2(s0, s1); s0 = s0 * dec + bflo(src[j]); s1 = s1 * dec + bfhi(src[j]); } } while (0)
        SCAN_LD(ka, 0); SCAN_LD(kb, 32); SCAN_UP(ka, 0); SCAN_LD(ka, 64); SCAN_UP(kb, 32); SCAN_LD(kb, 96); SCAN_UP(ka, 64); SCAN_UP(kb, 96);
#undef SCAN_LD
#undef SCAN_UP
    }
}

__device__ __forceinline__ void ret2_item(Frame& F, int item) {
    const int h = item & 3, c = (item >> 2) & (NCH - 1), b = item >> 9;
    const int lane = launder(mk_lane()), w = F.wave, r32 = lane & 31, hi = lane >> 5;
    const int ib = w & 1, db = w >> 1, iloc = 32 * ib + r32;
    LAS float* part = (LAS float*)F.lds;
    const bf16* HC = (const bf16*)(F.ap->ws + WS_BIG);
    const size_t tok = (size_t)b * SEQ + (size_t)c * 64 + iloc;
    const bf16* stp = (const bf16*)(F.ap->ws + WS_BUFB) + ((size_t)(b * NCH + c) * 4 + h) * 16384 + (size_t)(32 * db + r32) * 128 + 8 * hi;
    const bf16* qp = (const bf16*)(F.ap->ws + WS_BUFA) + tok * D + 512 + h * 128 + 8 * hi;
    f32x16 oc = (f32x16){};
#pragma unroll
    for (int s = 0; s < 8; ++s) { const bf16x8 a = *(const bf16x8*)(stp + 16 * s); const bf16x8 q = *(const bf16x8*)(qp + 16 * s); oc = MFMA32(a, q, oc); }
    const float qdec = exp2f(head_lg2(h) * (float)(iloc + 1));
    const float* op = (const float*)(F.ap->ws + WS_XB) + tok * 512 + h * 128 + 32 * db + 4 * hi;
    float ss = 0.f;
#pragma unroll
    for (int gi = 0; gi < 4; ++gi) { const f32x4 oi = *(const f32x4*)(op + 8 * gi);
#pragma unroll
        for (int e = 0; e < 4; ++e) { const float v = oi[e] + oc[4 * gi + e] * qdec; oc[4 * gi + e] = v; ss += v * v; } }
    ss += __shfl_xor(ss, 32);
    if (hi == 0) part[iloc * 4 + db] = ss;
    __syncthreads();
    const f32x4 pp = *(const LAS f32x4*)(part + iloc * 4);
    const float rs = 1.0f / sqrtf(((pp[0] + pp[1]) + (pp[2] + pp[3])) * (1.0f / 128.0f) + EPS);
    const bf16* gp = HC + tok * EIN + C_BG + h * 128 + 32 * db + 4 * hi;
    bf16* yp = (bf16*)(F.ap->ws + WS_BUFA) + tok * D + 512 + h * 128 + 32 * db + 4 * hi;
#pragma unroll
    for (int gi = 0; gi < 4; ++gi) { const u32x2 g = *(const u32x2*)(gp + 8 * gi);
        u32x2 y; y.x = pk2(oc[4 * gi + 0] * rs * silu(bflo(g.x)), oc[4 * gi + 1] * rs * silu(bfhi(g.x))); y.y = pk2(oc[4 * gi + 2] * rs * silu(bflo(g.y)), oc[4 * gi + 3] * rs * silu(bfhi(g.y)));
        *(u32x2*)(yp + 8 * gi) = y; }
    __syncthreads();
}

constexpr int XKS = 264, XVS = 288;
#define LBAR() asm volatile("s_waitcnt lgkmcnt(0)\n\ts_barrier" ::: "memory")
__device__ __forceinline__ void xattn_unit(Frame& F, int layer, int unit) {
    const int h = unit & 3, rt = unit >> 2, b = rt >> 5;
    const int tid = launder((F.wave * 64 + mk_lane())), lane = tid & 63, w = F.wave, r32 = lane & 31, hi = lane >> 5;
    LAS bf16* buf0 = (LAS bf16*)F.lds; LAS bf16* buf1 = buf0 + 64 * XVS;
    const bf16* Kg = (const bf16*)(F.ap->ws + WS_KV) + ((size_t)layer * BATCH * MEMLEN + (size_t)b * MEMLEN) * 2048 + h * 256;
    const size_t row = (size_t)rt * 256 + w * 32 + r32;
    const bf16* qp = (const bf16*)(F.ap->ws + WS_BUFB) + row * D + h * 256 + 8 * hi;
    const bf16* gsrc = Kg + (size_t)(tid >> 5) * 2048 + (tid & 31) * 8;
    const int ldst = (tid >> 5) * XKS + (tid & 31) * 8, ldstv = (tid >> 5) * XVS + (tid & 31) * 8;
    u32x4 pf[4];
#define XLOAD(blk) do { _Pragma("unroll") for (int i_ = 0; i_ < 4; ++i_) pf[i_] = *(const u32x4*)(gsrc + (size_t)((((blk) & 3) * 64 + 16 * i_) * 2048 + ((blk) >= 4 ? 1024 : 0))); } while (0)
#define XSTORE(bufp) do { _Pragma("unroll") for (int i_ = 0; i_ < 4; ++i_) *(LAS u32x4*)((bufp) + ldst + 16 * i_ * XKS) = pf[i_]; } while (0)
#define XSTOREV(bufp) do { _Pragma("unroll") for (int i_ = 0; i_ < 4; ++i_) *(LAS u32x4*)((bufp) + ldstv + 16 * i_ * XVS) = pf[i_]; } while (0)
    __syncthreads();
    XLOAD(0);
    bf16x8 qf[8];
    LAS bf16* qs = (LAS bf16*)(F.lds + 73728) + w * (32 * 136) + r32 * 136 + 8 * hi;
#pragma unroll
    for (int s = 0; s < 8; ++s) qf[s] = *(const bf16x8*)(qp + 16 * s);
#pragma unroll
    for (int s = 0; s < 8; ++s) { const bf16x8 t = *(const bf16x8*)(qp + 128 + 16 * s); *(LAS bf16x8*)(qs + 16 * s) = t; }
    XSTORE(buf0);
    XLOAD(1);
    LBAR();
    f32x16 st[8];
#pragma unroll
    for (int kblk = 0; kblk < 4; ++kblk) {
        const LAS bf16* cur = (kblk & 1) ? buf1 : buf0; LAS bf16* nxt = (kblk & 1) ? buf0 : buf1;
#pragma unroll
        for (int kk = 0; kk < 2; ++kk) { f32x16 acc = (f32x16){};
#pragma unroll
            for (int s = 0; s < 8; ++s) { const bf16x8 a = *(const LAS bf16x8*)(cur + (32 * kk + r32) * XKS + 16 * s + 8 * hi); acc = MFMA32(a, qf[s], acc); }
#pragma unroll
            for (int s = 0; s < 8; ++s) { const bf16x8 a = *(const LAS bf16x8*)(cur + (32 * kk + r32) * XKS + 128 + 16 * s + 8 * hi); const bf16x8 q = *(const LAS bf16x8*)(qs + 16 * s); acc = MFMA32(a, q, acc); }
            st[2 * kblk + kk] = acc; }
        if (kblk < 3) XSTORE(nxt); else XSTOREV(nxt);
        XLOAD(kblk + 2);
        LBAR();
    }
    float mx = -3.0e38f;
#pragma unroll
    for (int kb = 0; kb < 8; ++kb)
#pragma unroll
        for (int i = 0; i < 16; ++i) mx = fmaxf(mx, st[kb][i]);
    mx = fmaxf(mx, __shfl_xor(mx, 32));
    const float SC = 0.0625f * 1.4426950408889634f;
    float sum = 0.f;
#pragma unroll
    for (int kb = 0; kb < 8; ++kb)
#pragma unroll
        for (int i = 0; i < 16; ++i) { const float p = exp2f((st[kb][i] - mx) * SC); st[kb][i] = p; sum += p; }
    sum += __shfl_xor(sum, 32);
    const float inv = 1.0f / sum;
    bf16x8 pw[8][2];
#pragma unroll
    for (int kb = 0; kb < 8; ++kb)
#pragma unroll
        for (int s = 0; s < 2; ++s) pw[kb][s] = pack8(st[kb][8 * s + 0] * inv, st[kb][8 * s + 1] * inv, st[kb][8 * s + 2] * inv, st[kb][8 * s + 3] * inv, st[kb][8 * s + 4] * inv, st[kb][8 * s + 5] * inv, st[kb][8 * s + 6] * inv, st[kb][8 * s + 7] * inv);
    f32x16 o[8];
#pragma unroll
    for (int db = 0; db < 8; ++db) o[db] = (f32x16){};
#pragma unroll
    for (int vblk = 0; vblk < 4; ++vblk) {
        const LAS bf16* cur = (vblk & 1) ? buf1 : buf0; LAS bf16* nxt = (vblk & 1) ? buf0 : buf1;
#pragma unroll
        for (int kk = 0; kk < 2; ++kk)
#pragma unroll
            for (int s = 0; s < 2; ++s)
#pragma unroll
                for (int db = 0; db < 8; ++db) { const bf16x8 vf = tr_frag(cur, XVS, 32 * kk + 16 * s, 32 * db, lane); o[db] = MFMA32(vf, pw[2 * vblk + kk][s], o[db]); }
        if (vblk < 3) XSTOREV(nxt);
        if (vblk < 2) XLOAD(vblk + 6);
        LBAR();
    }
#undef XLOAD
#undef XSTORE
#undef XSTOREV
    bf16* op = (bf16*)(F.ap->ws + WS_BUFA) + row * D + h * 256 + 4 * hi;
#pragma unroll
    for (int db = 0; db < 8; ++db)
#pragma unroll
        for (int gi = 0; gi < 4; ++gi) { u32x2 y; y.x = pk2(o[db][4 * gi], o[db][4 * gi + 1]); y.y = pk2(o[db][4 * gi + 2], o[db][4 * gi + 3]); *(u32x2*)(op + 32 * db + 8 * gi) = y; }
}

__device__ __forceinline__ void conv_phase(Frame& F) {
    const bf16* H4 = (const bf16*)(F.ap->ws + WS_BIG); bf16* Y = (bf16*)(F.ap->ws + WS_BUFA);
    const float* cw = F.ap->in[8]; const float* cb = F.ap->in[9];
    for (int it = F.bid * NTHR + launder((F.wave * 64 + mk_lane())); it < (MTOK / 8) * 128; it += F.G * NTHR) {
        const int cgi = it & 127, tg = it >> 7, col = cgi * 8, t0 = tg * 8;
        float w0[8], w1[8], w2[8], bs[8];
#pragma unroll
        for (int e = 0; e < 8; ++e) { w0[e] = cw[col + e]; w1[e] = cw[D + col + e]; w2[e] = cw[2 * D + col + e]; bs[e] = cb[col + e]; }
        float zm2[8], zm1[8];
        const bool first = (t0 & (SEQ - 1)) == 0;
#pragma unroll
        for (int e = 0; e < 8; ++e) { zm2[e] = 0.f; zm1[e] = 0.f; }
        if (!first) {
            const bf16* r2 = H4 + (size_t)(t0 - 2) * OIN + col; const bf16* r1 = H4 + (size_t)(t0 - 1) * OIN + col;
            const u32x4 c2 = *(const u32x4*)(r2 + 1024), u2 = *(const u32x4*)(r2 + 2048), c1 = *(const u32x4*)(r1 + 1024), u1 = *(const u32x4*)(r1 + 2048);
#pragma unroll
            for (int e = 0; e < 4; ++e) { zm2[2 * e] = bflo(c2[e]) * bflo(u2[e]); zm2[2 * e + 1] = bfhi(c2[e]) * bfhi(u2[e]); zm1[2 * e] = bflo(c1[e]) * bflo(u1[e]); zm1[2 * e + 1] = bfhi(c1[e]) * bfhi(u1[e]); }
        }
#pragma unroll
        for (int tt = 0; tt < 8; ++tt) {
            const bf16* r = H4 + (size_t)(t0 + tt) * OIN + col;
            const u32x4 gb = *(const u32x4*)(r), gc = *(const u32x4*)(r + 1024), uu = *(const u32x4*)(r + 2048), gt = *(const u32x4*)(r + 3072);
            float z[8], y[8];
#pragma unroll
            for (int e = 0; e < 4; ++e) { z[2 * e] = bflo(gc[e]) * bflo(uu[e]); z[2 * e + 1] = bfhi(gc[e]) * bfhi(uu[e]); }
#pragma unroll
            for (int e = 0; e < 4; ++e) {
                const float cv0 = bs[2 * e] + zm2[2 * e] * w0[2 * e] + zm1[2 * e] * w1[2 * e] + z[2 * e] * w2[2 * e];
                const float cv1 = bs[2 * e + 1] + zm2[2 * e + 1] * w0[2 * e + 1] + zm1[2 * e + 1] * w1[2 * e + 1] + z[2 * e + 1] * w2[2 * e + 1];
                y[2 * e] = bflo(gb[e]) * cv0 * silu(bflo(gt[e])); y[2 * e + 1] = bfhi(gb[e]) * cv1 * silu(bfhi(gt[e])); }
            u32x4 o; o.x = pk2(y[0], y[1]); o.y = pk2(y[2], y[3]); o.z = pk2(y[4], y[5]); o.w = pk2(y[6], y[7]);
            *(u32x4*)(Y + (size_t)(t0 + tt) * D + col) = o;
#pragma unroll
            for (int e = 0; e < 8; ++e) { zm2[e] = zm1[e]; zm1[e] = z[e]; }
        }
    }
}

__device__ __forceinline__ void final_phase(Frame& F) {
    const int gw = F.bid * NWAVES + F.wave, NGW = F.G * NWAVES, lane = mk_lane();
    const float* ssp = (const float*)(F.ap->ws + WS_SSP);
    for (int row = gw; row < MTOK; row += NGW) {
        const f32x4* p = (const f32x4*)(ssp + (size_t)row * 16); const f32x4 a = p[0], b = p[1], c = p[2], d = p[3];
        const float s = ((a[0] + a[1]) + (a[2] + a[3])) + ((b[0] + b[1]) + (b[2] + b[3])) + ((c[0] + c[1]) + (c[2] + c[3])) + ((d[0] + d[1]) + (d[2] + d[3]));
        const float rs = 1.0f / sqrtf(s * (1.0f / D) + EPS);
        f32x4* xr = (f32x4*)(F.ap->out + (size_t)row * D) + lane; const f32x4* gr = (const f32x4*)F.ap->in[16] + lane;
#pragma unroll
        for (int j = 0; j < 4; ++j) { const f32x4 v = xr[64 * j], g = gr[64 * j]; xr[64 * j] = v * rs * g; }
    }
}

#ifndef TS_PROBE
#define TS_PROBE 0
#endif
#define TS_A_HI 5
#define TS_A_LO 2
#define TS_B_HI 1
#define TS_B_LO 0
#ifndef DUP_MASK
#define DUP_MASK 0
#endif
#define REP(k) _Pragma("unroll 1") for (int rep_ = 0; rep_ < ((((DUP_MASK) >> (k)) & 1) + 1); ++rep_)
#ifndef MK_SPLIT
#define MK_SPLIT 0
#endif
constexpr int NPHASE = 16;
__global__ void __launch_bounds__(NTHR, 2) fwd_megakernel(Args args) {
    extern __shared__ __attribute__((aligned(16))) unsigned char lds_raw[];
    cg::grid_group grid = cg::this_grid();
    Frame F;
    F.lds = (LAS unsigned char*)lds_raw; F.wave = __builtin_amdgcn_readfirstlane((int)threadIdx.x >> 6); F.G = gridDim.x; F.bid = blockIdx.x;
    F.ap = (const Args*)__builtin_amdgcn_kernarg_segment_ptr();
    if ((F.wave * 64 + mk_lane()) < 2) ((LAS unsigned*)(F.lds + XB_LDS_OFF))[(F.wave * 64 + mk_lane())] = 0u;
    __syncthreads();
    const XcdBarrier xbar = xcd_barrier_post((unsigned*)(args.ws + XB_WS_OFF), (volatile LAS unsigned*)(F.lds + XB_LDS_OFF), F.wave);
    const int lo = args.ph_lo, hi = args.ph_hi;
    if (hi > NPHASE) grid.sync();
#define IN(k) (lo <= (k) && (k) < hi)
#define SEAM(k) do { if (IN(k) && IN((k) + 1)) xcd_barrier(xbar); STAMP((k) + 1); } while (0)
    typedef pg8::EpiScaleBf16<true> EpiS; typedef pg8::EpiScaleBf16<false> EpiN;
#define ws (F.ap->ws)
#define XB ((bf16*)(ws + WS_XB))
#define SSP ((float*)(ws + WS_SSP))
#define BIG ((bf16*)(ws + WS_BIG))
#define BUFA ((bf16*)(ws + WS_BUFA))
#define BUFB ((bf16*)(ws + WS_BUFB))

#if TS_PROBE
#define STAMP(i) do { if (blockIdx.x == 0 && threadIdx.x == 0) ((unsigned long long*)ws)[i] = __builtin_amdgcn_s_memrealtime(); } while (0)
#else
#define STAMP(i) do { } while (0)
#endif
    STAMP(0);
    REP(0) {
    if (IN(0)) { p0_prologue(F); } SEAM(0); }
    REP(1) {
    if (IN(1)) {
        { pg8::Gemm g{XB, (const bf16*)(ws + WS_WEIN), MTOK, EIN, D}; pg8::StaticOrder S; S.init(MTOK, EIN, F.G, F.bid); pg8::rs_prepass((LAS float*)(F.lds + 131072), S, SSP, (F.wave * 64 + mk_lane())); EpiS E{BIG, EIN, (const LAS float*)(F.lds + 131072)};
          pg8::gemm_phase<EpiS, pg8::StaticOrder, true, true>(F.lds, g, S, E, F.wave); }
#pragma unroll 1
        for (int l = 0; l < 2; ++l) { pg8::Gemm g{(const bf16*)(ws + WS_MEMN) + (size_t)l * BATCH * MEMLEN * D, (const bf16*)(ws + WS_WKV) + (size_t)l * 2 * D * D, BATCH * MEMLEN, 2 * D, D};
          pg8::StaticOrder S; S.init(BATCH * MEMLEN, 2 * D, F.G, (F.bid + F.G - (F.G / 2 + 32 * l) % F.G) % F.G); EpiN E{(bf16*)(ws + WS_KV) + (size_t)l * BATCH * MEMLEN * 2 * D, 2 * D, nullptr};
          pg8::gemm_phase<EpiN, pg8::StaticOrder, true, true>(F.lds, g, S, E, F.wave); }
    } SEAM(1); }
    REP(2) {
    if (IN(2)) {
        for (int it = F.bid; it < BATCH * NCH * 4; it += F.G) ret1_item(F, it);
        for (int it = F.bid; it < BATCH * NCH * 2; it += F.G) swa_item(F, it);
    } SEAM(2); }
    REP(3) {
    if (IN(3)) { scan_phase(F); } SEAM(3); }
    REP(4) {
    if (IN(4)) { for (int it = F.bid; it < BATCH * NCH * 4; it += F.G) ret2_item(F, it); } SEAM(4); }
    REP(5) {
    if (IN(5)) {
        pg8::Gemm g{BUFA, (const bf16*)(ws + WS_WEOUT), MTOK, D, D}; pg8::StaticOrder S; S.init(MTOK, D, F.G, F.bid); typedef pg8::EpiResidual<true, false> EpiR0; EpiR0 E{F.ap->in[0], XB, SSP, D};
        pg8::gemm_phase<EpiR0, pg8::StaticOrder, true, true>(F.lds, g, S, E, F.wave);
    } SEAM(5); }
#pragma unroll
    for (int l = 0; l < 2; ++l) {
        const int pb = (l == 0) ? 6 : 12;
        REP(pb) {
        if (IN(pb)) {
            pg8::Gemm g{XB, (const bf16*)(ws + WS_WQ) + (size_t)l * D * D, MTOK, D, D}; pg8::StaticOrder S; S.init(MTOK, D, F.G, F.bid); pg8::rs_prepass((LAS float*)(F.lds + 131072), S, SSP, (F.wave * 64 + mk_lane())); EpiS E{BUFB, D, (const LAS float*)(F.lds + 131072)};
            pg8::gemm_phase<EpiS, pg8::StaticOrder, true, true>(F.lds, g, S, E, F.wave);
        } SEAM(pb); }
        REP(pb + 1) {
        if (IN(pb + 1)) { for (int it = F.bid; it < (MTOK / 256) * 4; it += F.G) xattn_unit(F, l, it); } SEAM(pb + 1); }
        REP(pb + 2) {
        if (IN(pb + 2)) {
            pg8::Gemm g{BUFA, (const bf16*)(ws + WS_WO) + (size_t)l * D * D, MTOK, D, D}; pg8::StaticOrder S; S.init(MTOK, D, F.G, F.bid); if (l == 0) { typedef pg8::EpiResidual<false, false> EpiR1; EpiR1 E{XB, XB, SSP, D}; pg8::gemm_phase<EpiR1, pg8::StaticOrder, true, true>(F.lds, g, S, E, F.wave); }
            else { typedef pg8::EpiResidual<false, true> EpiR2; EpiR2 E{XB, F.ap->out, SSP, D}; pg8::gemm_phase<EpiR2, pg8::StaticOrder, true, true>(F.lds, g, S, E, F.wave); }
        } SEAM(pb + 2); }
        if (l == 0) {
            REP(9) {
            if (IN(9)) {
                pg8::Gemm g{XB, (const bf16*)(ws + WS_WOIN), MTOK, OIN, D}; pg8::StaticOrder S; S.init(MTOK, OIN, F.G, F.bid); pg8::rs_prepass((LAS float*)(F.lds + 131072), S, SSP, (F.wave * 64 + mk_lane())); EpiS E{BIG, OIN, (const LAS float*)(F.lds + 131072)};
                pg8::gemm_phase<EpiS, pg8::StaticOrder, true, true>(F.lds, g, S, E, F.wave);
            } SEAM(9); }
            REP(10) {
            if (IN(10)) { conv_phase(F); } SEAM(10); }
            REP(11) {
            if (IN(11)) {
                pg8::Gemm g{BUFA, (const bf16*)(ws + WS_WOOUT), MTOK, D, D}; pg8::StaticOrder S; S.init(MTOK, D, F.G, F.bid); typedef pg8::EpiResidual<false, false> EpiR1; EpiR1 E{XB, XB, SSP, D};
                pg8::gemm_phase<EpiR1, pg8::StaticOrder, true, true>(F.lds, g, S, E, F.wave);
            } SEAM(11); }
        }
    }
    if (IN(15)) { final_phase(F); }
#if TS_PROBE
    __syncthreads();
    if (blockIdx.x == 0 && threadIdx.x == 0) { const unsigned long long* ts = (const unsigned long long*)ws;
        const float ta = (float)(ts[TS_A_HI] - ts[TS_A_LO]) * 0.01f, tb = (float)(ts[TS_B_HI] - ts[TS_B_LO]) * 0.01f;
        F.ap->out[0] = ta; for (int i = 1; i <= 1000; ++i) F.ap->out[i] = tb; }
#endif
#undef IN
#undef SEAM
#undef ws
#undef XB
#undef SSP
#undef BIG
#undef BUFA
#undef BUFB
}

extern "C" void kernel_launch(void* const* d_in, const int* in_sizes, int n_in, void* d_out, int out_size, void* d_ws, size_t ws_size, hipStream_t stream) {
    static int grid = 0;
    if (grid == 0) {
        if (n_in != 17 || out_size != MTOK * D || ws_size < WS_END) { fprintf(stderr, "kernel_launch: unexpected shapes (n_in %d out %d ws %zu)\n", n_in, out_size, ws_size); grid = -1; return; }
        int dev = 0, cus = 0, per_cu = 0;
        hipGetDevice(&dev); hipDeviceGetAttribute(&cus, hipDeviceAttributeMultiprocessorCount, dev);
        if (hipFuncSetAttribute((const void*)fwd_megakernel, hipFuncAttributeMaxDynamicSharedMemorySize, LDS_BYTES) != hipSuccess) { fprintf(stderr, "kernel_launch: hipFuncSetAttribute failed\n"); grid = -1; return; }
        if (hipOccupancyMaxActiveBlocksPerMultiprocessor(&per_cu, (const void*)fwd_megakernel, NTHR, LDS_BYTES) != hipSuccess || per_cu < 1) { fprintf(stderr, "kernel_launch: occupancy query says %d\n", per_cu); per_cu = 1; }
        (void)hipGetLastError();
        grid = cus;
    }
    if (grid < 0) return;
    if (hipMemsetAsync(d_ws, 0, 65536, stream) != hipSuccess) { fprintf(stderr, "kernel_launch: hipMemsetAsync failed\n"); return; }
    Args a{};
    for (int i = 0; i < 17; ++i) a.in[i] = (const float*)d_in[i];
    a.out = (float*)d_out; a.ws = (unsigned char*)d_ws;
#if MK_SPLIT
    for (int p = 0; p < NPHASE; ++p) { a.ph_lo = p; a.ph_hi = p + 1; hipLaunchKernelGGL(fwd_megakernel, dim3(grid), dim3(NTHR), LDS_BYTES, stream, a); }
#else
    a.ph_lo = 0; a.ph_hi = NPHASE;
    void* kargs[] = {&a};
    hipError_t e = hipLaunchCooperativeKernel((const void*)fwd_megakernel, dim3(grid), dim3(NTHR), kargs, LDS_BYTES, stream);
    if (e != hipSuccess) fprintf(stderr, "kernel_launch: cooperative launch failed: %s (grid %d)\n", hipGetErrorString(e), grid);
#endif
}
```

```cpp
#include <hip/hip_runtime.h>
#include <hip/hip_cooperative_groups.h>
#include <cstdio>
#include <cstdint>
namespace cg = cooperative_groups;
__device__ __forceinline__ int mk_lane() { int l = (int)__builtin_amdgcn_mbcnt_hi(~0u, __builtin_amdgcn_mbcnt_lo(~0u, 0u)); asm volatile("" : "+v"(l)); return l; }
namespace pg8 {
#define PG8_LAS __attribute__((address_space(3)))
typedef unsigned short bf16_t;
typedef short bf16x8 __attribute__((ext_vector_type(8)));
typedef float f32x4 __attribute__((ext_vector_type(4)));
typedef unsigned u32x4 __attribute__((ext_vector_type(4)));
constexpr int BM = 256, BK = 64, HALF = 128, HTB = HALF * BK * 2  , STAGE_BYTES = 8 * HTB, NXCD = 8, WGM = 8;

__host__ __device__ __forceinline__ int lds_byte(int r, int c) { const int st = (r >> 4) * 2 + (c >> 5), rr = r & 15, cc = c & 31, ob = rr * 64 + cc * 2; return st * 1024 + (ob ^ (((ob >> 9) & 1) << 5)); }
__host__ __device__ __forceinline__ void stage_rc(int b, int& R, int& C) { const int st = b / 1024, sb = b % 1024, swz = sb ^ (((sb >> 9) & 1) << 5); R = (st >> 1) * 16 + swz / 64; C = (st & 1) * 32 + (swz % 64) / 2; }
__host__ __device__ __forceinline__ int perm32(int rho) { const int n = rho >> 4, i = rho & 15; return 8 * (i >> 2) + 4 * n + (i & 3); }

struct Unit { int pm, pn, idx; };
struct Gemm { const bf16_t* A; const bf16_t* Bt; int M, N, K; };

struct StaticOrder {
    int nM, nN, nwg, G, c;
    __host__ __device__ void init(int M, int N, int G_, int c_) { nM = M / BM; nN = N / BM; nwg = nM * nN; G = G_; c = c_; }
    __host__ __device__ bool next(int i, Unit& u) const {
        const long L = (long)i * G + c; if (L >= nwg) return false;
        int wgid = (int)L; { const int q = nwg / NXCD, r = nwg % NXCD, xcd = wgid % NXCD, off = wgid / NXCD; wgid = (xcd < r ? xcd * (q + 1) : r * (q + 1) + (xcd - r) * q) + off; }
        const int nig = WGM * nN, gid = wgid / nig, fm = gid * WGM, gsz = (nM - fm) < WGM ? (nM - fm) : WGM;
        u.pm = fm + ((wgid % nig) % gsz); u.pn = (wgid % nig) / gsz; u.idx = i; return true;
    }
    __device__ __forceinline__ void a_ready(const Unit&) const {}
    __device__ __forceinline__ void done(const Unit&) const {}
};

typedef float f32x2 __attribute__((ext_vector_type(2))); typedef __bf16 bf16x2_t __attribute__((ext_vector_type(2)));
__device__ __forceinline__ unsigned cvt_pk_bf16(float lo, float hi) { const f32x2 v = {lo, hi}; const bf16x2_t b = __builtin_convertvector(v, bf16x2_t); return __builtin_bit_cast(unsigned, b); }
template <bool SCALE> struct EpiScaleBf16 {
    static constexpr bool PERM = true, AFTER_DRAIN = false;
    bf16_t* O; int ldc; const PG8_LAS float* rs;
    __device__ __forceinline__ void operator()(const f32x4 (&acc)[2][2][4][2], const Unit& u, int wr, int wc, int fr, int fq) const {
        const int rl0 = wr * 64 + fr; const int col0 = u.pn * BM + wc * 32 + 8 * fq;
#pragma unroll
        for (int ai = 0; ai < 2; ++ai)
#pragma unroll
            for (int m = 0; m < 4; ++m) {
                const float sc = SCALE ? rs[256 * u.idx + rl0 + ai * HALF + m * 16] : 1.f;
                bf16_t* rowp = O + (size_t)(u.pm * BM + rl0 + ai * HALF + m * 16) * ldc + col0;
#pragma unroll
                for (int bj = 0; bj < 2; ++bj) { const f32x4 v0 = acc[ai][bj][m][0] * sc, v1 = acc[ai][bj][m][1] * sc;
                    u32x4 w; w.x = cvt_pk_bf16(v0[0], v0[1]); w.y = cvt_pk_bf16(v0[2], v0[3]); w.z = cvt_pk_bf16(v1[0], v1[1]); w.w = cvt_pk_bf16(v1[2], v1[3]);
                    *(u32x4*)(rowp + bj * HALF) = w; }
            }
    }
};
template <class Sched> __device__ __forceinline__ void rs_prepass(PG8_LAS float* rs, const Sched& S, const float* ssp, int tid) {
    const int row = tid >> 1, half = tid & 1;
    f32x4 v[8][2]; bool have[8];
#pragma unroll
    for (int i = 0; i < 8; ++i) { Unit u; have[i] = S.next(i, u);
        if (have[i]) { const f32x4* p = (const f32x4*)(ssp + (size_t)(u.pm * BM + row) * 16) + 2 * half; v[i][0] = p[0]; v[i][1] = p[1]; } }
#pragma unroll
    for (int i = 0; i < 8; ++i) if (have[i]) {
        float s = ((v[i][0][0] + v[i][0][1]) + (v[i][0][2] + v[i][0][3])) + ((v[i][1][0] + v[i][1][1]) + (v[i][1][2] + v[i][1][3]));
        s += __shfl_xor(s, 1);
        if (half == 0) rs[256 * i + row] = 1.0f / sqrtf(s * (1.0f / 1024.0f) + 1e-6f); }
    __syncthreads();
}
template <bool BASE_F32, bool OUT_F32> struct EpiResidual {
    static constexpr bool PERM = true, AFTER_DRAIN = false;
    const void* base; void* out; float* ssp; int ldc;
    __device__ __forceinline__ void operator()(const f32x4 (&acc)[2][2][4][2], const Unit& u, int wr, int wc, int fr, int fq) const {
        const int row0 = u.pm * BM + wr * 64 + fr; const int col0 = u.pn * BM + wc * 32 + 8 * fq;
#pragma unroll
        for (int ai = 0; ai < 2; ++ai)
#pragma unroll
          for (int mh = 0; mh < 2; ++mh) {
            u32x4 pb[2][2]; f32x4 fb[2][2][2];
#pragma unroll
            for (int m2 = 0; m2 < 2; ++m2)
#pragma unroll
                for (int bj = 0; bj < 2; ++bj) { const size_t off = (size_t)(row0 + ai * HALF + (2 * mh + m2) * 16) * ldc + col0 + bj * HALF;
                    if (BASE_F32) { fb[m2][bj][0] = *(const f32x4*)((const float*)base + off); fb[m2][bj][1] = *(const f32x4*)((const float*)base + off + 4); }
                    else pb[m2][bj] = *(const u32x4*)((const bf16_t*)base + off); }
#pragma unroll
            for (int m2 = 0; m2 < 2; ++m2) {
                const int m = 2 * mh + m2, row = row0 + ai * HALF + m * 16;
                float ss = 0.f;
#pragma unroll
                for (int bj = 0; bj < 2; ++bj) { const size_t off = (size_t)row * ldc + col0 + bj * HALF;
                    f32x4 b0, b1;
                    if (BASE_F32) { b0 = fb[m2][bj][0]; b1 = fb[m2][bj][1]; }
                    else { const u32x4 w = pb[m2][bj];
                        b0 = (f32x4){__uint_as_float(w.x << 16), __uint_as_float(w.x & 0xffff0000u), __uint_as_float(w.y << 16), __uint_as_float(w.y & 0xffff0000u)};
                        b1 = (f32x4){__uint_as_float(w.z << 16), __uint_as_float(w.z & 0xffff0000u), __uint_as_float(w.w << 16), __uint_as_float(w.w & 0xffff0000u)}; }
                    const f32x4 o0 = b0 + acc[ai][bj][m][0], o1 = b1 + acc[ai][bj][m][1];
                    ss += ((o0[0] * o0[0] + o0[1] * o0[1]) + (o0[2] * o0[2] + o0[3] * o0[3])) + ((o1[0] * o1[0] + o1[1] * o1[1]) + (o1[2] * o1[2] + o1[3] * o1[3]));
                    if (OUT_F32) { *(f32x4*)((float*)out + off) = o0; *(f32x4*)((float*)out + off + 4) = o1; }
                    else { u32x4 w; w.x = cvt_pk_bf16(o0[0], o0[1]); w.y = cvt_pk_bf16(o0[2], o0[3]); w.z = cvt_pk_bf16(o1[0], o1[1]); w.w = cvt_pk_bf16(o1[2], o1[3]);
                        *(u32x4*)((bf16_t*)out + off) = w; } }
                ss += __shfl_xor(ss, 16); ss += __shfl_xor(ss, 32);
                if (fq == 0) ssp[(size_t)row * 16 + u.pn * 4 + wc] = ss;
            }
            asm volatile("" ::: "memory");
          }
    }
};
template <class Epi, class Sched, bool ALIGN_EPI = false, bool SP2 = false>
__device__ __forceinline__ void gemm_phase(PG8_LAS unsigned char* lds, const Gemm g, const Sched& S, const Epi& E, const int wave_in) {
    int tid_ = wave_in * 64 + mk_lane(); asm volatile("" : "+v"(tid_));
    const int tid = tid_, wid = __builtin_amdgcn_readfirstlane(tid >> 6), lane = tid & 63, wr = wid >> 2, wc = wid & 3, fr = lane & 15, fq = lane >> 4;
    const int K = g.K, nt = K / BK;
    unsigned voffA[2], voffB[2];
#pragma unroll
    for (int i = 0; i < 2; ++i) { int R, C; stage_rc(tid * 16 + i * 8192, R, C); const int Rb = Epi::PERM ? ((R & ~31) + perm32(R & 31)) : R;
        voffA[i] = (unsigned)(R * K + C) * 2u; voffB[i] = (unsigned)(Rb * K + C) * 2u; }
    const size_t kstep = (size_t)(BK * 2);
    const size_t hstep = (size_t)HALF * K * 2;
    const size_t tstep = 2 * hstep;
    const unsigned ldsw = (unsigned)wid * 1024u;
    const int aoff = lds_byte(wr * 64 + fr, fq * 8), boff = lds_byte(wc * 32 + fr, fq * 8);
#define PG8_SA(b, h) (((b) * 2 + (h)) * HTB)
#define PG8_SB(b, h) ((4 + (b) * 2 + (h)) * HTB)
#define PG8_STAGE(bufoff, gbase, voff) do { _Pragma("unroll") for (int _i = 0; _i < 2; ++_i) \
        __builtin_amdgcn_global_load_lds((const unsigned*)((const char*)(gbase) + (voff)[_i]), (PG8_LAS unsigned*)(lds + (bufoff) + ldsw + _i * 8192), 16, 0, 0); } while (0)
#define PG8_LDA(dst, b, h) do { _Pragma("unroll") for (int m = 0; m < 4; ++m) _Pragma("unroll") for (int k = 0; k < 2; ++k) dst[m][k] = *(const PG8_LAS bf16x8*)(lds + PG8_SA(b, h) + aoff + m * 2048 + k * 1024); } while (0)
#define PG8_LDB(dst, b, h) do { _Pragma("unroll") for (int n = 0; n < 2; ++n) _Pragma("unroll") for (int k = 0; k < 2; ++k) dst[n][k] = *(const PG8_LAS bf16x8*)(lds + PG8_SB(b, h) + boff + n * 2048 + k * 1024); } while (0)
#define PG8_MMA(ai, bj, At, Bt) do { __builtin_amdgcn_s_setprio(1); _Pragma("unroll") for (int m = 0; m < 4; ++m) _Pragma("unroll") for (int n = 0; n < 2; ++n) _Pragma("unroll") for (int k = 0; k < 2; ++k) \
        acc[ai][bj][m][n] = __builtin_amdgcn_mfma_f32_16x16x32_bf16(Bt[n][k], At[m][k], acc[ai][bj][m][n], 0, 0, 0); __builtin_amdgcn_s_setprio(0); } while (0)
#define PG8_WAIT_V(n) asm volatile("s_waitcnt vmcnt(" #n ")" ::: "memory")
#define PG8_WAIT_L(n) asm volatile("s_waitcnt lgkmcnt(" #n ")" ::: "memory")
#define PG8_BAR __builtin_amdgcn_s_barrier()
#define PG8_SCHED __builtin_amdgcn_sched_barrier(0)
    Unit cur, nxt; int ui = 0;
    if (!S.next(0, cur)) return;
    f32x4 acc[2][2][4][2];
#pragma unroll
    for (int a = 0; a < 2; ++a)
#pragma unroll
        for (int b = 0; b < 2; ++b)
#pragma unroll
            for (int m = 0; m < 4; ++m)
#pragma unroll
                for (int n = 0; n < 2; ++n) acc[a][b][m][n] = (f32x4){0.f, 0.f, 0.f, 0.f};
    bf16x8 At[4][2], B0[2][2], B1[2][2];
    const char* cA = (const char*)g.A + (size_t)cur.pm * tstep; const char* cB = (const char*)g.Bt + (size_t)cur.pn * tstep;
    S.a_ready(cur);
    if constexpr (SP2) {
        PG8_STAGE(PG8_SB(0, 0), cB, voffB); PG8_STAGE(PG8_SB(0, 1), cB + hstep, voffB); PG8_STAGE(PG8_SA(0, 0), cA, voffA); PG8_STAGE(PG8_SA(0, 1), cA + hstep, voffA);
        if (wr == 1) PG8_BAR;
        PG8_WAIT_V(2); PG8_BAR;
        PG8_STAGE(PG8_SB(1, 0), cB + kstep, voffB); PG8_STAGE(PG8_SA(1, 0), cA + kstep, voffA); PG8_STAGE(PG8_SB(1, 1), cB + hstep + kstep, voffB);
        PG8_WAIT_V(6); PG8_BAR;
    } else {
        PG8_STAGE(PG8_SB(0, 0), cB, voffB); PG8_STAGE(PG8_SA(0, 0), cA, voffA); PG8_STAGE(PG8_SB(0, 1), cB + hstep, voffB); PG8_STAGE(PG8_SA(0, 1), cA + hstep, voffA);
        if (wr == 1) PG8_BAR;
        PG8_WAIT_V(4); PG8_BAR;
        PG8_STAGE(PG8_SB(1, 0), cB + kstep, voffB); PG8_STAGE(PG8_SA(1, 0), cA + kstep, voffA); PG8_STAGE(PG8_SB(1, 1), cB + hstep + kstep, voffB);
        PG8_WAIT_V(6); PG8_BAR;
    }
    for (;;) {
        const bool has_next = S.next(ui + 1, nxt);
        const char* nA = has_next ? (const char*)g.A + (size_t)nxt.pm * tstep : cA; const char* nB = has_next ? (const char*)g.Bt + (size_t)nxt.pn * tstep : cB;
        for (int t = 0; t < nt; t += 2) {
            const bool last = (t == nt - 2);
            const char* a1 = cA + (size_t)(t + 1) * kstep;
            const char* a2 = last ? nA : cA + (size_t)(t + 2) * kstep; const char* b2 = last ? nB : cB + (size_t)(t + 2) * kstep;
            const char* a3 = a2 + kstep; const char* b3 = b2 + kstep;
            if (last && has_next) S.a_ready(nxt);
            if constexpr (SP2) {
            PG8_LDB(B0, 0, 0); PG8_LDB(B1, 0, 1); PG8_SCHED; PG8_LDA(At, 0, 0); PG8_STAGE(PG8_SA(1, 1), a1 + hstep, voffA);
            PG8_WAIT_V(8); PG8_WAIT_L(0); PG8_BAR; PG8_MMA(0, 0, At, B0); PG8_MMA(0, 1, At, B1); PG8_BAR; PG8_SCHED;
            PG8_LDA(At, 0, 1); PG8_STAGE(PG8_SB(0, 0), b2, voffB); PG8_STAGE(PG8_SB(0, 1), b2 + hstep, voffB); PG8_STAGE(PG8_SA(0, 0), a2, voffA);
            PG8_WAIT_V(8); PG8_WAIT_L(0); PG8_BAR; PG8_MMA(1, 0, At, B0); PG8_MMA(1, 1, At, B1); PG8_BAR; PG8_SCHED;
            PG8_LDB(B0, 1, 0); PG8_LDB(B1, 1, 1); PG8_SCHED; PG8_LDA(At, 1, 0); PG8_STAGE(PG8_SA(0, 1), a2 + hstep, voffA);
            PG8_WAIT_V(8); PG8_WAIT_L(0); PG8_BAR; PG8_MMA(0, 0, At, B0); PG8_MMA(0, 1, At, B1); PG8_BAR; PG8_SCHED;
            PG8_LDA(At, 1, 1); PG8_STAGE(PG8_SB(1, 0), b3, voffB); PG8_STAGE(PG8_SB(1, 1), b3 + hstep, voffB); PG8_STAGE(PG8_SA(1, 0), a3, voffA);
            PG8_WAIT_V(8); PG8_WAIT_L(0); PG8_BAR; PG8_MMA(1, 0, At, B0); PG8_MMA(1, 1, At, B1); PG8_BAR; PG8_SCHED;
            } else {
            PG8_LDB(B0, 0, 0); PG8_SCHED; PG8_LDA(At, 0, 0); PG8_STAGE(PG8_SA(1, 1), a1 + hstep, voffA);
            PG8_WAIT_L(8); PG8_BAR; PG8_WAIT_L(0); PG8_MMA(0, 0, At, B0); PG8_BAR; PG8_SCHED;
            PG8_LDB(B1, 0, 1); PG8_STAGE(PG8_SB(0, 0), b2, voffB);
            PG8_BAR; PG8_WAIT_L(0); PG8_MMA(0, 1, At, B1); PG8_BAR;
            PG8_LDA(At, 0, 1); PG8_STAGE(PG8_SA(0, 0), a2, voffA);
            PG8_BAR; PG8_WAIT_L(0); PG8_MMA(1, 0, At, B0); PG8_BAR; PG8_SCHED;
            PG8_STAGE(PG8_SB(0, 1), b2 + hstep, voffB);
            PG8_WAIT_V(6); PG8_BAR; PG8_MMA(1, 1, At, B1); PG8_BAR;
            PG8_LDB(B0, 1, 0); PG8_SCHED; PG8_LDA(At, 1, 0); PG8_STAGE(PG8_SA(0, 1), a2 + hstep, voffA);
            PG8_WAIT_L(8); PG8_BAR; PG8_WAIT_L(0); PG8_MMA(0, 0, At, B0); PG8_BAR; PG8_SCHED;
            PG8_LDB(B1, 1, 1); PG8_STAGE(PG8_SB(1, 0), b3, voffB);
            PG8_BAR; PG8_WAIT_L(0); PG8_MMA(0, 1, At, B1); PG8_BAR;
            PG8_LDA(At, 1, 1); PG8_STAGE(PG8_SA(1, 0), a3, voffA);
            PG8_BAR; PG8_WAIT_L(0); PG8_MMA(1, 0, At, B0); PG8_BAR; PG8_SCHED;
            PG8_STAGE(PG8_SB(1, 1), b3 + hstep, voffB);
            PG8_WAIT_V(6); PG8_BAR; PG8_MMA(1, 1, At, B1); PG8_BAR;
            }
        }
        if constexpr (ALIGN_EPI) { if (wr == 0) PG8_BAR; }
        if constexpr (!Epi::AFTER_DRAIN) { E(acc, cur, wr, wc, fr, fq); S.done(cur); }
        if (!has_next) break;
#pragma unroll
        for (int a = 0; a < 2; ++a)
#pragma unroll
            for (int b = 0; b < 2; ++b)
#pragma unroll
                for (int m = 0; m < 4; ++m)
#pragma unroll
                    for (int n = 0; n < 2; ++n) acc[a][b][m][n] = (f32x4){0.f, 0.f, 0.f, 0.f};
        cur = nxt; cA = nA; cB = nB; ++ui;
        if constexpr (ALIGN_EPI) { if (wr == 1) PG8_BAR; }
    }
    PG8_WAIT_V(0);
    if constexpr (!ALIGN_EPI) { if (wr == 0) PG8_BAR; }
    PG8_BAR;
    if constexpr (Epi::AFTER_DRAIN) { E.fused(acc, cur, wr, wc, fr, fq, lds, wid, lane); S.done(cur); }
#undef PG8_SA
#undef PG8_SB
#undef PG8_STAGE
#undef PG8_LDA
#undef PG8_LDB
#undef PG8_MMA
#undef PG8_WAIT_V
#undef PG8_WAIT_L
#undef PG8_BAR
#undef PG8_SCHED
}
}

constexpr int D = 1024, BATCH = 4, SEQ = 8192, MTOK = BATCH * SEQ, NCH = SEQ / 64, MEMLEN = 256;
constexpr int EIN = 3328, OIN = 4096;
constexpr float EPS = 1e-6f;
constexpr int C_AQ = 0, C_AK = 512, C_AV = 640, C_AG = 768, C_BQ = 1280, C_BK = 1792, C_BV = 2304, C_BG = 2816;
constexpr int NWAVES = 8, NTHR = 512;
constexpr size_t MiB = 1u << 20;
constexpr size_t WS_WEIN = 1 * MiB, WS_WEOUT = 8 * MiB, WS_WOIN = 10 * MiB, WS_WOOUT = 18 * MiB, WS_WQ = 20 * MiB, WS_WKV = 24 * MiB, WS_WO = 32 * MiB;
constexpr size_t WS_MEMN = 36 * MiB, WS_KV = 40 * MiB, WS_ROT = 48 * MiB, WS_SSP = 52 * MiB;
constexpr size_t WS_XB = 56 * MiB;
constexpr size_t WS_BIG = 120 * MiB;
constexpr size_t WS_BUFA = 376 * MiB;
constexpr size_t WS_BUFB = 440 * MiB;
constexpr size_t WS_END = 504 * MiB;
constexpr int LDS_BYTES = 147456;

#define LAS __attribute__((address_space(3)))
typedef unsigned short bf16;
typedef short bf16x8 __attribute__((ext_vector_type(8)));
typedef short s16x4 __attribute__((ext_vector_type(4)));
typedef float f32x2 __attribute__((ext_vector_type(2)));
typedef float f32x4 __attribute__((ext_vector_type(4)));
typedef float f32x16 __attribute__((ext_vector_type(16)));
typedef unsigned u32x2 __attribute__((ext_vector_type(2)));
typedef unsigned u32x4 __attribute__((ext_vector_type(4)));

__device__ __forceinline__ unsigned pk2(float lo, float hi) { return pg8::cvt_pk_bf16(lo, hi); }
__device__ __forceinline__ float bflo(unsigned w) { return __uint_as_float(w << 16); }
__device__ __forceinline__ float bfhi(unsigned w) { return __uint_as_float(w & 0xffff0000u); }
__device__ __forceinline__ int crow(int r, int hi) { return (r & 3) + 8 * (r >> 2) + 4 * hi; }
__device__ __forceinline__ float wave_sum(float v) {
#pragma unroll
    for (int o = 1; o < 64; o <<= 1) v += __shfl_xor(v, o);
    return v;
}
__device__ __forceinline__ float silu(float x) { return x / (1.0f + __expf(-x)); }
__device__ __forceinline__ s16x4 trd(const LAS bf16* p) { return __builtin_bit_cast(s16x4, __builtin_amdgcn_ds_read_tr16_b64_v4i16((LAS s16x4*)p)); }
__device__ __forceinline__ bf16x8 tr_frag(const LAS bf16* T, int ld, int k0, int n0, int lane) {
    const int g4 = lane >> 4, li = lane & 15, q = li >> 2, p = li & 3, hi = g4 >> 1;
    const LAS bf16* a = T + (k0 + 4 * hi + q) * ld + n0 + 16 * (g4 & 1) + 4 * p;
    const s16x4 lo = trd(a), up = trd(a + 8 * ld);
    return (bf16x8){lo[0], lo[1], lo[2], lo[3], up[0], up[1], up[2], up[3]};
}
__device__ __forceinline__ bf16x8 pack8(float a0, float a1, float a2, float a3, float a4, float a5, float a6, float a7) {
    u32x4 w; w.x = pk2(a0, a1); w.y = pk2(a2, a3); w.z = pk2(a4, a5); w.w = pk2(a6, a7); return __builtin_bit_cast(bf16x8, w);
}
__device__ __forceinline__ int launder(int v) { asm volatile("" : "+v"(v)); return v; }
#define MFMA32(a, b, c) __builtin_amdgcn_mfma_f32_32x32x16_bf16((a), (b), (c), 0, 0, 0)

#define XB_TMO      128
#define XB_XCNT(j)  (256  + 64 * (j))
#define XB_XSUB(j)  (1280 + 64 * (j))
#define XB_XGEN(j)  (2304 + 64 * (j))
#define XB_TOP      3328
#define XB_TOPGEN   3392
#define XCD_BAR_WORDS 3456
#define XB_SPIN_CAP (1u << 18)

__device__ __forceinline__ unsigned xb_ld(unsigned* p)              { return __hip_atomic_load(p, __ATOMIC_RELAXED, __HIP_MEMORY_SCOPE_AGENT); }
__device__ __forceinline__ unsigned xb_add(unsigned* p, unsigned v) { return __hip_atomic_fetch_add(p, v, __ATOMIC_RELAXED, __HIP_MEMORY_SCOPE_AGENT); }
__device__ __forceinline__ unsigned xb_xcc_id() { return (unsigned)__builtin_amdgcn_s_getreg((3 << 11) | 20) & 0xFu; }
#define XB_SPIN(cond, bar) do { unsigned _sp = 0; while (cond) { __builtin_amdgcn_s_sleep(1); \
    if ((++_sp & 255u) == 0u) { if (xb_ld(&(bar)[XB_TMO])) break; if (_sp > XB_SPIN_CAP) { atomicAdd(&(bar)[XB_TMO], 1u); break; } } } } while (0)

struct XcdBarrier {
    unsigned* bar; unsigned x; int wv;
    volatile LAS unsigned* st;
};

__device__ __forceinline__ XcdBarrier xcd_barrier_post(unsigned* bar, volatile LAS unsigned* st, int wv) {
    XcdBarrier b; b.bar = bar; b.x = xb_xcc_id(); b.st = st; b.wv = wv;
    if (wv == 0 && mk_lane() == 0) (void)xb_add(&bar[XB_XCNT(b.x)], 1u);
    return b;
}
__device__ __forceinline__ void xcd_barrier_complete(unsigned* bar, unsigned x, unsigned& nloc, unsigned& nx) {
    const unsigned G = gridDim.x * gridDim.y * gridDim.z;
    unsigned sum, cnt, mine, sp = 0u;
    for (;;) {
        sum = 0u; cnt = 0u; mine = 0u;
#pragma unroll
        for (unsigned j = 0; j < 16; ++j) { const unsigned c = xb_ld(&bar[XB_XCNT(j)]); sum += c; cnt += (c > 0u) ? 1u : 0u; mine = (j == x) ? c : mine; }
        if (sum == G) break;
        __builtin_amdgcn_s_sleep(1);
        if ((++sp & 255u) == 0u) { if (xb_ld(&bar[XB_TMO])) break; if (sp > XB_SPIN_CAP) { atomicAdd(&bar[XB_TMO], 1u); break; } }
    }
    nloc = mine > 0u ? mine : 1u; nx = cnt > 0u ? cnt : 1u;
}

__device__ __forceinline__ void xcd_barrier(const XcdBarrier& b) {
    asm volatile("s_waitcnt vmcnt(0)" ::: "memory");
    __syncthreads();
    if (b.wv == 0 && mk_lane() == 0) {
        unsigned* bar = b.bar;
        __builtin_amdgcn_s_waitcnt(0);
        unsigned nloc = b.st[0], nx = b.st[1];
        if (nloc == 0u) { xcd_barrier_complete(bar, b.x, nloc, nx); b.st[0] = nloc; b.st[1] = nx; }
        const unsigned old = xb_add(&bar[XB_XSUB(b.x)], 1u);
        const unsigned gen = old / nloc;
        if (old + 1u == (gen + 1u) * nloc) {
            __builtin_amdgcn_fence(__ATOMIC_RELEASE, "agent");
            asm volatile("s_waitcnt vmcnt(0)" ::: "memory");
            const unsigned og = xb_add(&bar[XB_TOP], 1u);
            const unsigned tg = og / nx;
            if (og + 1u == (tg + 1u) * nx) xb_add(&bar[XB_TOPGEN], 1u);
            else XB_SPIN(xb_ld(&bar[XB_TOPGEN]) == tg, bar);
            __builtin_amdgcn_fence(__ATOMIC_ACQUIRE, "agent");
            xb_add(&bar[XB_XGEN(b.x)], 1u);
            asm volatile("s_waitcnt vmcnt(0)" ::: "memory");
        } else {
            XB_SPIN(xb_ld(&bar[XB_XGEN(b.x)]) == gen, bar);
            __builtin_amdgcn_fence(__ATOMIC_ACQUIRE, "agent");
            asm volatile("s_waitcnt vmcnt(0)" ::: "memory");
        }
    }
    __syncthreads();
}

constexpr int XB_WS_OFF = 4096, XB_LDS_OFF = 147200;
struct Args { const float* in[17]; float* out; unsigned char* ws; int ph_lo, ph_hi; };
struct Frame {
    LAS unsigned char* lds; int wave, G, bid;
    const Args* ap;
};

__device__ __forceinline__ void p0_transpose_item(const float* W, const float* gain, int K, int N, bf16* WT, LAS float* scr, int item, int lane) {
    const int nblk = N / 32, kb = item / nblk, nb = item % nblk, k0 = 64 * kb, n0 = 32 * nb;
    float wv[32];
#pragma unroll
    for (int i = 0; i < 32; ++i) wv[i] = W[(size_t)(k0 + 2 * i + (lane >> 5)) * N + n0 + (lane & 31)];
    if (gain) {
#pragma unroll
        for (int i = 0; i < 32; ++i) wv[i] *= gain[k0 + 2 * i + (lane >> 5)]; }
#pragma unroll
    for (int i = 0; i < 32; ++i) scr[(2 * i + (lane >> 5)) * 33 + (lane & 31)] = wv[i];
    asm volatile("s_waitcnt lgkmcnt(0)" ::: "memory");
    const int c = lane & 7;
#pragma unroll
    for (int j = 0; j < 4; ++j) { const int n = (lane >> 3) + 8 * j; const LAS float* s = scr + (8 * c) * 33 + n;
        u32x4 o; o.x = pk2(s[0 * 33], s[1 * 33]); o.y = pk2(s[2 * 33], s[3 * 33]); o.z = pk2(s[4 * 33], s[5 * 33]); o.w = pk2(s[6 * 33], s[7 * 33]);
        *(u32x4*)(WT + (size_t)(n0 + n) * K + k0 + 8 * c) = o; }
    asm volatile("s_waitcnt lgkmcnt(0)" ::: "memory");
}
__device__ __forceinline__ void p0_prologue(Frame& F) {
    LAS float* scr = (LAS float*)(F.lds + F.wave * 16384);
    const int gw = F.bid * NWAVES + F.wave, NGW = F.G * NWAVES, lane = mk_lane();
    unsigned char* ws = F.ap->ws;
    constexpr int I_EIN = 16 * (EIN / 32), I_SQ = 16 * 32, I_OIN = 16 * (OIN / 32), I_KV = 16 * 64;
    constexpr int NITEMS = I_EIN + I_SQ + I_OIN + I_SQ + 2 * I_SQ + 2 * I_KV + 2 * I_SQ;
    for (int it = gw; it < NITEMS; it += NGW) {
        int r = it;
        if (r < I_EIN) { p0_transpose_item(F.ap->in[3], F.ap->in[2], D, EIN, (bf16*)(ws + WS_WEIN), scr, r, lane); continue; } r -= I_EIN;
        if (r < I_SQ) { p0_transpose_item(F.ap->in[5], nullptr, D, D, (bf16*)(ws + WS_WEOUT), scr, r, lane); continue; } r -= I_SQ;
        if (r < I_OIN) { p0_transpose_item(F.ap->in[7], F.ap->in[6], D, OIN, (bf16*)(ws + WS_WOIN), scr, r, lane); continue; } r -= I_OIN;
        if (r < I_SQ) { p0_transpose_item(F.ap->in[10], nullptr, D, D, (bf16*)(ws + WS_WOOUT), scr, r, lane); continue; } r -= I_SQ;
        if (r < 2 * I_SQ) { const int l = r / I_SQ; p0_transpose_item(F.ap->in[13] + (size_t)l * D * D, F.ap->in[11] + l * D, D, D, (bf16*)(ws + WS_WQ) + (size_t)l * D * D, scr, r % I_SQ, lane); continue; } r -= 2 * I_SQ;
        if (r < 2 * I_KV) { const int l = r / I_KV; p0_transpose_item(F.ap->in[14] + (size_t)l * D * 2 * D, nullptr, D, 2 * D, (bf16*)(ws + WS_WKV) + (size_t)l * 2 * D * D, scr, r % I_KV, lane); continue; } r -= 2 * I_KV;
        { const int l = r / I_SQ; p0_transpose_item(F.ap->in[15] + (size_t)l * D * D, nullptr, D, D, (bf16*)(ws + WS_WO) + (size_t)l * D * D, scr, r % I_SQ, lane); }
    }
    for (int it = gw; it < 2 * BATCH * MEMLEN; it += NGW) {
        const int l = it / (BATCH * MEMLEN), row = it % (BATCH * MEMLEN);
        const f32x4* xr = (const f32x4*)(F.ap->in[1] + (size_t)row * D) + lane; const f32x4* gr = (const f32x4*)(F.ap->in[12] + l * D) + lane;
        f32x4 v[4]; float s = 0.f;
#pragma unroll
        for (int j = 0; j < 4; ++j) { v[j] = xr[64 * j]; s += (v[j][0] * v[j][0] + v[j][1] * v[j][1]) + (v[j][2] * v[j][2] + v[j][3] * v[j][3]); }
        const float rs = 1.0f / sqrtf(wave_sum(s) * (1.0f / D) + EPS);
        u32x2* o8 = (u32x2*)((bf16*)(ws + WS_MEMN) + (size_t)it * D) + lane;
#pragma unroll
        for (int j = 0; j < 4; ++j) { const f32x4 g = gr[64 * j]; u32x2 w; w.x = pk2(v[j][0] * rs * g[0], v[j][1] * rs * g[1]); w.y = pk2(v[j][2] * rs * g[2], v[j][3] * rs * g[3]); o8[64 * j] = w; }
    }
    for (int row = 2 * gw; row < MTOK; row += 2 * NGW) {
        f32x4 v[2][4];
#pragma unroll
        for (int t = 0; t < 2; ++t) { const f32x4* xr = (const f32x4*)(F.ap->in[0] + (size_t)(row + t) * D) + lane;
#pragma unroll
            for (int j = 0; j < 4; ++j) v[t][j] = xr[64 * j]; }
#pragma unroll
        for (int t = 0; t < 2; ++t) { float s = 0.f;
#pragma unroll
            for (int j = 0; j < 4; ++j) s += (v[t][j][0] * v[t][j][0] + v[t][j][1] * v[t][j][1]) + (v[t][j][2] * v[t][j][2] + v[t][j][3] * v[t][j][3]);
            s = wave_sum(s);
            u32x2* o8 = (u32x2*)((bf16*)(ws + WS_XB) + (size_t)(row + t) * D) + lane;
#pragma unroll
            for (int j = 0; j < 4; ++j) { u32x2 w; w.x = pk2(v[t][j][0], v[t][j][1]); w.y = pk2(v[t][j][2], v[t][j][3]); o8[64 * j] = w; }
            if (lane < 16) ((float*)(ws + WS_SSP))[(size_t)(row + t) * 16 + lane] = (lane == 0) ? s : 0.f; }
    }
    for (int e = F.bid * NTHR + launder((F.wave * 64 + mk_lane())); e < SEQ * 64; e += F.G * NTHR) {
        const int pos = e >> 6, j = e & 63;
        const float inv = 1.0f / exp2f(((float)j / 63.0f) * 13.287712379549449f);
        const float ang = (float)pos * inv;
        const double a = (double)ang, kk = rint(a * 0.63661977236758134308);
        const float r = (float)fma(-kk, 1.57079632679489661923, a), r2 = r * r;
        const float sn = r + r * r2 * (-1.6666654611e-1f + r2 * (8.3321608736e-3f + r2 * (-1.9515295891e-4f)));
        const float cs = 1.0f - 0.5f * r2 + r2 * r2 * (4.166664568298827e-2f + r2 * (-1.388731625493765e-3f + r2 * 2.443315711809948e-5f));
        const int q = ((int)kk) & 3;
        f32x2 o; o.x = (q == 0) ? cs : (q == 1) ? -sn : (q == 2) ? -cs : sn; o.y = (q == 0) ? sn : (q == 1) ? cs : (q == 2) ? -sn : -cs;
        ((f32x2*)(ws + WS_ROT))[e] = o;
    }
}

constexpr int AKS = 72;
__device__ __forceinline__ void swa_item(Frame& F, int item) {
    const int kvh = item & 1, c = (item >> 1) & (NCH - 1), b = item >> 8;
    const int c0 = c >= 2 ? c - 2 : 0, nch = c - c0 + 1;
    const int tid = launder((F.wave * 64 + mk_lane())), lane = tid & 63, w = F.wave, r32 = lane & 31, hi = lane >> 5;
    LAS bf16* Ks = (LAS bf16*)F.lds; LAS bf16* Vs = Ks + 192 * AKS;
    const bf16* HC = (const bf16*)(F.ap->ws + WS_BIG);
    const size_t rowbase = (size_t)b * SEQ;
    const int qh = kvh * 4 + (w >> 1);
    const size_t tok = rowbase + c * 64 + (w & 1) * 32 + r32;
    const bf16* qp = HC + tok * EIN + C_AQ + qh * 64 + hi * 8;
    const bf16* gp = HC + tok * EIN + C_AG + qh * 64;
    u32x4 kx[3], vx[3]; bf16x8 qf[4]; u32x2 gg[2][4];
#pragma unroll
    for (int i = 0; i < 3; ++i) if (i < nch) { const int p = tid + i * NTHR, r = p >> 3, ch = p & 7; const bf16* src = HC + (rowbase + c0 * 64 + r) * EIN + kvh * 64 + ch * 8;
        kx[i] = *(const u32x4*)(src + C_AK); vx[i] = *(const u32x4*)(src + C_AV); }
#pragma unroll
    for (int s = 0; s < 4; ++s) qf[s] = *(const bf16x8*)(qp + 16 * s);
#pragma unroll
    for (int db = 0; db < 2; ++db)
#pragma unroll
        for (int gi = 0; gi < 4; ++gi) gg[db][gi] = *(const u32x2*)(gp + 32 * db + 8 * gi + 4 * hi);
#pragma unroll
    for (int i = 0; i < 3; ++i) if (i < nch) { const int p = tid + i * NTHR, r = p >> 3, ch = p & 7; *(LAS u32x4*)(Ks + r * AKS + ch * 8) = kx[i]; *(LAS u32x4*)(Vs + r * AKS + ch * 8) = vx[i]; }
    __syncthreads();
    const int nkb = 2 * nch;
    f32x16 st[6];
#pragma unroll
    for (int kb = 0; kb < 6; ++kb) { st[kb] = (f32x16){};
        if (kb < nkb) {
#pragma unroll
            for (int s = 0; s < 4; ++s) { const bf16x8 a = *(const LAS bf16x8*)(Ks + (32 * kb + r32) * AKS + 16 * s + 8 * hi); st[kb] = MFMA32(a, qf[s], st[kb]); } } }
    float mx = -3.0e38f;
#pragma unroll
    for (int kb = 0; kb < 6; ++kb) if (kb < nkb) {
#pragma unroll
        for (int i = 0; i < 16; ++i) mx = fmaxf(mx, st[kb][i]); }
    mx = fmaxf(mx, __shfl_xor(mx, 32));
    const float sink = F.ap->in[4][qh];
    const float mref = fmaxf(mx * 0.125f, sink);
    const float L2E = 1.4426950408889634f;
    float sum = 0.f;
#pragma unroll
    for (int kb = 0; kb < 6; ++kb) if (kb < nkb) {
#pragma unroll
        for (int i = 0; i < 16; ++i) { const float p = exp2f((st[kb][i] * 0.125f - mref) * L2E); st[kb][i] = p; sum += p; } }
    sum += __shfl_xor(sum, 32);
    const float inv = 1.0f / (sum + exp2f((sink - mref) * L2E));
    f32x16 o[2]; o[0] = (f32x16){}; o[1] = (f32x16){};
#pragma unroll
    for (int kb = 0; kb < 6; ++kb) if (kb < nkb) {
#pragma unroll
        for (int s = 0; s < 2; ++s) {
            const bf16x8 pf = pack8(st[kb][8 * s + 0] * inv, st[kb][8 * s + 1] * inv, st[kb][8 * s + 2] * inv, st[kb][8 * s + 3] * inv, st[kb][8 * s + 4] * inv, st[kb][8 * s + 5] * inv, st[kb][8 * s + 6] * inv, st[kb][8 * s + 7] * inv);
#pragma unroll
            for (int db = 0; db < 2; ++db) { const bf16x8 vf = tr_frag(Vs, AKS, 32 * kb + 16 * s, 32 * db, lane); o[db] = MFMA32(vf, pf, o[db]); } } }
    bf16* yp = (bf16*)(F.ap->ws + WS_BUFA) + tok * D + qh * 64;
#pragma unroll
    for (int db = 0; db < 2; ++db)
#pragma unroll
        for (int gi = 0; gi < 4; ++gi) { const int d0 = 32 * db + 8 * gi + 4 * hi; const u32x2 g = gg[db][gi];
            u32x2 y; y.x = pk2(o[db][4 * gi + 0] * silu(bflo(g.x)), o[db][4 * gi + 1] * silu(bfhi(g.x))); y.y = pk2(o[db][4 * gi + 2] * silu(bflo(g.y)), o[db][4 * gi + 3] * silu(bfhi(g.y)));
            *(u32x2*)(yp + d0) = y; }
    __syncthreads();
}

constexpr int RKS = 136;
__device__ __forceinline__ float head_lg2(int h) { return log2f(1.0f - exp2f(-5.0f - (float)h)); }
__device__ __forceinline__ void ret1_item(Frame& F, int item) {
    const int h = item & 3, c = (item >> 2) & (NCH - 1), b = item >> 9;
    const int tid = launder((F.wave * 64 + mk_lane())), lane = tid & 63, w = F.wave, r32 = lane & 31, hi = lane >> 5;
    LAS bf16* Qr = (LAS bf16*)F.lds; LAS bf16* Kr = Qr + 64 * RKS; LAS bf16* Vs = Kr + 64 * RKS; LAS bf16* Vd = Vs + 64 * RKS;
    bf16* HC = (bf16*)(F.ap->ws + WS_BIG);
    const size_t rowbase = (size_t)b * SEQ + (size_t)c * 64;
    const float lg2 = head_lg2(h);
    {
        const int j = tid >> 3, pc = tid & 7;
        bf16* rowp = HC + (rowbase + j) * EIN;
        const u32x4 q1 = *(const u32x4*)(rowp + C_BQ + h * 128 + 8 * pc), q2 = *(const u32x4*)(rowp + C_BQ + h * 128 + 64 + 8 * pc);
        const u32x4 k1 = *(const u32x4*)(rowp + C_BK + h * 128 + 8 * pc), k2 = *(const u32x4*)(rowp + C_BK + h * 128 + 64 + 8 * pc);
        const u32x4 v1 = *(const u32x4*)(rowp + C_BV + h * 128 + 16 * pc), v2 = *(const u32x4*)(rowp + C_BV + h * 128 + 16 * pc + 8);
        const f32x4* rt = (const f32x4*)((const f32x2*)(F.ap->ws + WS_ROT) + (size_t)(c * 64 + j) * 64 + 8 * pc);
        u32x4 qa, qb, ka, kb;
        const float ksc = 0.08838834764831845f;
#pragma unroll
        for (int e = 0; e < 4; ++e) { const f32x4 cs = rt[e];
            const float a0 = bflo(q1[e]), a1 = bfhi(q1[e]), b0 = bflo(q2[e]), b1 = bfhi(q2[e]);
            qa[e] = pk2(a0 * cs[0] - b0 * cs[1], a1 * cs[2] - b1 * cs[3]); qb[e] = pk2(a0 * cs[1] + b0 * cs[0], a1 * cs[3] + b1 * cs[2]);
            const float c0 = bflo(k1[e]), c1 = bfhi(k1[e]), d0 = bflo(k2[e]), d1 = bfhi(k2[e]);
            ka[e] = pk2((c0 * cs[0] - d0 * cs[1]) * ksc, (c1 * cs[2] - d1 * cs[3]) * ksc); kb[e] = pk2((c0 * cs[1] + d0 * cs[0]) * ksc, (c1 * cs[3] + d1 * cs[2]) * ksc); }
        *(LAS u32x4*)(Qr + j * RKS + 8 * pc) = qa; *(LAS u32x4*)(Qr + j * RKS + 64 + 8 * pc) = qb;
        *(LAS u32x4*)(Kr + j * RKS + 8 * pc) = ka; *(LAS u32x4*)(Kr + j * RKS + 64 + 8 * pc) = kb;
        { bf16* yq = (bf16*)(F.ap->ws + WS_BUFA) + (rowbase + j) * D + 512 + h * 128 + 8 * pc; *(u32x4*)yq = qa; *(u32x4*)(yq + 64) = qb; }
        *(LAS u32x4*)(Vs + j * RKS + 16 * pc) = v1; *(LAS u32x4*)(Vs + j * RKS + 16 * pc + 8) = v2;
        const float kd = exp2f(lg2 * (float)(63 - j));
        u32x4 w1, w2;
#pragma unroll
        for (int e = 0; e < 4; ++e) { w1[e] = pk2(bflo(v1[e]) * kd, bfhi(v1[e]) * kd); w2[e] = pk2(bflo(v2[e]) * kd, bfhi(v2[e]) * kd); }
        *(LAS u32x4*)(Vd + j * RKS + 16 * pc) = w1; *(LAS u32x4*)(Vd + j * RKS + 16 * pc + 8) = w2;
    }
    __syncthreads();
    const int ib = w & 1, db = w >> 1;
    f32x16 st[2];
#pragma unroll
    for (int jb = 0; jb < 2; ++jb) { st[jb] = (f32x16){};
#pragma unroll
        for (int s = 0; s < 8; ++s) { const bf16x8 a = *(const LAS bf16x8*)(Kr + (32 * jb + r32) * RKS + 16 * s + 8 * hi); const bf16x8 q = *(const LAS bf16x8*)(Qr + (32 * ib + r32) * RKS + 16 * s + 8 * hi);
            st[jb] = MFMA32(a, q, st[jb]); } }
    const int iloc = 32 * ib + r32;
#pragma unroll
    for (int jb = 0; jb < 2; ++jb)
#pragma unroll
        for (int i = 0; i < 16; ++i) { const int j = 32 * jb + crow(i, hi); const int dd = iloc > j ? iloc - j : j - iloc; st[jb][i] *= exp2f(lg2 * (float)dd); }
    f32x16 o = (f32x16){};
#pragma unroll
    for (int jb = 0; jb < 2; ++jb)
#pragma unroll
        for (int s = 0; s < 2; ++s) {
            const bf16x8 pf = pack8(st[jb][8 * s + 0], st[jb][8 * s + 1], st[jb][8 * s + 2], st[jb][8 * s + 3], st[jb][8 * s + 4], st[jb][8 * s + 5], st[jb][8 * s + 6], st[jb][8 * s + 7]);
            const bf16x8 vf = tr_frag(Vs, RKS, 32 * jb + 16 * s, 32 * db, lane);
            o = MFMA32(vf, pf, o); }
    {
        float* op = (float*)(F.ap->ws + WS_XB) + (rowbase + iloc) * 512 + h * 128 + 32 * db + 4 * hi;
#pragma unroll
        for (int gi = 0; gi < 4; ++gi) *(f32x4*)(op + 8 * gi) = (f32x4){o[4 * gi], o[4 * gi + 1], o[4 * gi + 2], o[4 * gi + 3]};
    }
    const int rb = w >> 1;
    f32x16 kv[2]; kv[0] = (f32x16){}; kv[1] = (f32x16){};
#pragma unroll
    for (int s = 0; s < 4; ++s) { const bf16x8 af = tr_frag(Kr, RKS, 16 * s, 32 * rb, lane);
#pragma unroll
        for (int t = 0; t < 2; ++t) { const bf16x8 bf = tr_frag(Vd, RKS, 16 * s, 32 * (2 * (w & 1) + t), lane); kv[t] = MFMA32(af, bf, kv[t]); } }
    bf16* stp = (bf16*)(F.ap->ws + WS_BUFB) + ((size_t)(b * NCH + c) * 4 + h) * 16384;
#pragma unroll
    for (int t = 0; t < 2; ++t) { const int dv = 32 * (2 * (w & 1) + t) + r32;
#pragma unroll
        for (int gi = 0; gi < 4; ++gi) { const int dk = 32 * rb + 8 * gi + 4 * hi; u32x2 y; y.x = pk2(kv[t][4 * gi], kv[t][4 * gi + 1]); y.y = pk2(kv[t][4 * gi + 2], kv[t][4 * gi + 3]);
            *(u32x2*)(stp + dv * 128 + dk) = y; } }
    __syncthreads();
}

__device__ __forceinline__ void scan_phase(Frame& F) {
    unsigned* ST = (unsigned*)(F.ap->ws + WS_BUFB);
    for (int e = F.bid * NTHR + launder((F.wave * 64 + mk_lane())); e < BATCH * 4 * 8192; e += F.G * NTHR) {
        const int idx = e & 8191, h = (e >> 13) & 3, b = e >> 15;
        const float dec = exp2f(head_lg2(h) * 64.0f);
        unsigned* p = ST + ((size_t)(b * NCH) * 4 + h) * 8192 + idx;
        float s0 = 0.f, s1 = 0.f;
        unsigned ka[32], kb[32];
#define SCAN_LD(dst, c0) do { _Pragma("unroll") for (int j = 0; j < 32; ++j) dst[j] = p[(size_t)((c0) + j) * 4 * 8192]; } while (0)
#define SCAN_UP(src, c0) do { _Pragma("unroll") for (int j = 0; j < 32; ++j) { p[(size_t)((c0) + j) * 4 * 8192] = pk2(s0, s1); s0 = s0 * dec + bflo(src[j]); s1 = s1 * dec + bfhi(src[j]); } } while (0)
        SCAN_LD(ka, 0); SCAN_LD(kb, 32); SCAN_UP(ka, 0); SCAN_LD(ka, 64); SCAN_UP(kb, 32); SCAN_LD(kb, 96); SCAN_UP(ka, 64); SCAN_UP(kb, 96);
#undef SCAN_LD
#undef SCAN_UP
    }
}

__device__ __forceinline__ void ret2_item(Frame& F, int item) {
    const int h = item & 3, c = (item >> 2) & (NCH - 1), b = item >> 9;
    const int lane = launder(mk_lane()), w = F.wave, r32 = lane & 31, hi = lane >> 5;
    const int ib = w & 1, db = w >> 1, iloc = 32 * ib + r32;
    LAS float* part = (LAS float*)F.lds;
    const bf16* HC = (const bf16*)(F.ap->ws + WS_BIG);
    const size_t tok = (size_t)b * SEQ + (size_t)c * 64 + iloc;
    const bf16* stp = (const bf16*)(F.ap->ws + WS_BUFB) + ((size_t)(b * NCH + c) * 4 + h) * 16384 + (size_t)(32 * db + r32) * 128 + 8 * hi;
    const bf16* qp = (const bf16*)(F.ap->ws + WS_BUFA) + tok * D + 512 + h * 128 + 8 * hi;
    const float* op = (const float*)(F.ap->ws + WS_XB) + tok * 512 + h * 128 + 32 * db + 4 * hi;
    const bf16* gp = HC + tok * EIN + C_BG + h * 128 + 32 * db + 4 * hi;
    bf16x8 af[8], qv[8]; f32x4 oi[4]; u32x2 gg[4];
#pragma unroll
    for (int s = 0; s < 8; ++s) { af[s] = *(const bf16x8*)(stp + 16 * s); qv[s] = *(const bf16x8*)(qp + 16 * s); }
#pragma unroll
    for (int gi = 0; gi < 4; ++gi) { oi[gi] = *(const f32x4*)(op + 8 * gi); gg[gi] = *(const u32x2*)(gp + 8 * gi); }
    f32x16 oc = (f32x16){};
#pragma unroll
    for (int s = 0; s < 8; ++s) oc = MFMA32(af[s], qv[s], oc);
    const float qdec = exp2f(head_lg2(h) * (float)(iloc + 1));
    float ss = 0.f;
#pragma unroll
    for (int gi = 0; gi < 4; ++gi) {
#pragma unroll
        for (int e = 0; e < 4; ++e) { const float v = oi[gi][e] + oc[4 * gi + e] * qdec; oc[4 * gi + e] = v; ss += v * v; } }
    ss += __shfl_xor(ss, 32);
    if (hi == 0) part[iloc * 4 + db] = ss;
    __syncthreads();
    const f32x4 pp = *(const LAS f32x4*)(part + iloc * 4);
    const float rs = 1.0f / sqrtf(((pp[0] + pp[1]) + (pp[2] + pp[3])) * (1.0f / 128.0f) + EPS);
    bf16* yp = (bf16*)(F.ap->ws + WS_BUFA) + tok * D + 512 + h * 128 + 32 * db + 4 * hi;
#pragma unroll
    for (int gi = 0; gi < 4; ++gi) { const u32x2 g = gg[gi];
        u32x2 y; y.x = pk2(oc[4 * gi + 0] * rs * silu(bflo(g.x)), oc[4 * gi + 1] * rs * silu(bfhi(g.x))); y.y = pk2(oc[4 * gi + 2] * rs * silu(bflo(g.y)), oc[4 * gi + 3] * rs * silu(bfhi(g.y)));
        *(u32x2*)(yp + 8 * gi) = y; }
    __syncthreads();
}

constexpr int XKS = 264, XVS = 288;
#define LBAR() asm volatile("s_waitcnt lgkmcnt(0)\n\ts_barrier" ::: "memory")
__device__ __forceinline__ void xattn_unit(Frame& F, int layer, int unit) {
    const int h = unit & 3, rt = unit >> 2, b = rt >> 5;
    const int tid = launder((F.wave * 64 + mk_lane())), lane = tid & 63, w = F.wave, r32 = lane & 31, hi = lane >> 5;
    LAS bf16* buf0 = (LAS bf16*)F.lds; LAS bf16* buf1 = buf0 + 64 * XVS;
    const bf16* Kg = (const bf16*)(F.ap->ws + WS_KV) + ((size_t)layer * BATCH * MEMLEN + (size_t)b * MEMLEN) * 2048 + h * 256;
    const size_t row = (size_t)rt * 256 + w * 32 + r32;
    const bf16* qp = (const bf16*)(F.ap->ws + WS_BUFB) + row * D + h * 256 + 8 * hi;
    const bf16* gsrc = Kg + (size_t)(tid >> 5) * 2048 + (tid & 31) * 8;
    const int ldst = (tid >> 5) * XKS + (tid & 31) * 8, ldstv = (tid >> 5) * XVS + (tid & 31) * 8;
    u32x4 pf[4];
#define XLOAD(blk) do { _Pragma("unroll") for (int i_ = 0; i_ < 4; ++i_) pf[i_] = *(const u32x4*)(gsrc + (size_t)((((blk) & 3) * 64 + 16 * i_) * 2048 + ((blk) >= 4 ? 1024 : 0))); } while (0)
#define XSTORE(bufp) do { _Pragma("unroll") for (int i_ = 0; i_ < 4; ++i_) *(LAS u32x4*)((bufp) + ldst + 16 * i_ * XKS) = pf[i_]; } while (0)
#define XSTOREV(bufp) do { _Pragma("unroll") for (int i_ = 0; i_ < 4; ++i_) *(LAS u32x4*)((bufp) + ldstv + 16 * i_ * XVS) = pf[i_]; } while (0)
    __syncthreads();
    XLOAD(0);
    bf16x8 qf[8];
    LAS bf16* qs = (LAS bf16*)(F.lds + 73728) + w * (32 * 136) + r32 * 136 + 8 * hi;
#pragma unroll
    for (int s = 0; s < 8; ++s) qf[s] = *(const bf16x8*)(qp + 16 * s);
#pragma unroll
    for (int s = 0; s < 8; ++s) { const bf16x8 t = *(const bf16x8*)(qp + 128 + 16 * s); *(LAS bf16x8*)(qs + 16 * s) = t; }
    XSTORE(buf0);
    XLOAD(1);
    LBAR();
    f32x16 st[8];
#pragma unroll
    for (int kblk = 0; kblk < 4; ++kblk) {
        const LAS bf16* cur = (kblk & 1) ? buf1 : buf0; LAS bf16* nxt = (kblk & 1) ? buf0 : buf1;
#pragma unroll
        for (int kk = 0; kk < 2; ++kk) { f32x16 acc = (f32x16){};
#pragma unroll
            for (int s = 0; s < 8; ++s) { const bf16x8 a = *(const LAS bf16x8*)(cur + (32 * kk + r32) * XKS + 16 * s + 8 * hi); acc = MFMA32(a, qf[s], acc); }
#pragma unroll
            for (int s = 0; s < 8; ++s) { const bf16x8 a = *(const LAS bf16x8*)(cur + (32 * kk + r32) * XKS + 128 + 16 * s + 8 * hi); const bf16x8 q = *(const LAS bf16x8*)(qs + 16 * s); acc = MFMA32(a, q, acc); }
            st[2 * kblk + kk] = acc; }
        if (kblk < 3) XSTORE(nxt); else XSTOREV(nxt);
        XLOAD(kblk + 2);
        LBAR();
    }
    float mx = -3.0e38f;
#pragma unroll
    for (int kb = 0; kb < 8; ++kb)
#pragma unroll
        for (int i = 0; i < 16; ++i) mx = fmaxf(mx, st[kb][i]);
    mx = fmaxf(mx, __shfl_xor(mx, 32));
    const float SC = 0.0625f * 1.4426950408889634f;
    float sum = 0.f;
#pragma unroll
    for (int kb = 0; kb < 8; ++kb)
#pragma unroll
        for (int i = 0; i < 16; ++i) { const float p = exp2f((st[kb][i] - mx) * SC); st[kb][i] = p; sum += p; }
    sum += __shfl_xor(sum, 32);
    const float inv = 1.0f / sum;
    bf16x8 pw[8][2];
#pragma unroll
    for (int kb = 0; kb < 8; ++kb)
#pragma unroll
        for (int s = 0; s < 2; ++s) pw[kb][s] = pack8(st[kb][8 * s + 0] * inv, st[kb][8 * s + 1] * inv, st[kb][8 * s + 2] * inv, st[kb][8 * s + 3] * inv, st[kb][8 * s + 4] * inv, st[kb][8 * s + 5] * inv, st[kb][8 * s + 6] * inv, st[kb][8 * s + 7] * inv);
    f32x16 o[8];
#pragma unroll
    for (int db = 0; db < 8; ++db) o[db] = (f32x16){};
#pragma unroll
    for (int vblk = 0; vblk < 4; ++vblk) {
        const LAS bf16* cur = (vblk & 1) ? buf1 : buf0; LAS bf16* nxt = (vblk & 1) ? buf0 : buf1;
#pragma unroll
        for (int kk = 0; kk < 2; ++kk)
#pragma unroll
            for (int s = 0; s < 2; ++s)
#pragma unroll
                for (int db = 0; db < 8; ++db) { const bf16x8 vf = tr_frag(cur, XVS, 32 * kk + 16 * s, 32 * db, lane); o[db] = MFMA32(vf, pw[2 * vblk + kk][s], o[db]); }
        if (vblk < 3) XSTOREV(nxt);
        if (vblk < 2) XLOAD(vblk + 6);
        LBAR();
    }
#undef XLOAD
#undef XSTORE
#undef XSTOREV
    bf16* op = (bf16*)(F.ap->ws + WS_BUFA) + row * D + h * 256 + 4 * hi;
#pragma unroll
    for (int db = 0; db < 8; ++db)
#pragma unroll
        for (int gi = 0; gi < 4; ++gi) { u32x2 y; y.x = pk2(o[db][4 * gi], o[db][4 * gi + 1]); y.y = pk2(o[db][4 * gi + 2], o[db][4 * gi + 3]); *(u32x2*)(op + 32 * db + 8 * gi) = y; }
}

__device__ __forceinline__ void conv_phase(Frame& F) {
    const bf16* H4 = (const bf16*)(F.ap->ws + WS_BIG); bf16* Y = (bf16*)(F.ap->ws + WS_BUFA);
    const float* cw = F.ap->in[8]; const float* cb = F.ap->in[9];
    for (int it = F.bid * NTHR + launder((F.wave * 64 + mk_lane())); it < (MTOK / 8) * 128; it += F.G * NTHR) {
        const int cgi = it & 127, tg = it >> 7, col = cgi * 8, t0 = tg * 8;
        float w0[8], w1[8], w2[8], bs[8];
#pragma unroll
        for (int e = 0; e < 8; ++e) { w0[e] = cw[col + e]; w1[e] = cw[D + col + e]; w2[e] = cw[2 * D + col + e]; bs[e] = cb[col + e]; }
        float zm2[8], zm1[8];
        const bool first = (t0 & (SEQ - 1)) == 0;
#pragma unroll
        for (int e = 0; e < 8; ++e) { zm2[e] = 0.f; zm1[e] = 0.f; }
        if (!first) {
            const bf16* r2 = H4 + (size_t)(t0 - 2) * OIN + col; const bf16* r1 = H4 + (size_t)(t0 - 1) * OIN + col;
            const u32x4 c2 = *(const u32x4*)(r2 + 1024), u2 = *(const u32x4*)(r2 + 2048), c1 = *(const u32x4*)(r1 + 1024), u1 = *(const u32x4*)(r1 + 2048);
#pragma unroll
            for (int e = 0; e < 4; ++e) { zm2[2 * e] = bflo(c2[e]) * bflo(u2[e]); zm2[2 * e + 1] = bfhi(c2[e]) * bfhi(u2[e]); zm1[2 * e] = bflo(c1[e]) * bflo(u1[e]); zm1[2 * e + 1] = bfhi(c1[e]) * bfhi(u1[e]); }
        }
#pragma unroll
        for (int tt = 0; tt < 8; ++tt) {
            const bf16* r = H4 + (size_t)(t0 + tt) * OIN + col;
            const u32x4 gb = *(const u32x4*)(r), gc = *(const u32x4*)(r + 1024), uu = *(const u32x4*)(r + 2048), gt = *(const u32x4*)(r + 3072);
            float z[8], y[8];
#pragma unroll
            for (int e = 0; e < 4; ++e) { z[2 * e] = bflo(gc[e]) * bflo(uu[e]); z[2 * e + 1] = bfhi(gc[e]) * bfhi(uu[e]); }
#pragma unroll
            for (int e = 0; e < 4; ++e) {
                const float cv0 = bs[2 * e] + zm2[2 * e] * w0[2 * e] + zm1[2 * e] * w1[2 * e] + z[2 * e] * w2[2 * e];
                const float cv1 = bs[2 * e + 1] + zm2[2 * e + 1] * w0[2 * e + 1] + zm1[2 * e + 1] * w1[2 * e + 1] + z[2 * e + 1] * w2[2 * e + 1];
                y[2 * e] = bflo(gb[e]) * cv0 * silu(bflo(gt[e])); y[2 * e + 1] = bfhi(gb[e]) * cv1 * silu(bfhi(gt[e])); }
            u32x4 o; o.x = pk2(y[0], y[1]); o.y = pk2(y[2], y[3]); o.z = pk2(y[4], y[5]); o.w = pk2(y[6], y[7]);
            *(u32x4*)(Y + (size_t)(t0 + tt) * D + col) = o;
#pragma unroll
            for (int e = 0; e < 8; ++e) { zm2[e] = zm1[e]; zm1[e] = z[e]; }
        }
    }
}

__device__ __forceinline__ void final_phase(Frame& F) {
    const int gw = F.bid * NWAVES + F.wave, NGW = F.G * NWAVES, lane = mk_lane();
    const float* ssp = (const float*)(F.ap->ws + WS_SSP);
    const f32x4* gr = (const f32x4*)F.ap->in[16] + lane;
    f32x4 g[4];
#pragma unroll
    for (int j = 0; j < 4; ++j) g[j] = gr[64 * j];
    for (int row = 2 * gw; row < MTOK; row += 2 * NGW) {
        f32x4 pv[2][4], xv[2][4];
#pragma unroll
        for (int t = 0; t < 2; ++t) { const f32x4* p = (const f32x4*)(ssp + (size_t)(row + t) * 16); const f32x4* xr = (const f32x4*)(F.ap->out + (size_t)(row + t) * D) + lane;
#pragma unroll
            for (int j = 0; j < 4; ++j) { pv[t][j] = p[j]; xv[t][j] = xr[64 * j]; } }
#pragma unroll
        for (int t = 0; t < 2; ++t) {
            const float s = ((pv[t][0][0] + pv[t][0][1]) + (pv[t][0][2] + pv[t][0][3])) + ((pv[t][1][0] + pv[t][1][1]) + (pv[t][1][2] + pv[t][1][3])) + ((pv[t][2][0] + pv[t][2][1]) + (pv[t][2][2] + pv[t][2][3])) + ((pv[t][3][0] + pv[t][3][1]) + (pv[t][3][2] + pv[t][3][3]));
            const float rs = 1.0f / sqrtf(s * (1.0f / D) + EPS);
            f32x4* xr = (f32x4*)(F.ap->out + (size_t)(row + t) * D) + lane;
#pragma unroll
            for (int j = 0; j < 4; ++j) xr[64 * j] = xv[t][j] * rs * g[j]; }
    }
}

#ifndef TS_PROBE
#define TS_PROBE 0
#endif
#define TS_A_HI 5
#define TS_A_LO 2
#define TS_B_HI 1
#define TS_B_LO 0
#ifndef DUP_MASK
#define DUP_MASK 0
#endif
__device__ __forceinline__ bool PHASE_ENTER_(Frame& F) { asm volatile("" : "+s"(F.bid), "+s"(F.G), "+s"(F.wave)); return true; }
#define REP(k) _Pragma("unroll 1") for (int rep_ = 0; rep_ < ((((DUP_MASK) >> (k)) & 1) + 1); ++rep_) if (PHASE_ENTER_(F))
#ifndef MK_SPLIT
#define MK_SPLIT 0
#endif
constexpr int NPHASE = 16;
__global__ void __launch_bounds__(NTHR, 2) fwd_megakernel(Args args) {
    extern __shared__ __attribute__((aligned(16))) unsigned char lds_raw[];
    cg::grid_group grid = cg::this_grid();
    Frame F;
    F.lds = (LAS unsigned char*)lds_raw; F.wave = __builtin_amdgcn_readfirstlane((int)threadIdx.x >> 6); F.G = gridDim.x; F.bid = blockIdx.x;
    F.ap = (const Args*)__builtin_amdgcn_kernarg_segment_ptr();
    if ((F.wave * 64 + mk_lane()) < 2) ((LAS unsigned*)(F.lds + XB_LDS_OFF))[(F.wave * 64 + mk_lane())] = 0u;
    __syncthreads();
    const XcdBarrier xbar = xcd_barrier_post((unsigned*)(args.ws + XB_WS_OFF), (volatile LAS unsigned*)(F.lds + XB_LDS_OFF), F.wave);
    const int lo = args.ph_lo, hi = args.ph_hi;
    if (hi > NPHASE) grid.sync();
#define PHASE_ENTER() do { asm volatile("" : "+s"(F.bid), "+s"(F.G), "+s"(F.wave)); } while (0)
#define IN(k) (lo <= (k) && (k) < hi)
#define SEAM(k) do { if (IN(k) && IN((k) + 1)) xcd_barrier(xbar); STAMP((k) + 1); } while (0)
    typedef pg8::EpiScaleBf16<true> EpiS; typedef pg8::EpiScaleBf16<false> EpiN;
#define ws (F.ap->ws)
#define XB ((bf16*)(ws + WS_XB))
#define SSP ((float*)(ws + WS_SSP))
#define BIG ((bf16*)(ws + WS_BIG))
#define BUFA ((bf16*)(ws + WS_BUFA))
#define BUFB ((bf16*)(ws + WS_BUFB))

#if TS_PROBE
#define STAMP(i) do { if (blockIdx.x == 0 && threadIdx.x == 0) ((unsigned long long*)ws)[i] = __builtin_amdgcn_s_memrealtime(); } while (0)
#else
#define STAMP(i) do { } while (0)
#endif
    STAMP(0);
    REP(0) {
    if (IN(0)) { p0_prologue(F); } SEAM(0); }
    REP(1) {
    if (IN(1)) {
        { pg8::Gemm g{XB, (const bf16*)(ws + WS_WEIN), MTOK, EIN, D}; pg8::StaticOrder S; S.init(MTOK, EIN, F.G, F.bid); pg8::rs_prepass((LAS float*)(F.lds + 131072), S, SSP, (F.wave * 64 + mk_lane())); EpiS E{BIG, EIN, (const LAS float*)(F.lds + 131072)};
          pg8::gemm_phase<EpiS, pg8::StaticOrder, true, true>(F.lds, g, S, E, F.wave); }
#pragma unroll 1
        for (int l = 0; l < 2; ++l) { pg8::Gemm g{(const bf16*)(ws + WS_MEMN) + (size_t)l * BATCH * MEMLEN * D, (const bf16*)(ws + WS_WKV) + (size_t)l * 2 * D * D, BATCH * MEMLEN, 2 * D, D};
          pg8::StaticOrder S; S.init(BATCH * MEMLEN, 2 * D, F.G, (F.bid + F.G - (F.G / 2 + 32 * l) % F.G) % F.G); EpiN E{(bf16*)(ws + WS_KV) + (size_t)l * BATCH * MEMLEN * 2 * D, 2 * D, nullptr};
          pg8::gemm_phase<EpiN, pg8::StaticOrder, true, true>(F.lds, g, S, E, F.wave); }
    } SEAM(1); }
    REP(2) {
    if (IN(2)) {
        for (int it = F.bid; it < BATCH * NCH * 4; it += F.G) ret1_item(F, it);
        for (int it = F.bid; it < BATCH * NCH * 2; it += F.G) swa_item(F, it);
    } SEAM(2); }
    REP(3) {
    if (IN(3)) { scan_phase(F); } SEAM(3); }
    REP(4) {
    if (IN(4)) { for (int it = F.bid; it < BATCH * NCH * 4; it += F.G) ret2_item(F, it); } SEAM(4); }
    REP(5) {
    if (IN(5)) {
        pg8::Gemm g{BUFA, (const bf16*)(ws + WS_WEOUT), MTOK, D, D}; pg8::StaticOrder S; S.init(MTOK, D, F.G, F.bid); typedef pg8::EpiResidual<true, false> EpiR0; EpiR0 E{F.ap->in[0], XB, SSP, D};
        pg8::gemm_phase<EpiR0, pg8::StaticOrder, true, true>(F.lds, g, S, E, F.wave);
    } SEAM(5); }
#pragma unroll
    for (int l = 0; l < 2; ++l) {
        const int pb = (l == 0) ? 6 : 12;
        REP(pb) {
        if (IN(pb)) {
            pg8::Gemm g{XB, (const bf16*)(ws + WS_WQ) + (size_t)l * D * D, MTOK, D, D}; pg8::StaticOrder S; S.init(MTOK, D, F.G, F.bid); pg8::rs_prepass((LAS float*)(F.lds + 131072), S, SSP, (F.wave * 64 + mk_lane())); EpiS E{BUFB, D, (const LAS float*)(F.lds + 131072)};
            pg8::gemm_phase<EpiS, pg8::StaticOrder, true, true>(F.lds, g, S, E, F.wave);
        } SEAM(pb); }
        REP(pb + 1) {
        if (IN(pb + 1)) { for (int it = F.bid; it < (MTOK / 256) * 4; it += F.G) xattn_unit(F, l, it); } SEAM(pb + 1); }
        REP(pb + 2) {
        if (IN(pb + 2)) {
            pg8::Gemm g{BUFA, (const bf16*)(ws + WS_WO) + (size_t)l * D * D, MTOK, D, D}; pg8::StaticOrder S; S.init(MTOK, D, F.G, F.bid); if (l == 0) { typedef pg8::EpiResidual<false, false> EpiR1; EpiR1 E{XB, XB, SSP, D}; pg8::gemm_phase<EpiR1, pg8::StaticOrder, true, true>(F.lds, g, S, E, F.wave); }
            else { typedef pg8::EpiResidual<false, true> EpiR2; EpiR2 E{XB, F.ap->out, SSP, D}; pg8::gemm_phase<EpiR2, pg8::StaticOrder, true, true>(F.lds, g, S, E, F.wave); }
        } SEAM(pb + 2); }
        if (l == 0) {
            REP(9) {
            if (IN(9)) {
                pg8::Gemm g{XB, (const bf16*)(ws + WS_WOIN), MTOK, OIN, D}; pg8::StaticOrder S; S.init(MTOK, OIN, F.G, F.bid); pg8::rs_prepass((LAS float*)(F.lds + 131072), S, SSP, (F.wave * 64 + mk_lane())); EpiS E{BIG, OIN, (const LAS float*)(F.lds + 131072)};
                pg8::gemm_phase<EpiS, pg8::StaticOrder, true, true>(F.lds, g, S, E, F.wave);
            } SEAM(9); }
            REP(10) {
            if (IN(10)) { conv_phase(F); } SEAM(10); }
            REP(11) {
            if (IN(11)) {
                pg8::Gemm g{BUFA, (const bf16*)(ws + WS_WOOUT), MTOK, D, D}; pg8::StaticOrder S; S.init(MTOK, D, F.G, F.bid); typedef pg8::EpiResidual<false, false> EpiR1; EpiR1 E{XB, XB, SSP, D};
                pg8::gemm_phase<EpiR1, pg8::StaticOrder, true, true>(F.lds, g, S, E, F.wave);
            } SEAM(11); }
        }
    }
    if (IN(15)) { final_phase(F); }
#if TS_PROBE
    __syncthreads();
    if (blockIdx.x == 0 && threadIdx.x == 0) { const unsigned long long* ts = (const unsigned long long*)ws;
        const float ta = (float)(ts[TS_A_HI] - ts[TS_A_LO]) * 0.01f, tb = (float)(ts[TS_B_HI] - ts[TS_B_LO]) * 0.01f;
        F.ap->out[0] = ta; for (int i = 1; i <= 1000; ++i) F.ap->out[i] = tb; }
#endif
#undef IN
#undef SEAM
#undef ws
#undef XB
#undef SSP
#undef BIG
#undef BUFA
#undef BUFB
}

extern "C" void kernel_launch(void* const* d_in, const int* in_sizes, int n_in, void* d_out, int out_size, void* d_ws, size_t ws_size, hipStream_t stream) {
    static int grid = 0;
    if (grid == 0) {
        if (n_in != 17 || out_size != MTOK * D || ws_size < WS_END) { fprintf(stderr, "kernel_launch: unexpected shapes (n_in %d out %d ws %zu)\n", n_in, out_size, ws_size); grid = -1; return; }
        int dev = 0, cus = 0, per_cu = 0;
        hipGetDevice(&dev); hipDeviceGetAttribute(&cus, hipDeviceAttributeMultiprocessorCount, dev);
        if (hipFuncSetAttribute((const void*)fwd_megakernel, hipFuncAttributeMaxDynamicSharedMemorySize, LDS_BYTES) != hipSuccess) { fprintf(stderr, "kernel_launch: hipFuncSetAttribute failed\n"); grid = -1; return; }
        if (hipOccupancyMaxActiveBlocksPerMultiprocessor(&per_cu, (const void*)fwd_megakernel, NTHR, LDS_BYTES) != hipSuccess || per_cu < 1) { fprintf(stderr, "kernel_launch: occupancy query says %d\n", per_cu); per_cu = 1; }
        (void)hipGetLastError();
        grid = cus;
    }
    if (grid < 0) return;
    if (hipMemsetAsync(d_ws, 0, 65536, stream) != hipSuccess) { fprintf(stderr, "kernel_launch: hipMemsetAsync failed\n"); return; }
    Args a{};
    for (int i = 0; i < 17; ++i) a.in[i] = (const float*)d_in[i];
    a.out = (float*)d_out; a.ws = (unsigned char*)d_ws;
#if MK_SPLIT
    for (int p = 0; p < NPHASE; ++p) { a.ph_lo = p; a.ph_hi = p + 1; hipLaunchKernelGGL(fwd_megakernel, dim3(grid), dim3(NTHR), LDS_BYTES, stream, a); }
#else
    a.ph_lo = 0; a.ph_hi = NPHASE;
    void* kargs[] = {&a};
    hipError_t e = hipLaunchCooperativeKernel((const void*)fwd_megakernel, dim3(grid), dim3(NTHR), kargs, LDS_BYTES, stream);
    if (e != hipSuccess) fprintf(stderr, "kernel_launch: cooperative launch failed: %s (grid %d)\n", hipGetErrorString(e), grid);
#endif
}
```

```cpp
#include <hip/hip_runtime.h>
#include <hip/hip_cooperative_groups.h>
#include <cstdio>
#include <cstdint>
namespace cg = cooperative_groups;
__device__ __forceinline__ int mk_lane() { int l = (int)__builtin_amdgcn_mbcnt_hi(~0u, __builtin_amdgcn_mbcnt_lo(~0u, 0u)); asm volatile("" : "+v"(l)); return l; }
namespace pg8 {
#define PG8_LAS __attribute__((address_space(3)))
typedef unsigned short bf16_t;
typedef short bf16x8 __attribute__((ext_vector_type(8)));
typedef float f32x4 __attribute__((ext_vector_type(4)));
typedef unsigned u32x4 __attribute__((ext_vector_type(4)));
constexpr int BM = 256, BK = 64, HALF = 128, HTB = HALF * BK * 2  , STAGE_BYTES = 8 * HTB, NXCD = 8, WGM = 8;

__host__ __device__ __forceinline__ int lds_byte(int r, int c) { const int st = (r >> 4) * 2 + (c >> 5), rr = r & 15, cc = c & 31, ob = rr * 64 + cc * 2; return st * 1024 + (ob ^ (((ob >> 9) & 1) << 5)); }
__host__ __device__ __forceinline__ void stage_rc(int b, int& R, int& C) { const int st = b / 1024, sb = b % 1024, swz = sb ^ (((sb >> 9) & 1) << 5); R = (st >> 1) * 16 + swz / 64; C = (st & 1) * 32 + (swz % 64) / 2; }
__host__ __device__ __forceinline__ int perm32(int rho) { const int n = rho >> 4, i = rho & 15; return 8 * (i >> 2) + 4 * n + (i & 3); }

struct Unit { int pm, pn, idx; };
struct Gemm { const bf16_t* A; const bf16_t* Bt; int M, N, K; };

struct StaticOrder {
    int nM, nN, nwg, G, c;
    __host__ __device__ void init(int M, int N, int G_, int c_) { nM = M / BM; nN = N / BM; nwg = nM * nN; G = G_; c = c_; }
    __host__ __device__ bool next(int i, Unit& u) const {
        const long L = (long)i * G + c; if (L >= nwg) return false;
        int wgid = (int)L; { const int q = nwg / NXCD, r = nwg % NXCD, xcd = wgid % NXCD, off = wgid / NXCD; wgid = (xcd < r ? xcd * (q + 1) : r * (q + 1) + (xcd - r) * q) + off; }
        const int nig = WGM * nN, gid = wgid / nig, fm = gid * WGM, gsz = (nM - fm) < WGM ? (nM - fm) : WGM;
        u.pm = fm + ((wgid % nig) % gsz); u.pn = (wgid % nig) / gsz; u.idx = i; return true;
    }
    __device__ __forceinline__ void a_ready(const Unit&) const {}
    __device__ __forceinline__ void done(const Unit&) const {}
};

typedef float f32x2 __attribute__((ext_vector_type(2))); typedef __bf16 bf16x2_t __attribute__((ext_vector_type(2)));
__device__ __forceinline__ unsigned cvt_pk_bf16(float lo, float hi) { const f32x2 v = {lo, hi}; const bf16x2_t b = __builtin_convertvector(v, bf16x2_t); return __builtin_bit_cast(unsigned, b); }
template <bool SCALE> struct EpiScaleBf16 {
    static constexpr bool PERM = true, AFTER_DRAIN = false;
    bf16_t* O; int ldc; const PG8_LAS float* rs;
    __device__ __forceinline__ void operator()(const f32x4 (&acc)[2][2][4][2], const Unit& u, int wr, int wc, int fr, int fq) const {
        const int rl0 = wr * 64 + fr; const int col0 = u.pn * BM + wc * 32 + 8 * fq;
#pragma unroll
        for (int ai = 0; ai < 2; ++ai)
#pragma unroll
            for (int m = 0; m < 4; ++m) {
                const float sc = SCALE ? rs[256 * u.idx + rl0 + ai * HALF + m * 16] : 1.f;
                bf16_t* rowp = O + (size_t)(u.pm * BM + rl0 + ai * HALF + m * 16) * ldc + col0;
#pragma unroll
                for (int bj = 0; bj < 2; ++bj) { const f32x4 v0 = acc[ai][bj][m][0] * sc, v1 = acc[ai][bj][m][1] * sc;
                    u32x4 w; w.x = cvt_pk_bf16(v0[0], v0[1]); w.y = cvt_pk_bf16(v0[2], v0[3]); w.z = cvt_pk_bf16(v1[0], v1[1]); w.w = cvt_pk_bf16(v1[2], v1[3]);
                    *(u32x4*)(rowp + bj * HALF) = w; }
            }
    }
};
template <class Sched> __device__ __forceinline__ void rs_prepass(PG8_LAS float* rs, const Sched& S, const float* ssp, int tid) {
    const int row = tid >> 1, half = tid & 1;
    f32x4 v[8][2]; bool have[8];
#pragma unroll
    for (int i = 0; i < 8; ++i) { Unit u; have[i] = S.next(i, u);
        if (have[i]) { const f32x4* p = (const f32x4*)(ssp + (size_t)(u.pm * BM + row) * 16) + 2 * half; v[i][0] = p[0]; v[i][1] = p[1]; } }
#pragma unroll
    for (int i = 0; i < 8; ++i) if (have[i]) {
        float s = ((v[i][0][0] + v[i][0][1]) + (v[i][0][2] + v[i][0][3])) + ((v[i][1][0] + v[i][1][1]) + (v[i][1][2] + v[i][1][3]));
        s += __shfl_xor(s, 1);
        if (half == 0) rs[256 * i + row] = 1.0f / sqrtf(s * (1.0f / 1024.0f) + 1e-6f); }
    __syncthreads();
}
struct EpiConv {
    static constexpr bool PERM = true, AFTER_DRAIN = false;
    bf16_t* Z; bf16_t* G2; const PG8_LAS float* rs;
    __device__ __forceinline__ void operator()(const f32x4 (&acc)[2][2][4][2], const Unit& u, int wr, int wc, int fr, int fq) const {
        const int rl0 = wr * 64 + fr; const int c = 64 * u.pn + 32 * (wc & 1) + 8 * fq;
        bf16_t* O = (wc < 2) ? Z : G2;
#pragma unroll
        for (int ai = 0; ai < 2; ++ai)
#pragma unroll
            for (int m = 0; m < 4; ++m) {
                const float sc = rs[256 * u.idx + rl0 + ai * HALF + m * 16];
                float v[8];
#pragma unroll
                for (int n = 0; n < 2; ++n)
#pragma unroll
                    for (int e = 0; e < 4; ++e) { const float a = acc[ai][0][m][n][e] * sc, b = acc[ai][1][m][n][e] * sc;
                        v[4 * n + e] = (wc < 2) ? a * b : a * (b / (1.0f + __expf(-b))); }
                u32x4 w; w.x = cvt_pk_bf16(v[0], v[1]); w.y = cvt_pk_bf16(v[2], v[3]); w.z = cvt_pk_bf16(v[4], v[5]); w.w = cvt_pk_bf16(v[6], v[7]);
                *(u32x4*)(O + (size_t)(u.pm * BM + rl0 + ai * HALF + m * 16) * 1024 + c) = w;
            }
    }
};
template <bool BASE_F32, bool OUT_F32> struct EpiResidual {
    static constexpr bool PERM = true, AFTER_DRAIN = false;
    const void* base; void* out; float* ssp; int ldc;
    __device__ __forceinline__ void operator()(const f32x4 (&acc)[2][2][4][2], const Unit& u, int wr, int wc, int fr, int fq) const {
        const int row0 = u.pm * BM + wr * 64 + fr; const int col0 = u.pn * BM + wc * 32 + 8 * fq;
#pragma unroll
        for (int ai = 0; ai < 2; ++ai)
#pragma unroll
          for (int mh = 0; mh < 2; ++mh) {
            u32x4 pb[2][2]; f32x4 fb[2][2][2];
#pragma unroll
            for (int m2 = 0; m2 < 2; ++m2)
#pragma unroll
                for (int bj = 0; bj < 2; ++bj) { const size_t off = (size_t)(row0 + ai * HALF + (2 * mh + m2) * 16) * ldc + col0 + bj * HALF;
                    if (BASE_F32) { fb[m2][bj][0] = *(const f32x4*)((const float*)base + off); fb[m2][bj][1] = *(const f32x4*)((const float*)base + off + 4); }
                    else pb[m2][bj] = *(const u32x4*)((const bf16_t*)base + off); }
#pragma unroll
            for (int m2 = 0; m2 < 2; ++m2) {
                const int m = 2 * mh + m2, row = row0 + ai * HALF + m * 16;
                float ss = 0.f;
#pragma unroll
                for (int bj = 0; bj < 2; ++bj) { const size_t off = (size_t)row * ldc + col0 + bj * HALF;
                    f32x4 b0, b1;
                    if (BASE_F32) { b0 = fb[m2][bj][0]; b1 = fb[m2][bj][1]; }
                    else { const u32x4 w = pb[m2][bj];
                        b0 = (f32x4){__uint_as_float(w.x << 16), __uint_as_float(w.x & 0xffff0000u), __uint_as_float(w.y << 16), __uint_as_float(w.y & 0xffff0000u)};
                        b1 = (f32x4){__uint_as_float(w.z << 16), __uint_as_float(w.z & 0xffff0000u), __uint_as_float(w.w << 16), __uint_as_float(w.w & 0xffff0000u)}; }
                    const f32x4 o0 = b0 + acc[ai][bj][m][0], o1 = b1 + acc[ai][bj][m][1];
                    ss += ((o0[0] * o0[0] + o0[1] * o0[1]) + (o0[2] * o0[2] + o0[3] * o0[3])) + ((o1[0] * o1[0] + o1[1] * o1[1]) + (o1[2] * o1[2] + o1[3] * o1[3]));
                    if (OUT_F32) { *(f32x4*)((float*)out + off) = o0; *(f32x4*)((float*)out + off + 4) = o1; }
                    else { u32x4 w; w.x = cvt_pk_bf16(o0[0], o0[1]); w.y = cvt_pk_bf16(o0[2], o0[3]); w.z = cvt_pk_bf16(o1[0], o1[1]); w.w = cvt_pk_bf16(o1[2], o1[3]);
                        *(u32x4*)((bf16_t*)out + off) = w; } }
                ss += __shfl_xor(ss, 16); ss += __shfl_xor(ss, 32);
                if (fq == 0) ssp[(size_t)row * 16 + u.pn * 4 + wc] = ss;
            }
            asm volatile("" ::: "memory");
          }
    }
};
template <class Epi, class Sched, bool ALIGN_EPI = false, bool SP2 = false>
__device__ __forceinline__ void gemm_phase(PG8_LAS unsigned char* lds, const Gemm g, const Sched& S, const Epi& E, const int wave_in) {
    int tid_ = wave_in * 64 + mk_lane(); asm volatile("" : "+v"(tid_));
    const int tid = tid_, wid = __builtin_amdgcn_readfirstlane(tid >> 6), lane = tid & 63, wr = wid >> 2, wc = wid & 3, fr = lane & 15, fq = lane >> 4;
    const int K = g.K, nt = K / BK;
    unsigned voffA[2], voffB[2];
#pragma unroll
    for (int i = 0; i < 2; ++i) { int R, C; stage_rc(tid * 16 + i * 8192, R, C); const int Rb = Epi::PERM ? ((R & ~31) + perm32(R & 31)) : R;
        voffA[i] = (unsigned)(R * K + C) * 2u; voffB[i] = (unsigned)(Rb * K + C) * 2u; }
    const size_t kstep = (size_t)(BK * 2);
    const size_t hstep = (size_t)HALF * K * 2;
    const size_t tstep = 2 * hstep;
    const unsigned ldsw = (unsigned)wid * 1024u;
    const int aoff = lds_byte(wr * 64 + fr, fq * 8), boff = lds_byte(wc * 32 + fr, fq * 8);
#define PG8_SA(b, h) (((b) * 2 + (h)) * HTB)
#define PG8_SB(b, h) ((4 + (b) * 2 + (h)) * HTB)
#define PG8_STAGE(bufoff, gbase, voff) do { _Pragma("unroll") for (int _i = 0; _i < 2; ++_i) \
        __builtin_amdgcn_global_load_lds((const unsigned*)((const char*)(gbase) + (voff)[_i]), (PG8_LAS unsigned*)(lds + (bufoff) + ldsw + _i * 8192), 16, 0, 0); } while (0)
#define PG8_LDA(dst, b, h) do { _Pragma("unroll") for (int m = 0; m < 4; ++m) _Pragma("unroll") for (int k = 0; k < 2; ++k) dst[m][k] = *(const PG8_LAS bf16x8*)(lds + PG8_SA(b, h) + aoff + m * 2048 + k * 1024); } while (0)
#define PG8_LDB(dst, b, h) do { _Pragma("unroll") for (int n = 0; n < 2; ++n) _Pragma("unroll") for (int k = 0; k < 2; ++k) dst[n][k] = *(const PG8_LAS bf16x8*)(lds + PG8_SB(b, h) + boff + n * 2048 + k * 1024); } while (0)
#define PG8_MMA(ai, bj, At, Bt) do { __builtin_amdgcn_s_setprio(1); _Pragma("unroll") for (int m = 0; m < 4; ++m) _Pragma("unroll") for (int n = 0; n < 2; ++n) _Pragma("unroll") for (int k = 0; k < 2; ++k) \
        acc[ai][bj][m][n] = __builtin_amdgcn_mfma_f32_16x16x32_bf16(Bt[n][k], At[m][k], acc[ai][bj][m][n], 0, 0, 0); __builtin_amdgcn_s_setprio(0); } while (0)
#define PG8_WAIT_V(n) asm volatile("s_waitcnt vmcnt(" #n ")" ::: "memory")
#define PG8_WAIT_L(n) asm volatile("s_waitcnt lgkmcnt(" #n ")" ::: "memory")
#define PG8_BAR __builtin_amdgcn_s_barrier()
#define PG8_SCHED __builtin_amdgcn_sched_barrier(0)
    Unit cur, nxt; int ui = 0;
    if (!S.next(0, cur)) return;
    f32x4 acc[2][2][4][2];
#pragma unroll
    for (int a = 0; a < 2; ++a)
#pragma unroll
        for (int b = 0; b < 2; ++b)
#pragma unroll
            for (int m = 0; m < 4; ++m)
#pragma unroll
                for (int n = 0; n < 2; ++n) acc[a][b][m][n] = (f32x4){0.f, 0.f, 0.f, 0.f};
    bf16x8 At[4][2], B0[2][2], B1[2][2];
    const char* cA = (const char*)g.A + (size_t)cur.pm * tstep; const char* cB = (const char*)g.Bt + (size_t)cur.pn * tstep;
    S.a_ready(cur);
    if constexpr (SP2) {
        PG8_STAGE(PG8_SB(0, 0), cB, voffB); PG8_STAGE(PG8_SB(0, 1), cB + hstep, voffB); PG8_STAGE(PG8_SA(0, 0), cA, voffA); PG8_STAGE(PG8_SA(0, 1), cA + hstep, voffA);
        if (wr == 1) PG8_BAR;
        PG8_WAIT_V(2); PG8_BAR;
        PG8_STAGE(PG8_SB(1, 0), cB + kstep, voffB); PG8_STAGE(PG8_SA(1, 0), cA + kstep, voffA); PG8_STAGE(PG8_SB(1, 1), cB + hstep + kstep, voffB);
        PG8_WAIT_V(6); PG8_BAR;
    } else {
        PG8_STAGE(PG8_SB(0, 0), cB, voffB); PG8_STAGE(PG8_SA(0, 0), cA, voffA); PG8_STAGE(PG8_SB(0, 1), cB + hstep, voffB); PG8_STAGE(PG8_SA(0, 1), cA + hstep, voffA);
        if (wr == 1) PG8_BAR;
        PG8_WAIT_V(4); PG8_BAR;
        PG8_STAGE(PG8_SB(1, 0), cB + kstep, voffB); PG8_STAGE(PG8_SA(1, 0), cA + kstep, voffA); PG8_STAGE(PG8_SB(1, 1), cB + hstep + kstep, voffB);
        PG8_WAIT_V(6); PG8_BAR;
    }
    for (;;) {
        const bool has_next = S.next(ui + 1, nxt);
        const char* nA = has_next ? (const char*)g.A + (size_t)nxt.pm * tstep : cA; const char* nB = has_next ? (const char*)g.Bt + (size_t)nxt.pn * tstep : cB;
        for (int t = 0; t < nt; t += 2) {
            const bool last = (t == nt - 2);
            const char* a1 = cA + (size_t)(t + 1) * kstep;
            const char* a2 = last ? nA : cA + (size_t)(t + 2) * kstep; const char* b2 = last ? nB : cB + (size_t)(t + 2) * kstep;
            const char* a3 = a2 + kstep; const char* b3 = b2 + kstep;
            if (last && has_next) S.a_ready(nxt);
            if constexpr (SP2) {
            PG8_LDB(B0, 0, 0); PG8_LDB(B1, 0, 1); PG8_SCHED; PG8_LDA(At, 0, 0); PG8_STAGE(PG8_SA(1, 1), a1 + hstep, voffA);
            PG8_WAIT_V(8); PG8_WAIT_L(0); PG8_BAR; PG8_MMA(0, 0, At, B0); PG8_MMA(0, 1, At, B1); PG8_BAR; PG8_SCHED;
            PG8_LDA(At, 0, 1); PG8_STAGE(PG8_SB(0, 0), b2, voffB); PG8_STAGE(PG8_SB(0, 1), b2 + hstep, voffB); PG8_STAGE(PG8_SA(0, 0), a2, voffA);
            PG8_WAIT_V(8); PG8_WAIT_L(0); PG8_BAR; PG8_MMA(1, 0, At, B0); PG8_MMA(1, 1, At, B1); PG8_BAR; PG8_SCHED;
            PG8_LDB(B0, 1, 0); PG8_LDB(B1, 1, 1); PG8_SCHED; PG8_LDA(At, 1, 0); PG8_STAGE(PG8_SA(0, 1), a2 + hstep, voffA);
            PG8_WAIT_V(8); PG8_WAIT_L(0); PG8_BAR; PG8_MMA(0, 0, At, B0); PG8_MMA(0, 1, At, B1); PG8_BAR; PG8_SCHED;
            PG8_LDA(At, 1, 1); PG8_STAGE(PG8_SB(1, 0), b3, voffB); PG8_STAGE(PG8_SB(1, 1), b3 + hstep, voffB); PG8_STAGE(PG8_SA(1, 0), a3, voffA);
            PG8_WAIT_V(8); PG8_WAIT_L(0); PG8_BAR; PG8_MMA(1, 0, At, B0); PG8_MMA(1, 1, At, B1); PG8_BAR; PG8_SCHED;
            } else {
            PG8_LDB(B0, 0, 0); PG8_SCHED; PG8_LDA(At, 0, 0); PG8_STAGE(PG8_SA(1, 1), a1 + hstep, voffA);
            PG8_WAIT_L(8); PG8_BAR; PG8_WAIT_L(0); PG8_MMA(0, 0, At, B0); PG8_BAR; PG8_SCHED;
            PG8_LDB(B1, 0, 1); PG8_STAGE(PG8_SB(0, 0), b2, voffB);
            PG8_BAR; PG8_WAIT_L(0); PG8_MMA(0, 1, At, B1); PG8_BAR;
            PG8_LDA(At, 0, 1); PG8_STAGE(PG8_SA(0, 0), a2, voffA);
            PG8_BAR; PG8_WAIT_L(0); PG8_MMA(1, 0, At, B0); PG8_BAR; PG8_SCHED;
            PG8_STAGE(PG8_SB(0, 1), b2 + hstep, voffB);
            PG8_WAIT_V(6); PG8_BAR; PG8_MMA(1, 1, At, B1); PG8_BAR;
            PG8_LDB(B0, 1, 0); PG8_SCHED; PG8_LDA(At, 1, 0); PG8_STAGE(PG8_SA(0, 1), a2 + hstep, voffA);
            PG8_WAIT_L(8); PG8_BAR; PG8_WAIT_L(0); PG8_MMA(0, 0, At, B0); PG8_BAR; PG8_SCHED;
            PG8_LDB(B1, 1, 1); PG8_STAGE(PG8_SB(1, 0), b3, voffB);
            PG8_BAR; PG8_WAIT_L(0); PG8_MMA(0, 1, At, B1); PG8_BAR;
            PG8_LDA(At, 1, 1); PG8_STAGE(PG8_SA(1, 0), a3, voffA);
            PG8_BAR; PG8_WAIT_L(0); PG8_MMA(1, 0, At, B0); PG8_BAR; PG8_SCHED;
            PG8_STAGE(PG8_SB(1, 1), b3 + hstep, voffB);
            PG8_WAIT_V(6); PG8_BAR; PG8_MMA(1, 1, At, B1); PG8_BAR;
            }
        }
        if constexpr (ALIGN_EPI) { if (wr == 0) PG8_BAR; }
        if constexpr (!Epi::AFTER_DRAIN) { E(acc, cur, wr, wc, fr, fq); S.done(cur); }
        if (!has_next) break;
#pragma unroll
        for (int a = 0; a < 2; ++a)
#pragma unroll
            for (int b = 0; b < 2; ++b)
#pragma unroll
                for (int m = 0; m < 4; ++m)
#pragma unroll
                    for (int n = 0; n < 2; ++n) acc[a][b][m][n] = (f32x4){0.f, 0.f, 0.f, 0.f};
        cur = nxt; cA = nA; cB = nB; ++ui;
        if constexpr (ALIGN_EPI) { if (wr == 1) PG8_BAR; }
    }
    PG8_WAIT_V(0);
    if constexpr (!ALIGN_EPI) { if (wr == 0) PG8_BAR; }
    PG8_BAR;
    if constexpr (Epi::AFTER_DRAIN) { E.fused(acc, cur, wr, wc, fr, fq, lds, wid, lane); S.done(cur); }
#undef PG8_SA
#undef PG8_SB
#undef PG8_STAGE
#undef PG8_LDA
#undef PG8_LDB
#undef PG8_MMA
#undef PG8_WAIT_V
#undef PG8_WAIT_L
#undef PG8_BAR
#undef PG8_SCHED
}
}

constexpr int D = 1024, BATCH = 4, SEQ = 8192, MTOK = BATCH * SEQ, NCH = SEQ / 64, MEMLEN = 256;
constexpr int EIN = 3328, OIN = 4096;
constexpr float EPS = 1e-6f;
constexpr int C_AQ = 0, C_AK = 512, C_AV = 640, C_AG = 768, C_BQ = 1280, C_BK = 1792, C_BV = 2304, C_BG = 2816;
constexpr int NWAVES = 8, NTHR = 512;
constexpr size_t MiB = 1u << 20;
constexpr size_t WS_WEIN = 1 * MiB, WS_WEOUT = 8 * MiB, WS_WOIN = 10 * MiB, WS_WOOUT = 18 * MiB, WS_WQ = 20 * MiB, WS_WKV = 24 * MiB, WS_WO = 32 * MiB;
constexpr size_t WS_MEMN = 36 * MiB, WS_KV = 40 * MiB, WS_ROT = 48 * MiB, WS_SSP = 52 * MiB;
constexpr size_t WS_XB = 56 * MiB;
constexpr size_t WS_BIG = 120 * MiB;
constexpr size_t WS_BUFA = 376 * MiB;
constexpr size_t WS_BUFB = 440 * MiB;
constexpr size_t WS_END = 504 * MiB;
constexpr int LDS_BYTES = 147456;

#define LAS __attribute__((address_space(3)))
typedef unsigned short bf16;
typedef short bf16x8 __attribute__((ext_vector_type(8)));
typedef short s16x4 __attribute__((ext_vector_type(4)));
typedef float f32x2 __attribute__((ext_vector_type(2)));
typedef float f32x4 __attribute__((ext_vector_type(4)));
typedef float f32x16 __attribute__((ext_vector_type(16)));
typedef unsigned u32x2 __attribute__((ext_vector_type(2)));
typedef unsigned u32x4 __attribute__((ext_vector_type(4)));

__device__ __forceinline__ unsigned pk2(float lo, float hi) { return pg8::cvt_pk_bf16(lo, hi); }
__device__ __forceinline__ float bflo(unsigned w) { return __uint_as_float(w << 16); }
__device__ __forceinline__ float bfhi(unsigned w) { return __uint_as_float(w & 0xffff0000u); }
__device__ __forceinline__ int crow(int r, int hi) { return (r & 3) + 8 * (r >> 2) + 4 * hi; }
__device__ __forceinline__ float wave_sum(float v) {
#pragma unroll
    for (int o = 1; o < 64; o <<= 1) v += __shfl_xor(v, o);
    return v;
}
__device__ __forceinline__ float silu(float x) { return x / (1.0f + __expf(-x)); }
__device__ __forceinline__ s16x4 trd(const LAS bf16* p) { return __builtin_bit_cast(s16x4, __builtin_amdgcn_ds_read_tr16_b64_v4i16((LAS s16x4*)p)); }
__device__ __forceinline__ bf16x8 tr_frag(const LAS bf16* T, int ld, int k0, int n0, int lane) {
    const int g4 = lane >> 4, li = lane & 15, q = li >> 2, p = li & 3, hi = g4 >> 1;
    const LAS bf16* a = T + (k0 + 4 * hi + q) * ld + n0 + 16 * (g4 & 1) + 4 * p;
    const s16x4 lo = trd(a), up = trd(a + 8 * ld);
    return (bf16x8){lo[0], lo[1], lo[2], lo[3], up[0], up[1], up[2], up[3]};
}
__device__ __forceinline__ bf16x8 pack8(float a0, float a1, float a2, float a3, float a4, float a5, float a6, float a7) {
    u32x4 w; w.x = pk2(a0, a1); w.y = pk2(a2, a3); w.z = pk2(a4, a5); w.w = pk2(a6, a7); return __builtin_bit_cast(bf16x8, w);
}
__device__ __forceinline__ int launder(int v) { asm volatile("" : "+v"(v)); return v; }
#define LBAR() asm volatile("s_waitcnt lgkmcnt(0)\n\ts_barrier" ::: "memory")
#define MFMA32(a, b, c) __builtin_amdgcn_mfma_f32_32x32x16_bf16((a), (b), (c), 0, 0, 0)

#define XB_TMO      128
#define XB_XCNT(j)  (256  + 64 * (j))
#define XB_XSUB(j)  (1280 + 64 * (j))
#define XB_XGEN(j)  (2304 + 64 * (j))
#define XB_TOP      3328
#define XB_TOPGEN   3392
#define XCD_BAR_WORDS 3456
#define XB_SPIN_CAP (1u << 18)

__device__ __forceinline__ unsigned xb_ld(unsigned* p)              { return __hip_atomic_load(p, __ATOMIC_RELAXED, __HIP_MEMORY_SCOPE_AGENT); }
__device__ __forceinline__ unsigned xb_add(unsigned* p, unsigned v) { return __hip_atomic_fetch_add(p, v, __ATOMIC_RELAXED, __HIP_MEMORY_SCOPE_AGENT); }
__device__ __forceinline__ unsigned xb_xcc_id() { return (unsigned)__builtin_amdgcn_s_getreg((3 << 11) | 20) & 0xFu; }
#define XB_SPIN(cond, bar) do { unsigned _sp = 0; while (cond) { __builtin_amdgcn_s_sleep(1); \
    if ((++_sp & 255u) == 0u) { if (xb_ld(&(bar)[XB_TMO])) break; if (_sp > XB_SPIN_CAP) { atomicAdd(&(bar)[XB_TMO], 1u); break; } } } } while (0)

struct XcdBarrier {
    unsigned* bar; unsigned x; int wv;
    volatile LAS unsigned* st;
};

__device__ __forceinline__ XcdBarrier xcd_barrier_post(unsigned* bar, volatile LAS unsigned* st, int wv) {
    XcdBarrier b; b.bar = bar; b.x = xb_xcc_id(); b.st = st; b.wv = wv;
    if (wv == 0 && mk_lane() == 0) (void)xb_add(&bar[XB_XCNT(b.x)], 1u);
    return b;
}
__device__ __forceinline__ void xcd_barrier_complete(unsigned* bar, unsigned x, unsigned& nloc, unsigned& nx) {
    const unsigned G = gridDim.x * gridDim.y * gridDim.z;
    unsigned sum, cnt, mine, sp = 0u;
    for (;;) {
        sum = 0u; cnt = 0u; mine = 0u;
#pragma unroll
        for (unsigned j = 0; j < 16; ++j) { const unsigned c = xb_ld(&bar[XB_XCNT(j)]); sum += c; cnt += (c > 0u) ? 1u : 0u; mine = (j == x) ? c : mine; }
        if (sum == G) break;
        __builtin_amdgcn_s_sleep(1);
        if ((++sp & 255u) == 0u) { if (xb_ld(&bar[XB_TMO])) break; if (sp > XB_SPIN_CAP) { atomicAdd(&bar[XB_TMO], 1u); break; } }
    }
    nloc = mine > 0u ? mine : 1u; nx = cnt > 0u ? cnt : 1u;
}

__device__ __forceinline__ void xcd_barrier(const XcdBarrier& b) {
    asm volatile("s_waitcnt vmcnt(0)" ::: "memory");
    __syncthreads();
    if (b.wv == 0 && mk_lane() == 0) {
        unsigned* bar = b.bar;
        __builtin_amdgcn_s_waitcnt(0);
        unsigned nloc = b.st[0], nx = b.st[1];
        if (nloc == 0u) { xcd_barrier_complete(bar, b.x, nloc, nx); b.st[0] = nloc; b.st[1] = nx; }
        const unsigned old = xb_add(&bar[XB_XSUB(b.x)], 1u);
        const unsigned gen = old / nloc;
        if (old + 1u == (gen + 1u) * nloc) {
            __builtin_amdgcn_fence(__ATOMIC_RELEASE, "agent");
            asm volatile("s_waitcnt vmcnt(0)" ::: "memory");
            const unsigned og = xb_add(&bar[XB_TOP], 1u);
            const unsigned tg = og / nx;
            if (og + 1u == (tg + 1u) * nx) xb_add(&bar[XB_TOPGEN], 1u);
            else XB_SPIN(xb_ld(&bar[XB_TOPGEN]) == tg, bar);
            __builtin_amdgcn_fence(__ATOMIC_ACQUIRE, "agent");
            xb_add(&bar[XB_XGEN(b.x)], 1u);
            asm volatile("s_waitcnt vmcnt(0)" ::: "memory");
        } else {
            XB_SPIN(xb_ld(&bar[XB_XGEN(b.x)]) == gen, bar);
            __builtin_amdgcn_fence(__ATOMIC_ACQUIRE, "agent");
            asm volatile("s_waitcnt vmcnt(0)" ::: "memory");
        }
    }
    __syncthreads();
}

constexpr int XB_WS_OFF = 4096, XB_LDS_OFF = 147200;
struct Args { const float* in[17]; float* out; unsigned char* ws; int ph_lo, ph_hi; };
struct Frame {
    LAS unsigned char* lds; int wave, G, bid;
    const Args* ap;
};

__device__ __forceinline__ int oin_src_col(int np) { const int t = np >> 8, j = np & 255, bj = j >> 7, wc = (j >> 5) & 3, r = j & 31, c = 64 * t + 32 * (wc & 1) + r;
    const int grp = (wc < 2) ? (bj ? 2 : 1) : (bj ? 3 : 0); return grp * 1024 + c; }
template <bool PERMC = false> __device__ __forceinline__ void p0_transpose_item(const float* W, const float* gain, int K, int N, bf16* WT, LAS float* scr, int item, int lane) {
    const int nblk = N / 32, kb = item / nblk, nb = item % nblk, k0 = 64 * kb, n0 = 32 * nb, ns0 = PERMC ? oin_src_col(n0) : n0;
    float wv[32];
#pragma unroll
    for (int i = 0; i < 32; ++i) wv[i] = W[(size_t)(k0 + 2 * i + (lane >> 5)) * N + ns0 + (lane & 31)];
    if (gain) {
#pragma unroll
        for (int i = 0; i < 32; ++i) wv[i] *= gain[k0 + 2 * i + (lane >> 5)]; }
#pragma unroll
    for (int i = 0; i < 32; ++i) scr[(2 * i + (lane >> 5)) * 33 + (lane & 31)] = wv[i];
    asm volatile("s_waitcnt lgkmcnt(0)" ::: "memory");
    const int c = lane & 7;
#pragma unroll
    for (int j = 0; j < 4; ++j) { const int n = (lane >> 3) + 8 * j; const LAS float* s = scr + (8 * c) * 33 + n;
        u32x4 o; o.x = pk2(s[0 * 33], s[1 * 33]); o.y = pk2(s[2 * 33], s[3 * 33]); o.z = pk2(s[4 * 33], s[5 * 33]); o.w = pk2(s[6 * 33], s[7 * 33]);
        *(u32x4*)(WT + (size_t)(n0 + n) * K + k0 + 8 * c) = o; }
    asm volatile("s_waitcnt lgkmcnt(0)" ::: "memory");
}
__device__ __forceinline__ void p0_prologue(Frame& F) {
    LAS float* scr = (LAS float*)(F.lds + F.wave * 16384);
    const int gw = F.bid * NWAVES + F.wave, NGW = F.G * NWAVES, lane = mk_lane();
    unsigned char* ws = F.ap->ws;
    constexpr int I_EIN = 16 * (EIN / 32), I_SQ = 16 * 32, I_OIN = 16 * (OIN / 32), I_KV = 16 * 64;
    constexpr int NITEMS = I_EIN + I_SQ + I_OIN + I_SQ + 2 * I_SQ + 2 * I_KV + 2 * I_SQ;
    for (int it = gw; it < NITEMS; it += NGW) {
        int r = it;
        if (r < I_EIN) { p0_transpose_item(F.ap->in[3], F.ap->in[2], D, EIN, (bf16*)(ws + WS_WEIN), scr, r, lane); continue; } r -= I_EIN;
        if (r < I_SQ) { p0_transpose_item(F.ap->in[5], nullptr, D, D, (bf16*)(ws + WS_WEOUT), scr, r, lane); continue; } r -= I_SQ;
        if (r < I_OIN) { p0_transpose_item<true>(F.ap->in[7], F.ap->in[6], D, OIN, (bf16*)(ws + WS_WOIN), scr, r, lane); continue; } r -= I_OIN;
        if (r < I_SQ) { p0_transpose_item(F.ap->in[10], nullptr, D, D, (bf16*)(ws + WS_WOOUT), scr, r, lane); continue; } r -= I_SQ;
        if (r < 2 * I_SQ) { const int l = r / I_SQ; p0_transpose_item(F.ap->in[13] + (size_t)l * D * D, F.ap->in[11] + l * D, D, D, (bf16*)(ws + WS_WQ) + (size_t)l * D * D, scr, r % I_SQ, lane); continue; } r -= 2 * I_SQ;
        if (r < 2 * I_KV) { const int l = r / I_KV; p0_transpose_item(F.ap->in[14] + (size_t)l * D * 2 * D, nullptr, D, 2 * D, (bf16*)(ws + WS_WKV) + (size_t)l * 2 * D * D, scr, r % I_KV, lane); continue; } r -= 2 * I_KV;
        { const int l = r / I_SQ; p0_transpose_item(F.ap->in[15] + (size_t)l * D * D, nullptr, D, D, (bf16*)(ws + WS_WO) + (size_t)l * D * D, scr, r % I_SQ, lane); }
    }
    for (int it = gw; it < 2 * BATCH * MEMLEN; it += NGW) {
        const int l = it / (BATCH * MEMLEN), row = it % (BATCH * MEMLEN);
        const f32x4* xr = (const f32x4*)(F.ap->in[1] + (size_t)row * D) + lane; const f32x4* gr = (const f32x4*)(F.ap->in[12] + l * D) + lane;
        f32x4 v[4]; float s = 0.f;
#pragma unroll
        for (int j = 0; j < 4; ++j) { v[j] = xr[64 * j]; s += (v[j][0] * v[j][0] + v[j][1] * v[j][1]) + (v[j][2] * v[j][2] + v[j][3] * v[j][3]); }
        const float rs = 1.0f / sqrtf(wave_sum(s) * (1.0f / D) + EPS);
        u32x2* o8 = (u32x2*)((bf16*)(ws + WS_MEMN) + (size_t)it * D) + lane;
#pragma unroll
        for (int j = 0; j < 4; ++j) { const f32x4 g = gr[64 * j]; u32x2 w; w.x = pk2(v[j][0] * rs * g[0], v[j][1] * rs * g[1]); w.y = pk2(v[j][2] * rs * g[2], v[j][3] * rs * g[3]); o8[64 * j] = w; }
    }
    for (int row = 2 * gw; row < MTOK; row += 2 * NGW) {
        f32x4 v[2][4];
#pragma unroll
        for (int t = 0; t < 2; ++t) { const f32x4* xr = (const f32x4*)(F.ap->in[0] + (size_t)(row + t) * D) + lane;
#pragma unroll
            for (int j = 0; j < 4; ++j) v[t][j] = xr[64 * j]; }
#pragma unroll
        for (int t = 0; t < 2; ++t) { float s = 0.f;
#pragma unroll
            for (int j = 0; j < 4; ++j) s += (v[t][j][0] * v[t][j][0] + v[t][j][1] * v[t][j][1]) + (v[t][j][2] * v[t][j][2] + v[t][j][3] * v[t][j][3]);
            s = wave_sum(s);
            u32x2* o8 = (u32x2*)((bf16*)(ws + WS_XB) + (size_t)(row + t) * D) + lane;
#pragma unroll
            for (int j = 0; j < 4; ++j) { u32x2 w; w.x = pk2(v[t][j][0], v[t][j][1]); w.y = pk2(v[t][j][2], v[t][j][3]); o8[64 * j] = w; }
            if (lane < 16) ((float*)(ws + WS_SSP))[(size_t)(row + t) * 16 + lane] = (lane == 0) ? s : 0.f; }
    }
    for (int e = F.bid * NTHR + launder((F.wave * 64 + mk_lane())); e < SEQ * 64; e += F.G * NTHR) {
        const int pos = e >> 6, j = e & 63;
        const float inv = 1.0f / exp2f(((float)j / 63.0f) * 13.287712379549449f);
        const float ang = (float)pos * inv;
        const double a = (double)ang, kk = rint(a * 0.63661977236758134308);
        const float r = (float)fma(-kk, 1.57079632679489661923, a), r2 = r * r;
        const float sn = r + r * r2 * (-1.6666654611e-1f + r2 * (8.3321608736e-3f + r2 * (-1.9515295891e-4f)));
        const float cs = 1.0f - 0.5f * r2 + r2 * r2 * (4.166664568298827e-2f + r2 * (-1.388731625493765e-3f + r2 * 2.443315711809948e-5f));
        const int q = ((int)kk) & 3;
        f32x2 o; o.x = (q == 0) ? cs : (q == 1) ? -sn : (q == 2) ? -cs : sn; o.y = (q == 0) ? sn : (q == 1) ? cs : (q == 2) ? -sn : -cs;
        ((f32x2*)(ws + WS_ROT))[e] = o;
    }
}

constexpr int AKS = 72;
struct SwPre { u32x4 kx[3], vx[3]; bf16x8 qf[4]; };
__device__ __forceinline__ void swa_load(Frame& F, int item, SwPre& P) {
    const int kvh = item & 1, c = (item >> 1) & (NCH - 1), b = item >> 8;
    const int c0 = c >= 2 ? c - 2 : 0, nch = c - c0 + 1;
    const int tid = launder((F.wave * 64 + mk_lane())), lane = tid & 63, w = F.wave, r32 = lane & 31, hi = lane >> 5;
    const bf16* HC = (const bf16*)(F.ap->ws + WS_BIG);
    const size_t rowbase = (size_t)b * SEQ;
    const int qh = kvh * 4 + (w >> 1);
    const size_t tok = rowbase + c * 64 + (w & 1) * 32 + r32;
    const bf16* qp = HC + tok * EIN + C_AQ + qh * 64 + hi * 8;
#pragma unroll
    for (int i = 0; i < 3; ++i) if (i < nch) { const int p = tid + i * NTHR, r = p >> 3, ch = p & 7; const bf16* src = HC + (rowbase + c0 * 64 + r) * EIN + kvh * 64 + ch * 8;
        P.kx[i] = *(const u32x4*)(src + C_AK); P.vx[i] = *(const u32x4*)(src + C_AV); }
#pragma unroll
    for (int s = 0; s < 4; ++s) P.qf[s] = *(const bf16x8*)(qp + 16 * s);
}
__device__ __forceinline__ void swa_item(Frame& F, int item, SwPre& P, int next_item, int n_items) {
    const int kvh = item & 1, c = (item >> 1) & (NCH - 1), b = item >> 8;
    const int c0 = c >= 2 ? c - 2 : 0, nch = c - c0 + 1;
    const int tid = launder((F.wave * 64 + mk_lane())), lane = tid & 63, w = F.wave, r32 = lane & 31, hi = lane >> 5;
    LAS bf16* Ks = (LAS bf16*)F.lds; LAS bf16* Vs = Ks + 192 * AKS;
    const bf16* HC = (const bf16*)(F.ap->ws + WS_BIG);
    const size_t rowbase = (size_t)b * SEQ;
    const int qh = kvh * 4 + (w >> 1);
    const size_t tok = rowbase + c * 64 + (w & 1) * 32 + r32;
    const bf16* gp = HC + tok * EIN + C_AG + qh * 64;
#pragma unroll
    for (int i = 0; i < 3; ++i) if (i < nch) { const int p = tid + i * NTHR, r = p >> 3, ch = p & 7; *(LAS u32x4*)(Ks + r * AKS + ch * 8) = P.kx[i]; *(LAS u32x4*)(Vs + r * AKS + ch * 8) = P.vx[i]; }
    bf16x8 qf[4]; u32x2 gg[2][4];
#pragma unroll
    for (int s = 0; s < 4; ++s) qf[s] = P.qf[s];
    if (next_item < n_items) swa_load(F, next_item, P);
#pragma unroll
    for (int db = 0; db < 2; ++db)
#pragma unroll
        for (int gi = 0; gi < 4; ++gi) gg[db][gi] = *(const u32x2*)(gp + 32 * db + 8 * gi + 4 * hi);
    LBAR();
    const int nkb = 2 * nch;
    f32x16 st[6];
#pragma unroll
    for (int kb = 0; kb < 6; ++kb) { st[kb] = (f32x16){};
        if (kb < nkb) {
#pragma unroll
            for (int s = 0; s < 4; ++s) { const bf16x8 a = *(const LAS bf16x8*)(Ks + (32 * kb + r32) * AKS + 16 * s + 8 * hi); st[kb] = MFMA32(a, qf[s], st[kb]); } } }
    float mx = -3.0e38f;
#pragma unroll
    for (int kb = 0; kb < 6; ++kb) if (kb < nkb) {
#pragma unroll
        for (int i = 0; i < 16; ++i) mx = fmaxf(mx, st[kb][i]); }
    mx = fmaxf(mx, __shfl_xor(mx, 32));
    const float sink = F.ap->in[4][qh];
    const float mref = fmaxf(mx * 0.125f, sink);
    const float L2E = 1.4426950408889634f;
    float sum = 0.f;
#pragma unroll
    for (int kb = 0; kb < 6; ++kb) if (kb < nkb) {
#pragma unroll
        for (int i = 0; i < 16; ++i) { const float p = exp2f((st[kb][i] * 0.125f - mref) * L2E); st[kb][i] = p; sum += p; } }
    sum += __shfl_xor(sum, 32);
    const float inv = 1.0f / (sum + exp2f((sink - mref) * L2E));
    f32x16 o[2]; o[0] = (f32x16){}; o[1] = (f32x16){};
#pragma unroll
    for (int kb = 0; kb < 6; ++kb) if (kb < nkb) {
#pragma unroll
        for (int s = 0; s < 2; ++s) {
            const bf16x8 pf = pack8(st[kb][8 * s + 0] * inv, st[kb][8 * s + 1] * inv, st[kb][8 * s + 2] * inv, st[kb][8 * s + 3] * inv, st[kb][8 * s + 4] * inv, st[kb][8 * s + 5] * inv, st[kb][8 * s + 6] * inv, st[kb][8 * s + 7] * inv);
#pragma unroll
            for (int db = 0; db < 2; ++db) { const bf16x8 vf = tr_frag(Vs, AKS, 32 * kb + 16 * s, 32 * db, lane); o[db] = MFMA32(vf, pf, o[db]); } } }
    bf16* yp = (bf16*)(F.ap->ws + WS_BUFA) + tok * D + qh * 64;
#pragma unroll
    for (int db = 0; db < 2; ++db)
#pragma unroll
        for (int gi = 0; gi < 4; ++gi) { const int d0 = 32 * db + 8 * gi + 4 * hi; const u32x2 g = gg[db][gi];
            u32x2 y; y.x = pk2(o[db][4 * gi + 0] * silu(bflo(g.x)), o[db][4 * gi + 1] * silu(bfhi(g.x))); y.y = pk2(o[db][4 * gi + 2] * silu(bflo(g.y)), o[db][4 * gi + 3] * silu(bfhi(g.y)));
            *(u32x2*)(yp + d0) = y; }
    LBAR();
}

constexpr int RKS = 136;
__device__ __forceinline__ float head_lg2(int h) { return log2f(1.0f - exp2f(-5.0f - (float)h)); }
struct R1Pre { u32x4 q1, q2, k1, k2, v1, v2; f32x4 rt[4]; };
__device__ __forceinline__ void ret1_load(Frame& F, int item, R1Pre& P) {
    const int h = item & 3, c = (item >> 2) & (NCH - 1), b = item >> 9;
    const int tid = launder((F.wave * 64 + mk_lane())), j = tid >> 3, pc = tid & 7;
    const bf16* rowp = (const bf16*)(F.ap->ws + WS_BIG) + ((size_t)b * SEQ + (size_t)c * 64 + j) * EIN;
    P.q1 = *(const u32x4*)(rowp + C_BQ + h * 128 + 8 * pc); P.q2 = *(const u32x4*)(rowp + C_BQ + h * 128 + 64 + 8 * pc);
    P.k1 = *(const u32x4*)(rowp + C_BK + h * 128 + 8 * pc); P.k2 = *(const u32x4*)(rowp + C_BK + h * 128 + 64 + 8 * pc);
    P.v1 = *(const u32x4*)(rowp + C_BV + h * 128 + 16 * pc); P.v2 = *(const u32x4*)(rowp + C_BV + h * 128 + 16 * pc + 8);
    const f32x4* rt = (const f32x4*)((const f32x2*)(F.ap->ws + WS_ROT) + (size_t)(c * 64 + j) * 64 + 8 * pc);
#pragma unroll
    for (int e = 0; e < 4; ++e) P.rt[e] = rt[e];
}
__device__ __forceinline__ void ret1_item(Frame& F, int item, R1Pre& P, int next_item, int n_items) {
    const int h = item & 3, c = (item >> 2) & (NCH - 1), b = item >> 9;
    const int tid = launder((F.wave * 64 + mk_lane())), lane = tid & 63, w = F.wave, r32 = lane & 31, hi = lane >> 5;
    LAS bf16* Qr = (LAS bf16*)F.lds; LAS bf16* Kr = Qr + 64 * RKS; LAS bf16* Vs = Kr + 64 * RKS; LAS bf16* Vd = Vs + 64 * RKS;
    bf16* HC = (bf16*)(F.ap->ws + WS_BIG);
    const size_t rowbase = (size_t)b * SEQ + (size_t)c * 64;
    const float lg2 = head_lg2(h);
    {
        const int j = tid >> 3, pc = tid & 7;
        const u32x4 q1 = P.q1, q2 = P.q2, k1 = P.k1, k2 = P.k2, v1 = P.v1, v2 = P.v2;
        const f32x4* rt = P.rt;
        u32x4 qa, qb, ka, kb;
        const float ksc = 0.08838834764831845f;
#pragma unroll
        for (int e = 0; e < 4; ++e) { const f32x4 cs = rt[e];
            const float a0 = bflo(q1[e]), a1 = bfhi(q1[e]), b0 = bflo(q2[e]), b1 = bfhi(q2[e]);
            qa[e] = pk2(a0 * cs[0] - b0 * cs[1], a1 * cs[2] - b1 * cs[3]); qb[e] = pk2(a0 * cs[1] + b0 * cs[0], a1 * cs[3] + b1 * cs[2]);
            const float c0 = bflo(k1[e]), c1 = bfhi(k1[e]), d0 = bflo(k2[e]), d1 = bfhi(k2[e]);
            ka[e] = pk2((c0 * cs[0] - d0 * cs[1]) * ksc, (c1 * cs[2] - d1 * cs[3]) * ksc); kb[e] = pk2((c0 * cs[1] + d0 * cs[0]) * ksc, (c1 * cs[3] + d1 * cs[2]) * ksc); }
        *(LAS u32x4*)(Qr + j * RKS + 8 * pc) = qa; *(LAS u32x4*)(Qr + j * RKS + 64 + 8 * pc) = qb;
        *(LAS u32x4*)(Kr + j * RKS + 8 * pc) = ka; *(LAS u32x4*)(Kr + j * RKS + 64 + 8 * pc) = kb;
        { bf16* yq = (bf16*)(F.ap->ws + WS_BUFA) + (rowbase + j) * D + 512 + h * 128 + 8 * pc; *(u32x4*)yq = qa; *(u32x4*)(yq + 64) = qb; }
        *(LAS u32x4*)(Vs + j * RKS + 16 * pc) = v1; *(LAS u32x4*)(Vs + j * RKS + 16 * pc + 8) = v2;
        const float kd = exp2f(lg2 * (float)(63 - j));
        u32x4 w1, w2;
#pragma unroll
        for (int e = 0; e < 4; ++e) { w1[e] = pk2(bflo(v1[e]) * kd, bfhi(v1[e]) * kd); w2[e] = pk2(bflo(v2[e]) * kd, bfhi(v2[e]) * kd); }
        *(LAS u32x4*)(Vd + j * RKS + 16 * pc) = w1; *(LAS u32x4*)(Vd + j * RKS + 16 * pc + 8) = w2;
    }
    if (next_item < n_items) ret1_load(F, next_item, P);
    LBAR();
    const int ib = w & 1, db = w >> 1;
    f32x16 st[2];
#pragma unroll
    for (int jb = 0; jb < 2; ++jb) { st[jb] = (f32x16){};
#pragma unroll
        for (int s = 0; s < 8; ++s) { const bf16x8 a = *(const LAS bf16x8*)(Kr + (32 * jb + r32) * RKS + 16 * s + 8 * hi); const bf16x8 q = *(const LAS bf16x8*)(Qr + (32 * ib + r32) * RKS + 16 * s + 8 * hi);
            st[jb] = MFMA32(a, q, st[jb]); } }
    const int iloc = 32 * ib + r32;
#pragma unroll
    for (int jb = 0; jb < 2; ++jb)
#pragma unroll
        for (int i = 0; i < 16; ++i) { const int j = 32 * jb + crow(i, hi); const int dd = iloc > j ? iloc - j : j - iloc; st[jb][i] *= exp2f(lg2 * (float)dd); }
    f32x16 o = (f32x16){};
#pragma unroll
    for (int jb = 0; jb < 2; ++jb)
#pragma unroll
        for (int s = 0; s < 2; ++s) {
            const bf16x8 pf = pack8(st[jb][8 * s + 0], st[jb][8 * s + 1], st[jb][8 * s + 2], st[jb][8 * s + 3], st[jb][8 * s + 4], st[jb][8 * s + 5], st[jb][8 * s + 6], st[jb][8 * s + 7]);
            const bf16x8 vf = tr_frag(Vs, RKS, 32 * jb + 16 * s, 32 * db, lane);
            o = MFMA32(vf, pf, o); }
    {
        float* op = (float*)(F.ap->ws + WS_XB) + (rowbase + iloc) * 512 + h * 128 + 32 * db + 4 * hi;
#pragma unroll
        for (int gi = 0; gi < 4; ++gi) *(f32x4*)(op + 8 * gi) = (f32x4){o[4 * gi], o[4 * gi + 1], o[4 * gi + 2], o[4 * gi + 3]};
    }
    const int rb = w >> 1;
    f32x16 kv[2]; kv[0] = (f32x16){}; kv[1] = (f32x16){};
#pragma unroll
    for (int s = 0; s < 4; ++s) { const bf16x8 af = tr_frag(Kr, RKS, 16 * s, 32 * rb, lane);
#pragma unroll
        for (int t = 0; t < 2; ++t) { const bf16x8 bf = tr_frag(Vd, RKS, 16 * s, 32 * (2 * (w & 1) + t), lane); kv[t] = MFMA32(af, bf, kv[t]); } }
    bf16* stp = (bf16*)(F.ap->ws + WS_BUFB) + ((size_t)(b * NCH + c) * 4 + h) * 16384;
#pragma unroll
    for (int t = 0; t < 2; ++t) { const int dv = 32 * (2 * (w & 1) + t) + r32;
#pragma unroll
        for (int gi = 0; gi < 4; ++gi) { const int dk = 32 * rb + 8 * gi + 4 * hi; u32x2 y; y.x = pk2(kv[t][4 * gi], kv[t][4 * gi + 1]); y.y = pk2(kv[t][4 * gi + 2], kv[t][4 * gi + 3]);
            *(u32x2*)(stp + dv * 128 + dk) = y; } }
    LBAR();
}

__device__ __forceinline__ void scan_phase(Frame& F) {
    unsigned* ST = (unsigned*)(F.ap->ws + WS_BUFB);
    for (int e = F.bid * NTHR + launder((F.wave * 64 + mk_lane())); e < BATCH * 4 * 8192; e += F.G * NTHR) {
        const int idx = e & 8191, h = (e >> 13) & 3, b = e >> 15;
        const float dec = exp2f(head_lg2(h) * 64.0f);
        unsigned* p = ST + ((size_t)(b * NCH) * 4 + h) * 8192 + idx;
        float s0 = 0.f, s1 = 0.f;
        unsigned ka[32], kb[32];
#define SCAN_LD(dst, c0) do { _Pragma("unroll") for (int j = 0; j < 32; ++j) dst[j] = p[(size_t)((c0) + j) * 4 * 8192]; } while (0)
#define SCAN_UP(src, c0) do { _Pragma("unroll") for (int j = 0; j < 32; ++j) { p[(size_t)((c0) + j) * 4 * 8192] = pk2(s0, s1); s0 = s0 * dec + bflo(src[j]); s1 = s1 * dec + bfhi(src[j]); } } while (0)
        SCAN_LD(ka, 0); SCAN_LD(kb, 32); SCAN_UP(ka, 0); SCAN_LD(ka, 64); SCAN_UP(kb, 32); SCAN_LD(kb, 96); SCAN_UP(ka, 64); SCAN_UP(kb, 96);
#undef SCAN_LD
#undef SCAN_UP
    }
}

struct R2Pre { bf16x8 af[8], qv[8]; f32x4 oi[4]; u32x2 gg[4]; };
__device__ __forceinline__ void ret2_load(Frame& F, int item, R2Pre& P) {
    const int h = item & 3, c = (item >> 2) & (NCH - 1), b = item >> 9;
    const int lane = launder(mk_lane()), w = F.wave, r32 = lane & 31, hi = lane >> 5;
    const int ib = w & 1, db = w >> 1, iloc = 32 * ib + r32;
    const size_t tok = (size_t)b * SEQ + (size_t)c * 64 + iloc;
    const bf16* stp = (const bf16*)(F.ap->ws + WS_BUFB) + ((size_t)(b * NCH + c) * 4 + h) * 16384 + (size_t)(32 * db + r32) * 128 + 8 * hi;
    const bf16* qp = (const bf16*)(F.ap->ws + WS_BUFA) + tok * D + 512 + h * 128 + 8 * hi;
    const float* op = (const float*)(F.ap->ws + WS_XB) + tok * 512 + h * 128 + 32 * db + 4 * hi;
    const bf16* gp = (const bf16*)(F.ap->ws + WS_BIG) + tok * EIN + C_BG + h * 128 + 32 * db + 4 * hi;
#pragma unroll
    for (int s = 0; s < 8; ++s) { P.af[s] = *(const bf16x8*)(stp + 16 * s); P.qv[s] = *(const bf16x8*)(qp + 16 * s); }
#pragma unroll
    for (int gi = 0; gi < 4; ++gi) { P.oi[gi] = *(const f32x4*)(op + 8 * gi); P.gg[gi] = *(const u32x2*)(gp + 8 * gi); }
}
__device__ __forceinline__ void ret2_item(Frame& F, int item, R2Pre& P, int next_item, int n_items) {
    const int h = item & 3, c = (item >> 2) & (NCH - 1), b = item >> 9;
    const int lane = launder(mk_lane()), w = F.wave, r32 = lane & 31, hi = lane >> 5;
    const int ib = w & 1, db = w >> 1, iloc = 32 * ib + r32;
    LAS float* part = (LAS float*)F.lds;
    const size_t tok = (size_t)b * SEQ + (size_t)c * 64 + iloc;
    f32x16 oc = (f32x16){};
#pragma unroll
    for (int s = 0; s < 8; ++s) oc = MFMA32(P.af[s], P.qv[s], oc);
    const float qdec = exp2f(head_lg2(h) * (float)(iloc + 1));
    float ss = 0.f;
#pragma unroll
    for (int gi = 0; gi < 4; ++gi) {
#pragma unroll
        for (int e = 0; e < 4; ++e) { const float v = P.oi[gi][e] + oc[4 * gi + e] * qdec; oc[4 * gi + e] = v; ss += v * v; } }
    u32x2 gg[4];
#pragma unroll
    for (int gi = 0; gi < 4; ++gi) gg[gi] = P.gg[gi];
    if (next_item < n_items) ret2_load(F, next_item, P);
    ss += __shfl_xor(ss, 32);
    if (hi == 0) part[iloc * 4 + db] = ss;
    LBAR();
    const f32x4 pp = *(const LAS f32x4*)(part + iloc * 4);
    const float rs = 1.0f / sqrtf(((pp[0] + pp[1]) + (pp[2] + pp[3])) * (1.0f / 128.0f) + EPS);
    bf16* yp = (bf16*)(F.ap->ws + WS_BUFA) + tok * D + 512 + h * 128 + 32 * db + 4 * hi;
#pragma unroll
    for (int gi = 0; gi < 4; ++gi) { const u32x2 g = gg[gi];
        u32x2 y; y.x = pk2(oc[4 * gi + 0] * rs * silu(bflo(g.x)), oc[4 * gi + 1] * rs * silu(bfhi(g.x))); y.y = pk2(oc[4 * gi + 2] * rs * silu(bflo(g.y)), oc[4 * gi + 3] * rs * silu(bfhi(g.y)));
        *(u32x2*)(yp + 8 * gi) = y; }
    LBAR();
}

constexpr int XKS = 264, XVS = 288;
__device__ __forceinline__ void xattn_unit(Frame& F, int layer, int unit) {
    const int h = unit & 3, rt = unit >> 2, b = rt >> 5;
    const int tid = launder((F.wave * 64 + mk_lane())), lane = tid & 63, w = F.wave, r32 = lane & 31, hi = lane >> 5;
    LAS bf16* buf0 = (LAS bf16*)F.lds; LAS bf16* buf1 = buf0 + 64 * XVS;
    const bf16* Kg = (const bf16*)(F.ap->ws + WS_KV) + ((size_t)layer * BATCH * MEMLEN + (size_t)b * MEMLEN) * 2048 + h * 256;
    const size_t row = (size_t)rt * 256 + w * 32 + r32;
    const bf16* qp = (const bf16*)(F.ap->ws + WS_BUFB) + row * D + h * 256 + 8 * hi;
    const bf16* gsrc = Kg + (size_t)(tid >> 5) * 2048 + (tid & 31) * 8;
    const int ldst = (tid >> 5) * XKS + (tid & 31) * 8, ldstv = (tid >> 5) * XVS + (tid & 31) * 8;
    u32x4 pf[4];
#define XLOAD(blk) do { _Pragma("unroll") for (int i_ = 0; i_ < 4; ++i_) pf[i_] = *(const u32x4*)(gsrc + (size_t)((((blk) & 3) * 64 + 16 * i_) * 2048 + ((blk) >= 4 ? 1024 : 0))); } while (0)
#define XSTORE(bufp) do { _Pragma("unroll") for (int i_ = 0; i_ < 4; ++i_) *(LAS u32x4*)((bufp) + ldst + 16 * i_ * XKS) = pf[i_]; } while (0)
#define XSTOREV(bufp) do { _Pragma("unroll") for (int i_ = 0; i_ < 4; ++i_) *(LAS u32x4*)((bufp) + ldstv + 16 * i_ * XVS) = pf[i_]; } while (0)
    __syncthreads();
    XLOAD(0);
    bf16x8 qf[8];
    LAS bf16* qs = (LAS bf16*)(F.lds + 73728) + w * (32 * 136) + r32 * 136 + 8 * hi;
#pragma unroll
    for (int s = 0; s < 8; ++s) qf[s] = *(const bf16x8*)(qp + 16 * s);
#pragma unroll
    for (int s = 0; s < 8; ++s) { const bf16x8 t = *(const bf16x8*)(qp + 128 + 16 * s); *(LAS bf16x8*)(qs + 16 * s) = t; }
    XSTORE(buf0);
    XLOAD(1);
    LBAR();
    f32x16 st[8];
#pragma unroll
    for (int kblk = 0; kblk < 4; ++kblk) {
        const LAS bf16* cur = (kblk & 1) ? buf1 : buf0; LAS bf16* nxt = (kblk & 1) ? buf0 : buf1;
#pragma unroll
        for (int kk = 0; kk < 2; ++kk) { f32x16 acc = (f32x16){};
#pragma unroll
            for (int s = 0; s < 8; ++s) { const bf16x8 a = *(const LAS bf16x8*)(cur + (32 * kk + r32) * XKS + 16 * s + 8 * hi); acc = MFMA32(a, qf[s], acc); }
#pragma unroll
            for (int s = 0; s < 8; ++s) { const bf16x8 a = *(const LAS bf16x8*)(cur + (32 * kk + r32) * XKS + 128 + 16 * s + 8 * hi); const bf16x8 q = *(const LAS bf16x8*)(qs + 16 * s); acc = MFMA32(a, q, acc); }
            st[2 * kblk + kk] = acc; }
        if (kblk < 3) XSTORE(nxt); else XSTOREV(nxt);
        XLOAD(kblk + 2);
        LBAR();
    }
    float mx = -3.0e38f;
#pragma unroll
    for (int kb = 0; kb < 8; ++kb)
#pragma unroll
        for (int i = 0; i < 16; ++i) mx = fmaxf(mx, st[kb][i]);
    mx = fmaxf(mx, __shfl_xor(mx, 32));
    const float SC = 0.0625f * 1.4426950408889634f;
    float sum = 0.f;
#pragma unroll
    for (int kb = 0; kb < 8; ++kb)
#pragma unroll
        for (int i = 0; i < 16; ++i) { const float p = exp2f((st[kb][i] - mx) * SC); st[kb][i] = p; sum += p; }
    sum += __shfl_xor(sum, 32);
    const float inv = 1.0f / sum;
    bf16x8 pw[8][2];
#pragma unroll
    for (int kb = 0; kb < 8; ++kb)
#pragma unroll
        for (int s = 0; s < 2; ++s) pw[kb][s] = pack8(st[kb][8 * s + 0] * inv, st[kb][8 * s + 1] * inv, st[kb][8 * s + 2] * inv, st[kb][8 * s + 3] * inv, st[kb][8 * s + 4] * inv, st[kb][8 * s + 5] * inv, st[kb][8 * s + 6] * inv, st[kb][8 * s + 7] * inv);
    f32x16 o[8];
#pragma unroll
    for (int db = 0; db < 8; ++db) o[db] = (f32x16){};
#pragma unroll
    for (int vblk = 0; vblk < 4; ++vblk) {
        const LAS bf16* cur = (vblk & 1) ? buf1 : buf0; LAS bf16* nxt = (vblk & 1) ? buf0 : buf1;
#pragma unroll
        for (int kk = 0; kk < 2; ++kk)
#pragma unroll
            for (int s = 0; s < 2; ++s)
#pragma unroll
                for (int db = 0; db < 8; ++db) { const bf16x8 vf = tr_frag(cur, XVS, 32 * kk + 16 * s, 32 * db, lane); o[db] = MFMA32(vf, pw[2 * vblk + kk][s], o[db]); }
        if (vblk < 3) XSTOREV(nxt);
        if (vblk < 2) XLOAD(vblk + 6);
        LBAR();
    }
#undef XLOAD
#undef XSTORE
#undef XSTOREV
    bf16* op = (bf16*)(F.ap->ws + WS_BUFA) + row * D + h * 256 + 4 * hi;
#pragma unroll
    for (int db = 0; db < 8; ++db)
#pragma unroll
        for (int gi = 0; gi < 4; ++gi) { u32x2 y; y.x = pk2(o[db][4 * gi], o[db][4 * gi + 1]); y.y = pk2(o[db][4 * gi + 2], o[db][4 * gi + 3]); *(u32x2*)(op + 32 * db + 8 * gi) = y; }
}

__device__ __forceinline__ void conv_phase(Frame& F) {
    const bf16* Z = (const bf16*)(F.ap->ws + WS_BIG); const bf16* G2 = Z + (size_t)MTOK * D; bf16* Y = (bf16*)(F.ap->ws + WS_BUFA);
    const float* cw = F.ap->in[8]; const float* cb = F.ap->in[9];
    for (int it = F.bid * NTHR + launder(F.wave * 64 + mk_lane()); it < (MTOK / 8) * 128; it += F.G * NTHR) {
        const int cgi = it & 127, tg = it >> 7, col = cgi * 8, t0 = tg * 8;
        const bool first = (t0 & (SEQ - 1)) == 0;
        u32x4 zr[10], gr[8];
#pragma unroll
        for (int i = 0; i < 10; ++i) { zr[i] = (u32x4){0u, 0u, 0u, 0u}; if (i >= 2 || !first) zr[i] = *(const u32x4*)(Z + (size_t)(t0 - 2 + i) * D + col); }
#pragma unroll
        for (int i = 0; i < 8; ++i) gr[i] = *(const u32x4*)(G2 + (size_t)(t0 + i) * D + col);
        float w0[8], w1[8], w2[8], bs[8];
#pragma unroll
        for (int e = 0; e < 8; ++e) { w0[e] = cw[col + e]; w1[e] = cw[D + col + e]; w2[e] = cw[2 * D + col + e]; bs[e] = cb[col + e]; }
#pragma unroll
        for (int tt = 0; tt < 8; ++tt) {
            float y[8];
#pragma unroll
            for (int e = 0; e < 4; ++e) {
                const float cv0 = bs[2 * e] + bflo(zr[tt][e]) * w0[2 * e] + bflo(zr[tt + 1][e]) * w1[2 * e] + bflo(zr[tt + 2][e]) * w2[2 * e];
                const float cv1 = bs[2 * e + 1] + bfhi(zr[tt][e]) * w0[2 * e + 1] + bfhi(zr[tt + 1][e]) * w1[2 * e + 1] + bfhi(zr[tt + 2][e]) * w2[2 * e + 1];
                y[2 * e] = bflo(gr[tt][e]) * cv0; y[2 * e + 1] = bfhi(gr[tt][e]) * cv1; }
            u32x4 o; o.x = pk2(y[0], y[1]); o.y = pk2(y[2], y[3]); o.z = pk2(y[4], y[5]); o.w = pk2(y[6], y[7]);
            *(u32x4*)(Y + (size_t)(t0 + tt) * D + col) = o;
        }
    }
}

__device__ __forceinline__ void final_phase(Frame& F) {
    const int gw = F.bid * NWAVES + F.wave, NGW = F.G * NWAVES, lane = mk_lane();
    const float* ssp = (const float*)(F.ap->ws + WS_SSP);
    const f32x4* gr = (const f32x4*)F.ap->in[16] + lane;
    f32x4 g[4];
#pragma unroll
    for (int j = 0; j < 4; ++j) g[j] = gr[64 * j];
    for (int row = 2 * gw; row < MTOK; row += 2 * NGW) {
        f32x4 pv[2][4], xv[2][4];
#pragma unroll
        for (int t = 0; t < 2; ++t) { const f32x4* p = (const f32x4*)(ssp + (size_t)(row + t) * 16); const f32x4* xr = (const f32x4*)(F.ap->out + (size_t)(row + t) * D) + lane;
#pragma unroll
            for (int j = 0; j < 4; ++j) { pv[t][j] = p[j]; xv[t][j] = xr[64 * j]; } }
#pragma unroll
        for (int t = 0; t < 2; ++t) {
            const float s = ((pv[t][0][0] + pv[t][0][1]) + (pv[t][0][2] + pv[t][0][3])) + ((pv[t][1][0] + pv[t][1][1]) + (pv[t][1][2] + pv[t][1][3])) + ((pv[t][2][0] + pv[t][2][1]) + (pv[t][2][2] + pv[t][2][3])) + ((pv[t][3][0] + pv[t][3][1]) + (pv[t][3][2] + pv[t][3][3]));
            const float rs = 1.0f / sqrtf(s * (1.0f / D) + EPS);
            f32x4* xr = (f32x4*)(F.ap->out + (size_t)(row + t) * D) + lane;
#pragma unroll
            for (int j = 0; j < 4; ++j) xr[64 * j] = xv[t][j] * rs * g[j]; }
    }
}

#ifndef TS_PROBE
#define TS_PROBE 0
#endif
#define TS_A_HI 5
#define TS_A_LO 2
#define TS_B_HI 1
#define TS_B_LO 0
#ifndef DUP_MASK
#define DUP_MASK 0
#endif
__device__ __forceinline__ bool PHASE_ENTER_(Frame& F) { asm volatile("" : "+s"(F.bid), "+s"(F.G), "+s"(F.wave)); return true; }
#define REP(k) _Pragma("unroll 1") for (int rep_ = 0; rep_ < ((((DUP_MASK) >> (k)) & 1) + 1); ++rep_) if (PHASE_ENTER_(F))
#ifndef MK_SPLIT
#define MK_SPLIT 0
#endif
constexpr int NPHASE = 16;
__global__ void __launch_bounds__(NTHR, 2) fwd_megakernel(Args args) {
    extern __shared__ __attribute__((aligned(16))) unsigned char lds_raw[];
    cg::grid_group grid = cg::this_grid();
    Frame F;
    F.lds = (LAS unsigned char*)lds_raw; F.wave = __builtin_amdgcn_readfirstlane((int)threadIdx.x >> 6); F.G = gridDim.x; F.bid = blockIdx.x;
    F.ap = (const Args*)__builtin_amdgcn_kernarg_segment_ptr();
    if ((F.wave * 64 + mk_lane()) < 2) ((LAS unsigned*)(F.lds + XB_LDS_OFF))[(F.wave * 64 + mk_lane())] = 0u;
    __syncthreads();
    const XcdBarrier xbar = xcd_barrier_post((unsigned*)(args.ws + XB_WS_OFF), (volatile LAS unsigned*)(F.lds + XB_LDS_OFF), F.wave);
    const int lo = args.ph_lo, hi = args.ph_hi;
    if (hi > NPHASE) grid.sync();
#define PHASE_ENTER() do { asm volatile("" : "+s"(F.bid), "+s"(F.G), "+s"(F.wave)); } while (0)
#define IN(k) (lo <= (k) && (k) < hi)
#define SEAM(k) do { if (IN(k) && IN((k) + 1)) xcd_barrier(xbar); STAMP((k) + 1); } while (0)
    typedef pg8::EpiScaleBf16<true> EpiS; typedef pg8::EpiScaleBf16<false> EpiN;
#define ws (F.ap->ws)
#define XB ((bf16*)(ws + WS_XB))
#define SSP ((float*)(ws + WS_SSP))
#define BIG ((bf16*)(ws + WS_BIG))
#define BUFA ((bf16*)(ws + WS_BUFA))
#define BUFB ((bf16*)(ws + WS_BUFB))

#if TS_PROBE
#define STAMP(i) do { if (blockIdx.x == 0 && threadIdx.x == 0) ((unsigned long long*)ws)[i] = __builtin_amdgcn_s_memrealtime(); } while (0)
#else
#define STAMP(i) do { } while (0)
#endif
    STAMP(0);
    REP(0) {
    if (IN(0)) { p0_prologue(F); } SEAM(0); }
    REP(1) {
    if (IN(1)) {
        { pg8::Gemm g{XB, (const bf16*)(ws + WS_WEIN), MTOK, EIN, D}; pg8::StaticOrder S; S.init(MTOK, EIN, F.G, F.bid); pg8::rs_prepass((LAS float*)(F.lds + 131072), S, SSP, (F.wave * 64 + mk_lane())); EpiS E{BIG, EIN, (const LAS float*)(F.lds + 131072)};
          pg8::gemm_phase<EpiS, pg8::StaticOrder, true, true>(F.lds, g, S, E, F.wave); }
#pragma unroll 1
        for (int l = 0; l < 2; ++l) { pg8::Gemm g{(const bf16*)(ws + WS_MEMN) + (size_t)l * BATCH * MEMLEN * D, (const bf16*)(ws + WS_WKV) + (size_t)l * 2 * D * D, BATCH * MEMLEN, 2 * D, D};
          pg8::StaticOrder S; S.init(BATCH * MEMLEN, 2 * D, F.G, (F.bid + F.G - (F.G / 2 + 32 * l) % F.G) % F.G); EpiN E{(bf16*)(ws + WS_KV) + (size_t)l * BATCH * MEMLEN * 2 * D, 2 * D, nullptr};
          pg8::gemm_phase<EpiN, pg8::StaticOrder, true, true>(F.lds, g, S, E, F.wave); }
    } SEAM(1); }
    REP(2) {
    if (IN(2)) {
        { R1Pre P; if (F.bid < BATCH * NCH * 4) ret1_load(F, F.bid, P); __syncthreads();
          for (int it = F.bid; it < BATCH * NCH * 4; it += F.G) ret1_item(F, it, P, it + F.G, BATCH * NCH * 4); }
        { SwPre Q; if (F.bid < BATCH * NCH * 2) swa_load(F, F.bid, Q); __syncthreads();
          for (int it = F.bid; it < BATCH * NCH * 2; it += F.G) swa_item(F, it, Q, it + F.G, BATCH * NCH * 2); }
    } SEAM(2); }
    REP(3) {
    if (IN(3)) { scan_phase(F); } SEAM(3); }
    REP(4) {
    if (IN(4)) { R2Pre P; if (F.bid < BATCH * NCH * 4) ret2_load(F, F.bid, P); __syncthreads();
        for (int it = F.bid; it < BATCH * NCH * 4; it += F.G) ret2_item(F, it, P, it + F.G, BATCH * NCH * 4); } SEAM(4); }
    REP(5) {
    if (IN(5)) {
        pg8::Gemm g{BUFA, (const bf16*)(ws + WS_WEOUT), MTOK, D, D}; pg8::StaticOrder S; S.init(MTOK, D, F.G, F.bid); typedef pg8::EpiResidual<true, false> EpiR0; EpiR0 E{F.ap->in[0], XB, SSP, D};
        pg8::gemm_phase<EpiR0, pg8::StaticOrder, true, true>(F.lds, g, S, E, F.wave);
    } SEAM(5); }
#pragma unroll
    for (int l = 0; l < 2; ++l) {
        const int pb = (l == 0) ? 6 : 12;
        REP(pb) {
        if (IN(pb)) {
            pg8::Gemm g{XB, (const bf16*)(ws + WS_WQ) + (size_t)l * D * D, MTOK, D, D}; pg8::StaticOrder S; S.init(MTOK, D, F.G, F.bid); pg8::rs_prepass((LAS float*)(F.lds + 131072), S, SSP, (F.wave * 64 + mk_lane())); EpiS E{BUFB, D, (const LAS float*)(F.lds + 131072)};
            pg8::gemm_phase<EpiS, pg8::StaticOrder, true, true>(F.lds, g, S, E, F.wave);
        } SEAM(pb); }
        REP(pb + 1) {
        if (IN(pb + 1)) { for (int it = F.bid; it < (MTOK / 256) * 4; it += F.G) xattn_unit(F, l, it); } SEAM(pb + 1); }
        REP(pb + 2) {
        if (IN(pb + 2)) {
            pg8::Gemm g{BUFA, (const bf16*)(ws + WS_WO) + (size_t)l * D * D, MTOK, D, D}; pg8::StaticOrder S; S.init(MTOK, D, F.G, F.bid); if (l == 0) { typedef pg8::EpiResidual<false, false> EpiR1; EpiR1 E{XB, XB, SSP, D}; pg8::gemm_phase<EpiR1, pg8::StaticOrder, true, true>(F.lds, g, S, E, F.wave); }
            else { typedef pg8::EpiResidual<false, true> EpiR2; EpiR2 E{XB, F.ap->out, SSP, D}; pg8::gemm_phase<EpiR2, pg8::StaticOrder, true, true>(F.lds, g, S, E, F.wave); }
        } SEAM(pb + 2); }
        if (l == 0) {
            REP(9) {
            if (IN(9)) {
                pg8::Gemm g{XB, (const bf16*)(ws + WS_WOIN), MTOK, OIN, D}; pg8::StaticOrder S; S.init(MTOK, OIN, F.G, F.bid); pg8::rs_prepass((LAS float*)(F.lds + 131072), S, SSP, (F.wave * 64 + mk_lane()));
                pg8::EpiConv E{BIG, BIG + (size_t)MTOK * D, (const LAS float*)(F.lds + 131072)};
                pg8::gemm_phase<pg8::EpiConv, pg8::StaticOrder, true, true>(F.lds, g, S, E, F.wave);
            } SEAM(9); }
            REP(10) {
            if (IN(10)) { conv_phase(F); } SEAM(10); }
            REP(11) {
            if (IN(11)) {
                pg8::Gemm g{BUFA, (const bf16*)(ws + WS_WOOUT), MTOK, D, D}; pg8::StaticOrder S; S.init(MTOK, D, F.G, F.bid); typedef pg8::EpiResidual<false, false> EpiR1; EpiR1 E{XB, XB, SSP, D};
                pg8::gemm_phase<EpiR1, pg8::StaticOrder, true, true>(F.lds, g, S, E, F.wave);
            } SEAM(11); }
        }
    }
    if (IN(15)) { final_phase(F); }
#if TS_PROBE
    __syncthreads();
    if (blockIdx.x == 0 && threadIdx.x == 0) { const unsigned long long* ts = (const unsigned long long*)ws;
        const float ta = (float)(ts[TS_A_HI] - ts[TS_A_LO]) * 0.01f, tb = (float)(ts[TS_B_HI] - ts[TS_B_LO]) * 0.01f;
        F.ap->out[0] = ta; for (int i = 1; i <= 1000; ++i) F.ap->out[i] = tb; }
#endif
#undef IN
#undef SEAM
#undef ws
#undef XB
#undef SSP
#undef BIG
#undef BUFA
#undef BUFB
}

extern "C" void kernel_launch(void* const* d_in, const int* in_sizes, int n_in, void* d_out, int out_size, void* d_ws, size_t ws_size, hipStream_t stream) {
    static int grid = 0;
    if (grid == 0) {
        if (n_in != 17 || out_size != MTOK * D || ws_size < WS_END) { fprintf(stderr, "kernel_launch: unexpected shapes (n_in %d out %d ws %zu)\n", n_in, out_size, ws_size); grid = -1; return; }
        int dev = 0, cus = 0, per_cu = 0;
        hipGetDevice(&dev); hipDeviceGetAttribute(&cus, hipDeviceAttributeMultiprocessorCount, dev);
        if (hipFuncSetAttribute((const void*)fwd_megakernel, hipFuncAttributeMaxDynamicSharedMemorySize, LDS_BYTES) != hipSuccess) { fprintf(stderr, "kernel_launch: hipFuncSetAttribute failed\n"); grid = -1; return; }
        if (hipOccupancyMaxActiveBlocksPerMultiprocessor(&per_cu, (const void*)fwd_megakernel, NTHR, LDS_BYTES) != hipSuccess || per_cu < 1) { fprintf(stderr, "kernel_launch: occupancy query says %d\n", per_cu); per_cu = 1; }
        (void)hipGetLastError();
        grid = cus;
    }
    if (grid < 0) return;
    if (hipMemsetAsync(d_ws, 0, 65536, stream) != hipSuccess) { fprintf(stderr, "kernel_launch: hipMemsetAsync failed\n"); return; }
    Args a{};
    for (int i = 0; i < 17; ++i) a.in[i] = (const float*)d_in[i];
    a.out = (float*)d_out; a.ws = (unsigned char*)d_ws;
#if MK_SPLIT
    for (int p = 0; p < NPHASE; ++p) { a.ph_lo = p; a.ph_hi = p + 1; hipLaunchKernelGGL(fwd_megakernel, dim3(grid), dim3(NTHR), LDS_BYTES, stream, a); }
#else
    a.ph_lo = 0; a.ph_hi = NPHASE;
    void* kargs[] = {&a};
    hipError_t e = hipLaunchCooperativeKernel((const void*)fwd_megakernel, dim3(grid), dim3(NTHR), kargs, LDS_BYTES, stream);
    if (e != hipSuccess) fprintf(stderr, "kernel_launch: cooperative launch failed: %s (grid %d)\n", hipGetErrorString(e), grid);
#endif
}
```

```cpp
#include <hip/hip_runtime.h>
#include <hip/hip_cooperative_groups.h>
#include <cstdio>
#include <cstdint>
namespace cg = cooperative_groups;
__device__ __forceinline__ int mk_lane() { int l = (int)__builtin_amdgcn_mbcnt_hi(~0u, __builtin_amdgcn_mbcnt_lo(~0u, 0u)); asm volatile("" : "+v"(l)); return l; }
__device__ __forceinline__ float shx(float v, int mask) { return __int_as_float(__builtin_amdgcn_ds_bpermute((mk_lane() ^ mask) << 2, __float_as_int(v))); }
namespace pg8 {
#define PG8_LAS __attribute__((address_space(3)))
typedef unsigned short bf16_t;
typedef short bf16x8 __attribute__((ext_vector_type(8)));
typedef float f32x4 __attribute__((ext_vector_type(4)));
typedef unsigned u32x4 __attribute__((ext_vector_type(4)));
constexpr int BM = 256, BK = 64, HALF = 128, HTB = HALF * BK * 2  , STAGE_BYTES = 8 * HTB, NXCD = 8, WGM = 8;

__host__ __device__ __forceinline__ int lds_byte(int r, int c) { const int st = (r >> 4) * 2 + (c >> 5), rr = r & 15, cc = c & 31, ob = rr * 64 + cc * 2; return st * 1024 + (ob ^ (((ob >> 9) & 1) << 5)); }
__host__ __device__ __forceinline__ void stage_rc(int b, int& R, int& C) { const int st = b / 1024, sb = b % 1024, swz = sb ^ (((sb >> 9) & 1) << 5); R = (st >> 1) * 16 + swz / 64; C = (st & 1) * 32 + (swz % 64) / 2; }
__host__ __device__ __forceinline__ int perm32(int rho) { const int n = rho >> 4, i = rho & 15; return 8 * (i >> 2) + 4 * n + (i & 3); }

struct Unit { int pm, pn, idx; };
struct Gemm { const bf16_t* A; const bf16_t* Bt; int M, N, K; size_t bb_stride = 0; int bb_shift = 0; };

struct StaticOrder {
    int nM, nN, nwg, G, c;
    __host__ __device__ void init(int M, int N, int G_, int c_) { nM = M / BM; nN = N / BM; nwg = nM * nN; G = G_; c = c_; }
    __host__ __device__ bool next(int i, Unit& u) const {
        const long L = (long)i * G + c; if (L >= nwg) return false;
        int wgid = (int)L; { const int q = nwg / NXCD, r = nwg % NXCD, xcd = wgid % NXCD, off = wgid / NXCD; wgid = (xcd < r ? xcd * (q + 1) : r * (q + 1) + (xcd - r) * q) + off; }
        const int nig = WGM * nN, gid = wgid / nig, fm = gid * WGM, gsz = (nM - fm) < WGM ? (nM - fm) : WGM;
        u.pm = fm + ((wgid % nig) % gsz); u.pn = (wgid % nig) / gsz; u.idx = i; return true;
    }
    __device__ __forceinline__ void a_ready(const Unit&) const {}
    __device__ __forceinline__ void done(const Unit&) const {}
};

typedef float f32x2 __attribute__((ext_vector_type(2))); typedef __bf16 bf16x2_t __attribute__((ext_vector_type(2)));
__device__ __forceinline__ unsigned cvt_pk_bf16(float lo, float hi) { const f32x2 v = {lo, hi}; const bf16x2_t b = __builtin_convertvector(v, bf16x2_t); return __builtin_bit_cast(unsigned, b); }
template <bool SCALE> struct EpiScaleBf16 {
    static constexpr bool PERM = true, AFTER_DRAIN = false;
    bf16_t* O; int ldc; const PG8_LAS float* rs;
    __device__ __forceinline__ void operator()(const f32x4 (&acc)[2][2][4][2], const Unit& u, int wr, int wc, int fr, int fq) const {
        const int rl0 = wr * 64 + fr; const int col0 = u.pn * BM + wc * 32 + 8 * fq;
#pragma unroll
        for (int ai = 0; ai < 2; ++ai)
#pragma unroll
            for (int m = 0; m < 4; ++m) {
                const float sc = SCALE ? rs[256 * u.idx + rl0 + ai * HALF + m * 16] : 1.f;
                bf16_t* rowp = O + (size_t)(u.pm * BM + rl0 + ai * HALF + m * 16) * ldc + col0;
#pragma unroll
                for (int bj = 0; bj < 2; ++bj) { const f32x4 v0 = acc[ai][bj][m][0] * sc, v1 = acc[ai][bj][m][1] * sc;
                    u32x4 w; w.x = cvt_pk_bf16(v0[0], v0[1]); w.y = cvt_pk_bf16(v0[2], v0[3]); w.z = cvt_pk_bf16(v1[0], v1[1]); w.w = cvt_pk_bf16(v1[2], v1[3]);
                    *(u32x4*)(rowp + bj * HALF) = w; }
            }
    }
};
struct EpiDense {
    static constexpr bool PERM = true, AFTER_DRAIN = false;
    bf16_t* O; int nb;
    __device__ __forceinline__ void operator()(const f32x4 (&acc)[2][2][4][2], const Unit& u, int wr, int wc, int fr, int fq) const {
        bf16_t* base = O + (size_t)(u.pm * nb + u.pn) * 65536 + (wr * 64 + fr) * 256 + wc * 32 + 8 * fq;
#pragma unroll
        for (int ai = 0; ai < 2; ++ai)
#pragma unroll
            for (int m = 0; m < 4; ++m)
#pragma unroll
                for (int bj = 0; bj < 2; ++bj) { const f32x4 v0 = acc[ai][bj][m][0], v1 = acc[ai][bj][m][1];
                    u32x4 w; w.x = cvt_pk_bf16(v0[0], v0[1]); w.y = cvt_pk_bf16(v0[2], v0[3]); w.z = cvt_pk_bf16(v1[0], v1[1]); w.w = cvt_pk_bf16(v1[2], v1[3]);
                    *(u32x4*)(base + (ai * HALF + m * 16) * 256 + bj * HALF) = w; }
    }
};
struct EpiSoftmax {
    static constexpr bool PERM = true, AFTER_DRAIN = false;
    bf16_t* O; const PG8_LAS float* rs; PG8_LAS float* mxs; PG8_LAS float* sms;
    __device__ __forceinline__ void operator()(f32x4 (&acc)[2][2][4][2], const Unit& u, int wr, int wc, int fr, int fq) const {
        const int rl0 = wr * 64 + fr; const int col0 = u.pn * BM + wc * 32 + 8 * fq;
#pragma unroll
        for (int ai = 0; ai < 2; ++ai)
#pragma unroll
            for (int m = 0; m < 4; ++m) { const int rl = rl0 + ai * HALF + m * 16; const float sc = rs[256 * u.idx + rl] * (0.0625f * 1.4426950408889634f);
                float mx = -3.0e38f;
#pragma unroll
                for (int bj = 0; bj < 2; ++bj)
#pragma unroll
                    for (int n = 0; n < 2; ++n) { acc[ai][bj][m][n] = acc[ai][bj][m][n] * sc; const f32x4 v = acc[ai][bj][m][n]; mx = fmaxf(mx, fmaxf(fmaxf(v[0], v[1]), fmaxf(v[2], v[3]))); }
                mx = fmaxf(mx, shx(mx, 16)); mx = fmaxf(mx, shx(mx, 32));
                if (fq == 0) mxs[rl * 4 + wc] = mx; }
        asm volatile("s_waitcnt lgkmcnt(0)\n\ts_barrier" ::: "memory");
#pragma unroll
        for (int ai = 0; ai < 2; ++ai)
#pragma unroll
            for (int m = 0; m < 4; ++m) { const int rl = rl0 + ai * HALF + m * 16; const f32x4 pm4 = *(const PG8_LAS f32x4*)(mxs + rl * 4);
                const float mx = fmaxf(fmaxf(pm4[0], pm4[1]), fmaxf(pm4[2], pm4[3]));
                float sm = 0.f;
#pragma unroll
                for (int bj = 0; bj < 2; ++bj)
#pragma unroll
                    for (int n = 0; n < 2; ++n) { f32x4 v = acc[ai][bj][m][n];
                        v[0] = __builtin_amdgcn_exp2f(v[0] - mx); v[1] = __builtin_amdgcn_exp2f(v[1] - mx); v[2] = __builtin_amdgcn_exp2f(v[2] - mx); v[3] = __builtin_amdgcn_exp2f(v[3] - mx);
                        acc[ai][bj][m][n] = v; sm += (v[0] + v[1]) + (v[2] + v[3]); }
                sm += shx(sm, 16); sm += shx(sm, 32);
                if (fq == 0) sms[rl * 4 + wc] = sm; }
        asm volatile("s_waitcnt lgkmcnt(0)\n\ts_barrier" ::: "memory");
#pragma unroll
        for (int ai = 0; ai < 2; ++ai)
#pragma unroll
            for (int m = 0; m < 4; ++m) { const int rl = rl0 + ai * HALF + m * 16; const f32x4 ps4 = *(const PG8_LAS f32x4*)(sms + rl * 4);
                const float inv = 1.0f / ((ps4[0] + ps4[1]) + (ps4[2] + ps4[3]));
                bf16_t* rowp = O + (size_t)(u.pm * BM + rl) * 1024 + col0;
#pragma unroll
                for (int bj = 0; bj < 2; ++bj) { const f32x4 v0 = acc[ai][bj][m][0] * inv, v1 = acc[ai][bj][m][1] * inv;
                    u32x4 w; w.x = cvt_pk_bf16(v0[0], v0[1]); w.y = cvt_pk_bf16(v0[2], v0[3]); w.z = cvt_pk_bf16(v1[0], v1[1]); w.w = cvt_pk_bf16(v1[2], v1[3]);
                    *(u32x4*)(rowp + bj * HALF) = w; } }
        asm volatile("s_waitcnt lgkmcnt(0)\n\ts_barrier" ::: "memory");
    }
};
template <class Sched> __device__ __forceinline__ void rs_prepass(PG8_LAS float* rs, const Sched& S, const float* ssp, int tid) {
    const int row = tid >> 1, half = tid & 1;
    f32x4 v[8][2]; bool have[8];
#pragma unroll
    for (int i = 0; i < 8; ++i) { Unit u; have[i] = S.next(i, u);
        if (have[i]) { const f32x4* p = (const f32x4*)(ssp + (size_t)(u.pm * BM + row) * 16) + 2 * half; v[i][0] = p[0]; v[i][1] = p[1]; } }
#pragma unroll
    for (int i = 0; i < 8; ++i) if (have[i]) {
        float s = ((v[i][0][0] + v[i][0][1]) + (v[i][0][2] + v[i][0][3])) + ((v[i][1][0] + v[i][1][1]) + (v[i][1][2] + v[i][1][3]));
        s += shx(s, 1);
        if (half == 0) rs[256 * i + row] = 1.0f / sqrtf(s * (1.0f / 1024.0f) + 1e-6f); }
    __syncthreads();
}
struct EpiConv {
    static constexpr bool PERM = true, AFTER_DRAIN = false;
    bf16_t* Z; bf16_t* G2; const PG8_LAS float* rs;
    __device__ __forceinline__ void operator()(const f32x4 (&acc)[2][2][4][2], const Unit& u, int wr, int wc, int fr, int fq) const {
        const int rl0 = wr * 64 + fr; const int c = 64 * u.pn + 32 * (wc & 1) + 8 * fq;
        bf16_t* O = (wc < 2) ? Z : G2;
#pragma unroll
        for (int ai = 0; ai < 2; ++ai)
#pragma unroll
            for (int m = 0; m < 4; ++m) {
                const float sc = rs[256 * u.idx + rl0 + ai * HALF + m * 16];
                float v[8];
#pragma unroll
                for (int n = 0; n < 2; ++n)
#pragma unroll
                    for (int e = 0; e < 4; ++e) { const float a = acc[ai][0][m][n][e] * sc, b = acc[ai][1][m][n][e] * sc;
                        v[4 * n + e] = (wc < 2) ? a * b : a * (b / (1.0f + __expf(-b))); }
                u32x4 w; w.x = cvt_pk_bf16(v[0], v[1]); w.y = cvt_pk_bf16(v[2], v[3]); w.z = cvt_pk_bf16(v[4], v[5]); w.w = cvt_pk_bf16(v[6], v[7]);
                *(u32x4*)(O + (size_t)(u.pm * BM + rl0 + ai * HALF + m * 16) * 1024 + c) = w;
            }
    }
};
template <bool BASE_F32, bool OUT_F32> struct EpiResidual {
    static constexpr bool PERM = true, AFTER_DRAIN = false;
    const void* base; void* out; float* ssp; int ldc;
    __device__ __forceinline__ void operator()(const f32x4 (&acc)[2][2][4][2], const Unit& u, int wr, int wc, int fr, int fq) const {
        const int row0 = u.pm * BM + wr * 64 + fr; const int col0 = u.pn * BM + wc * 32 + 8 * fq;
#pragma unroll
        for (int ai = 0; ai < 2; ++ai)
#pragma unroll
          for (int mh = 0; mh < 2; ++mh) {
            u32x4 pb[2][2]; f32x4 fb[2][2][2];
#pragma unroll
            for (int m2 = 0; m2 < 2; ++m2)
#pragma unroll
                for (int bj = 0; bj < 2; ++bj) { const size_t off = (size_t)(row0 + ai * HALF + (2 * mh + m2) * 16) * ldc + col0 + bj * HALF;
                    if (BASE_F32) { fb[m2][bj][0] = *(const f32x4*)((const float*)base + off); fb[m2][bj][1] = *(const f32x4*)((const float*)base + off + 4); }
                    else pb[m2][bj] = *(const u32x4*)((const bf16_t*)base + off); }
#pragma unroll
            for (int m2 = 0; m2 < 2; ++m2) {
                const int m = 2 * mh + m2, row = row0 + ai * HALF + m * 16;
                float ss = 0.f;
#pragma unroll
                for (int bj = 0; bj < 2; ++bj) { const size_t off = (size_t)row * ldc + col0 + bj * HALF;
                    f32x4 b0, b1;
                    if (BASE_F32) { b0 = fb[m2][bj][0]; b1 = fb[m2][bj][1]; }
                    else { const u32x4 w = pb[m2][bj];
                        b0 = (f32x4){__uint_as_float(w.x << 16), __uint_as_float(w.x & 0xffff0000u), __uint_as_float(w.y << 16), __uint_as_float(w.y & 0xffff0000u)};
                        b1 = (f32x4){__uint_as_float(w.z << 16), __uint_as_float(w.z & 0xffff0000u), __uint_as_float(w.w << 16), __uint_as_float(w.w & 0xffff0000u)}; }
                    const f32x4 o0 = b0 + acc[ai][bj][m][0], o1 = b1 + acc[ai][bj][m][1];
                    ss += ((o0[0] * o0[0] + o0[1] * o0[1]) + (o0[2] * o0[2] + o0[3] * o0[3])) + ((o1[0] * o1[0] + o1[1] * o1[1]) + (o1[2] * o1[2] + o1[3] * o1[3]));
                    if (OUT_F32) { *(f32x4*)((float*)out + off) = o0; *(f32x4*)((float*)out + off + 4) = o1; }
                    else { u32x4 w; w.x = cvt_pk_bf16(o0[0], o0[1]); w.y = cvt_pk_bf16(o0[2], o0[3]); w.z = cvt_pk_bf16(o1[0], o1[1]); w.w = cvt_pk_bf16(o1[2], o1[3]);
                        *(u32x4*)((bf16_t*)out + off) = w; } }
                ss += shx(ss, 16); ss += shx(ss, 32);
                if (fq == 0) ssp[(size_t)row * 16 + u.pn * 4 + wc] = ss;
            }
            asm volatile("" ::: "memory");
          }
    }
};
template <class Epi, class Sched, bool ALIGN_EPI = false, bool SP2 = false>
__device__ __forceinline__ void gemm_phase(PG8_LAS unsigned char* lds, const Gemm g, const Sched& S, const Epi& E, const int wave_in) {
    int tid_ = wave_in * 64 + mk_lane(); asm volatile("" : "+v"(tid_));
    const int tid = tid_, wid = __builtin_amdgcn_readfirstlane(tid >> 6), lane = tid & 63, wr = wid >> 2, wc = wid & 3, fr = lane & 15, fq = lane >> 4;
    const int K = g.K, nt = K / BK;
    unsigned voffA[2], voffB[2];
#pragma unroll
    for (int i = 0; i < 2; ++i) { int R, C; stage_rc(tid * 16 + i * 8192, R, C); const int Rb = Epi::PERM ? ((R & ~31) + perm32(R & 31)) : R;
        voffA[i] = (unsigned)(R * K + C) * 2u; voffB[i] = (unsigned)(Rb * K + C) * 2u; }
    const size_t kstep = (size_t)(BK * 2);
    const size_t hstep = (size_t)HALF * K * 2;
    const size_t tstep = 2 * hstep;
    const unsigned ldsw = (unsigned)wid * 1024u;
    const int aoff = lds_byte(wr * 64 + fr, fq * 8), boff = lds_byte(wc * 32 + fr, fq * 8);
#define PG8_SA(b, h) (((b) * 2 + (h)) * HTB)
#define PG8_SB(b, h) ((4 + (b) * 2 + (h)) * HTB)
#define PG8_STAGE(bufoff, gbase, voff) do { _Pragma("unroll") for (int _i = 0; _i < 2; ++_i) \
        __builtin_amdgcn_global_load_lds((const unsigned*)((const char*)(gbase) + (voff)[_i]), (PG8_LAS unsigned*)(lds + (bufoff) + ldsw + _i * 8192), 16, 0, 0); } while (0)
#define PG8_LDA(dst, b, h) do { _Pragma("unroll") for (int m = 0; m < 4; ++m) _Pragma("unroll") for (int k = 0; k < 2; ++k) dst[m][k] = *(const PG8_LAS bf16x8*)(lds + PG8_SA(b, h) + aoff + m * 2048 + k * 1024); } while (0)
#define PG8_LDB(dst, b, h) do { _Pragma("unroll") for (int n = 0; n < 2; ++n) _Pragma("unroll") for (int k = 0; k < 2; ++k) dst[n][k] = *(const PG8_LAS bf16x8*)(lds + PG8_SB(b, h) + boff + n * 2048 + k * 1024); } while (0)
#define PG8_MMA(ai, bj, At, Bt) do { __builtin_amdgcn_s_setprio(1); _Pragma("unroll") for (int m = 0; m < 4; ++m) _Pragma("unroll") for (int n = 0; n < 2; ++n) _Pragma("unroll") for (int k = 0; k < 2; ++k) \
        acc[ai][bj][m][n] = __builtin_amdgcn_mfma_f32_16x16x32_bf16(Bt[n][k], At[m][k], acc[ai][bj][m][n], 0, 0, 0); __builtin_amdgcn_s_setprio(0); } while (0)
#define PG8_WAIT_V(n) asm volatile("s_waitcnt vmcnt(" #n ")" ::: "memory")
#define PG8_WAIT_L(n) asm volatile("s_waitcnt lgkmcnt(" #n ")" ::: "memory")
#define PG8_BAR __builtin_amdgcn_s_barrier()
#define PG8_SCHED __builtin_amdgcn_sched_barrier(0)
    Unit cur, nxt; int ui = 0;
    if (!S.next(0, cur)) return;
    f32x4 acc[2][2][4][2];
#pragma unroll
    for (int a = 0; a < 2; ++a)
#pragma unroll
        for (int b = 0; b < 2; ++b)
#pragma unroll
            for (int m = 0; m < 4; ++m)
#pragma unroll
                for (int n = 0; n < 2; ++n) acc[a][b][m][n] = (f32x4){0.f, 0.f, 0.f, 0.f};
    bf16x8 At[4][2], B0[2][2], B1[2][2];
    const char* cA = (const char*)g.A + (size_t)cur.pm * tstep; const char* cB = (const char*)g.Bt + (size_t)cur.pn * tstep + (size_t)(cur.pm >> g.bb_shift) * g.bb_stride;
    S.a_ready(cur);
    if constexpr (SP2) {
        PG8_STAGE(PG8_SB(0, 0), cB, voffB); PG8_STAGE(PG8_SB(0, 1), cB + hstep, voffB); PG8_STAGE(PG8_SA(0, 0), cA, voffA); PG8_STAGE(PG8_SA(0, 1), cA + hstep, voffA);
        if (wr == 1) PG8_BAR;
        PG8_WAIT_V(2); PG8_BAR;
        PG8_STAGE(PG8_SB(1, 0), cB + kstep, voffB); PG8_STAGE(PG8_SA(1, 0), cA + kstep, voffA); PG8_STAGE(PG8_SB(1, 1), cB + hstep + kstep, voffB);
        PG8_WAIT_V(6); PG8_BAR;
    } else {
        PG8_STAGE(PG8_SB(0, 0), cB, voffB); PG8_STAGE(PG8_SA(0, 0), cA, voffA); PG8_STAGE(PG8_SB(0, 1), cB + hstep, voffB); PG8_STAGE(PG8_SA(0, 1), cA + hstep, voffA);
        if (wr == 1) PG8_BAR;
        PG8_WAIT_V(4); PG8_BAR;
        PG8_STAGE(PG8_SB(1, 0), cB + kstep, voffB); PG8_STAGE(PG8_SA(1, 0), cA + kstep, voffA); PG8_STAGE(PG8_SB(1, 1), cB + hstep + kstep, voffB);
        PG8_WAIT_V(6); PG8_BAR;
    }
    for (;;) {
        const bool has_next = S.next(ui + 1, nxt);
        const char* nA = has_next ? (const char*)g.A + (size_t)nxt.pm * tstep : cA; const char* nB = has_next ? (const char*)g.Bt + (size_t)nxt.pn * tstep + (size_t)(nxt.pm >> g.bb_shift) * g.bb_stride : cB;
        for (int t = 0; t < nt; t += 2) {
            const bool last = (t == nt - 2);
            const char* a1 = cA + (size_t)(t + 1) * kstep;
            const char* a2 = last ? nA : cA + (size_t)(t + 2) * kstep; const char* b2 = last ? nB : cB + (size_t)(t + 2) * kstep;
            const char* a3 = a2 + kstep; const char* b3 = b2 + kstep;
            if (last && has_next) S.a_ready(nxt);
            if constexpr (SP2) {
            PG8_LDB(B0, 0, 0); PG8_LDB(B1, 0, 1); PG8_SCHED; PG8_LDA(At, 0, 0); PG8_STAGE(PG8_SA(1, 1), a1 + hstep, voffA);
            PG8_WAIT_V(8); PG8_WAIT_L(0); PG8_BAR; PG8_MMA(0, 0, At, B0); PG8_MMA(0, 1, At, B1); PG8_BAR; PG8_SCHED;
            PG8_LDA(At, 0, 1); PG8_STAGE(PG8_SB(0, 0), b2, voffB); PG8_STAGE(PG8_SB(0, 1), b2 + hstep, voffB); PG8_STAGE(PG8_SA(0, 0), a2, voffA);
            PG8_WAIT_V(8); PG8_WAIT_L(0); PG8_BAR; PG8_MMA(1, 0, At, B0); PG8_MMA(1, 1, At, B1); PG8_BAR; PG8_SCHED;
            PG8_LDB(B0, 1, 0); PG8_LDB(B1, 1, 1); PG8_SCHED; PG8_LDA(At, 1, 0); PG8_STAGE(PG8_SA(0, 1), a2 + hstep, voffA);
            PG8_WAIT_V(8); PG8_WAIT_L(0); PG8_BAR; PG8_MMA(0, 0, At, B0); PG8_MMA(0, 1, At, B1); PG8_BAR; PG8_SCHED;
            PG8_LDA(At, 1, 1); PG8_STAGE(PG8_SB(1, 0), b3, voffB); PG8_STAGE(PG8_SB(1, 1), b3 + hstep, voffB); PG8_STAGE(PG8_SA(1, 0), a3, voffA);
            PG8_WAIT_V(8); PG8_WAIT_L(0); PG8_BAR; PG8_MMA(1, 0, At, B0); PG8_MMA(1, 1, At, B1); PG8_BAR; PG8_SCHED;
            } else {
            PG8_LDB(B0, 0, 0); PG8_SCHED; PG8_LDA(At, 0, 0); PG8_STAGE(PG8_SA(1, 1), a1 + hstep, voffA);
            PG8_WAIT_L(8); PG8_BAR; PG8_WAIT_L(0); PG8_MMA(0, 0, At, B0); PG8_BAR; PG8_SCHED;
            PG8_LDB(B1, 0, 1); PG8_STAGE(PG8_SB(0, 0), b2, voffB);
            PG8_BAR; PG8_WAIT_L(0); PG8_MMA(0, 1, At, B1); PG8_BAR;
            PG8_LDA(At, 0, 1); PG8_STAGE(PG8_SA(0, 0), a2, voffA);
            PG8_BAR; PG8_WAIT_L(0); PG8_MMA(1, 0, At, B0); PG8_BAR; PG8_SCHED;
            PG8_STAGE(PG8_SB(0, 1), b2 + hstep, voffB);
            PG8_WAIT_V(6); PG8_BAR; PG8_MMA(1, 1, At, B1); PG8_BAR;
            PG8_LDB(B0, 1, 0); PG8_SCHED; PG8_LDA(At, 1, 0); PG8_STAGE(PG8_SA(0, 1), a2 + hstep, voffA);
            PG8_WAIT_L(8); PG8_BAR; PG8_WAIT_L(0); PG8_MMA(0, 0, At, B0); PG8_BAR; PG8_SCHED;
            PG8_LDB(B1, 1, 1); PG8_STAGE(PG8_SB(1, 0), b3, voffB);
            PG8_BAR; PG8_WAIT_L(0); PG8_MMA(0, 1, At, B1); PG8_BAR;
            PG8_LDA(At, 1, 1); PG8_STAGE(PG8_SA(1, 0), a3, voffA);
            PG8_BAR; PG8_WAIT_L(0); PG8_MMA(1, 0, At, B0); PG8_BAR; PG8_SCHED;
            PG8_STAGE(PG8_SB(1, 1), b3 + hstep, voffB);
            PG8_WAIT_V(6); PG8_BAR; PG8_MMA(1, 1, At, B1); PG8_BAR;
            }
        }
        if constexpr (ALIGN_EPI) { if (wr == 0) PG8_BAR; }
        if constexpr (!Epi::AFTER_DRAIN) { E(acc, cur, wr, wc, fr, fq); S.done(cur); }
        if (!has_next) break;
#pragma unroll
        for (int a = 0; a < 2; ++a)
#pragma unroll
            for (int b = 0; b < 2; ++b)
#pragma unroll
                for (int m = 0; m < 4; ++m)
#pragma unroll
                    for (int n = 0; n < 2; ++n) acc[a][b][m][n] = (f32x4){0.f, 0.f, 0.f, 0.f};
        cur = nxt; cA = nA; cB = nB; ++ui;
        if constexpr (ALIGN_EPI) { if (wr == 1) PG8_BAR; }
    }
    PG8_WAIT_V(0);
    if constexpr (!ALIGN_EPI) { if (wr == 0) PG8_BAR; }
    PG8_BAR;
    if constexpr (Epi::AFTER_DRAIN) { E.fused(acc, cur, wr, wc, fr, fq, lds, wid, lane); S.done(cur); }
#undef PG8_SA
#undef PG8_SB
#undef PG8_STAGE
#undef PG8_LDA
#undef PG8_LDB
#undef PG8_MMA
#undef PG8_WAIT_V
#undef PG8_WAIT_L
#undef PG8_BAR
#undef PG8_SCHED
}
}

constexpr int D = 1024, BATCH = 4, SEQ = 8192, MTOK = BATCH * SEQ, NCH = SEQ / 64, MEMLEN = 256;
constexpr int EIN = 3328, OIN = 4096;
constexpr float EPS = 1e-6f;
constexpr int C_AQ = 0, C_AK = 512, C_AV = 640, C_AG = 768, C_BQ = 1280, C_BK = 1792, C_BV = 2304, C_BG = 2816;
constexpr int NWAVES = 8, NTHR = 512;
constexpr size_t MiB = 1u << 20;
constexpr size_t WS_WEIN = 1 * MiB, WS_WEOUT = 8 * MiB, WS_WOIN = 10 * MiB, WS_WOOUT = 18 * MiB, WS_WQ = 20 * MiB, WS_WKV = 24 * MiB, WS_WO = 32 * MiB;
constexpr size_t WS_MEMN = 36 * MiB, WS_KV = 40 * MiB, WS_ROT = 48 * MiB, WS_SSP = 52 * MiB;
constexpr size_t WS_XB = 56 * MiB;
constexpr size_t WS_BIG = 120 * MiB;
constexpr size_t WS_BUFA = 376 * MiB;
constexpr size_t WS_BUFB = 440 * MiB;
constexpr size_t WS_BTO = 328 * MiB, WS_BTS = 344 * MiB;
constexpr size_t WS_END = 504 * MiB;
constexpr int LDS_BYTES = 147456;

#define LAS __attribute__((address_space(3)))
typedef unsigned short bf16;
typedef short bf16x8 __attribute__((ext_vector_type(8)));
typedef short s16x4 __attribute__((ext_vector_type(4)));
typedef float f32x2 __attribute__((ext_vector_type(2)));
typedef float f32x4 __attribute__((ext_vector_type(4)));
typedef float f32x16 __attribute__((ext_vector_type(16)));
typedef unsigned u32x2 __attribute__((ext_vector_type(2)));
typedef unsigned u32x4 __attribute__((ext_vector_type(4)));

__device__ __forceinline__ unsigned pk2(float lo, float hi) { return pg8::cvt_pk_bf16(lo, hi); }
__device__ __forceinline__ float bflo(unsigned w) { return __uint_as_float(w << 16); }
__device__ __forceinline__ float bfhi(unsigned w) { return __uint_as_float(w & 0xffff0000u); }
__device__ __forceinline__ int crow(int r, int hi) { return (r & 3) + 8 * (r >> 2) + 4 * hi; }
__device__ __forceinline__ float wave_sum(float v) {
#pragma unroll
    for (int o = 1; o < 64; o <<= 1) v += shx(v, o);
    return v;
}
__device__ __forceinline__ float silu(float x) { return x / (1.0f + __expf(-x)); }
__device__ __forceinline__ s16x4 trd(const LAS bf16* p) { return __builtin_bit_cast(s16x4, __builtin_amdgcn_ds_read_tr16_b64_v4i16((LAS s16x4*)p)); }
__device__ __forceinline__ bf16x8 tr_frag(const LAS bf16* T, int ld, int k0, int n0, int lane) {
    const int g4 = lane >> 4, li = lane & 15, q = li >> 2, p = li & 3, hi = g4 >> 1;
    const LAS bf16* a = T + (k0 + 4 * hi + q) * ld + n0 + 16 * (g4 & 1) + 4 * p;
    const s16x4 lo = trd(a), up = trd(a + 8 * ld);
    return (bf16x8){lo[0], lo[1], lo[2], lo[3], up[0], up[1], up[2], up[3]};
}
__device__ __forceinline__ bf16x8 pack8(float a0, float a1, float a2, float a3, float a4, float a5, float a6, float a7) {
    u32x4 w; w.x = pk2(a0, a1); w.y = pk2(a2, a3); w.z = pk2(a4, a5); w.w = pk2(a6, a7); return __builtin_bit_cast(bf16x8, w);
}
__device__ __forceinline__ int launder(int v) { asm volatile("" : "+v"(v)); return v; }
#define LBAR() asm volatile("s_waitcnt lgkmcnt(0)\n\ts_barrier" ::: "memory")
#define MFMA32(a, b, c) __builtin_amdgcn_mfma_f32_32x32x16_bf16((a), (b), (c), 0, 0, 0)

#define XB_TMO      128
#define XB_XCNT(j)  (256  + 64 * (j))
#define XB_XSUB(j)  (1280 + 64 * (j))
#define XB_XGEN(j)  (2304 + 64 * (j))
#define XB_TOP      3328
#define XB_TOPGEN   3392
#define XCD_BAR_WORDS 3456
#define XB_SPIN_CAP (1u << 18)

__device__ __forceinline__ unsigned xb_ld(unsigned* p)              { return __hip_atomic_load(p, __ATOMIC_RELAXED, __HIP_MEMORY_SCOPE_AGENT); }
__device__ __forceinline__ unsigned xb_add(unsigned* p, unsigned v) { return __hip_atomic_fetch_add(p, v, __ATOMIC_RELAXED, __HIP_MEMORY_SCOPE_AGENT); }
__device__ __forceinline__ unsigned xb_xcc_id() { return (unsigned)__builtin_amdgcn_s_getreg((3 << 11) | 20) & 0xFu; }
#define XB_SPIN(cond, bar) do { unsigned _sp = 0; while (cond) { __builtin_amdgcn_s_sleep(1); \
    if ((++_sp & 255u) == 0u) { if (xb_ld(&(bar)[XB_TMO])) break; if (_sp > XB_SPIN_CAP) { atomicAdd(&(bar)[XB_TMO], 1u); break; } } } } while (0)

struct XcdBarrier {
    unsigned* bar; unsigned x; int wv;
    volatile LAS unsigned* st;
};

__device__ __forceinline__ XcdBarrier xcd_barrier_post(unsigned* bar, volatile LAS unsigned* st, int wv) {
    XcdBarrier b; b.bar = bar; b.x = xb_xcc_id(); b.st = st; b.wv = wv;
    if (wv == 0 && mk_lane() == 0) (void)xb_add(&bar[XB_XCNT(b.x)], 1u);
    return b;
}
__device__ __forceinline__ void xcd_barrier_complete(unsigned* bar, unsigned x, unsigned& nloc, unsigned& nx) {
    const unsigned G = gridDim.x * gridDim.y * gridDim.z;
    unsigned sum, cnt, mine, sp = 0u;
    for (;;) {
        sum = 0u; cnt = 0u; mine = 0u;
#pragma unroll
        for (unsigned j = 0; j < 16; ++j) { const unsigned c = xb_ld(&bar[XB_XCNT(j)]); sum += c; cnt += (c > 0u) ? 1u : 0u; mine = (j == x) ? c : mine; }
        if (sum == G) break;
        __builtin_amdgcn_s_sleep(1);
        if ((++sp & 255u) == 0u) { if (xb_ld(&bar[XB_TMO])) break; if (sp > XB_SPIN_CAP) { atomicAdd(&bar[XB_TMO], 1u); break; } }
    }
    nloc = mine > 0u ? mine : 1u; nx = cnt > 0u ? cnt : 1u;
}

__device__ __forceinline__ void xcd_barrier(const XcdBarrier& b) {
    asm volatile("s_waitcnt vmcnt(0)" ::: "memory");
    __syncthreads();
    if (b.wv == 0 && mk_lane() == 0) {
        unsigned* bar = b.bar;
        __builtin_amdgcn_s_waitcnt(0);
        unsigned nloc = b.st[0], nx = b.st[1];
        if (nloc == 0u) { xcd_barrier_complete(bar, b.x, nloc, nx); b.st[0] = nloc; b.st[1] = nx; }
        const unsigned old = xb_add(&bar[XB_XSUB(b.x)], 1u);
        const unsigned gen = old / nloc;
        if (old + 1u == (gen + 1u) * nloc) {
            __builtin_amdgcn_fence(__ATOMIC_RELEASE, "agent");
            asm volatile("s_waitcnt vmcnt(0)" ::: "memory");
            const unsigned og = xb_add(&bar[XB_TOP], 1u);
            const unsigned tg = og / nx;
            if (og + 1u == (tg + 1u) * nx) xb_add(&bar[XB_TOPGEN], 1u);
            else XB_SPIN(xb_ld(&bar[XB_TOPGEN]) == tg, bar);
            __builtin_amdgcn_fence(__ATOMIC_ACQUIRE, "agent");
            xb_add(&bar[XB_XGEN(b.x)], 1u);
            asm volatile("s_waitcnt vmcnt(0)" ::: "memory");
        } else {
            XB_SPIN(xb_ld(&bar[XB_XGEN(b.x)]) == gen, bar);
            __builtin_amdgcn_fence(__ATOMIC_ACQUIRE, "agent");
            asm volatile("s_waitcnt vmcnt(0)" ::: "memory");
        }
    }
    __syncthreads();
}

constexpr int XB_WS_OFF = 4096, XB_LDS_OFF = 147200;
struct Args { const float* in[17]; float* out; unsigned char* ws; int ph_lo, ph_hi; };
struct Frame {
    LAS unsigned char* lds; int wave, G, bid;
    const Args* ap;
};

__device__ __forceinline__ int oin_src_col(int np) { const int t = np >> 8, j = np & 255, bj = j >> 7, wc = (j >> 5) & 3, r = j & 31, c = 64 * t + 32 * (wc & 1) + r;
    const int grp = (wc < 2) ? (bj ? 2 : 1) : (bj ? 3 : 0); return grp * 1024 + c; }
template <bool PERMC = false> __device__ __forceinline__ void p0_transpose_item(const float* W, const float* gain, int K, int N, bf16* WT, LAS float* scr, int item, int lane) {
    const int nblk = N / 32, kb = item / nblk, nb = item % nblk, k0 = 64 * kb, n0 = 32 * nb, ns0 = PERMC ? oin_src_col(n0) : n0;
    float wv[32];
#pragma unroll
    for (int i = 0; i < 32; ++i) wv[i] = W[(size_t)(k0 + 2 * i + (lane >> 5)) * N + ns0 + (lane & 31)];
    if (gain) {
#pragma unroll
        for (int i = 0; i < 32; ++i) wv[i] *= gain[k0 + 2 * i + (lane >> 5)]; }
#pragma unroll
    for (int i = 0; i < 32; ++i) scr[(2 * i + (lane >> 5)) * 33 + (lane & 31)] = wv[i];
    asm volatile("s_waitcnt lgkmcnt(0)" ::: "memory");
    const int c = lane & 7;
#pragma unroll
    for (int j = 0; j < 4; ++j) { const int n = (lane >> 3) + 8 * j; const LAS float* s = scr + (8 * c) * 33 + n;
        u32x4 o; o.x = pk2(s[0 * 33], s[1 * 33]); o.y = pk2(s[2 * 33], s[3 * 33]); o.z = pk2(s[4 * 33], s[5 * 33]); o.w = pk2(s[6 * 33], s[7 * 33]);
        *(u32x4*)(WT + (size_t)(n0 + n) * K + k0 + 8 * c) = o; }
    asm volatile("s_waitcnt lgkmcnt(0)" ::: "memory");
}
__device__ __forceinline__ void p0_prologue(Frame& F) {
    LAS float* scr = (LAS float*)(F.lds + F.wave * 16384);
    const int gw = F.bid * NWAVES + F.wave, NGW = F.G * NWAVES, lane = mk_lane();
    unsigned char* ws = F.ap->ws;
    constexpr int I_EIN = 16 * (EIN / 32), I_SQ = 16 * 32, I_OIN = 16 * (OIN / 32), I_KV = 16 * 64;
    constexpr int NITEMS = I_EIN + I_SQ + I_OIN + I_SQ + 2 * I_KV + 2 * I_SQ;
    for (int it = gw; it < NITEMS; it += NGW) {
        int r = it;
        if (r < I_EIN) { p0_transpose_item(F.ap->in[3], F.ap->in[2], D, EIN, (bf16*)(ws + WS_WEIN), scr, r, lane); continue; } r -= I_EIN;
        if (r < I_SQ) { p0_transpose_item(F.ap->in[5], nullptr, D, D, (bf16*)(ws + WS_WEOUT), scr, r, lane); continue; } r -= I_SQ;
        if (r < I_OIN) { p0_transpose_item<true>(F.ap->in[7], F.ap->in[6], D, OIN, (bf16*)(ws + WS_WOIN), scr, r, lane); continue; } r -= I_OIN;
        if (r < I_SQ) { p0_transpose_item(F.ap->in[10], nullptr, D, D, (bf16*)(ws + WS_WOOUT), scr, r, lane); continue; } r -= I_SQ;
        if (r < 2 * I_KV) { const int l = r / I_KV; p0_transpose_item(F.ap->in[14] + (size_t)l * D * 2 * D, nullptr, D, 2 * D, (bf16*)(ws + WS_WKV) + (size_t)l * 2 * D * D, scr, r % I_KV, lane); continue; } r -= 2 * I_KV;
        { const int lh = r / 128; p0_transpose_item(F.ap->in[15] + (size_t)lh * 256 * D, nullptr, 256, D, (bf16*)(ws + WS_WO) + (size_t)lh * 256 * D, scr, r % 128, lane); }
    }
    for (int e = F.bid * NTHR + launder(F.wave * 64 + mk_lane()); e < 2 * D * 4 * 32; e += F.G * NTHR) {
        const int ch = e & 31, h = (e >> 5) & 3, k = (e >> 7) & 1023, l = e >> 17;
        const float* src = F.ap->in[13] + ((size_t)l * D + k) * D + h * 256 + ch * 8; const float gk = F.ap->in[11][l * D + k];
        const f32x4 a = *(const f32x4*)src, b = *(const f32x4*)(src + 4);
        u32x4 w; w.x = pk2(a[0] * gk, a[1] * gk); w.y = pk2(a[2] * gk, a[3] * gk); w.z = pk2(b[0] * gk, b[1] * gk); w.w = pk2(b[2] * gk, b[3] * gk);
        *(u32x4*)((bf16*)(ws + WS_WQ) + ((size_t)(l * 4 + h) * D + k) * 256 + ch * 8) = w;
    }
    for (int it = gw; it < 2 * BATCH * MEMLEN; it += NGW) {
        const int l = it / (BATCH * MEMLEN), row = it % (BATCH * MEMLEN);
        const f32x4* xr = (const f32x4*)(F.ap->in[1] + (size_t)row * D) + lane; const f32x4* gr = (const f32x4*)(F.ap->in[12] + l * D) + lane;
        f32x4 v[4]; float s = 0.f;
#pragma unroll
        for (int j = 0; j < 4; ++j) { v[j] = xr[64 * j]; s += (v[j][0] * v[j][0] + v[j][1] * v[j][1]) + (v[j][2] * v[j][2] + v[j][3] * v[j][3]); }
        const float rs = 1.0f / sqrtf(wave_sum(s) * (1.0f / D) + EPS);
        u32x2* o8 = (u32x2*)((bf16*)(ws + WS_MEMN) + (size_t)it * D) + lane;
#pragma unroll
        for (int j = 0; j < 4; ++j) { const f32x4 g = gr[64 * j]; u32x2 w; w.x = pk2(v[j][0] * rs * g[0], v[j][1] * rs * g[1]); w.y = pk2(v[j][2] * rs * g[2], v[j][3] * rs * g[3]); o8[64 * j] = w; }
    }
    for (int row = 2 * gw; row < MTOK; row += 2 * NGW) {
        f32x4 v[2][4];
#pragma unroll
        for (int t = 0; t < 2; ++t) { const f32x4* xr = (const f32x4*)(F.ap->in[0] + (size_t)(row + t) * D) + lane;
#pragma unroll
            for (int j = 0; j < 4; ++j) v[t][j] = xr[64 * j]; }
#pragma unroll
        for (int t = 0; t < 2; ++t) { float s = 0.f;
#pragma unroll
            for (int j = 0; j < 4; ++j) s += (v[t][j][0] * v[t][j][0] + v[t][j][1] * v[t][j][1]) + (v[t][j][2] * v[t][j][2] + v[t][j][3] * v[t][j][3]);
            s = wave_sum(s);
            u32x2* o8 = (u32x2*)((bf16*)(ws + WS_XB) + (size_t)(row + t) * D) + lane;
#pragma unroll
            for (int j = 0; j < 4; ++j) { u32x2 w; w.x = pk2(v[t][j][0], v[t][j][1]); w.y = pk2(v[t][j][2], v[t][j][3]); o8[64 * j] = w; }
            if (lane < 16) ((float*)(ws + WS_SSP))[(size_t)(row + t) * 16 + lane] = (lane == 0) ? s : 0.f; }
    }
    for (int e = F.bid * NTHR + launder((F.wave * 64 + mk_lane())); e < SEQ * 64; e += F.G * NTHR) {
        const int pos = e >> 6, j = e & 63;
        const float inv = 1.0f / exp2f(((float)j / 63.0f) * 13.287712379549449f);
        const float ang = (float)pos * inv;
        const double a = (double)ang, kk = rint(a * 0.63661977236758134308);
        const float r = (float)fma(-kk, 1.57079632679489661923, a), r2 = r * r;
        const float sn = r + r * r2 * (-1.6666654611e-1f + r2 * (8.3321608736e-3f + r2 * (-1.9515295891e-4f)));
        const float cs = 1.0f - 0.5f * r2 + r2 * r2 * (4.166664568298827e-2f + r2 * (-1.388731625493765e-3f + r2 * 2.443315711809948e-5f));
        const int q = ((int)kk) & 3;
        f32x2 o; o.x = (q == 0) ? cs : (q == 1) ? -sn : (q == 2) ? -cs : sn; o.y = (q == 0) ? sn : (q == 1) ? cs : (q == 2) ? -sn : -cs;
        ((f32x2*)(ws + WS_ROT))[e] = o;
    }
}

constexpr int AKS = 72;
struct SwPre { u32x4 kx[3], vx[3]; bf16x8 qf[4]; };
__device__ __forceinline__ void swa_load(Frame& F, int item, SwPre& P) {
    const int kvh = item & 1, c = (item >> 1) & (NCH - 1), b = item >> 8;
    const int c0 = c >= 2 ? c - 2 : 0, nch = c - c0 + 1;
    const int tid = launder((F.wave * 64 + mk_lane())), lane = tid & 63, w = F.wave, r32 = lane & 31, hi = lane >> 5;
    const bf16* HC = (const bf16*)(F.ap->ws + WS_BIG);
    const size_t rowbase = (size_t)b * SEQ;
    const int qh = kvh * 4 + (w >> 1);
    const size_t tok = rowbase + c * 64 + (w & 1) * 32 + r32;
    const bf16* qp = HC + tok * EIN + C_AQ + qh * 64 + hi * 8;
#pragma unroll
    for (int i = 0; i < 3; ++i) if (i < nch) { const int p = tid + i * NTHR, r = p >> 3, ch = p & 7; const bf16* src = HC + (rowbase + c0 * 64 + r) * EIN + kvh * 64 + ch * 8;
        P.kx[i] = *(const u32x4*)(src + C_AK); P.vx[i] = *(const u32x4*)(src + C_AV); }
#pragma unroll
    for (int s = 0; s < 4; ++s) P.qf[s] = *(const bf16x8*)(qp + 16 * s);
}
__device__ __forceinline__ void swa_item(Frame& F, int item, SwPre& P, int next_item, int n_items) {
    const int kvh = item & 1, c = (item >> 1) & (NCH - 1), b = item >> 8;
    const int c0 = c >= 2 ? c - 2 : 0, nch = c - c0 + 1;
    const int tid = launder((F.wave * 64 + mk_lane())), lane = tid & 63, w = F.wave, r32 = lane & 31, hi = lane >> 5;
    LAS bf16* Ks = (LAS bf16*)F.lds; LAS bf16* Vs = Ks + 192 * AKS;
    const bf16* HC = (const bf16*)(F.ap->ws + WS_BIG);
    const size_t rowbase = (size_t)b * SEQ;
    const int qh = kvh * 4 + (w >> 1);
    const size_t tok = rowbase + c * 64 + (w & 1) * 32 + r32;
    const bf16* gp = HC + tok * EIN + C_AG + qh * 64;
#pragma unroll
    for (int i = 0; i < 3; ++i) if (i < nch) { const int p = tid + i * NTHR, r = p >> 3, ch = p & 7; *(LAS u32x4*)(Ks + r * AKS + ch * 8) = P.kx[i]; *(LAS u32x4*)(Vs + r * AKS + ch * 8) = P.vx[i]; }
    bf16x8 qf[4]; u32x2 gg[2][4];
#pragma unroll
    for (int s = 0; s < 4; ++s) qf[s] = P.qf[s];
    if (next_item < n_items) swa_load(F, next_item, P);
#pragma unroll
    for (int db = 0; db < 2; ++db)
#pragma unroll
        for (int gi = 0; gi < 4; ++gi) gg[db][gi] = *(const u32x2*)(gp + 32 * db + 8 * gi + 4 * hi);
    LBAR();
    const int nkb = 2 * nch;
    f32x16 st[6];
#pragma unroll
    for (int kb = 0; kb < 6; ++kb) { st[kb] = (f32x16){};
        if (kb < nkb) {
#pragma unroll
            for (int s = 0; s < 4; ++s) { const bf16x8 a = *(const LAS bf16x8*)(Ks + (32 * kb + r32) * AKS + 16 * s + 8 * hi); st[kb] = MFMA32(a, qf[s], st[kb]); } } }
    float mx = -3.0e38f;
#pragma unroll
    for (int kb = 0; kb < 6; ++kb) if (kb < nkb) {
#pragma unroll
        for (int i = 0; i < 16; ++i) mx = fmaxf(mx, st[kb][i]); }
    mx = fmaxf(mx, shx(mx, 32));
    const float sink = F.ap->in[4][qh];
    const float mref = fmaxf(mx * 0.125f, sink);
    const float L2E = 1.4426950408889634f;
    float sum = 0.f;
#pragma unroll
    for (int kb = 0; kb < 6; ++kb) if (kb < nkb) {
#pragma unroll
        for (int i = 0; i < 16; ++i) { const float p = exp2f((st[kb][i] * 0.125f - mref) * L2E); st[kb][i] = p; sum += p; } }
    sum += shx(sum, 32);
    const float inv = 1.0f / (sum + exp2f((sink - mref) * L2E));
    f32x16 o[2]; o[0] = (f32x16){}; o[1] = (f32x16){};
#pragma unroll
    for (int kb = 0; kb < 6; ++kb) if (kb < nkb) {
#pragma unroll
        for (int s = 0; s < 2; ++s) {
            const bf16x8 pf = pack8(st[kb][8 * s + 0] * inv, st[kb][8 * s + 1] * inv, st[kb][8 * s + 2] * inv, st[kb][8 * s + 3] * inv, st[kb][8 * s + 4] * inv, st[kb][8 * s + 5] * inv, st[kb][8 * s + 6] * inv, st[kb][8 * s + 7] * inv);
#pragma unroll
            for (int db = 0; db < 2; ++db) { const bf16x8 vf = tr_frag(Vs, AKS, 32 * kb + 16 * s, 32 * db, lane); o[db] = MFMA32(vf, pf, o[db]); } } }
    bf16* yp = (bf16*)(F.ap->ws + WS_BUFA) + tok * D + qh * 64;
#pragma unroll
    for (int db = 0; db < 2; ++db)
#pragma unroll
        for (int gi = 0; gi < 4; ++gi) { const int d0 = 32 * db + 8 * gi + 4 * hi; const u32x2 g = gg[db][gi];
            u32x2 y; y.x = pk2(o[db][4 * gi + 0] * silu(bflo(g.x)), o[db][4 * gi + 1] * silu(bfhi(g.x))); y.y = pk2(o[db][4 * gi + 2] * silu(bflo(g.y)), o[db][4 * gi + 3] * silu(bfhi(g.y)));
            *(u32x2*)(yp + d0) = y; }
    LBAR();
}

constexpr int RKS = 136;
__device__ __forceinline__ float head_lg2(int h) { return log2f(1.0f - exp2f(-5.0f - (float)h)); }
struct R1Pre { u32x4 q1, q2, k1, k2, v1, v2; f32x4 rt[4]; };
__device__ __forceinline__ void ret1_load(Frame& F, int item, R1Pre& P) {
    const int h = item & 3, c = (item >> 2) & (NCH - 1), b = item >> 9;
    const int tid = launder((F.wave * 64 + mk_lane())), j = tid >> 3, pc = tid & 7;
    const bf16* rowp = (const bf16*)(F.ap->ws + WS_BIG) + ((size_t)b * SEQ + (size_t)c * 64 + j) * EIN;
    P.q1 = *(const u32x4*)(rowp + C_BQ + h * 128 + 8 * pc); P.q2 = *(const u32x4*)(rowp + C_BQ + h * 128 + 64 + 8 * pc);
    P.k1 = *(const u32x4*)(rowp + C_BK + h * 128 + 8 * pc); P.k2 = *(const u32x4*)(rowp + C_BK + h * 128 + 64 + 8 * pc);
    P.v1 = *(const u32x4*)(rowp + C_BV + h * 128 + 16 * pc); P.v2 = *(const u32x4*)(rowp + C_BV + h * 128 + 16 * pc + 8);
    const f32x4* rt = (const f32x4*)((const f32x2*)(F.ap->ws + WS_ROT) + (size_t)(c * 64 + j) * 64 + 8 * pc);
#pragma unroll
    for (int e = 0; e < 4; ++e) P.rt[e] = rt[e];
}
__device__ __forceinline__ void ret1_item(Frame& F, int item, R1Pre& P, int next_item, int n_items) {
    const int h = item & 3, c = (item >> 2) & (NCH - 1), b = item >> 9;
    const int tid = launder((F.wave * 64 + mk_lane())), lane = tid & 63, w = F.wave, r32 = lane & 31, hi = lane >> 5;
    LAS bf16* Qr = (LAS bf16*)F.lds; LAS bf16* Kr = Qr + 64 * RKS; LAS bf16* Vs = Kr + 64 * RKS; LAS bf16* Vd = Vs + 64 * RKS;
    bf16* HC = (bf16*)(F.ap->ws + WS_BIG);
    const size_t rowbase = (size_t)b * SEQ + (size_t)c * 64;
    const float lg2 = head_lg2(h);
    {
        const int j = tid >> 3, pc = tid & 7;
        const u32x4 q1 = P.q1, q2 = P.q2, k1 = P.k1, k2 = P.k2, v1 = P.v1, v2 = P.v2;
        const f32x4* rt = P.rt;
        u32x4 qa, qb, ka, kb;
        const float ksc = 0.08838834764831845f;
#pragma unroll
        for (int e = 0; e < 4; ++e) { const f32x4 cs = rt[e];
            const float a0 = bflo(q1[e]), a1 = bfhi(q1[e]), b0 = bflo(q2[e]), b1 = bfhi(q2[e]);
            qa[e] = pk2(a0 * cs[0] - b0 * cs[1], a1 * cs[2] - b1 * cs[3]); qb[e] = pk2(a0 * cs[1] + b0 * cs[0], a1 * cs[3] + b1 * cs[2]);
            const float c0 = bflo(k1[e]), c1 = bfhi(k1[e]), d0 = bflo(k2[e]), d1 = bfhi(k2[e]);
            ka[e] = pk2((c0 * cs[0] - d0 * cs[1]) * ksc, (c1 * cs[2] - d1 * cs[3]) * ksc); kb[e] = pk2((c0 * cs[1] + d0 * cs[0]) * ksc, (c1 * cs[3] + d1 * cs[2]) * ksc); }
        *(LAS u32x4*)(Qr + j * RKS + 8 * pc) = qa; *(LAS u32x4*)(Qr + j * RKS + 64 + 8 * pc) = qb;
        *(LAS u32x4*)(Kr + j * RKS + 8 * pc) = ka; *(LAS u32x4*)(Kr + j * RKS + 64 + 8 * pc) = kb;
        { bf16* yq = (bf16*)(F.ap->ws + WS_BUFA) + (rowbase + j) * D + 512 + h * 128 + 8 * pc; *(u32x4*)yq = qa; *(u32x4*)(yq + 64) = qb; }
        *(LAS u32x4*)(Vs + j * RKS + 16 * pc) = v1; *(LAS u32x4*)(Vs + j * RKS + 16 * pc + 8) = v2;
        const float kd = exp2f(lg2 * (float)(63 - j));
        u32x4 w1, w2;
#pragma unroll
        for (int e = 0; e < 4; ++e) { w1[e] = pk2(bflo(v1[e]) * kd, bfhi(v1[e]) * kd); w2[e] = pk2(bflo(v2[e]) * kd, bfhi(v2[e]) * kd); }
        *(LAS u32x4*)(Vd + j * RKS + 16 * pc) = w1; *(LAS u32x4*)(Vd + j * RKS + 16 * pc + 8) = w2;
    }
    if (next_item < n_items) ret1_load(F, next_item, P);
    LBAR();
    const int ib = w & 1, db = w >> 1;
    f32x16 st[2];
#pragma unroll
    for (int jb = 0; jb < 2; ++jb) { st[jb] = (f32x16){};
#pragma unroll
        for (int s = 0; s < 8; ++s) { const bf16x8 a = *(const LAS bf16x8*)(Kr + (32 * jb + r32) * RKS + 16 * s + 8 * hi); const bf16x8 q = *(const LAS bf16x8*)(Qr + (32 * ib + r32) * RKS + 16 * s + 8 * hi);
            st[jb] = MFMA32(a, q, st[jb]); } }
    const int iloc = 32 * ib + r32;
#pragma unroll
    for (int jb = 0; jb < 2; ++jb)
#pragma unroll
        for (int i = 0; i < 16; ++i) { const int j = 32 * jb + crow(i, hi); const int dd = iloc > j ? iloc - j : j - iloc; st[jb][i] *= exp2f(lg2 * (float)dd); }
    f32x16 o = (f32x16){};
#pragma unroll
    for (int jb = 0; jb < 2; ++jb)
#pragma unroll
        for (int s = 0; s < 2; ++s) {
            const bf16x8 pf = pack8(st[jb][8 * s + 0], st[jb][8 * s + 1], st[jb][8 * s + 2], st[jb][8 * s + 3], st[jb][8 * s + 4], st[jb][8 * s + 5], st[jb][8 * s + 6], st[jb][8 * s + 7]);
            const bf16x8 vf = tr_frag(Vs, RKS, 32 * jb + 16 * s, 32 * db, lane);
            o = MFMA32(vf, pf, o); }
    {
        float* op = (float*)(F.ap->ws + WS_XB) + (rowbase + iloc) * 512 + h * 128 + 32 * db + 4 * hi;
#pragma unroll
        for (int gi = 0; gi < 4; ++gi) *(f32x4*)(op + 8 * gi) = (f32x4){o[4 * gi], o[4 * gi + 1], o[4 * gi + 2], o[4 * gi + 3]};
    }
    const int rb = w >> 1;
    f32x16 kv[2]; kv[0] = (f32x16){}; kv[1] = (f32x16){};
#pragma unroll
    for (int s = 0; s < 4; ++s) { const bf16x8 af = tr_frag(Kr, RKS, 16 * s, 32 * rb, lane);
#pragma unroll
        for (int t = 0; t < 2; ++t) { const bf16x8 bf = tr_frag(Vd, RKS, 16 * s, 32 * (2 * (w & 1) + t), lane); kv[t] = MFMA32(af, bf, kv[t]); } }
    bf16* stp = (bf16*)(F.ap->ws + WS_BUFB) + ((size_t)(b * NCH + c) * 4 + h) * 16384;
#pragma unroll
    for (int t = 0; t < 2; ++t) { const int dv = 32 * (2 * (w & 1) + t) + r32;
#pragma unroll
        for (int gi = 0; gi < 4; ++gi) { const int dk = 32 * rb + 8 * gi + 4 * hi; u32x2 y; y.x = pk2(kv[t][4 * gi], kv[t][4 * gi + 1]); y.y = pk2(kv[t][4 * gi + 2], kv[t][4 * gi + 3]);
            *(u32x2*)(stp + dv * 128 + dk) = y; } }
    LBAR();
}

__device__ __forceinline__ void scan_phase(Frame& F) {
    unsigned* ST = (unsigned*)(F.ap->ws + WS_BUFB);
    for (int e = F.bid * NTHR + launder((F.wave * 64 + mk_lane())); e < BATCH * 4 * 8192; e += F.G * NTHR) {
        const int idx = e & 8191, h = (e >> 13) & 3, b = e >> 15;
        const float dec = exp2f(head_lg2(h) * 64.0f);
        unsigned* p = ST + ((size_t)(b * NCH) * 4 + h) * 8192 + idx;
        float s0 = 0.f, s1 = 0.f;
        unsigned ka[32], kb[32];
#define SCAN_LD(dst, c0) do { _Pragma("unroll") for (int j = 0; j < 32; ++j) dst[j] = p[(size_t)((c0) + j) * 4 * 8192]; } while (0)
#define SCAN_UP(src, c0) do { _Pragma("unroll") for (int j = 0; j < 32; ++j) { p[(size_t)((c0) + j) * 4 * 8192] = pk2(s0, s1); s0 = s0 * dec + bflo(src[j]); s1 = s1 * dec + bfhi(src[j]); } } while (0)
        SCAN_LD(ka, 0); SCAN_LD(kb, 32); SCAN_UP(ka, 0); SCAN_LD(ka, 64); SCAN_UP(kb, 32); SCAN_LD(kb, 96); SCAN_UP(ka, 64); SCAN_UP(kb, 96);
#undef SCAN_LD
#undef SCAN_UP
    }
}

struct R2Pre { bf16x8 af[8], qv[8]; f32x4 oi[4]; u32x2 gg[4]; };
__device__ __forceinline__ void ret2_load(Frame& F, int item, R2Pre& P) {
    const int h = item & 3, c = (item >> 2) & (NCH - 1), b = item >> 9;
    const int lane = launder(mk_lane()), w = F.wave, r32 = lane & 31, hi = lane >> 5;
    const int ib = w & 1, db = w >> 1, iloc = 32 * ib + r32;
    const size_t tok = (size_t)b * SEQ + (size_t)c * 64 + iloc;
    const bf16* stp = (const bf16*)(F.ap->ws + WS_BUFB) + ((size_t)(b * NCH + c) * 4 + h) * 16384 + (size_t)(32 * db + r32) * 128 + 8 * hi;
    const bf16* qp = (const bf16*)(F.ap->ws + WS_BUFA) + tok * D + 512 + h * 128 + 8 * hi;
    const float* op = (const float*)(F.ap->ws + WS_XB) + tok * 512 + h * 128 + 32 * db + 4 * hi;
    const bf16* gp = (const bf16*)(F.ap->ws + WS_BIG) + tok * EIN + C_BG + h * 128 + 32 * db + 4 * hi;
#pragma unroll
    for (int s = 0; s < 8; ++s) { P.af[s] = *(const bf16x8*)(stp + 16 * s); P.qv[s] = *(const bf16x8*)(qp + 16 * s); }
#pragma unroll
    for (int gi = 0; gi < 4; ++gi) { P.oi[gi] = *(const f32x4*)(op + 8 * gi); P.gg[gi] = *(const u32x2*)(gp + 8 * gi); }
}
__device__ __forceinline__ void ret2_item(Frame& F, int item, R2Pre& P, int next_item, int n_items) {
    const int h = item & 3, c = (item >> 2) & (NCH - 1), b = item >> 9;
    const int lane = launder(mk_lane()), w = F.wave, r32 = lane & 31, hi = lane >> 5;
    const int ib = w & 1, db = w >> 1, iloc = 32 * ib + r32;
    LAS float* part = (LAS float*)F.lds;
    const size_t tok = (size_t)b * SEQ + (size_t)c * 64 + iloc;
    f32x16 oc = (f32x16){};
#pragma unroll
    for (int s = 0; s < 8; ++s) oc = MFMA32(P.af[s], P.qv[s], oc);
    const float qdec = exp2f(head_lg2(h) * (float)(iloc + 1));
    float ss = 0.f;
#pragma unroll
    for (int gi = 0; gi < 4; ++gi) {
#pragma unroll
        for (int e = 0; e < 4; ++e) { const float v = P.oi[gi][e] + oc[4 * gi + e] * qdec; oc[4 * gi + e] = v; ss += v * v; } }
    u32x2 gg[4];
#pragma unroll
    for (int gi = 0; gi < 4; ++gi) gg[gi] = P.gg[gi];
    if (next_item < n_items) ret2_load(F, next_item, P);
    ss += shx(ss, 32);
    if (hi == 0) part[iloc * 4 + db] = ss;
    LBAR();
    const f32x4 pp = *(const LAS f32x4*)(part + iloc * 4);
    const float rs = 1.0f / sqrtf(((pp[0] + pp[1]) + (pp[2] + pp[3])) * (1.0f / 128.0f) + EPS);
    bf16* yp = (bf16*)(F.ap->ws + WS_BUFA) + tok * D + 512 + h * 128 + 32 * db + 4 * hi;
#pragma unroll
    for (int gi = 0; gi < 4; ++gi) { const u32x2 g = gg[gi];
        u32x2 y; y.x = pk2(oc[4 * gi + 0] * rs * silu(bflo(g.x)), oc[4 * gi + 1] * rs * silu(bfhi(g.x))); y.y = pk2(oc[4 * gi + 2] * rs * silu(bflo(g.y)), oc[4 * gi + 3] * rs * silu(bfhi(g.y)));
        *(u32x2*)(yp + 8 * gi) = y; }
    LBAR();
}

constexpr int XKS = 264, XVS = 288;
__device__ __forceinline__ void xattn_unit(Frame& F, int layer, int unit) {
    const int h = unit & 3, rt = unit >> 2, b = rt >> 5;
    const int tid = launder((F.wave * 64 + mk_lane())), lane = tid & 63, w = F.wave, r32 = lane & 31, hi = lane >> 5;
    LAS bf16* buf0 = (LAS bf16*)F.lds; LAS bf16* buf1 = buf0 + 64 * XVS;
    const bf16* Kg = (const bf16*)(F.ap->ws + WS_KV) + (size_t)((layer * 4 + b) * 8 + h) * 65536;
    const size_t row = (size_t)rt * 256 + w * 32 + r32;
    const bf16* qp = (const bf16*)(F.ap->ws + WS_BUFB) + row * D + h * 256 + 8 * hi;
    const bf16* gsrc = Kg + (size_t)(tid >> 5) * 256 + (tid & 31) * 8;
    const int ldst = (tid >> 5) * XKS + (tid & 31) * 8, ldstv = (tid >> 5) * XVS + (tid & 31) * 8;
    u32x4 pf[4];
#define XLOAD(blk) do { _Pragma("unroll") for (int i_ = 0; i_ < 4; ++i_) pf[i_] = *(const u32x4*)(gsrc + (size_t)(((blk) * 64 + 16 * i_) * 256)); } while (0)
#define XSTORE(bufp) do { _Pragma("unroll") for (int i_ = 0; i_ < 4; ++i_) *(LAS u32x4*)((bufp) + ldst + 16 * i_ * XKS) = pf[i_]; } while (0)
#define XSTOREV(bufp) do { _Pragma("unroll") for (int i_ = 0; i_ < 4; ++i_) *(LAS u32x4*)((bufp) + ldstv + 16 * i_ * XVS) = pf[i_]; } while (0)
    __syncthreads();
    XLOAD(0);
    bf16x8 qf[8];
    LAS bf16* qs = (LAS bf16*)(F.lds + 73728) + w * (32 * 136) + r32 * 136 + 8 * hi;
#pragma unroll
    for (int s = 0; s < 8; ++s) qf[s] = *(const bf16x8*)(qp + 16 * s);
#pragma unroll
    for (int s = 0; s < 8; ++s) { const bf16x8 t = *(const bf16x8*)(qp + 128 + 16 * s); *(LAS bf16x8*)(qs + 16 * s) = t; }
    XSTORE(buf0);
    XLOAD(1);
    LBAR();
    f32x16 st[8];
#pragma unroll
    for (int kblk = 0; kblk < 4; ++kblk) {
        const LAS bf16* cur = (kblk & 1) ? buf1 : buf0; LAS bf16* nxt = (kblk & 1) ? buf0 : buf1;
#pragma unroll
        for (int kk = 0; kk < 2; ++kk) { f32x16 acc = (f32x16){};
#pragma unroll
            for (int s = 0; s < 8; ++s) { const bf16x8 a = *(const LAS bf16x8*)(cur + (32 * kk + r32) * XKS + 16 * s + 8 * hi); acc = MFMA32(a, qf[s], acc); }
#pragma unroll
            for (int s = 0; s < 8; ++s) { const bf16x8 a = *(const LAS bf16x8*)(cur + (32 * kk + r32) * XKS + 128 + 16 * s + 8 * hi); const bf16x8 q = *(const LAS bf16x8*)(qs + 16 * s); acc = MFMA32(a, q, acc); }
            st[2 * kblk + kk] = acc; }
        if (kblk < 3) XSTORE(nxt);
        if (kblk < 2) XLOAD(kblk + 2);
        LBAR();
    }
    float mx = -3.0e38f;
#pragma unroll
    for (int kb = 0; kb < 8; ++kb)
#pragma unroll
        for (int i = 0; i < 16; ++i) mx = fmaxf(mx, st[kb][i]);
    mx = fmaxf(mx, shx(mx, 32));
    const float SC = 0.0625f * 1.4426950408889634f;
    float sum = 0.f;
#pragma unroll
    for (int kb = 0; kb < 8; ++kb)
#pragma unroll
        for (int i = 0; i < 16; ++i) { const float p = exp2f((st[kb][i] - mx) * SC); st[kb][i] = p; sum += p; }
    sum += shx(sum, 32);
    const float inv = 1.0f / sum;
    bf16* pp = (bf16*)(F.ap->ws + WS_BUFA) + row * D + h * 256 + 4 * hi;
#pragma unroll
    for (int kb = 0; kb < 8; ++kb)
#pragma unroll
        for (int gi = 0; gi < 4; ++gi) { u32x2 y; y.x = pk2(st[kb][4 * gi] * inv, st[kb][4 * gi + 1] * inv); y.y = pk2(st[kb][4 * gi + 2] * inv, st[kb][4 * gi + 3] * inv); *(u32x2*)(pp + 32 * kb + 8 * gi) = y; }
#undef XLOAD
#undef XSTORE
#undef XSTOREV
}

__device__ __forceinline__ void conv_phase(Frame& F) {
    const bf16* Z = (const bf16*)(F.ap->ws + WS_BIG); const bf16* G2 = Z + (size_t)MTOK * D; bf16* Y = (bf16*)(F.ap->ws + WS_BUFA);
    const float* cw = F.ap->in[8]; const float* cb = F.ap->in[9];
    for (int it = F.bid * NTHR + launder(F.wave * 64 + mk_lane()); it < (MTOK / 8) * 128; it += F.G * NTHR) {
        const int cgi = it & 127, tg = it >> 7, col = cgi * 8, t0 = tg * 8;
        const bool first = (t0 & (SEQ - 1)) == 0;
        u32x4 zr[10], gr[8];
#pragma unroll
        for (int i = 0; i < 10; ++i) { zr[i] = (u32x4){0u, 0u, 0u, 0u}; if (i >= 2 || !first) zr[i] = *(const u32x4*)(Z + (size_t)(t0 - 2 + i) * D + col); }
#pragma unroll
        for (int i = 0; i < 8; ++i) gr[i] = *(const u32x4*)(G2 + (size_t)(t0 + i) * D + col);
        float w0[8], w1[8], w2[8], bs[8];
#pragma unroll
        for (int e = 0; e < 8; ++e) { w0[e] = cw[col + e]; w1[e] = cw[D + col + e]; w2[e] = cw[2 * D + col + e]; bs[e] = cb[col + e]; }
#pragma unroll
        for (int tt = 0; tt < 8; ++tt) {
            float y[8];
#pragma unroll
            for (int e = 0; e < 4; ++e) {
                const float cv0 = bs[2 * e] + bflo(zr[tt][e]) * w0[2 * e] + bflo(zr[tt + 1][e]) * w1[2 * e] + bflo(zr[tt + 2][e]) * w2[2 * e];
                const float cv1 = bs[2 * e + 1] + bfhi(zr[tt][e]) * w0[2 * e + 1] + bfhi(zr[tt + 1][e]) * w1[2 * e + 1] + bfhi(zr[tt + 2][e]) * w2[2 * e + 1];
                y[2 * e] = bflo(gr[tt][e]) * cv0; y[2 * e + 1] = bfhi(gr[tt][e]) * cv1; }
            u32x4 o; o.x = pk2(y[0], y[1]); o.y = pk2(y[2], y[3]); o.z = pk2(y[4], y[5]); o.w = pk2(y[6], y[7]);
            *(u32x4*)(Y + (size_t)(t0 + tt) * D + col) = o;
        }
    }
}

__device__ __forceinline__ void final_phase(Frame& F) {
    const int gw = F.bid * NWAVES + F.wave, NGW = F.G * NWAVES, lane = mk_lane();
    const float* ssp = (const float*)(F.ap->ws + WS_SSP);
    const f32x4* gr = (const f32x4*)F.ap->in[16] + lane;
    f32x4 g[4];
#pragma unroll
    for (int j = 0; j < 4; ++j) g[j] = gr[64 * j];
    for (int row = 2 * gw; row < MTOK; row += 2 * NGW) {
        f32x4 pv[2][4], xv[2][4];
#pragma unroll
        for (int t = 0; t < 2; ++t) { const f32x4* p = (const f32x4*)(ssp + (size_t)(row + t) * 16); const f32x4* xr = (const f32x4*)(F.ap->out + (size_t)(row + t) * D) + lane;
#pragma unroll
            for (int j = 0; j < 4; ++j) { pv[t][j] = p[j]; xv[t][j] = xr[64 * j]; } }
#pragma unroll
        for (int t = 0; t < 2; ++t) {
            const float s = ((pv[t][0][0] + pv[t][0][1]) + (pv[t][0][2] + pv[t][0][3])) + ((pv[t][1][0] + pv[t][1][1]) + (pv[t][1][2] + pv[t][1][3])) + ((pv[t][2][0] + pv[t][2][1]) + (pv[t][2][2] + pv[t][2][3])) + ((pv[t][3][0] + pv[t][3][1]) + (pv[t][3][2] + pv[t][3][3]));
            const float rs = 1.0f / sqrtf(s * (1.0f / D) + EPS);
            f32x4* xr = (f32x4*)(F.ap->out + (size_t)(row + t) * D) + lane;
#pragma unroll
            for (int j = 0; j < 4; ++j) xr[64 * j] = xv[t][j] * rs * g[j]; }
    }
}

#ifndef TS_PROBE
#define TS_PROBE 0
#endif
#define TS_A_HI 5
#define TS_A_LO 2
#define TS_B_HI 1
#define TS_B_LO 0
#ifndef DUP_MASK
#define DUP_MASK 0
#endif
__device__ __forceinline__ bool PHASE_ENTER_(Frame& F) { asm volatile("" : "+s"(F.bid), "+s"(F.G), "+s"(F.wave)); return true; }
#define REP(k) _Pragma("unroll 1") for (int rep_ = 0; rep_ < ((((DUP_MASK) >> (k)) & 1) + 1); ++rep_) if (PHASE_ENTER_(F))
#ifndef MK_SPLIT
#define MK_SPLIT 0
#endif
constexpr int NPHASE = 16;
__global__ void __launch_bounds__(NTHR, 2) fwd_megakernel(Args args) {
    extern __shared__ __attribute__((aligned(16))) unsigned char lds_raw[];
    cg::grid_group grid = cg::this_grid();
    Frame F;
    F.lds = (LAS unsigned char*)lds_raw; F.wave = __builtin_amdgcn_readfirstlane((int)threadIdx.x >> 6); F.G = gridDim.x; F.bid = blockIdx.x;
    F.ap = (const Args*)__builtin_amdgcn_kernarg_segment_ptr();
    if ((F.wave * 64 + mk_lane()) < 2) ((LAS unsigned*)(F.lds + XB_LDS_OFF))[(F.wave * 64 + mk_lane())] = 0u;
    __syncthreads();
    const XcdBarrier xbar = xcd_barrier_post((unsigned*)(args.ws + XB_WS_OFF), (volatile LAS unsigned*)(F.lds + XB_LDS_OFF), F.wave);
    const int lo = args.ph_lo, hi = args.ph_hi;
    if (hi > NPHASE) grid.sync();
#define PHASE_ENTER() do { asm volatile("" : "+s"(F.bid), "+s"(F.G), "+s"(F.wave)); } while (0)
#define IN(k) (lo <= (k) && (k) < hi)
#define SEAM(k) do { if (IN(k) && IN((k) + 1)) xcd_barrier(xbar); STAMP((k) + 1); } while (0)
    typedef pg8::EpiScaleBf16<true> EpiS; typedef pg8::EpiScaleBf16<false> EpiN;
#define ws (F.ap->ws)
#define XB ((bf16*)(ws + WS_XB))
#define SSP ((float*)(ws + WS_SSP))
#define BIG ((bf16*)(ws + WS_BIG))
#define BUFA ((bf16*)(ws + WS_BUFA))
#define BUFB ((bf16*)(ws + WS_BUFB))

#if TS_PROBE
#define STAMP(i) do { if (blockIdx.x == 0 && threadIdx.x == 0) ((unsigned long long*)ws)[i] = __builtin_amdgcn_s_memrealtime(); } while (0)
#else
#define STAMP(i) do { } while (0)
#endif
    STAMP(0);
    REP(0) {
    if (IN(0)) { p0_prologue(F); } SEAM(0); }
    REP(1) {
    if (IN(1)) {
        { pg8::Gemm g{XB, (const bf16*)(ws + WS_WEIN), MTOK, EIN, D}; pg8::StaticOrder S; S.init(MTOK, EIN, F.G, F.bid); pg8::rs_prepass((LAS float*)(F.lds + 131072), S, SSP, (F.wave * 64 + mk_lane())); EpiS E{BIG, EIN, (const LAS float*)(F.lds + 131072)};
          pg8::gemm_phase<EpiS, pg8::StaticOrder, true, true>(F.lds, g, S, E, F.wave); }
#pragma unroll 1
        for (int l = 0; l < 2; ++l) { pg8::Gemm g{(const bf16*)(ws + WS_MEMN) + (size_t)l * BATCH * MEMLEN * D, (const bf16*)(ws + WS_WKV) + (size_t)l * 2 * D * D, BATCH * MEMLEN, 2 * D, D};
          pg8::StaticOrder S; S.init(BATCH * MEMLEN, 2 * D, F.G, (F.bid + F.G - (F.G / 2 + 32 * l) % F.G) % F.G); pg8::EpiDense E{(bf16*)(ws + WS_KV) + (size_t)l * BATCH * MEMLEN * 2 * D, 8};
          pg8::gemm_phase<pg8::EpiDense, pg8::StaticOrder, true, true>(F.lds, g, S, E, F.wave); }
    } SEAM(1); }
    REP(2) {
    if (IN(2)) {
        { R1Pre P; if (F.bid < BATCH * NCH * 4) ret1_load(F, F.bid, P); __syncthreads();
          for (int it = F.bid; it < BATCH * NCH * 4; it += F.G) ret1_item(F, it, P, it + F.G, BATCH * NCH * 4); }
        { SwPre Q; if (F.bid < BATCH * NCH * 2) swa_load(F, F.bid, Q); __syncthreads();
          for (int it = F.bid; it < BATCH * NCH * 2; it += F.G) swa_item(F, it, Q, it + F.G, BATCH * NCH * 2); }
    } SEAM(2); }
    REP(3) {
    if (IN(3)) { scan_phase(F);
        if (F.bid < 128) { const int gi = F.bid >> 2, l = gi >> 4, b = (gi >> 2) & 3, h = gi & 3;
            pg8::Gemm g{(const bf16*)(ws + WS_WO) + (size_t)(l * 4 + h) * 256 * D, (const bf16*)(ws + WS_KV) + (size_t)((l * 4 + b) * 8 + 4 + h) * 65536, D, 256, 256};
            pg8::StaticOrder S; S.init(D, 256, 4, F.bid & 3); EpiN E{(bf16*)(ws + WS_BTO) + (size_t)(l * 4 + b) * D * D + h * 256, D, nullptr};
            pg8::gemm_phase<EpiN, pg8::StaticOrder, true, true>(F.lds, g, S, E, F.wave); }
        else if (F.bid < 256) { const int gi = (F.bid - 128) >> 2, l = gi >> 4, b = (gi >> 2) & 3, h = gi & 3;
            pg8::Gemm g{(const bf16*)(ws + WS_KV) + (size_t)((l * 4 + b) * 8 + h) * 65536, (const bf16*)(ws + WS_WQ) + (size_t)(l * 4 + h) * D * 256, 256, D, 256};
            pg8::StaticOrder S; S.init(256, D, 4, F.bid & 3); EpiN E{(bf16*)(ws + WS_BTS) + (size_t)(l * 4 + b) * D * D + (size_t)h * 256 * D, D, nullptr};
            pg8::gemm_phase<EpiN, pg8::StaticOrder, true, true>(F.lds, g, S, E, F.wave); }
    } SEAM(3); }
    REP(4) {
    if (IN(4)) { R2Pre P; if (F.bid < BATCH * NCH * 4) ret2_load(F, F.bid, P); __syncthreads();
        for (int it = F.bid; it < BATCH * NCH * 4; it += F.G) ret2_item(F, it, P, it + F.G, BATCH * NCH * 4); } SEAM(4); }
    REP(5) {
    if (IN(5)) {
        pg8::Gemm g{BUFA, (const bf16*)(ws + WS_WEOUT), MTOK, D, D}; pg8::StaticOrder S; S.init(MTOK, D, F.G, F.bid); typedef pg8::EpiResidual<true, false> EpiR0; EpiR0 E{F.ap->in[0], XB, SSP, D};
        pg8::gemm_phase<EpiR0, pg8::StaticOrder, true, true>(F.lds, g, S, E, F.wave);
    } SEAM(5); }
#pragma unroll
    for (int l = 0; l < 2; ++l) {
        const int pb = (l == 0) ? 6 : 12;
        REP(pb) {
        if (IN(pb)) {
            pg8::Gemm g{XB, (const bf16*)(ws + WS_BTS) + (size_t)l * 4 * D * D, MTOK, D, D, (size_t)D * D * 2, 5}; pg8::StaticOrder S; S.init(MTOK, D, F.G, F.bid);
            pg8::rs_prepass((LAS float*)(F.lds + 131072), S, SSP, (F.wave * 64 + mk_lane()));
            pg8::EpiSoftmax E{BUFA, (const LAS float*)(F.lds + 131072), (LAS float*)(F.lds + 135168), (LAS float*)(F.lds + 139264)};
            pg8::gemm_phase<pg8::EpiSoftmax, pg8::StaticOrder, true, true>(F.lds, g, S, E, F.wave);
        } SEAM(pb); }
        REP(pb + 2) {
        if (IN(pb + 2)) {
            pg8::Gemm g{BUFA, (const bf16*)(ws + WS_BTO) + (size_t)l * 4 * D * D, MTOK, D, D, (size_t)D * D * 2, 5};     pg8::StaticOrder S; S.init(MTOK, D, F.G, F.bid); if (l == 0) { typedef pg8::EpiResidual<false, false> EpiR1; EpiR1 E{XB, XB, SSP, D}; pg8::gemm_phase<EpiR1, pg8::StaticOrder, true, true>(F.lds, g, S, E, F.wave); }
            else { typedef pg8::EpiResidual<false, true> EpiR2; EpiR2 E{XB, F.ap->out, SSP, D}; pg8::gemm_phase<EpiR2, pg8::StaticOrder, true, true>(F.lds, g, S, E, F.wave); }
        } SEAM(pb + 2); }
        if (l == 0) {
            REP(9) {
            if (IN(9)) {
                pg8::Gemm g{XB, (const bf16*)(ws + WS_WOIN), MTOK, OIN, D}; pg8::StaticOrder S; S.init(MTOK, OIN, F.G, F.bid); pg8::rs_prepass((LAS float*)(F.lds + 131072), S, SSP, (F.wave * 64 + mk_lane()));
                pg8::EpiConv E{BIG, BIG + (size_t)MTOK * D, (const LAS float*)(F.lds + 131072)};
                pg8::gemm_phase<pg8::EpiConv, pg8::StaticOrder, true, true>(F.lds, g, S, E, F.wave);
            } SEAM(9); }
            REP(10) {
            if (IN(10)) { conv_phase(F); } SEAM(10); }
            REP(11) {
            if (IN(11)) {
                pg8::Gemm g{BUFA, (const bf16*)(ws + WS_WOOUT), MTOK, D, D}; pg8::StaticOrder S; S.init(MTOK, D, F.G, F.bid); typedef pg8::EpiResidual<false, false> EpiR1; EpiR1 E{XB, XB, SSP, D};
                pg8::gemm_phase<EpiR1, pg8::StaticOrder, true, true>(F.lds, g, S, E, F.wave);
            } SEAM(11); }
        }
    }
    if (IN(15)) { final_phase(F); }
#if TS_PROBE
    __syncthreads();
    if (blockIdx.x == 0 && threadIdx.x == 0) { const unsigned long long* ts = (const unsigned long long*)ws;
        const float ta = (float)(ts[TS_A_HI] - ts[TS_A_LO]) * 0.01f, tb = (float)(ts[TS_B_HI] - ts[TS_B_LO]) * 0.01f;
        F.ap->out[0] = ta; for (int i = 1; i <= 1000; ++i) F.ap->out[i] = tb; }
#endif
#undef IN
#undef SEAM
#undef ws
#undef XB
#undef SSP
#undef BIG
#undef BUFA
#undef BUFB
}

extern "C" void kernel_launch(void* const* d_in, const int* in_sizes, int n_in, void* d_out, int out_size, void* d_ws, size_t ws_size, hipStream_t stream) {
    static int grid = 0;
    if (grid == 0) {
        if (n_in != 17 || out_size != MTOK * D || ws_size < WS_END) { fprintf(stderr, "kernel_launch: unexpected shapes (n_in %d out %d ws %zu)\n", n_in, out_size, ws_size); grid = -1; return; }
        int dev = 0, cus = 0, per_cu = 0;
        hipGetDevice(&dev); hipDeviceGetAttribute(&cus, hipDeviceAttributeMultiprocessorCount, dev);
        if (hipFuncSetAttribute((const void*)fwd_megakernel, hipFuncAttributeMaxDynamicSharedMemorySize, LDS_BYTES) != hipSuccess) { fprintf(stderr, "kernel_launch: hipFuncSetAttribute failed\n"); grid = -1; return; }
        if (hipOccupancyMaxActiveBlocksPerMultiprocessor(&per_cu, (const void*)fwd_megakernel, NTHR, LDS_BYTES) != hipSuccess || per_cu < 1) { fprintf(stderr, "kernel_launch: occupancy query says %d\n", per_cu); per_cu = 1; }
        (void)hipGetLastError();
        grid = cus;
    }
    if (grid < 0) return;
    if (hipMemsetAsync(d_ws, 0, 65536, stream) != hipSuccess) { fprintf(stderr, "kernel_launch: hipMemsetAsync failed\n"); return; }
    Args a{};
    for (int i = 0; i < 17; ++i) a.in[i] = (const float*)d_in[i];
    a.out = (float*)d_out; a.ws = (unsigned char*)d_ws;
#if MK_SPLIT
    for (int p = 0; p < NPHASE; ++p) { a.ph_lo = p; a.ph_hi = p + 1; hipLaunchKernelGGL(fwd_megakernel, dim3(grid), dim3(NTHR), LDS_BYTES, stream, a); }
#else
    a.ph_lo = 0; a.ph_hi = NPHASE;
    void* kargs[] = {&a};
    hipError_t e = hipLaunchCooperativeKernel((const void*)fwd_megakernel, dim3(grid), dim3(NTHR), kargs, LDS_BYTES, stream);
    if (e != hipSuccess) fprintf(stderr, "kernel_launch: cooperative launch failed: %s (grid %d)\n", hipGetErrorString(e), grid);
#endif
}
```

```cpp
#include <hip/hip_runtime.h>
#include <hip/hip_cooperative_groups.h>
#include <cstdio>
#include <cstdint>
namespace cg = cooperative_groups;
__device__ __forceinline__ int mk_lane() { int l = (int)__builtin_amdgcn_mbcnt_hi(~0u, __builtin_amdgcn_mbcnt_lo(~0u, 0u)); asm volatile("" : "+v"(l)); return l; }
__device__ __forceinline__ float shx(float v, int mask) { return __int_as_float(__builtin_amdgcn_ds_bpermute((mk_lane() ^ mask) << 2, __float_as_int(v))); }
namespace pg8 {
#define PG8_LAS __attribute__((address_space(3)))
typedef unsigned short bf16_t;
typedef short bf16x8 __attribute__((ext_vector_type(8)));
typedef float f32x4 __attribute__((ext_vector_type(4)));
typedef unsigned u32x4 __attribute__((ext_vector_type(4)));
constexpr int BM = 256, BK = 64, HALF = 128, HTB = HALF * BK * 2  , STAGE_BYTES = 8 * HTB, NXCD = 8, WGM = 8;

__host__ __device__ __forceinline__ int lds_byte(int r, int c) { const int st = (r >> 4) * 2 + (c >> 5), rr = r & 15, cc = c & 31, ob = rr * 64 + cc * 2; return st * 1024 + (ob ^ (((ob >> 9) & 1) << 5)); }
__host__ __device__ __forceinline__ void stage_rc(int b, int& R, int& C) { const int st = b / 1024, sb = b % 1024, swz = sb ^ (((sb >> 9) & 1) << 5); R = (st >> 1) * 16 + swz / 64; C = (st & 1) * 32 + (swz % 64) / 2; }
__host__ __device__ __forceinline__ int perm32(int rho) { const int n = rho >> 4, i = rho & 15; return 8 * (i >> 2) + 4 * n + (i & 3); }

struct Unit { int pm, pn, idx; };
struct Gemm { const bf16_t* A; const bf16_t* Bt; int M, N, K; size_t bb_stride = 0; int bb_shift = 0; };

struct StaticOrder {
    int nM, nN, nwg, G, c;
    __host__ __device__ void init(int M, int N, int G_, int c_) { nM = M / BM; nN = N / BM; nwg = nM * nN; G = G_; c = c_; }
    __host__ __device__ bool next(int i, Unit& u) const {
        const long L = (long)i * G + c; if (L >= nwg) return false;
        int wgid = (int)L; { const int q = nwg / NXCD, r = nwg % NXCD, xcd = wgid % NXCD, off = wgid / NXCD; wgid = (xcd < r ? xcd * (q + 1) : r * (q + 1) + (xcd - r) * q) + off; }
        const int nig = WGM * nN, gid = wgid / nig, fm = gid * WGM, gsz = (nM - fm) < WGM ? (nM - fm) : WGM;
        u.pm = fm + ((wgid % nig) % gsz); u.pn = (wgid % nig) / gsz; u.idx = i; return true;
    }
    __device__ __forceinline__ void a_ready(const Unit&) const {}
    __device__ __forceinline__ void done(const Unit&) const {}
};

typedef float f32x2 __attribute__((ext_vector_type(2))); typedef __bf16 bf16x2_t __attribute__((ext_vector_type(2)));
__device__ __forceinline__ unsigned cvt_pk_bf16(float lo, float hi) { const f32x2 v = {lo, hi}; const bf16x2_t b = __builtin_convertvector(v, bf16x2_t); return __builtin_bit_cast(unsigned, b); }
template <bool SCALE> struct EpiScaleBf16 {
    static constexpr bool PERM = true, AFTER_DRAIN = false;
    bf16_t* O; int ldc; const PG8_LAS float* rs;
    __device__ __forceinline__ void operator()(const f32x4 (&acc)[2][2][4][2], const Unit& u, int wr, int wc, int fr, int fq) const {
        const int rl0 = wr * 64 + fr; const int col0 = u.pn * BM + wc * 32 + 8 * fq;
#pragma unroll
        for (int ai = 0; ai < 2; ++ai)
#pragma unroll
            for (int m = 0; m < 4; ++m) {
                const float sc = SCALE ? rs[256 * u.idx + rl0 + ai * HALF + m * 16] : 1.f;
                bf16_t* rowp = O + (size_t)(u.pm * BM + rl0 + ai * HALF + m * 16) * ldc + col0;
#pragma unroll
                for (int bj = 0; bj < 2; ++bj) { const f32x4 v0 = acc[ai][bj][m][0] * sc, v1 = acc[ai][bj][m][1] * sc;
                    u32x4 w; w.x = cvt_pk_bf16(v0[0], v0[1]); w.y = cvt_pk_bf16(v0[2], v0[3]); w.z = cvt_pk_bf16(v1[0], v1[1]); w.w = cvt_pk_bf16(v1[2], v1[3]);
                    *(u32x4*)(rowp + bj * HALF) = w; }
            }
    }
};
struct EpiDense {
    static constexpr bool PERM = true, AFTER_DRAIN = false;
    bf16_t* O; int nb;
    __device__ __forceinline__ void operator()(const f32x4 (&acc)[2][2][4][2], const Unit& u, int wr, int wc, int fr, int fq) const {
        bf16_t* base = O + (size_t)(u.pm * nb + u.pn) * 65536 + (wr * 64 + fr) * 256 + wc * 32 + 8 * fq;
#pragma unroll
        for (int ai = 0; ai < 2; ++ai)
#pragma unroll
            for (int m = 0; m < 4; ++m)
#pragma unroll
                for (int bj = 0; bj < 2; ++bj) { const f32x4 v0 = acc[ai][bj][m][0], v1 = acc[ai][bj][m][1];
                    u32x4 w; w.x = cvt_pk_bf16(v0[0], v0[1]); w.y = cvt_pk_bf16(v0[2], v0[3]); w.z = cvt_pk_bf16(v1[0], v1[1]); w.w = cvt_pk_bf16(v1[2], v1[3]);
                    *(u32x4*)(base + (ai * HALF + m * 16) * 256 + bj * HALF) = w; }
    }
};
struct EpiSoftmax {
    static constexpr bool PERM = true, AFTER_DRAIN = false;
    bf16_t* O; const PG8_LAS float* rs; PG8_LAS float* mxs; PG8_LAS float* sms;
    __device__ __forceinline__ void operator()(f32x4 (&acc)[2][2][4][2], const Unit& u, int wr, int wc, int fr, int fq) const {
        const int rl0 = wr * 64 + fr; const int col0 = u.pn * BM + wc * 32 + 8 * fq;
#pragma unroll
        for (int ai = 0; ai < 2; ++ai)
#pragma unroll
            for (int m = 0; m < 4; ++m) { const int rl = rl0 + ai * HALF + m * 16; const float sc = rs[256 * u.idx + rl] * (0.0625f * 1.4426950408889634f);
                float mx = -3.0e38f;
#pragma unroll
                for (int bj = 0; bj < 2; ++bj)
#pragma unroll
                    for (int n = 0; n < 2; ++n) { acc[ai][bj][m][n] = acc[ai][bj][m][n] * sc; const f32x4 v = acc[ai][bj][m][n]; mx = fmaxf(mx, fmaxf(fmaxf(v[0], v[1]), fmaxf(v[2], v[3]))); }
                mx = fmaxf(mx, shx(mx, 16)); mx = fmaxf(mx, shx(mx, 32));
                if (fq == 0) mxs[rl * 4 + wc] = mx; }
        asm volatile("s_waitcnt lgkmcnt(0)\n\ts_barrier" ::: "memory");
#pragma unroll
        for (int ai = 0; ai < 2; ++ai)
#pragma unroll
            for (int m = 0; m < 4; ++m) { const int rl = rl0 + ai * HALF + m * 16; const f32x4 pm4 = *(const PG8_LAS f32x4*)(mxs + rl * 4);
                const float mx = fmaxf(fmaxf(pm4[0], pm4[1]), fmaxf(pm4[2], pm4[3]));
                float sm = 0.f;
#pragma unroll
                for (int bj = 0; bj < 2; ++bj)
#pragma unroll
                    for (int n = 0; n < 2; ++n) { f32x4 v = acc[ai][bj][m][n];
                        v[0] = __builtin_amdgcn_exp2f(v[0] - mx); v[1] = __builtin_amdgcn_exp2f(v[1] - mx); v[2] = __builtin_amdgcn_exp2f(v[2] - mx); v[3] = __builtin_amdgcn_exp2f(v[3] - mx);
                        acc[ai][bj][m][n] = v; sm += (v[0] + v[1]) + (v[2] + v[3]); }
                sm += shx(sm, 16); sm += shx(sm, 32);
                if (fq == 0) sms[rl * 4 + wc] = sm; }
        asm volatile("s_waitcnt lgkmcnt(0)\n\ts_barrier" ::: "memory");
#pragma unroll
        for (int ai = 0; ai < 2; ++ai)
#pragma unroll
            for (int m = 0; m < 4; ++m) { const int rl = rl0 + ai * HALF + m * 16; const f32x4 ps4 = *(const PG8_LAS f32x4*)(sms + rl * 4);
                const float inv = 1.0f / ((ps4[0] + ps4[1]) + (ps4[2] + ps4[3]));
                bf16_t* rowp = O + (size_t)(u.pm * BM + rl) * 1024 + col0;
#pragma unroll
                for (int bj = 0; bj < 2; ++bj) { const f32x4 v0 = acc[ai][bj][m][0] * inv, v1 = acc[ai][bj][m][1] * inv;
                    u32x4 w; w.x = cvt_pk_bf16(v0[0], v0[1]); w.y = cvt_pk_bf16(v0[2], v0[3]); w.z = cvt_pk_bf16(v1[0], v1[1]); w.w = cvt_pk_bf16(v1[2], v1[3]);
                    *(u32x4*)(rowp + bj * HALF) = w; } }
        asm volatile("s_waitcnt lgkmcnt(0)\n\ts_barrier" ::: "memory");
    }
};
template <class Sched> __device__ __forceinline__ void rs_prepass(PG8_LAS float* rs, const Sched& S, const float* ssp, int tid) {
    const int row = tid >> 1, half = tid & 1;
    f32x4 v[8][2]; bool have[8];
#pragma unroll
    for (int i = 0; i < 8; ++i) { Unit u; have[i] = S.next(i, u);
        if (have[i]) { const f32x4* p = (const f32x4*)(ssp + (size_t)(u.pm * BM + row) * 16) + 2 * half; v[i][0] = p[0]; v[i][1] = p[1]; } }
#pragma unroll
    for (int i = 0; i < 8; ++i) if (have[i]) {
        float s = ((v[i][0][0] + v[i][0][1]) + (v[i][0][2] + v[i][0][3])) + ((v[i][1][0] + v[i][1][1]) + (v[i][1][2] + v[i][1][3]));
        s += shx(s, 1);
        if (half == 0) rs[256 * i + row] = 1.0f / sqrtf(s * (1.0f / 1024.0f) + 1e-6f); }
    __syncthreads();
}
struct EpiConv {
    static constexpr bool PERM = true, AFTER_DRAIN = false;
    bf16_t* Z; bf16_t* G2; const PG8_LAS float* rs;
    __device__ __forceinline__ void operator()(const f32x4 (&acc)[2][2][4][2], const Unit& u, int wr, int wc, int fr, int fq) const {
        const int rl0 = wr * 64 + fr; const int c = 64 * u.pn + 32 * (wc & 1) + 8 * fq;
        bf16_t* O = (wc < 2) ? Z : G2;
#pragma unroll
        for (int ai = 0; ai < 2; ++ai)
#pragma unroll
            for (int m = 0; m < 4; ++m) {
                const float sc = rs[256 * u.idx + rl0 + ai * HALF + m * 16];
                float v[8];
#pragma unroll
                for (int n = 0; n < 2; ++n)
#pragma unroll
                    for (int e = 0; e < 4; ++e) { const float a = acc[ai][0][m][n][e] * sc, b = acc[ai][1][m][n][e] * sc;
                        v[4 * n + e] = (wc < 2) ? a * b : a * (b / (1.0f + __expf(-b))); }
                u32x4 w; w.x = cvt_pk_bf16(v[0], v[1]); w.y = cvt_pk_bf16(v[2], v[3]); w.z = cvt_pk_bf16(v[4], v[5]); w.w = cvt_pk_bf16(v[6], v[7]);
                *(u32x4*)(O + (size_t)(u.pm * BM + rl0 + ai * HALF + m * 16) * 1024 + c) = w;
            }
    }
};
template <bool BASE_F32, bool OUT_F32> struct EpiResidual {
    static constexpr bool PERM = true, AFTER_DRAIN = false;
    const void* base; void* out; float* ssp; int ldc;
    __device__ __forceinline__ void operator()(const f32x4 (&acc)[2][2][4][2], const Unit& u, int wr, int wc, int fr, int fq) const {
        const int row0 = u.pm * BM + wr * 64 + fr; const int col0 = u.pn * BM + wc * 32 + 8 * fq;
#pragma unroll
        for (int ai = 0; ai < 2; ++ai)
#pragma unroll
          for (int mh = 0; mh < 2; ++mh) {
            u32x4 pb[2][2]; f32x4 fb[2][2][2];
#pragma unroll
            for (int m2 = 0; m2 < 2; ++m2)
#pragma unroll
                for (int bj = 0; bj < 2; ++bj) { const size_t off = (size_t)(row0 + ai * HALF + (2 * mh + m2) * 16) * ldc + col0 + bj * HALF;
                    if (BASE_F32) { fb[m2][bj][0] = *(const f32x4*)((const float*)base + off); fb[m2][bj][1] = *(const f32x4*)((const float*)base + off + 4); }
                    else pb[m2][bj] = *(const u32x4*)((const bf16_t*)base + off); }
#pragma unroll
            for (int m2 = 0; m2 < 2; ++m2) {
                const int m = 2 * mh + m2, row = row0 + ai * HALF + m * 16;
                float ss = 0.f;
#pragma unroll
                for (int bj = 0; bj < 2; ++bj) { const size_t off = (size_t)row * ldc + col0 + bj * HALF;
                    f32x4 b0, b1;
                    if (BASE_F32) { b0 = fb[m2][bj][0]; b1 = fb[m2][bj][1]; }
                    else { const u32x4 w = pb[m2][bj];
                        b0 = (f32x4){__uint_as_float(w.x << 16), __uint_as_float(w.x & 0xffff0000u), __uint_as_float(w.y << 16), __uint_as_float(w.y & 0xffff0000u)};
                        b1 = (f32x4){__uint_as_float(w.z << 16), __uint_as_float(w.z & 0xffff0000u), __uint_as_float(w.w << 16), __uint_as_float(w.w & 0xffff0000u)}; }
                    const f32x4 o0 = b0 + acc[ai][bj][m][0], o1 = b1 + acc[ai][bj][m][1];
                    ss += ((o0[0] * o0[0] + o0[1] * o0[1]) + (o0[2] * o0[2] + o0[3] * o0[3])) + ((o1[0] * o1[0] + o1[1] * o1[1]) + (o1[2] * o1[2] + o1[3] * o1[3]));
                    if (OUT_F32) { *(f32x4*)((float*)out + off) = o0; *(f32x4*)((float*)out + off + 4) = o1; }
                    else { u32x4 w; w.x = cvt_pk_bf16(o0[0], o0[1]); w.y = cvt_pk_bf16(o0[2], o0[3]); w.z = cvt_pk_bf16(o1[0], o1[1]); w.w = cvt_pk_bf16(o1[2], o1[3]);
                        *(u32x4*)((bf16_t*)out + off) = w; } }
                ss += shx(ss, 16); ss += shx(ss, 32);
                if (fq == 0) ssp[(size_t)row * 16 + u.pn * 4 + wc] = ss;
            }
            asm volatile("" ::: "memory");
          }
    }
};
template <class Epi, class Sched, bool ALIGN_EPI = false, bool SP2 = false>
__device__ __forceinline__ void gemm_phase(PG8_LAS unsigned char* lds, const Gemm g, const Sched& S, const Epi& E, const int wave_in) {
    int tid_ = wave_in * 64 + mk_lane(); asm volatile("" : "+v"(tid_));
    const int tid = tid_, wid = __builtin_amdgcn_readfirstlane(tid >> 6), lane = tid & 63, wr = wid >> 2, wc = wid & 3, fr = lane & 15, fq = lane >> 4;
    const int K = g.K, nt = K / BK;
    unsigned voffA[2], voffB[2];
#pragma unroll
    for (int i = 0; i < 2; ++i) { int R, C; stage_rc(tid * 16 + i * 8192, R, C); const int Rb = Epi::PERM ? ((R & ~31) + perm32(R & 31)) : R;
        voffA[i] = (unsigned)(R * K + C) * 2u; voffB[i] = (unsigned)(Rb * K + C) * 2u; }
    const size_t kstep = (size_t)(BK * 2);
    const size_t hstep = (size_t)HALF * K * 2;
    const size_t tstep = 2 * hstep;
    const unsigned ldsw = (unsigned)wid * 1024u;
    const int aoff = lds_byte(wr * 64 + fr, fq * 8), boff = lds_byte(wc * 32 + fr, fq * 8);
#define PG8_SA(b, h) (((b) * 2 + (h)) * HTB)
#define PG8_SB(b, h) ((4 + (b) * 2 + (h)) * HTB)
#define PG8_STAGE(bufoff, gbase, voff) do { _Pragma("unroll") for (int _i = 0; _i < 2; ++_i) \
        __builtin_amdgcn_global_load_lds((const unsigned*)((const char*)(gbase) + (voff)[_i]), (PG8_LAS unsigned*)(lds + (bufoff) + ldsw + _i * 8192), 16, 0, 0); } while (0)
#define PG8_LDA(dst, b, h) do { _Pragma("unroll") for (int m = 0; m < 4; ++m) _Pragma("unroll") for (int k = 0; k < 2; ++k) dst[m][k] = *(const PG8_LAS bf16x8*)(lds + PG8_SA(b, h) + aoff + m * 2048 + k * 1024); } while (0)
#define PG8_LDB(dst, b, h) do { _Pragma("unroll") for (int n = 0; n < 2; ++n) _Pragma("unroll") for (int k = 0; k < 2; ++k) dst[n][k] = *(const PG8_LAS bf16x8*)(lds + PG8_SB(b, h) + boff + n * 2048 + k * 1024); } while (0)
#define PG8_MMA(ai, bj, At, Bt) do { __builtin_amdgcn_s_setprio(1); _Pragma("unroll") for (int m = 0; m < 4; ++m) _Pragma("unroll") for (int n = 0; n < 2; ++n) _Pragma("unroll") for (int k = 0; k < 2; ++k) \
        acc[ai][bj][m][n] = __builtin_amdgcn_mfma_f32_16x16x32_bf16(Bt[n][k], At[m][k], acc[ai][bj][m][n], 0, 0, 0); __builtin_amdgcn_s_setprio(0); } while (0)
#define PG8_WAIT_V(n) asm volatile("s_waitcnt vmcnt(" #n ")" ::: "memory")
#define PG8_WAIT_L(n) asm volatile("s_waitcnt lgkmcnt(" #n ")" ::: "memory")
#define PG8_BAR __builtin_amdgcn_s_barrier()
#define PG8_SCHED __builtin_amdgcn_sched_barrier(0)
    Unit cur, nxt; int ui = 0;
    if (!S.next(0, cur)) return;
    f32x4 acc[2][2][4][2];
#pragma unroll
    for (int a = 0; a < 2; ++a)
#pragma unroll
        for (int b = 0; b < 2; ++b)
#pragma unroll
            for (int m = 0; m < 4; ++m)
#pragma unroll
                for (int n = 0; n < 2; ++n) acc[a][b][m][n] = (f32x4){0.f, 0.f, 0.f, 0.f};
    bf16x8 At[4][2], B0[2][2], B1[2][2];
    const char* cA = (const char*)g.A + (size_t)cur.pm * tstep; const char* cB = (const char*)g.Bt + (size_t)cur.pn * tstep + (size_t)(cur.pm >> g.bb_shift) * g.bb_stride;
    S.a_ready(cur);
    if constexpr (SP2) {
        PG8_STAGE(PG8_SB(0, 0), cB, voffB); PG8_STAGE(PG8_SB(0, 1), cB + hstep, voffB); PG8_STAGE(PG8_SA(0, 0), cA, voffA); PG8_STAGE(PG8_SA(0, 1), cA + hstep, voffA);
        if (wr == 1) PG8_BAR;
        PG8_WAIT_V(2); PG8_BAR;
        PG8_STAGE(PG8_SB(1, 0), cB + kstep, voffB); PG8_STAGE(PG8_SA(1, 0), cA + kstep, voffA); PG8_STAGE(PG8_SB(1, 1), cB + hstep + kstep, voffB);
        PG8_WAIT_V(6); PG8_BAR;
    } else {
        PG8_STAGE(PG8_SB(0, 0), cB, voffB); PG8_STAGE(PG8_SA(0, 0), cA, voffA); PG8_STAGE(PG8_SB(0, 1), cB + hstep, voffB); PG8_STAGE(PG8_SA(0, 1), cA + hstep, voffA);
        if (wr == 1) PG8_BAR;
        PG8_WAIT_V(4); PG8_BAR;
        PG8_STAGE(PG8_SB(1, 0), cB + kstep, voffB); PG8_STAGE(PG8_SA(1, 0), cA + kstep, voffA); PG8_STAGE(PG8_SB(1, 1), cB + hstep + kstep, voffB);
        PG8_WAIT_V(6); PG8_BAR;
    }
    for (;;) {
        const bool has_next = S.next(ui + 1, nxt);
        const char* nA = has_next ? (const char*)g.A + (size_t)nxt.pm * tstep : cA; const char* nB = has_next ? (const char*)g.Bt + (size_t)nxt.pn * tstep + (size_t)(nxt.pm >> g.bb_shift) * g.bb_stride : cB;
        for (int t = 0; t < nt; t += 2) {
            const bool last = (t == nt - 2);
            const char* a1 = cA + (size_t)(t + 1) * kstep;
            const char* a2 = last ? nA : cA + (size_t)(t + 2) * kstep; const char* b2 = last ? nB : cB + (size_t)(t + 2) * kstep;
            const char* a3 = a2 + kstep; const char* b3 = b2 + kstep;
            if (last && has_next) S.a_ready(nxt);
            if constexpr (SP2) {
            PG8_LDB(B0, 0, 0); PG8_LDB(B1, 0, 1); PG8_SCHED; PG8_LDA(At, 0, 0); PG8_STAGE(PG8_SA(1, 1), a1 + hstep, voffA);
            PG8_WAIT_V(8); PG8_WAIT_L(0); PG8_BAR; PG8_MMA(0, 0, At, B0); PG8_MMA(0, 1, At, B1); PG8_BAR; PG8_SCHED;
            PG8_LDA(At, 0, 1); PG8_STAGE(PG8_SB(0, 0), b2, voffB); PG8_STAGE(PG8_SB(0, 1), b2 + hstep, voffB); PG8_STAGE(PG8_SA(0, 0), a2, voffA);
            PG8_WAIT_V(8); PG8_WAIT_L(0); PG8_BAR; PG8_MMA(1, 0, At, B0); PG8_MMA(1, 1, At, B1); PG8_BAR; PG8_SCHED;
            PG8_LDB(B0, 1, 0); PG8_LDB(B1, 1, 1); PG8_SCHED; PG8_LDA(At, 1, 0); PG8_STAGE(PG8_SA(0, 1), a2 + hstep, voffA);
            PG8_WAIT_V(8); PG8_WAIT_L(0); PG8_BAR; PG8_MMA(0, 0, At, B0); PG8_MMA(0, 1, At, B1); PG8_BAR; PG8_SCHED;
            PG8_LDA(At, 1, 1); PG8_STAGE(PG8_SB(1, 0), b3, voffB); PG8_STAGE(PG8_SB(1, 1), b3 + hstep, voffB); PG8_STAGE(PG8_SA(1, 0), a3, voffA);
            PG8_WAIT_V(8); PG8_WAIT_L(0); PG8_BAR; PG8_MMA(1, 0, At, B0); PG8_MMA(1, 1, At, B1); PG8_BAR; PG8_SCHED;
            } else {
            PG8_LDB(B0, 0, 0); PG8_SCHED; PG8_LDA(At, 0, 0); PG8_STAGE(PG8_SA(1, 1), a1 + hstep, voffA);
            PG8_WAIT_L(8); PG8_BAR; PG8_WAIT_L(0); PG8_MMA(0, 0, At, B0); PG8_BAR; PG8_SCHED;
            PG8_LDB(B1, 0, 1); PG8_STAGE(PG8_SB(0, 0), b2, voffB);
            PG8_BAR; PG8_WAIT_L(0); PG8_MMA(0, 1, At, B1); PG8_BAR;
            PG8_LDA(At, 0, 1); PG8_STAGE(PG8_SA(0, 0), a2, voffA);
            PG8_BAR; PG8_WAIT_L(0); PG8_MMA(1, 0, At, B0); PG8_BAR; PG8_SCHED;
            PG8_STAGE(PG8_SB(0, 1), b2 + hstep, voffB);
            PG8_WAIT_V(6); PG8_BAR; PG8_MMA(1, 1, At, B1); PG8_BAR;
            PG8_LDB(B0, 1, 0); PG8_SCHED; PG8_LDA(At, 1, 0); PG8_STAGE(PG8_SA(0, 1), a2 + hstep, voffA);
            PG8_WAIT_L(8); PG8_BAR; PG8_WAIT_L(0); PG8_MMA(0, 0, At, B0); PG8_BAR; PG8_SCHED;
            PG8_LDB(B1, 1, 1); PG8_STAGE(PG8_SB(1, 0), b3, voffB);
            PG8_BAR; PG8_WAIT_L(0); PG8_MMA(0, 1, At, B1); PG8_BAR;
            PG8_LDA(At, 1, 1); PG8_STAGE(PG8_SA(1, 0), a3, voffA);
            PG8_BAR; PG8_WAIT_L(0); PG8_MMA(1, 0, At, B0); PG8_BAR; PG8_SCHED;
            PG8_STAGE(PG8_SB(1, 1), b3 + hstep, voffB);
            PG8_WAIT_V(6); PG8_BAR; PG8_MMA(1, 1, At, B1); PG8_BAR;
            }
        }
        if constexpr (ALIGN_EPI) { if (wr == 0) PG8_BAR; }
        if constexpr (!Epi::AFTER_DRAIN) { E(acc, cur, wr, wc, fr, fq); S.done(cur); }
        if (!has_next) break;
#pragma unroll
        for (int a = 0; a < 2; ++a)
#pragma unroll
            for (int b = 0; b < 2; ++b)
#pragma unroll
                for (int m = 0; m < 4; ++m)
#pragma unroll
                    for (int n = 0; n < 2; ++n) acc[a][b][m][n] = (f32x4){0.f, 0.f, 0.f, 0.f};
        cur = nxt; cA = nA; cB = nB; ++ui;
        if constexpr (ALIGN_EPI) { if (wr == 1) PG8_BAR; }
    }
    PG8_WAIT_V(0);
    if constexpr (!ALIGN_EPI) { if (wr == 0) PG8_BAR; }
    PG8_BAR;
    if constexpr (Epi::AFTER_DRAIN) { E.fused(acc, cur, wr, wc, fr, fq, lds, wid, lane); S.done(cur); }
#undef PG8_SA
#undef PG8_SB
#undef PG8_STAGE
#undef PG8_LDA
#undef PG8_LDB
#undef PG8_MMA
#undef PG8_WAIT_V
#undef PG8_WAIT_L
#undef PG8_BAR
#undef PG8_SCHED
}
}

constexpr int D = 1024, BATCH = 4, SEQ = 8192, MTOK = BATCH * SEQ, NCH = SEQ / 64, MEMLEN = 256;
constexpr int EIN = 3328, OIN = 4096;
constexpr float EPS = 1e-6f;
constexpr int C_AQ = 0, C_AK = 512, C_AV = 640, C_AG = 768, C_BQ = 1280, C_BK = 1792, C_BV = 2304, C_BG = 2816;
constexpr int NWAVES = 8, NTHR = 512;
constexpr size_t MiB = 1u << 20;
constexpr size_t WS_WEIN = 1 * MiB, WS_WEOUT = 8 * MiB, WS_WOIN = 10 * MiB, WS_WOOUT = 18 * MiB, WS_WQ = 20 * MiB, WS_WKV = 24 * MiB, WS_WO = 32 * MiB;
constexpr size_t WS_MEMN = 36 * MiB, WS_KV = 40 * MiB, WS_ROT = 48 * MiB, WS_SSP = 52 * MiB;
constexpr size_t WS_XB = 56 * MiB;
constexpr size_t WS_BIG = 120 * MiB;
constexpr size_t WS_BUFA = 376 * MiB;
constexpr size_t WS_BUFB = 440 * MiB;
constexpr size_t WS_BTO = 328 * MiB, WS_BTS = 344 * MiB;
constexpr size_t WS_END = 504 * MiB;
constexpr int LDS_BYTES = 147456;

#define LAS __attribute__((address_space(3)))
typedef unsigned short bf16;
typedef short bf16x8 __attribute__((ext_vector_type(8)));
typedef short s16x4 __attribute__((ext_vector_type(4)));
typedef float f32x2 __attribute__((ext_vector_type(2)));
typedef float f32x4 __attribute__((ext_vector_type(4)));
typedef float f32x16 __attribute__((ext_vector_type(16)));
typedef unsigned u32x2 __attribute__((ext_vector_type(2)));
typedef unsigned u32x4 __attribute__((ext_vector_type(4)));

__device__ __forceinline__ unsigned pk2(float lo, float hi) { return pg8::cvt_pk_bf16(lo, hi); }
__device__ __forceinline__ float bflo(unsigned w) { return __uint_as_float(w << 16); }
__device__ __forceinline__ float bfhi(unsigned w) { return __uint_as_float(w & 0xffff0000u); }
__device__ __forceinline__ int crow(int r, int hi) { return (r & 3) + 8 * (r >> 2) + 4 * hi; }
__device__ __forceinline__ float wave_sum(float v) {
#pragma unroll
    for (int o = 1; o < 64; o <<= 1) v += shx(v, o);
    return v;
}
__device__ __forceinline__ float silu(float x) { return x / (1.0f + __expf(-x)); }
__device__ __forceinline__ s16x4 trd(const LAS bf16* p) { return __builtin_bit_cast(s16x4, __builtin_amdgcn_ds_read_tr16_b64_v4i16((LAS s16x4*)p)); }
__device__ __forceinline__ bf16x8 tr_frag(const LAS bf16* T, int ld, int k0, int n0, int lane) {
    const int g4 = lane >> 4, li = lane & 15, q = li >> 2, p = li & 3, hi = g4 >> 1;
    const LAS bf16* a = T + (k0 + 4 * hi + q) * ld + n0 + 16 * (g4 & 1) + 4 * p;
    const s16x4 lo = trd(a), up = trd(a + 8 * ld);
    return (bf16x8){lo[0], lo[1], lo[2], lo[3], up[0], up[1], up[2], up[3]};
}
__device__ __forceinline__ bf16x8 pack8(float a0, float a1, float a2, float a3, float a4, float a5, float a6, float a7) {
    u32x4 w; w.x = pk2(a0, a1); w.y = pk2(a2, a3); w.z = pk2(a4, a5); w.w = pk2(a6, a7); return __builtin_bit_cast(bf16x8, w);
}
__device__ __forceinline__ int launder(int v) { asm volatile("" : "+v"(v)); return v; }
#define LBAR() asm volatile("s_waitcnt lgkmcnt(0)\n\ts_barrier" ::: "memory")
#define MFMA32(a, b, c) __builtin_amdgcn_mfma_f32_32x32x16_bf16((a), (b), (c), 0, 0, 0)

#define XB_TMO      128
#define XB_XCNT(j)  (256  + 64 * (j))
#define XB_XSUB(j)  (1280 + 64 * (j))
#define XB_XGEN(j)  (2304 + 64 * (j))
#define XB_TOP      3328
#define XB_TOPGEN   3392
#define XCD_BAR_WORDS 3456
#define XB_SPIN_CAP (1u << 18)

__device__ __forceinline__ unsigned xb_ld(unsigned* p)              { return __hip_atomic_load(p, __ATOMIC_RELAXED, __HIP_MEMORY_SCOPE_AGENT); }
__device__ __forceinline__ unsigned xb_add(unsigned* p, unsigned v) { return __hip_atomic_fetch_add(p, v, __ATOMIC_RELAXED, __HIP_MEMORY_SCOPE_AGENT); }
__device__ __forceinline__ unsigned xb_xcc_id() { return (unsigned)__builtin_amdgcn_s_getreg((3 << 11) | 20) & 0xFu; }
#define XB_SPIN(cond, bar) do { unsigned _sp = 0; while (cond) { __builtin_amdgcn_s_sleep(1); \
    if ((++_sp & 255u) == 0u) { if (xb_ld(&(bar)[XB_TMO])) break; if (_sp > XB_SPIN_CAP) { atomicAdd(&(bar)[XB_TMO], 1u); break; } } } } while (0)

struct XcdBarrier {
    unsigned* bar; unsigned x; int wv;
    volatile LAS unsigned* st;
};

__device__ __forceinline__ XcdBarrier xcd_barrier_post(unsigned* bar, volatile LAS unsigned* st, int wv) {
    XcdBarrier b; b.bar = bar; b.x = xb_xcc_id(); b.st = st; b.wv = wv;
    if (wv == 0 && mk_lane() == 0) (void)xb_add(&bar[XB_XCNT(b.x)], 1u);
    return b;
}
__device__ __forceinline__ void xcd_barrier_complete(unsigned* bar, unsigned x, unsigned& nloc, unsigned& nx) {
    const unsigned G = gridDim.x * gridDim.y * gridDim.z;
    unsigned sum, cnt, mine, sp = 0u;
    for (;;) {
        sum = 0u; cnt = 0u; mine = 0u;
#pragma unroll
        for (unsigned j = 0; j < 16; ++j) { const unsigned c = xb_ld(&bar[XB_XCNT(j)]); sum += c; cnt += (c > 0u) ? 1u : 0u; mine = (j == x) ? c : mine; }
        if (sum == G) break;
        __builtin_amdgcn_s_sleep(1);
        if ((++sp & 255u) == 0u) { if (xb_ld(&bar[XB_TMO])) break; if (sp > XB_SPIN_CAP) { atomicAdd(&bar[XB_TMO], 1u); break; } }
    }
    nloc = mine > 0u ? mine : 1u; nx = cnt > 0u ? cnt : 1u;
}

__device__ __forceinline__ void xcd_barrier(const XcdBarrier& b) {
    asm volatile("s_waitcnt vmcnt(0)" ::: "memory");
    __syncthreads();
    if (b.wv == 0 && mk_lane() == 0) {
        unsigned* bar = b.bar;
        __builtin_amdgcn_s_waitcnt(0);
        unsigned nloc = b.st[0], nx = b.st[1];
        if (nloc == 0u) { xcd_barrier_complete(bar, b.x, nloc, nx); b.st[0] = nloc; b.st[1] = nx; }
        const unsigned old = xb_add(&bar[XB_XSUB(b.x)], 1u);
        const unsigned gen = old / nloc;
        if (old + 1u == (gen + 1u) * nloc) {
            __builtin_amdgcn_fence(__ATOMIC_RELEASE, "agent");
            asm volatile("s_waitcnt vmcnt(0)" ::: "memory");
            const unsigned og = xb_add(&bar[XB_TOP], 1u);
            const unsigned tg = og / nx;
            if (og + 1u == (tg + 1u) * nx) xb_add(&bar[XB_TOPGEN], 1u);
            else XB_SPIN(xb_ld(&bar[XB_TOPGEN]) == tg, bar);
            __builtin_amdgcn_fence(__ATOMIC_ACQUIRE, "agent");
            xb_add(&bar[XB_XGEN(b.x)], 1u);
            asm volatile("s_waitcnt vmcnt(0)" ::: "memory");
        } else {
            XB_SPIN(xb_ld(&bar[XB_XGEN(b.x)]) == gen, bar);
            __builtin_amdgcn_fence(__ATOMIC_ACQUIRE, "agent");
            asm volatile("s_waitcnt vmcnt(0)" ::: "memory");
        }
    }
    __syncthreads();
}

constexpr int XB_WS_OFF = 4096, XB_LDS_OFF = 147200;
struct Args { const float* in[17]; float* out; unsigned char* ws; int ph_lo, ph_hi; };
struct Frame {
    LAS unsigned char* lds; int wave, G, bid;
    const Args* ap;
};

__device__ __forceinline__ int oin_src_col(int np) { const int t = np >> 8, j = np & 255, bj = j >> 7, wc = (j >> 5) & 3, r = j & 31, c = 64 * t + 32 * (wc & 1) + r;
    const int grp = (wc < 2) ? (bj ? 2 : 1) : (bj ? 3 : 0); return grp * 1024 + c; }
template <bool PERMC = false> __device__ __forceinline__ void p0_transpose_item(const float* W, const float* gain, int K, int N, bf16* WT, LAS float* scr, int item, int lane) {
    const int nblk = N / 32, kb = item / nblk, nb = item % nblk, k0 = 64 * kb, n0 = 32 * nb, ns0 = PERMC ? oin_src_col(n0) : n0;
    float wv[32];
#pragma unroll
    for (int i = 0; i < 32; ++i) wv[i] = W[(size_t)(k0 + 2 * i + (lane >> 5)) * N + ns0 + (lane & 31)];
    if (gain) {
#pragma unroll
        for (int i = 0; i < 32; ++i) wv[i] *= gain[k0 + 2 * i + (lane >> 5)]; }
#pragma unroll
    for (int i = 0; i < 32; ++i) scr[(2 * i + (lane >> 5)) * 33 + (lane & 31)] = wv[i];
    asm volatile("s_waitcnt lgkmcnt(0)" ::: "memory");
    const int c = lane & 7;
#pragma unroll
    for (int j = 0; j < 4; ++j) { const int n = (lane >> 3) + 8 * j; const LAS float* s = scr + (8 * c) * 33 + n;
        u32x4 o; o.x = pk2(s[0 * 33], s[1 * 33]); o.y = pk2(s[2 * 33], s[3 * 33]); o.z = pk2(s[4 * 33], s[5 * 33]); o.w = pk2(s[6 * 33], s[7 * 33]);
        *(u32x4*)(WT + (size_t)(n0 + n) * K + k0 + 8 * c) = o; }
    asm volatile("s_waitcnt lgkmcnt(0)" ::: "memory");
}
__device__ __forceinline__ void p0_prologue(Frame& F) {
    LAS float* scr = (LAS float*)(F.lds + F.wave * 16384);
    const int gw = F.bid * NWAVES + F.wave, NGW = F.G * NWAVES, lane = mk_lane();
    unsigned char* ws = F.ap->ws;
    constexpr int I_EIN = 16 * (EIN / 32), I_SQ = 16 * 32, I_OIN = 16 * (OIN / 32), I_KV = 16 * 64;
    constexpr int NITEMS = I_EIN + I_SQ + I_OIN + I_SQ + 2 * I_KV + 2 * I_SQ;
    for (int it = gw; it < NITEMS; it += NGW) {
        int r = it;
        if (r < I_EIN) { p0_transpose_item(F.ap->in[3], F.ap->in[2], D, EIN, (bf16*)(ws + WS_WEIN), scr, r, lane); continue; } r -= I_EIN;
        if (r < I_SQ) { p0_transpose_item(F.ap->in[5], nullptr, D, D, (bf16*)(ws + WS_WEOUT), scr, r, lane); continue; } r -= I_SQ;
        if (r < I_OIN) { p0_transpose_item<true>(F.ap->in[7], F.ap->in[6], D, OIN, (bf16*)(ws + WS_WOIN), scr, r, lane); continue; } r -= I_OIN;
        if (r < I_SQ) { p0_transpose_item(F.ap->in[10], nullptr, D, D, (bf16*)(ws + WS_WOOUT), scr, r, lane); continue; } r -= I_SQ;
        if (r < 2 * I_KV) { const int l = r / I_KV; p0_transpose_item(F.ap->in[14] + (size_t)l * D * 2 * D, nullptr, D, 2 * D, (bf16*)(ws + WS_WKV) + (size_t)l * 2 * D * D, scr, r % I_KV, lane); continue; } r -= 2 * I_KV;
        { const int lh = r / 128; p0_transpose_item(F.ap->in[15] + (size_t)lh * 256 * D, nullptr, 256, D, (bf16*)(ws + WS_WO) + (size_t)lh * 256 * D, scr, r % 128, lane); }
    }
    for (int e = F.bid * NTHR + launder(F.wave * 64 + mk_lane()); e < 2 * D * 4 * 32; e += F.G * NTHR) {
        const int ch = e & 31, h = (e >> 5) & 3, k = (e >> 7) & 1023, l = e >> 17;
        const float* src = F.ap->in[13] + ((size_t)l * D + k) * D + h * 256 + ch * 8; const float gk = F.ap->in[11][l * D + k];
        const f32x4 a = *(const f32x4*)src, b = *(const f32x4*)(src + 4);
        u32x4 w; w.x = pk2(a[0] * gk, a[1] * gk); w.y = pk2(a[2] * gk, a[3] * gk); w.z = pk2(b[0] * gk, b[1] * gk); w.w = pk2(b[2] * gk, b[3] * gk);
        *(u32x4*)((bf16*)(ws + WS_WQ) + ((size_t)(l * 4 + h) * D + k) * 256 + ch * 8) = w;
    }
    for (int it = gw; it < 2 * BATCH * MEMLEN; it += NGW) {
        const int l = it / (BATCH * MEMLEN), row = it % (BATCH * MEMLEN);
        const f32x4* xr = (const f32x4*)(F.ap->in[1] + (size_t)row * D) + lane; const f32x4* gr = (const f32x4*)(F.ap->in[12] + l * D) + lane;
        f32x4 v[4]; float s = 0.f;
#pragma unroll
        for (int j = 0; j < 4; ++j) { v[j] = xr[64 * j]; s += (v[j][0] * v[j][0] + v[j][1] * v[j][1]) + (v[j][2] * v[j][2] + v[j][3] * v[j][3]); }
        const float rs = 1.0f / sqrtf(wave_sum(s) * (1.0f / D) + EPS);
        u32x2* o8 = (u32x2*)((bf16*)(ws + WS_MEMN) + (size_t)it * D) + lane;
#pragma unroll
        for (int j = 0; j < 4; ++j) { const f32x4 g = gr[64 * j]; u32x2 w; w.x = pk2(v[j][0] * rs * g[0], v[j][1] * rs * g[1]); w.y = pk2(v[j][2] * rs * g[2], v[j][3] * rs * g[3]); o8[64 * j] = w; }
    }
    for (int row = 2 * gw; row < MTOK; row += 2 * NGW) {
        f32x4 v[2][4];
#pragma unroll
        for (int t = 0; t < 2; ++t) { const f32x4* xr = (const f32x4*)(F.ap->in[0] + (size_t)(row + t) * D) + lane;
#pragma unroll
            for (int j = 0; j < 4; ++j) v[t][j] = xr[64 * j]; }
#pragma unroll
        for (int t = 0; t < 2; ++t) { float s = 0.f;
#pragma unroll
            for (int j = 0; j < 4; ++j) s += (v[t][j][0] * v[t][j][0] + v[t][j][1] * v[t][j][1]) + (v[t][j][2] * v[t][j][2] + v[t][j][3] * v[t][j][3]);
            s = wave_sum(s);
            u32x2* o8 = (u32x2*)((bf16*)(ws + WS_XB) + (size_t)(row + t) * D) + lane;
#pragma unroll
            for (int j = 0; j < 4; ++j) { u32x2 w; w.x = pk2(v[t][j][0], v[t][j][1]); w.y = pk2(v[t][j][2], v[t][j][3]); o8[64 * j] = w; }
            if (lane < 16) ((float*)(ws + WS_SSP))[(size_t)(row + t) * 16 + lane] = (lane == 0) ? s : 0.f; }
    }
    for (int e = F.bid * NTHR + launder((F.wave * 64 + mk_lane())); e < SEQ * 64; e += F.G * NTHR) {
        const int pos = e >> 6, j = e & 63;
        const float inv = 1.0f / exp2f(((float)j / 63.0f) * 13.287712379549449f);
        const float ang = (float)pos * inv;
        const double a = (double)ang, kk = rint(a * 0.63661977236758134308);
        const float r = (float)fma(-kk, 1.57079632679489661923, a), r2 = r * r;
        const float sn = r + r * r2 * (-1.6666654611e-1f + r2 * (8.3321608736e-3f + r2 * (-1.9515295891e-4f)));
        const float cs = 1.0f - 0.5f * r2 + r2 * r2 * (4.166664568298827e-2f + r2 * (-1.388731625493765e-3f + r2 * 2.443315711809948e-5f));
        const int q = ((int)kk) & 3;
        f32x2 o; o.x = (q == 0) ? cs : (q == 1) ? -sn : (q == 2) ? -cs : sn; o.y = (q == 0) ? sn : (q == 1) ? cs : (q == 2) ? -sn : -cs;
        ((f32x2*)(ws + WS_ROT))[e] = o;
    }
}

constexpr int AKS = 72;
struct SwPre { u32x4 kx[3], vx[3]; bf16x8 qf[4]; };
__device__ __forceinline__ void swa_load(Frame& F, int item, SwPre& P) {
    const int kvh = item & 1, c = (item >> 1) & (NCH - 1), b = item >> 8;
    const int c0 = c >= 2 ? c - 2 : 0, nch = c - c0 + 1;
    const int tid = launder((F.wave * 64 + mk_lane())), lane = tid & 63, w = F.wave, r32 = lane & 31, hi = lane >> 5;
    const bf16* HC = (const bf16*)(F.ap->ws + WS_BIG);
    const size_t rowbase = (size_t)b * SEQ;
    const int qh = kvh * 4 + (w >> 1);
    const size_t tok = rowbase + c * 64 + (w & 1) * 32 + r32;
    const bf16* qp = HC + tok * EIN + C_AQ + qh * 64 + hi * 8;
#pragma unroll
    for (int i = 0; i < 3; ++i) if (i < nch) { const int p = tid + i * NTHR, r = p >> 3, ch = p & 7; const bf16* src = HC + (rowbase + c0 * 64 + r) * EIN + kvh * 64 + ch * 8;
        P.kx[i] = *(const u32x4*)(src + C_AK); P.vx[i] = *(const u32x4*)(src + C_AV); }
#pragma unroll
    for (int s = 0; s < 4; ++s) P.qf[s] = *(const bf16x8*)(qp + 16 * s);
}
__device__ __forceinline__ void swa_item(Frame& F, int item, SwPre& P, int next_item, int n_items) {
    const int kvh = item & 1, c = (item >> 1) & (NCH - 1), b = item >> 8;
    const int c0 = c >= 2 ? c - 2 : 0, nch = c - c0 + 1;
    const int tid = launder((F.wave * 64 + mk_lane())), lane = tid & 63, w = F.wave, r32 = lane & 31, hi = lane >> 5;
    LAS bf16* Ks = (LAS bf16*)F.lds; LAS bf16* Vs = Ks + 192 * AKS;
    const bf16* HC = (const bf16*)(F.ap->ws + WS_BIG);
    const size_t rowbase = (size_t)b * SEQ;
    const int qh = kvh * 4 + (w >> 1);
    const size_t tok = rowbase + c * 64 + (w & 1) * 32 + r32;
    const bf16* gp = HC + tok * EIN + C_AG + qh * 64;
#pragma unroll
    for (int i = 0; i < 3; ++i) if (i < nch) { const int p = tid + i * NTHR, r = p >> 3, ch = p & 7; *(LAS u32x4*)(Ks + r * AKS + ch * 8) = P.kx[i]; *(LAS u32x4*)(Vs + r * AKS + ch * 8) = P.vx[i]; }
    bf16x8 qf[4]; u32x2 gg[2][4];
#pragma unroll
    for (int s = 0; s < 4; ++s) qf[s] = P.qf[s];
    if (next_item < n_items) swa_load(F, next_item, P);
#pragma unroll
    for (int db = 0; db < 2; ++db)
#pragma unroll
        for (int gi = 0; gi < 4; ++gi) gg[db][gi] = *(const u32x2*)(gp + 32 * db + 8 * gi + 4 * hi);
    LBAR();
    const int nkb = 2 * nch;
    f32x16 st[6];
#pragma unroll
    for (int kb = 0; kb < 6; ++kb) { st[kb] = (f32x16){};
        if (kb < nkb) {
#pragma unroll
            for (int s = 0; s < 4; ++s) { const bf16x8 a = *(const LAS bf16x8*)(Ks + (32 * kb + r32) * AKS + 16 * s + 8 * hi); st[kb] = MFMA32(a, qf[s], st[kb]); } } }
    float mx = -3.0e38f;
#pragma unroll
    for (int kb = 0; kb < 6; ++kb) if (kb < nkb) {
#pragma unroll
        for (int i = 0; i < 16; ++i) mx = fmaxf(mx, st[kb][i]); }
    mx = fmaxf(mx, shx(mx, 32));
    const float sink = F.ap->in[4][qh];
    const float mref = fmaxf(mx * 0.125f, sink);
    const float L2E = 1.4426950408889634f;
    float sum = 0.f;
#pragma unroll
    for (int kb = 0; kb < 6; ++kb) if (kb < nkb) {
#pragma unroll
        for (int i = 0; i < 16; ++i) { const float p = exp2f((st[kb][i] * 0.125f - mref) * L2E); st[kb][i] = p; sum += p; } }
    sum += shx(sum, 32);
    const float inv = 1.0f / (sum + exp2f((sink - mref) * L2E));
    f32x16 o[2]; o[0] = (f32x16){}; o[1] = (f32x16){};
#pragma unroll
    for (int kb = 0; kb < 6; ++kb) if (kb < nkb) {
#pragma unroll
        for (int s = 0; s < 2; ++s) {
            const bf16x8 pf = pack8(st[kb][8 * s + 0] * inv, st[kb][8 * s + 1] * inv, st[kb][8 * s + 2] * inv, st[kb][8 * s + 3] * inv, st[kb][8 * s + 4] * inv, st[kb][8 * s + 5] * inv, st[kb][8 * s + 6] * inv, st[kb][8 * s + 7] * inv);
#pragma unroll
            for (int db = 0; db < 2; ++db) { const bf16x8 vf = tr_frag(Vs, AKS, 32 * kb + 16 * s, 32 * db, lane); o[db] = MFMA32(vf, pf, o[db]); } } }
    bf16* yp = (bf16*)(F.ap->ws + WS_BUFA) + tok * D + qh * 64;
#pragma unroll
    for (int db = 0; db < 2; ++db)
#pragma unroll
        for (int gi = 0; gi < 4; ++gi) { const int d0 = 32 * db + 8 * gi + 4 * hi; const u32x2 g = gg[db][gi];
            u32x2 y; y.x = pk2(o[db][4 * gi + 0] * silu(bflo(g.x)), o[db][4 * gi + 1] * silu(bfhi(g.x))); y.y = pk2(o[db][4 * gi + 2] * silu(bflo(g.y)), o[db][4 * gi + 3] * silu(bfhi(g.y)));
            *(u32x2*)(yp + d0) = y; }
    LBAR();
}

constexpr int RKS = 136;
__device__ __forceinline__ float head_lg2(int h) { return log2f(1.0f - exp2f(-5.0f - (float)h)); }
struct R1Pre { u32x4 q1, q2, k1, k2, v1, v2; f32x4 rt[4]; };
__device__ __forceinline__ void ret1_load(Frame& F, int item, R1Pre& P) {
    const int h = item & 3, c = (item >> 2) & (NCH - 1), b = item >> 9;
    const int tid = launder((F.wave * 64 + mk_lane())), j = tid >> 3, pc = tid & 7;
    const bf16* rowp = (const bf16*)(F.ap->ws + WS_BIG) + ((size_t)b * SEQ + (size_t)c * 64 + j) * EIN;
    P.q1 = *(const u32x4*)(rowp + C_BQ + h * 128 + 8 * pc); P.q2 = *(const u32x4*)(rowp + C_BQ + h * 128 + 64 + 8 * pc);
    P.k1 = *(const u32x4*)(rowp + C_BK + h * 128 + 8 * pc); P.k2 = *(const u32x4*)(rowp + C_BK + h * 128 + 64 + 8 * pc);
    P.v1 = *(const u32x4*)(rowp + C_BV + h * 128 + 16 * pc); P.v2 = *(const u32x4*)(rowp + C_BV + h * 128 + 16 * pc + 8);
    const f32x4* rt = (const f32x4*)((const f32x2*)(F.ap->ws + WS_ROT) + (size_t)(c * 64 + j) * 64 + 8 * pc);
#pragma unroll
    for (int e = 0; e < 4; ++e) P.rt[e] = rt[e];
}
__device__ __forceinline__ void ret1_item(Frame& F, int item, R1Pre& P, int next_item, int n_items) {
    const int h = item & 3, c = (item >> 2) & (NCH - 1), b = item >> 9;
    const int tid = launder((F.wave * 64 + mk_lane())), lane = tid & 63, w = F.wave, r32 = lane & 31, hi = lane >> 5;
    LAS bf16* Qr = (LAS bf16*)F.lds; LAS bf16* Kr = Qr + 64 * RKS; LAS bf16* Vs = Kr + 64 * RKS; LAS bf16* Vd = Vs + 64 * RKS;
    bf16* HC = (bf16*)(F.ap->ws + WS_BIG);
    const size_t rowbase = (size_t)b * SEQ + (size_t)c * 64;
    const float lg2 = head_lg2(h);
    {
        const int j = tid >> 3, pc = tid & 7;
        const u32x4 q1 = P.q1, q2 = P.q2, k1 = P.k1, k2 = P.k2, v1 = P.v1, v2 = P.v2;
        const f32x4* rt = P.rt;
        u32x4 qa, qb, ka, kb;
        const float ksc = 0.08838834764831845f;
#pragma unroll
        for (int e = 0; e < 4; ++e) { const f32x4 cs = rt[e];
            const float a0 = bflo(q1[e]), a1 = bfhi(q1[e]), b0 = bflo(q2[e]), b1 = bfhi(q2[e]);
            qa[e] = pk2(a0 * cs[0] - b0 * cs[1], a1 * cs[2] - b1 * cs[3]); qb[e] = pk2(a0 * cs[1] + b0 * cs[0], a1 * cs[3] + b1 * cs[2]);
            const float c0 = bflo(k1[e]), c1 = bfhi(k1[e]), d0 = bflo(k2[e]), d1 = bfhi(k2[e]);
            ka[e] = pk2((c0 * cs[0] - d0 * cs[1]) * ksc, (c1 * cs[2] - d1 * cs[3]) * ksc); kb[e] = pk2((c0 * cs[1] + d0 * cs[0]) * ksc, (c1 * cs[3] + d1 * cs[2]) * ksc); }
        *(LAS u32x4*)(Qr + j * RKS + 8 * pc) = qa; *(LAS u32x4*)(Qr + j * RKS + 64 + 8 * pc) = qb;
        *(LAS u32x4*)(Kr + j * RKS + 8 * pc) = ka; *(LAS u32x4*)(Kr + j * RKS + 64 + 8 * pc) = kb;
        { bf16* yq = (bf16*)(F.ap->ws + WS_BUFA) + (rowbase + j) * D + 512 + h * 128 + 8 * pc; *(u32x4*)yq = qa; *(u32x4*)(yq + 64) = qb; }
        *(LAS u32x4*)(Vs + j * RKS + 16 * pc) = v1; *(LAS u32x4*)(Vs + j * RKS + 16 * pc + 8) = v2;
        const float kd = exp2f(lg2 * (float)(63 - j));
        u32x4 w1, w2;
#pragma unroll
        for (int e = 0; e < 4; ++e) { w1[e] = pk2(bflo(v1[e]) * kd, bfhi(v1[e]) * kd); w2[e] = pk2(bflo(v2[e]) * kd, bfhi(v2[e]) * kd); }
        *(LAS u32x4*)(Vd + j * RKS + 16 * pc) = w1; *(LAS u32x4*)(Vd + j * RKS + 16 * pc + 8) = w2;
    }
    if (next_item < n_items) ret1_load(F, next_item, P);
    LBAR();
    const int ib = w & 1, db = w >> 1;
    f32x16 st[2];
#pragma unroll
    for (int jb = 0; jb < 2; ++jb) { st[jb] = (f32x16){};
#pragma unroll
        for (int s = 0; s < 8; ++s) { const bf16x8 a = *(const LAS bf16x8*)(Kr + (32 * jb + r32) * RKS + 16 * s + 8 * hi); const bf16x8 q = *(const LAS bf16x8*)(Qr + (32 * ib + r32) * RKS + 16 * s + 8 * hi);
            st[jb] = MFMA32(a, q, st[jb]); } }
    const int iloc = 32 * ib + r32;
#pragma unroll
    for (int jb = 0; jb < 2; ++jb)
#pragma unroll
        for (int i = 0; i < 16; ++i) { const int j = 32 * jb + crow(i, hi); const int dd = iloc > j ? iloc - j : j - iloc; st[jb][i] *= exp2f(lg2 * (float)dd); }
    f32x16 o = (f32x16){};
#pragma unroll
    for (int jb = 0; jb < 2; ++jb)
#pragma unroll
        for (int s = 0; s < 2; ++s) {
            const bf16x8 pf = pack8(st[jb][8 * s + 0], st[jb][8 * s + 1], st[jb][8 * s + 2], st[jb][8 * s + 3], st[jb][8 * s + 4], st[jb][8 * s + 5], st[jb][8 * s + 6], st[jb][8 * s + 7]);
            const bf16x8 vf = tr_frag(Vs, RKS, 32 * jb + 16 * s, 32 * db, lane);
            o = MFMA32(vf, pf, o); }
    {
        bf16* op = (bf16*)(F.ap->ws + WS_XB) + (rowbase + iloc) * 512 + h * 128 + 32 * db + 4 * hi;
#pragma unroll
        for (int gi = 0; gi < 4; ++gi) { u32x2 y; y.x = pk2(o[4 * gi], o[4 * gi + 1]); y.y = pk2(o[4 * gi + 2], o[4 * gi + 3]); *(u32x2*)(op + 8 * gi) = y; }
    }
    const int rb = w >> 1;
    f32x16 kv[2]; kv[0] = (f32x16){}; kv[1] = (f32x16){};
#pragma unroll
    for (int s = 0; s < 4; ++s) { const bf16x8 af = tr_frag(Kr, RKS, 16 * s, 32 * rb, lane);
#pragma unroll
        for (int t = 0; t < 2; ++t) { const bf16x8 bf = tr_frag(Vd, RKS, 16 * s, 32 * (2 * (w & 1) + t), lane); kv[t] = MFMA32(af, bf, kv[t]); } }
    bf16* stp = (bf16*)(F.ap->ws + WS_BUFB) + ((size_t)(b * NCH + c) * 4 + h) * 16384;
#pragma unroll
    for (int t = 0; t < 2; ++t) { const int dv = 32 * (2 * (w & 1) + t) + r32;
#pragma unroll
        for (int gi = 0; gi < 4; ++gi) { const int dk = 32 * rb + 8 * gi + 4 * hi; u32x2 y; y.x = pk2(kv[t][4 * gi], kv[t][4 * gi + 1]); y.y = pk2(kv[t][4 * gi + 2], kv[t][4 * gi + 3]);
            *(u32x2*)(stp + dv * 128 + dk) = y; } }
    LBAR();
}

__device__ __forceinline__ void scan_phase(Frame& F) {
    u32x4* ST = (u32x4*)(F.ap->ws + WS_BUFB);
    const int tsc = launder(F.wave * 64 + mk_lane());
    if (tsc < 128)
    for (int e = F.bid * 128 + tsc; e < BATCH * 4 * 2048; e += F.G * 128) {
        const int idx = e & 2047, h = (e >> 11) & 3, b = e >> 13;
        const float dec = exp2f(head_lg2(h) * 64.0f);
        u32x4* p = ST + ((size_t)(b * NCH) * 4 + h) * 2048 + idx;
        float st[8];
#pragma unroll
        for (int i = 0; i < 8; ++i) st[i] = 0.f;
        u32x4 ka[16], kb[16];
#define SCAN_LD(dst, c0) do { _Pragma("unroll") for (int j = 0; j < 16; ++j) dst[j] = p[(size_t)((c0) + j) * 4 * 2048]; } while (0)
#define SCAN_UP(src, c0) do { _Pragma("unroll") for (int j = 0; j < 16; ++j) { u32x4 o; o.x = pk2(st[0], st[1]); o.y = pk2(st[2], st[3]); o.z = pk2(st[4], st[5]); o.w = pk2(st[6], st[7]); p[(size_t)((c0) + j) * 4 * 2048] = o; \
            _Pragma("unroll") for (int i = 0; i < 4; ++i) { st[2 * i] = st[2 * i] * dec + bflo(src[j][i]); st[2 * i + 1] = st[2 * i + 1] * dec + bfhi(src[j][i]); } } } while (0)
        SCAN_LD(ka, 0);
#pragma unroll 1
        for (int c0 = 0; c0 < NCH; c0 += 32) { SCAN_LD(kb, c0 + 16); SCAN_UP(ka, c0); if (c0 + 32 < NCH) SCAN_LD(ka, c0 + 32); SCAN_UP(kb, c0 + 16); }
#undef SCAN_LD
#undef SCAN_UP
    }
}

struct R2Pre { bf16x8 af[8], qv[8]; u32x2 oi[4]; u32x2 gg[4]; };
__device__ __forceinline__ void ret2_load(Frame& F, int item, R2Pre& P) {
    const int h = item & 3, c = (item >> 2) & (NCH - 1), b = item >> 9;
    const int lane = launder(mk_lane()), w = F.wave, r32 = lane & 31, hi = lane >> 5;
    const int ib = w & 1, db = w >> 1, iloc = 32 * ib + r32;
    const size_t tok = (size_t)b * SEQ + (size_t)c * 64 + iloc;
    const bf16* stp = (const bf16*)(F.ap->ws + WS_BUFB) + ((size_t)(b * NCH + c) * 4 + h) * 16384 + (size_t)(32 * db + r32) * 128 + 8 * hi;
    const bf16* qp = (const bf16*)(F.ap->ws + WS_BUFA) + tok * D + 512 + h * 128 + 8 * hi;
    const bf16* op = (const bf16*)(F.ap->ws + WS_XB) + tok * 512 + h * 128 + 32 * db + 4 * hi;
    const bf16* gp = (const bf16*)(F.ap->ws + WS_BIG) + tok * EIN + C_BG + h * 128 + 32 * db + 4 * hi;
#pragma unroll
    for (int s = 0; s < 8; ++s) { P.af[s] = *(const bf16x8*)(stp + 16 * s); P.qv[s] = *(const bf16x8*)(qp + 16 * s); }
#pragma unroll
    for (int gi = 0; gi < 4; ++gi) { P.oi[gi] = *(const u32x2*)(op + 8 * gi); P.gg[gi] = *(const u32x2*)(gp + 8 * gi); }
}
__device__ __forceinline__ void ret2_item(Frame& F, int item, R2Pre& P, int next_item, int n_items) {
    const int h = item & 3, c = (item >> 2) & (NCH - 1), b = item >> 9;
    const int lane = launder(mk_lane()), w = F.wave, r32 = lane & 31, hi = lane >> 5;
    const int ib = w & 1, db = w >> 1, iloc = 32 * ib + r32;
    LAS float* part = (LAS float*)F.lds;
    const size_t tok = (size_t)b * SEQ + (size_t)c * 64 + iloc;
    f32x16 oc = (f32x16){};
#pragma unroll
    for (int s = 0; s < 8; ++s) oc = MFMA32(P.af[s], P.qv[s], oc);
    const float qdec = exp2f(head_lg2(h) * (float)(iloc + 1));
    float ss = 0.f;
#pragma unroll
    for (int gi = 0; gi < 4; ++gi) {
#pragma unroll
        for (int e = 0; e < 4; ++e) { const unsigned wq_ = (e < 2) ? P.oi[gi].x : P.oi[gi].y; const float v = ((e & 1) ? bfhi(wq_) : bflo(wq_)) + oc[4 * gi + e] * qdec; oc[4 * gi + e] = v; ss += v * v; } }
    u32x2 gg[4];
#pragma unroll
    for (int gi = 0; gi < 4; ++gi) gg[gi] = P.gg[gi];
    if (next_item < n_items) ret2_load(F, next_item, P);
    ss += shx(ss, 32);
    if (hi == 0) part[iloc * 4 + db] = ss;
    LBAR();
    const f32x4 pp = *(const LAS f32x4*)(part + iloc * 4);
    const float rs = 1.0f / sqrtf(((pp[0] + pp[1]) + (pp[2] + pp[3])) * (1.0f / 128.0f) + EPS);
    bf16* yp = (bf16*)(F.ap->ws + WS_BUFA) + tok * D + 512 + h * 128 + 32 * db + 4 * hi;
#pragma unroll
    for (int gi = 0; gi < 4; ++gi) { const u32x2 g = gg[gi];
        u32x2 y; y.x = pk2(oc[4 * gi + 0] * rs * silu(bflo(g.x)), oc[4 * gi + 1] * rs * silu(bfhi(g.x))); y.y = pk2(oc[4 * gi + 2] * rs * silu(bflo(g.y)), oc[4 * gi + 3] * rs * silu(bfhi(g.y)));
        *(u32x2*)(yp + 8 * gi) = y; }
    LBAR();
}

__device__ __forceinline__ void conv_phase(Frame& F) {
    const bf16* Z = (const bf16*)(F.ap->ws + WS_BIG); const bf16* G2 = Z + (size_t)MTOK * D; bf16* Y = (bf16*)(F.ap->ws + WS_BUFA);
    const float* cw = F.ap->in[8]; const float* cb = F.ap->in[9];
    for (int it = F.bid * NTHR + launder(F.wave * 64 + mk_lane()); it < (MTOK / 8) * 128; it += F.G * NTHR) {
        const int cgi = it & 127, tg = it >> 7, col = cgi * 8, t0 = tg * 8;
        const bool first = (t0 & (SEQ - 1)) == 0;
        u32x4 zr[10], gr[8];
#pragma unroll
        for (int i = 0; i < 10; ++i) { zr[i] = (u32x4){0u, 0u, 0u, 0u}; if (i >= 2 || !first) zr[i] = *(const u32x4*)(Z + (size_t)(t0 - 2 + i) * D + col); }
#pragma unroll
        for (int i = 0; i < 8; ++i) gr[i] = *(const u32x4*)(G2 + (size_t)(t0 + i) * D + col);
        float w0[8], w1[8], w2[8], bs[8];
#pragma unroll
        for (int e = 0; e < 8; ++e) { w0[e] = cw[col + e]; w1[e] = cw[D + col + e]; w2[e] = cw[2 * D + col + e]; bs[e] = cb[col + e]; }
#pragma unroll
        for (int tt = 0; tt < 8; ++tt) {
            float y[8];
#pragma unroll
            for (int e = 0; e < 4; ++e) {
                const float cv0 = bs[2 * e] + bflo(zr[tt][e]) * w0[2 * e] + bflo(zr[tt + 1][e]) * w1[2 * e] + bflo(zr[tt + 2][e]) * w2[2 * e];
                const float cv1 = bs[2 * e + 1] + bfhi(zr[tt][e]) * w0[2 * e + 1] + bfhi(zr[tt + 1][e]) * w1[2 * e + 1] + bfhi(zr[tt + 2][e]) * w2[2 * e + 1];
                y[2 * e] = bflo(gr[tt][e]) * cv0; y[2 * e + 1] = bfhi(gr[tt][e]) * cv1; }
            u32x4 o; o.x = pk2(y[0], y[1]); o.y = pk2(y[2], y[3]); o.z = pk2(y[4], y[5]); o.w = pk2(y[6], y[7]);
            *(u32x4*)(Y + (size_t)(t0 + tt) * D + col) = o;
        }
    }
}

__device__ __forceinline__ void final_phase(Frame& F) {
    const int gw = F.bid * NWAVES + F.wave, NGW = F.G * NWAVES, lane = mk_lane();
    const float* ssp = (const float*)(F.ap->ws + WS_SSP);
    const f32x4* gr = (const f32x4*)F.ap->in[16];
    f32x4 g[4];
#pragma unroll
    for (int j = 0; j < 2; ++j) { g[2 * j] = gr[128 * j + 2 * lane]; g[2 * j + 1] = gr[128 * j + 2 * lane + 1]; }
    for (int row = 2 * gw; row < MTOK; row += 2 * NGW) {
        f32x4 pv[2][4]; u32x4 xv[2][2];
#pragma unroll
        for (int t = 0; t < 2; ++t) { const f32x4* p = (const f32x4*)(ssp + (size_t)(row + t) * 16); const u32x4* xr = (const u32x4*)((const bf16*)(F.ap->ws + WS_XB) + (size_t)(row + t) * D) + lane;
#pragma unroll
            for (int j = 0; j < 4; ++j) pv[t][j] = p[j];
            xv[t][0] = xr[0]; xv[t][1] = xr[64]; }
#pragma unroll
        for (int t = 0; t < 2; ++t) {
            const float s = ((pv[t][0][0] + pv[t][0][1]) + (pv[t][0][2] + pv[t][0][3])) + ((pv[t][1][0] + pv[t][1][1]) + (pv[t][1][2] + pv[t][1][3])) + ((pv[t][2][0] + pv[t][2][1]) + (pv[t][2][2] + pv[t][2][3])) + ((pv[t][3][0] + pv[t][3][1]) + (pv[t][3][2] + pv[t][3][3]));
            const float rs = 1.0f / sqrtf(s * (1.0f / D) + EPS);
            f32x4* orow = (f32x4*)(F.ap->out + (size_t)(row + t) * D);
#pragma unroll
            for (int j = 0; j < 2; ++j) { const u32x4 w = xv[t][j];
                const f32x4 a = (f32x4){bflo(w.x), bfhi(w.x), bflo(w.y), bfhi(w.y)}, b = (f32x4){bflo(w.z), bfhi(w.z), bflo(w.w), bfhi(w.w)};
                orow[128 * j + 2 * lane] = a * rs * g[2 * j]; orow[128 * j + 2 * lane + 1] = b * rs * g[2 * j + 1]; } }
    }
}

#ifndef TS_PROBE
#define TS_PROBE 0
#endif
#define TS_A_HI 5
#define TS_A_LO 2
#define TS_B_HI 1
#define TS_B_LO 0
#ifndef DUP_MASK
#define DUP_MASK 0
#endif
__device__ __forceinline__ bool PHASE_ENTER_(Frame& F) { asm volatile("" : "+s"(F.bid), "+s"(F.G), "+s"(F.wave)); return true; }
#define REP(k) _Pragma("unroll 1") for (int rep_ = 0; rep_ < ((((DUP_MASK) >> (k)) & 1) + 1); ++rep_) if (PHASE_ENTER_(F))
#ifndef MK_SPLIT
#define MK_SPLIT 0
#endif
constexpr int NPHASE = 16;
__global__ void __launch_bounds__(NTHR, 2) fwd_megakernel(Args args) {
    extern __shared__ __attribute__((aligned(16))) unsigned char lds_raw[];
    cg::grid_group grid = cg::this_grid();
    Frame F;
    F.lds = (LAS unsigned char*)lds_raw; F.wave = __builtin_amdgcn_readfirstlane((int)threadIdx.x >> 6); F.G = gridDim.x; F.bid = blockIdx.x;
    F.ap = (const Args*)__builtin_amdgcn_kernarg_segment_ptr();
    if ((F.wave * 64 + mk_lane()) < 2) ((LAS unsigned*)(F.lds + XB_LDS_OFF))[(F.wave * 64 + mk_lane())] = 0u;
    __syncthreads();
    const XcdBarrier xbar = xcd_barrier_post((unsigned*)(args.ws + XB_WS_OFF), (volatile LAS unsigned*)(F.lds + XB_LDS_OFF), F.wave);
    const int lo = args.ph_lo, hi = args.ph_hi;
    if (hi > NPHASE) grid.sync();
#define PHASE_ENTER() do { asm volatile("" : "+s"(F.bid), "+s"(F.G), "+s"(F.wave)); } while (0)
#define IN(k) (lo <= (k) && (k) < hi)
#define SEAM(k) do { if (IN(k) && IN((k) + 1)) xcd_barrier(xbar); STAMP((k) + 1); } while (0)
    typedef pg8::EpiScaleBf16<true> EpiS; typedef pg8::EpiScaleBf16<false> EpiN;
#define ws (F.ap->ws)
#define XB ((bf16*)(ws + WS_XB))
#define SSP ((float*)(ws + WS_SSP))
#define BIG ((bf16*)(ws + WS_BIG))
#define BUFA ((bf16*)(ws + WS_BUFA))
#define BUFB ((bf16*)(ws + WS_BUFB))

#if TS_PROBE
#define STAMP(i) do { if (blockIdx.x == 0 && threadIdx.x == 0) ((unsigned long long*)ws)[i] = __builtin_amdgcn_s_memrealtime(); } while (0)
#else
#define STAMP(i) do { } while (0)
#endif
    STAMP(0);
    REP(0) {
    if (IN(0)) { p0_prologue(F); } SEAM(0); }
    REP(1) {
    if (IN(1)) {
        { pg8::Gemm g{XB, (const bf16*)(ws + WS_WEIN), MTOK, EIN, D}; pg8::StaticOrder S; S.init(MTOK, EIN, F.G, F.bid); pg8::rs_prepass((LAS float*)(F.lds + 131072), S, SSP, (F.wave * 64 + mk_lane())); EpiS E{BIG, EIN, (const LAS float*)(F.lds + 131072)};
          pg8::gemm_phase<EpiS, pg8::StaticOrder, true, true>(F.lds, g, S, E, F.wave); }
#pragma unroll 1
        for (int l = 0; l < 2; ++l) { pg8::Gemm g{(const bf16*)(ws + WS_MEMN) + (size_t)l * BATCH * MEMLEN * D, (const bf16*)(ws + WS_WKV) + (size_t)l * 2 * D * D, BATCH * MEMLEN, 2 * D, D};
          pg8::StaticOrder S; S.init(BATCH * MEMLEN, 2 * D, F.G, (F.bid + F.G - (F.G / 2 + 32 * l) % F.G) % F.G); pg8::EpiDense E{(bf16*)(ws + WS_KV) + (size_t)l * BATCH * MEMLEN * 2 * D, 8};
          pg8::gemm_phase<pg8::EpiDense, pg8::StaticOrder, true, true>(F.lds, g, S, E, F.wave); }
    } SEAM(1); }
    REP(2) {
    if (IN(2)) {
        { R1Pre P; if (F.bid < BATCH * NCH * 4) ret1_load(F, F.bid, P); __syncthreads();
          for (int it = F.bid; it < BATCH * NCH * 4; it += F.G) ret1_item(F, it, P, it + F.G, BATCH * NCH * 4); }
        { SwPre Q; if (F.bid < BATCH * NCH * 2) swa_load(F, F.bid, Q); __syncthreads();
          for (int it = F.bid; it < BATCH * NCH * 2; it += F.G) swa_item(F, it, Q, it + F.G, BATCH * NCH * 2); }
    } SEAM(2); }
    REP(3) {
    if (IN(3)) { scan_phase(F);
        if (F.bid < 128) { const int gi = F.bid >> 2, l = gi >> 4, b = (gi >> 2) & 3, h = gi & 3;
            pg8::Gemm g{(const bf16*)(ws + WS_WO) + (size_t)(l * 4 + h) * 256 * D, (const bf16*)(ws + WS_KV) + (size_t)((l * 4 + b) * 8 + 4 + h) * 65536, D, 256, 256};
            pg8::StaticOrder S; S.init(D, 256, 4, F.bid & 3); EpiN E{(bf16*)(ws + WS_BTO) + (size_t)(l * 4 + b) * D * D + h * 256, D, nullptr};
            pg8::gemm_phase<EpiN, pg8::StaticOrder, true, true>(F.lds, g, S, E, F.wave); }
        else if (F.bid < 256) { const int gi = (F.bid - 128) >> 2, l = gi >> 4, b = (gi >> 2) & 3, h = gi & 3;
            pg8::Gemm g{(const bf16*)(ws + WS_KV) + (size_t)((l * 4 + b) * 8 + h) * 65536, (const bf16*)(ws + WS_WQ) + (size_t)(l * 4 + h) * D * 256, 256, D, 256};
            pg8::StaticOrder S; S.init(256, D, 4, F.bid & 3); EpiN E{(bf16*)(ws + WS_BTS) + (size_t)(l * 4 + b) * D * D + (size_t)h * 256 * D, D, nullptr};
            pg8::gemm_phase<EpiN, pg8::StaticOrder, true, true>(F.lds, g, S, E, F.wave); }
    } SEAM(3); }
    REP(4) {
    if (IN(4)) { R2Pre P; if (F.bid < BATCH * NCH * 4) ret2_load(F, F.bid, P); __syncthreads();
        for (int it = F.bid; it < BATCH * NCH * 4; it += F.G) ret2_item(F, it, P, it + F.G, BATCH * NCH * 4); } SEAM(4); }
    REP(5) {
    if (IN(5)) {
        pg8::Gemm g{BUFA, (const bf16*)(ws + WS_WEOUT), MTOK, D, D}; pg8::StaticOrder S; S.init(MTOK, D, F.G, F.bid); typedef pg8::EpiResidual<true, false> EpiR0; EpiR0 E{F.ap->in[0], XB, SSP, D};
        pg8::gemm_phase<EpiR0, pg8::StaticOrder, true, true>(F.lds, g, S, E, F.wave);
    } SEAM(5); }
#pragma unroll
    for (int l = 0; l < 2; ++l) {
        const int pb = (l == 0) ? 6 : 12;
        REP(pb) {
        if (IN(pb)) {
            pg8::Gemm g{XB, (const bf16*)(ws + WS_BTS) + (size_t)l * 4 * D * D, MTOK, D, D, (size_t)D * D * 2, 5}; pg8::StaticOrder S; S.init(MTOK, D, F.G, F.bid);
            pg8::rs_prepass((LAS float*)(F.lds + 131072), S, SSP, (F.wave * 64 + mk_lane()));
            pg8::EpiSoftmax E{BUFA, (const LAS float*)(F.lds + 131072), (LAS float*)(F.lds + 135168), (LAS float*)(F.lds + 139264)};
            pg8::gemm_phase<pg8::EpiSoftmax, pg8::StaticOrder, true, true>(F.lds, g, S, E, F.wave);
        } SEAM(pb); }
        REP(pb + 2) {
        if (IN(pb + 2)) {
            pg8::Gemm g{BUFA, (const bf16*)(ws + WS_BTO) + (size_t)l * 4 * D * D, MTOK, D, D, (size_t)D * D * 2, 5};     pg8::StaticOrder S; S.init(MTOK, D, F.G, F.bid); { typedef pg8::EpiResidual<false, false> EpiR1; EpiR1 E{XB, XB, SSP, D}; pg8::gemm_phase<EpiR1, pg8::StaticOrder, true, true>(F.lds, g, S, E, F.wave); }
        } SEAM(pb + 2); }
        if (l == 0) {
            REP(9) {
            if (IN(9)) {
                pg8::Gemm g{XB, (const bf16*)(ws + WS_WOIN), MTOK, OIN, D}; pg8::StaticOrder S; S.init(MTOK, OIN, F.G, F.bid); pg8::rs_prepass((LAS float*)(F.lds + 131072), S, SSP, (F.wave * 64 + mk_lane()));
                pg8::EpiConv E{BIG, BIG + (size_t)MTOK * D, (const LAS float*)(F.lds + 131072)};
                pg8::gemm_phase<pg8::EpiConv, pg8::StaticOrder, true, true>(F.lds, g, S, E, F.wave);
            } SEAM(9); }
            REP(10) {
            if (IN(10)) { conv_phase(F); } SEAM(10); }
            REP(11) {
            if (IN(11)) {
                pg8::Gemm g{BUFA, (const bf16*)(ws + WS_WOOUT), MTOK, D, D}; pg8::StaticOrder S; S.init(MTOK, D, F.G, F.bid); typedef pg8::EpiResidual<false, false> EpiR1; EpiR1 E{XB, XB, SSP, D};
                pg8::gemm_phase<EpiR1, pg8::StaticOrder, true, true>(F.lds, g, S, E, F.wave);
            } SEAM(11); }
        }
    }
    if (IN(15)) { final_phase(F); }
#if TS_PROBE
    __syncthreads();
    if (blockIdx.x == 0 && threadIdx.x == 0) { const unsigned long long* ts = (const unsigned long long*)ws;
        const float ta = (float)(ts[TS_A_HI] - ts[TS_A_LO]) * 0.01f, tb = (float)(ts[TS_B_HI] - ts[TS_B_LO]) * 0.01f;
        F.ap->out[0] = ta; for (int i = 1; i <= 1000; ++i) F.ap->out[i] = tb; }
#endif
#undef IN
#undef SEAM
#undef ws
#undef XB
#undef SSP
#undef BIG
#undef BUFA
#undef BUFB
}

extern "C" void kernel_launch(void* const* d_in, const int* in_sizes, int n_in, void* d_out, int out_size, void* d_ws, size_t ws_size, hipStream_t stream) {
    static int grid = 0;
    if (grid == 0) {
        if (n_in != 17 || out_size != MTOK * D || ws_size < WS_END) { fprintf(stderr, "kernel_launch: unexpected shapes (n_in %d out %d ws %zu)\n", n_in, out_size, ws_size); grid = -1; return; }
        int dev = 0, cus = 0, per_cu = 0;
        hipGetDevice(&dev); hipDeviceGetAttribute(&cus, hipDeviceAttributeMultiprocessorCount, dev);
        if (hipFuncSetAttribute((const void*)fwd_megakernel, hipFuncAttributeMaxDynamicSharedMemorySize, LDS_BYTES) != hipSuccess) { fprintf(stderr, "kernel_launch: hipFuncSetAttribute failed\n"); grid = -1; return; }
        if (hipOccupancyMaxActiveBlocksPerMultiprocessor(&per_cu, (const void*)fwd_megakernel, NTHR, LDS_BYTES) != hipSuccess || per_cu < 1) { fprintf(stderr, "kernel_launch: occupancy query says %d\n", per_cu); per_cu = 1; }
        (void)hipGetLastError();
        grid = cus;
    }
    if (grid < 0) return;
    if (hipMemsetAsync(d_ws, 0, 65536, stream) != hipSuccess) { fprintf(stderr, "kernel_launch: hipMemsetAsync failed\n"); return; }
    Args a{};
    for (int i = 0; i < 17; ++i) a.in[i] = (const float*)d_in[i];
    a.out = (float*)d_out; a.ws = (unsigned char*)d_ws;
#if MK_SPLIT
    for (int p = 0; p < NPHASE; ++p) { a.ph_lo = p; a.ph_hi = p + 1; hipLaunchKernelGGL(fwd_megakernel, dim3(grid), dim3(NTHR), LDS_BYTES, stream, a); }
#else
    a.ph_lo = 0; a.ph_hi = NPHASE;
    void* kargs[] = {&a};
    hipError_t e = hipLaunchCooperativeKernel((const void*)fwd_megakernel, dim3(grid), dim3(NTHR), kargs, LDS_BYTES, stream);
    if (e != hipSuccess) fprintf(stderr, "kernel_launch: cooperative launch failed: %s (grid %d)\n", hipGetErrorString(e), grid);
#endif
}
```

```cpp
#include <hip/hip_runtime.h>
#include <hip/hip_cooperative_groups.h>
#include <cstdio>
#include <cstdint>
namespace cg = cooperative_groups;
__device__ __forceinline__ int mk_lane() { int l = (int)__builtin_amdgcn_mbcnt_hi(~0u, __builtin_amdgcn_mbcnt_lo(~0u, 0u)); asm volatile("" : "+v"(l)); return l; }
__device__ __forceinline__ float shx(float v, int mask) { return __int_as_float(__builtin_amdgcn_ds_bpermute((mk_lane() ^ mask) << 2, __float_as_int(v))); }
namespace pg8 {
#define PG8_LAS __attribute__((address_space(3)))
typedef unsigned short bf16_t;
typedef short bf16x8 __attribute__((ext_vector_type(8)));
typedef float f32x4 __attribute__((ext_vector_type(4)));
typedef unsigned u32x4 __attribute__((ext_vector_type(4)));
constexpr int BM = 256, BK = 64, HALF = 128, HTB = HALF * BK * 2  , STAGE_BYTES = 8 * HTB, NXCD = 8, WGM = 8;

__host__ __device__ __forceinline__ int lds_byte(int r, int c) { const int st = (r >> 4) * 2 + (c >> 5), rr = r & 15, cc = c & 31, ob = rr * 64 + cc * 2; return st * 1024 + (ob ^ (((ob >> 9) & 1) << 5)); }
__host__ __device__ __forceinline__ void stage_rc(int b, int& R, int& C) { const int st = b / 1024, sb = b % 1024, swz = sb ^ (((sb >> 9) & 1) << 5); R = (st >> 1) * 16 + swz / 64; C = (st & 1) * 32 + (swz % 64) / 2; }
__host__ __device__ __forceinline__ int perm32(int rho) { const int n = rho >> 4, i = rho & 15; return 8 * (i >> 2) + 4 * n + (i & 3); }

struct Unit { int pm, pn, idx; };
struct Gemm { const bf16_t* A; const bf16_t* Bt; int M, N, K; size_t bb_stride = 0; int bb_shift = 0; };

struct StaticOrder {
    int nM, nN, nwg, G, c;
    __host__ __device__ void init(int M, int N, int G_, int c_) { nM = M / BM; nN = N / BM; nwg = nM * nN; G = G_; c = c_; }
    __host__ __device__ bool next(int i, Unit& u) const {
        const long L = (long)i * G + c; if (L >= nwg) return false;
        int wgid = (int)L; { const int q = nwg / NXCD, r = nwg % NXCD, xcd = wgid % NXCD, off = wgid / NXCD; wgid = (xcd < r ? xcd * (q + 1) : r * (q + 1) + (xcd - r) * q) + off; }
        const int nig = WGM * nN, gid = wgid / nig, fm = gid * WGM, gsz = (nM - fm) < WGM ? (nM - fm) : WGM;
        u.pm = fm + ((wgid % nig) % gsz); u.pn = (wgid % nig) / gsz; u.idx = i; return true;
    }
    __device__ __forceinline__ void a_ready(const Unit&) const {}
    __device__ __forceinline__ void done(const Unit&) const {}
};

typedef float f32x2 __attribute__((ext_vector_type(2))); typedef __bf16 bf16x2_t __attribute__((ext_vector_type(2)));
__device__ __forceinline__ unsigned cvt_pk_bf16(float lo, float hi) { const f32x2 v = {lo, hi}; const bf16x2_t b = __builtin_convertvector(v, bf16x2_t); return __builtin_bit_cast(unsigned, b); }
template <bool SCALE> struct EpiScaleBf16 {
    static constexpr bool PERM = true, AFTER_DRAIN = false;
    bf16_t* O; int ldc; const PG8_LAS float* rs;
    __device__ __forceinline__ void operator()(const f32x4 (&acc)[2][2][4][2], const Unit& u, int wr, int wc, int fr, int fq) const {
        const int rl0 = wr * 64 + fr; const int col0 = u.pn * BM + wc * 32 + 8 * fq;
#pragma unroll
        for (int ai = 0; ai < 2; ++ai)
#pragma unroll
            for (int m = 0; m < 4; ++m) {
                const float sc = SCALE ? rs[256 * u.idx + rl0 + ai * HALF + m * 16] : 1.f;
                bf16_t* rowp = O + (size_t)(u.pm * BM + rl0 + ai * HALF + m * 16) * ldc + col0;
#pragma unroll
                for (int bj = 0; bj < 2; ++bj) { const f32x4 v0 = acc[ai][bj][m][0] * sc, v1 = acc[ai][bj][m][1] * sc;
                    u32x4 w; w.x = cvt_pk_bf16(v0[0], v0[1]); w.y = cvt_pk_bf16(v0[2], v0[3]); w.z = cvt_pk_bf16(v1[0], v1[1]); w.w = cvt_pk_bf16(v1[2], v1[3]);
                    *(u32x4*)(rowp + bj * HALF) = w; }
            }
    }
};
struct EpiDense {
    static constexpr bool PERM = true, AFTER_DRAIN = false;
    bf16_t* O; int nb;
    __device__ __forceinline__ void operator()(const f32x4 (&acc)[2][2][4][2], const Unit& u, int wr, int wc, int fr, int fq) const {
        bf16_t* base = O + (size_t)(u.pm * nb + u.pn) * 65536 + (wr * 64 + fr) * 256 + wc * 32 + 8 * fq;
#pragma unroll
        for (int ai = 0; ai < 2; ++ai)
#pragma unroll
            for (int m = 0; m < 4; ++m)
#pragma unroll
                for (int bj = 0; bj < 2; ++bj) { const f32x4 v0 = acc[ai][bj][m][0], v1 = acc[ai][bj][m][1];
                    u32x4 w; w.x = cvt_pk_bf16(v0[0], v0[1]); w.y = cvt_pk_bf16(v0[2], v0[3]); w.z = cvt_pk_bf16(v1[0], v1[1]); w.w = cvt_pk_bf16(v1[2], v1[3]);
                    *(u32x4*)(base + (ai * HALF + m * 16) * 256 + bj * HALF) = w; }
    }
};
struct EpiSoftmax {
    static constexpr bool PERM = true, AFTER_DRAIN = false;
    bf16_t* O; const PG8_LAS float* rs; PG8_LAS float* mxs; PG8_LAS float* sms;
    __device__ __forceinline__ void operator()(f32x4 (&acc)[2][2][4][2], const Unit& u, int wr, int wc, int fr, int fq) const {
        const int rl0 = wr * 64 + fr; const int col0 = u.pn * BM + wc * 32 + 8 * fq;
#pragma unroll
        for (int ai = 0; ai < 2; ++ai)
#pragma unroll
            for (int m = 0; m < 4; ++m) { const int rl = rl0 + ai * HALF + m * 16; const float sc = rs[256 * u.idx + rl] * (0.0625f * 1.4426950408889634f);
                float mx = -3.0e38f;
#pragma unroll
                for (int bj = 0; bj < 2; ++bj)
#pragma unroll
                    for (int n = 0; n < 2; ++n) { acc[ai][bj][m][n] = acc[ai][bj][m][n] * sc; const f32x4 v = acc[ai][bj][m][n]; mx = fmaxf(mx, fmaxf(fmaxf(v[0], v[1]), fmaxf(v[2], v[3]))); }
                mx = fmaxf(mx, shx(mx, 16)); mx = fmaxf(mx, shx(mx, 32));
                if (fq == 0) mxs[rl * 4 + wc] = mx; }
        asm volatile("s_waitcnt lgkmcnt(0)\n\ts_barrier" ::: "memory");
#pragma unroll
        for (int ai = 0; ai < 2; ++ai)
#pragma unroll
            for (int m = 0; m < 4; ++m) { const int rl = rl0 + ai * HALF + m * 16; const f32x4 pm4 = *(const PG8_LAS f32x4*)(mxs + rl * 4);
                const float mx = fmaxf(fmaxf(pm4[0], pm4[1]), fmaxf(pm4[2], pm4[3]));
                float sm = 0.f;
#pragma unroll
                for (int bj = 0; bj < 2; ++bj)
#pragma unroll
                    for (int n = 0; n < 2; ++n) { f32x4 v = acc[ai][bj][m][n];
                        v[0] = __builtin_amdgcn_exp2f(v[0] - mx); v[1] = __builtin_amdgcn_exp2f(v[1] - mx); v[2] = __builtin_amdgcn_exp2f(v[2] - mx); v[3] = __builtin_amdgcn_exp2f(v[3] - mx);
                        acc[ai][bj][m][n] = v; sm += (v[0] + v[1]) + (v[2] + v[3]); }
                sm += shx(sm, 16); sm += shx(sm, 32);
                if (fq == 0) sms[rl * 4 + wc] = sm; }
        asm volatile("s_waitcnt lgkmcnt(0)\n\ts_barrier" ::: "memory");
#pragma unroll
        for (int ai = 0; ai < 2; ++ai)
#pragma unroll
            for (int m = 0; m < 4; ++m) { const int rl = rl0 + ai * HALF + m * 16; const f32x4 ps4 = *(const PG8_LAS f32x4*)(sms + rl * 4);
                const float inv = 1.0f / ((ps4[0] + ps4[1]) + (ps4[2] + ps4[3]));
                bf16_t* rowp = O + (size_t)(u.pm * BM + rl) * 1024 + col0;
#pragma unroll
                for (int bj = 0; bj < 2; ++bj) { const f32x4 v0 = acc[ai][bj][m][0] * inv, v1 = acc[ai][bj][m][1] * inv;
                    u32x4 w; w.x = cvt_pk_bf16(v0[0], v0[1]); w.y = cvt_pk_bf16(v0[2], v0[3]); w.z = cvt_pk_bf16(v1[0], v1[1]); w.w = cvt_pk_bf16(v1[2], v1[3]);
                    *(u32x4*)(rowp + bj * HALF) = w; } }
        asm volatile("s_waitcnt lgkmcnt(0)\n\ts_barrier" ::: "memory");
    }
};
template <class Sched> __device__ __forceinline__ void rs_prepass(PG8_LAS float* rs, const Sched& S, const float* ssp, int tid) {
    const int row = tid >> 1, half = tid & 1;
    f32x4 v[8][2]; bool have[8];
#pragma unroll
    for (int i = 0; i < 8; ++i) { Unit u; have[i] = S.next(i, u);
        if (have[i]) { const f32x4* p = (const f32x4*)(ssp + (size_t)(u.pm * BM + row) * 16) + 2 * half; v[i][0] = p[0]; v[i][1] = p[1]; } }
#pragma unroll
    for (int i = 0; i < 8; ++i) if (have[i]) {
        float s = ((v[i][0][0] + v[i][0][1]) + (v[i][0][2] + v[i][0][3])) + ((v[i][1][0] + v[i][1][1]) + (v[i][1][2] + v[i][1][3]));
        s += shx(s, 1);
        if (half == 0) rs[256 * i + row] = 1.0f / sqrtf(s * (1.0f / 1024.0f) + 1e-6f); }
    __syncthreads();
}
struct EpiConv {
    static constexpr bool PERM = true, AFTER_DRAIN = false;
    bf16_t* Z; bf16_t* G2; const PG8_LAS float* rs;
    __device__ __forceinline__ void operator()(const f32x4 (&acc)[2][2][4][2], const Unit& u, int wr, int wc, int fr, int fq) const {
        const int rl0 = wr * 64 + fr; const int c = 64 * u.pn + 32 * (wc & 1) + 8 * fq;
        bf16_t* O = (wc < 2) ? Z : G2;
#pragma unroll
        for (int ai = 0; ai < 2; ++ai)
#pragma unroll
            for (int m = 0; m < 4; ++m) {
                const float sc = rs[256 * u.idx + rl0 + ai * HALF + m * 16];
                float v[8];
#pragma unroll
                for (int n = 0; n < 2; ++n)
#pragma unroll
                    for (int e = 0; e < 4; ++e) { const float a = acc[ai][0][m][n][e] * sc, b = acc[ai][1][m][n][e] * sc;
                        v[4 * n + e] = (wc < 2) ? a * b : a * (b / (1.0f + __expf(-b))); }
                u32x4 w; w.x = cvt_pk_bf16(v[0], v[1]); w.y = cvt_pk_bf16(v[2], v[3]); w.z = cvt_pk_bf16(v[4], v[5]); w.w = cvt_pk_bf16(v[6], v[7]);
                *(u32x4*)(O + (size_t)(u.pm * BM + rl0 + ai * HALF + m * 16) * 1024 + c) = w;
            }
    }
};
template <bool BASE_F32, bool OUT_F32> struct EpiResidual {
    static constexpr bool PERM = true, AFTER_DRAIN = false;
    const void* base; void* out; float* ssp; int ldc;
    __device__ __forceinline__ void operator()(const f32x4 (&acc)[2][2][4][2], const Unit& u, int wr, int wc, int fr, int fq) const {
        const int row0 = u.pm * BM + wr * 64 + fr; const int col0 = u.pn * BM + wc * 32 + 8 * fq;
#pragma unroll
        for (int ai = 0; ai < 2; ++ai)
#pragma unroll
          for (int mh = 0; mh < 2; ++mh) {
            u32x4 pb[2][2]; f32x4 fb[2][2][2];
#pragma unroll
            for (int m2 = 0; m2 < 2; ++m2)
#pragma unroll
                for (int bj = 0; bj < 2; ++bj) { const size_t off = (size_t)(row0 + ai * HALF + (2 * mh + m2) * 16) * ldc + col0 + bj * HALF;
                    if (BASE_F32) { fb[m2][bj][0] = *(const f32x4*)((const float*)base + off); fb[m2][bj][1] = *(const f32x4*)((const float*)base + off + 4); }
                    else pb[m2][bj] = *(const u32x4*)((const bf16_t*)base + off); }
#pragma unroll
            for (int m2 = 0; m2 < 2; ++m2) {
                const int m = 2 * mh + m2, row = row0 + ai * HALF + m * 16;
                float ss = 0.f;
#pragma unroll
                for (int bj = 0; bj < 2; ++bj) { const size_t off = (size_t)row * ldc + col0 + bj * HALF;
                    f32x4 b0, b1;
                    if (BASE_F32) { b0 = fb[m2][bj][0]; b1 = fb[m2][bj][1]; }
                    else { const u32x4 w = pb[m2][bj];
                        b0 = (f32x4){__uint_as_float(w.x << 16), __uint_as_float(w.x & 0xffff0000u), __uint_as_float(w.y << 16), __uint_as_float(w.y & 0xffff0000u)};
                        b1 = (f32x4){__uint_as_float(w.z << 16), __uint_as_float(w.z & 0xffff0000u), __uint_as_float(w.w << 16), __uint_as_float(w.w & 0xffff0000u)}; }
                    const f32x4 o0 = b0 + acc[ai][bj][m][0], o1 = b1 + acc[ai][bj][m][1];
                    ss += ((o0[0] * o0[0] + o0[1] * o0[1]) + (o0[2] * o0[2] + o0[3] * o0[3])) + ((o1[0] * o1[0] + o1[1] * o1[1]) + (o1[2] * o1[2] + o1[3] * o1[3]));
                    if (OUT_F32) { *(f32x4*)((float*)out + off) = o0; *(f32x4*)((float*)out + off + 4) = o1; }
                    else { u32x4 w; w.x = cvt_pk_bf16(o0[0], o0[1]); w.y = cvt_pk_bf16(o0[2], o0[3]); w.z = cvt_pk_bf16(o1[0], o1[1]); w.w = cvt_pk_bf16(o1[2], o1[3]);
                        *(u32x4*)((bf16_t*)out + off) = w; } }
                ss += shx(ss, 16); ss += shx(ss, 32);
                if (fq == 0) ssp[(size_t)row * 16 + u.pn * 4 + wc] = ss;
            }
            asm volatile("" ::: "memory");
          }
    }
};
template <class Epi, class Sched, bool ALIGN_EPI = false, bool SP2 = false>
__device__ __forceinline__ void gemm_phase(PG8_LAS unsigned char* lds, const Gemm g, const Sched& S, const Epi& E, const int wave_in) {
    int tid_ = wave_in * 64 + mk_lane(); asm volatile("" : "+v"(tid_));
    const int tid = tid_, wid = __builtin_amdgcn_readfirstlane(tid >> 6), lane = tid & 63, wr = wid >> 2, wc = wid & 3, fr = lane & 15, fq = lane >> 4;
    const int K = g.K, nt = K / BK;
    unsigned voffA[2], voffB[2];
#pragma unroll
    for (int i = 0; i < 2; ++i) { int R, C; stage_rc(tid * 16 + i * 8192, R, C); const int Rb = Epi::PERM ? ((R & ~31) + perm32(R & 31)) : R;
        voffA[i] = (unsigned)(R * K + C) * 2u; voffB[i] = (unsigned)(Rb * K + C) * 2u; }
    const size_t kstep = (size_t)(BK * 2);
    const size_t hstep = (size_t)HALF * K * 2;
    const size_t tstep = 2 * hstep;
    const unsigned ldsw = (unsigned)wid * 1024u;
    const int aoff = lds_byte(wr * 64 + fr, fq * 8), boff = lds_byte(wc * 32 + fr, fq * 8);
#define PG8_SA(b, h) (((b) * 2 + (h)) * HTB)
#define PG8_SB(b, h) ((4 + (b) * 2 + (h)) * HTB)
#define PG8_STAGE(bufoff, gbase, voff) do { _Pragma("unroll") for (int _i = 0; _i < 2; ++_i) \
        __builtin_amdgcn_global_load_lds((const unsigned*)((const char*)(gbase) + (voff)[_i]), (PG8_LAS unsigned*)(lds + (bufoff) + ldsw + _i * 8192), 16, 0, 0); } while (0)
#define PG8_LDA(dst, b, h) do { _Pragma("unroll") for (int m = 0; m < 4; ++m) _Pragma("unroll") for (int k = 0; k < 2; ++k) dst[m][k] = *(const PG8_LAS bf16x8*)(lds + PG8_SA(b, h) + aoff + m * 2048 + k * 1024); } while (0)
#define PG8_LDB(dst, b, h) do { _Pragma("unroll") for (int n = 0; n < 2; ++n) _Pragma("unroll") for (int k = 0; k < 2; ++k) dst[n][k] = *(const PG8_LAS bf16x8*)(lds + PG8_SB(b, h) + boff + n * 2048 + k * 1024); } while (0)
#define PG8_MMA(ai, bj, At, Bt) do { __builtin_amdgcn_s_setprio(1); _Pragma("unroll") for (int m = 0; m < 4; ++m) _Pragma("unroll") for (int n = 0; n < 2; ++n) _Pragma("unroll") for (int k = 0; k < 2; ++k) \
        acc[ai][bj][m][n] = __builtin_amdgcn_mfma_f32_16x16x32_bf16(Bt[n][k], At[m][k], acc[ai][bj][m][n], 0, 0, 0); __builtin_amdgcn_s_setprio(0); } while (0)
#define PG8_WAIT_V(n) asm volatile("s_waitcnt vmcnt(" #n ")" ::: "memory")
#define PG8_WAIT_L(n) asm volatile("s_waitcnt lgkmcnt(" #n ")" ::: "memory")
#define PG8_BAR __builtin_amdgcn_s_barrier()
#define PG8_SCHED __builtin_amdgcn_sched_barrier(0)
    Unit cur, nxt; int ui = 0;
    if (!S.next(0, cur)) return;
    f32x4 acc[2][2][4][2];
#pragma unroll
    for (int a = 0; a < 2; ++a)
#pragma unroll
        for (int b = 0; b < 2; ++b)
#pragma unroll
            for (int m = 0; m < 4; ++m)
#pragma unroll
                for (int n = 0; n < 2; ++n) acc[a][b][m][n] = (f32x4){0.f, 0.f, 0.f, 0.f};
    bf16x8 At[4][2], B0[2][2], B1[2][2];
    const char* cA = (const char*)g.A + (size_t)cur.pm * tstep; const char* cB = (const char*)g.Bt + (size_t)cur.pn * tstep + (size_t)(cur.pm >> g.bb_shift) * g.bb_stride;
    S.a_ready(cur);
    if constexpr (SP2) {
        PG8_STAGE(PG8_SB(0, 0), cB, voffB); PG8_STAGE(PG8_SB(0, 1), cB + hstep, voffB); PG8_STAGE(PG8_SA(0, 0), cA, voffA); PG8_STAGE(PG8_SA(0, 1), cA + hstep, voffA);
        if (wr == 1) PG8_BAR;
        PG8_WAIT_V(2); PG8_BAR;
        PG8_STAGE(PG8_SB(1, 0), cB + kstep, voffB); PG8_STAGE(PG8_SA(1, 0), cA + kstep, voffA); PG8_STAGE(PG8_SB(1, 1), cB + hstep + kstep, voffB);
        PG8_WAIT_V(6); PG8_BAR;
    } else {
        PG8_STAGE(PG8_SB(0, 0), cB, voffB); PG8_STAGE(PG8_SA(0, 0), cA, voffA); PG8_STAGE(PG8_SB(0, 1), cB + hstep, voffB); PG8_STAGE(PG8_SA(0, 1), cA + hstep, voffA);
        if (wr == 1) PG8_BAR;
        PG8_WAIT_V(4); PG8_BAR;
        PG8_STAGE(PG8_SB(1, 0), cB + kstep, voffB); PG8_STAGE(PG8_SA(1, 0), cA + kstep, voffA); PG8_STAGE(PG8_SB(1, 1), cB + hstep + kstep, voffB);
        PG8_WAIT_V(6); PG8_BAR;
    }
    for (;;) {
        const bool has_next = S.next(ui + 1, nxt);
        const char* nA = has_next ? (const char*)g.A + (size_t)nxt.pm * tstep : cA; const char* nB = has_next ? (const char*)g.Bt + (size_t)nxt.pn * tstep + (size_t)(nxt.pm >> g.bb_shift) * g.bb_stride : cB;
        for (int t = 0; t < nt; t += 2) {
            const bool last = (t == nt - 2);
            const char* a1 = cA + (size_t)(t + 1) * kstep;
            const char* a2 = last ? nA : cA + (size_t)(t + 2) * kstep; const char* b2 = last ? nB : cB + (size_t)(t + 2) * kstep;
            const char* a3 = a2 + kstep; const char* b3 = b2 + kstep;
            if (last && has_next) S.a_ready(nxt);
            if constexpr (SP2) {
            PG8_LDB(B0, 0, 0); PG8_LDB(B1, 0, 1); PG8_SCHED; PG8_LDA(At, 0, 0); PG8_STAGE(PG8_SA(1, 1), a1 + hstep, voffA);
            PG8_WAIT_V(8); PG8_WAIT_L(0); PG8_BAR; PG8_MMA(0, 0, At, B0); PG8_MMA(0, 1, At, B1); PG8_BAR; PG8_SCHED;
            PG8_LDA(At, 0, 1); PG8_STAGE(PG8_SB(0, 0), b2, voffB); PG8_STAGE(PG8_SB(0, 1), b2 + hstep, voffB); PG8_STAGE(PG8_SA(0, 0), a2, voffA);
            PG8_WAIT_V(8); PG8_WAIT_L(0); PG8_BAR; PG8_MMA(1, 0, At, B0); PG8_MMA(1, 1, At, B1); PG8_BAR; PG8_SCHED;
            PG8_LDB(B0, 1, 0); PG8_LDB(B1, 1, 1); PG8_SCHED; PG8_LDA(At, 1, 0); PG8_STAGE(PG8_SA(0, 1), a2 + hstep, voffA);
            PG8_WAIT_V(8); PG8_WAIT_L(0); PG8_BAR; PG8_MMA(0, 0, At, B0); PG8_MMA(0, 1, At, B1); PG8_BAR; PG8_SCHED;
            PG8_LDA(At, 1, 1); PG8_STAGE(PG8_SB(1, 0), b3, voffB); PG8_STAGE(PG8_SB(1, 1), b3 + hstep, voffB); PG8_STAGE(PG8_SA(1, 0), a3, voffA);
            PG8_WAIT_V(8); PG8_WAIT_L(0); PG8_BAR; PG8_MMA(1, 0, At, B0); PG8_MMA(1, 1, At, B1); PG8_BAR; PG8_SCHED;
            } else {
            PG8_LDB(B0, 0, 0); PG8_SCHED; PG8_LDA(At, 0, 0); PG8_STAGE(PG8_SA(1, 1), a1 + hstep, voffA);
            PG8_WAIT_L(8); PG8_BAR; PG8_WAIT_L(0); PG8_MMA(0, 0, At, B0); PG8_BAR; PG8_SCHED;
            PG8_LDB(B1, 0, 1); PG8_STAGE(PG8_SB(0, 0), b2, voffB);
            PG8_BAR; PG8_WAIT_L(0); PG8_MMA(0, 1, At, B1); PG8_BAR;
            PG8_LDA(At, 0, 1); PG8_STAGE(PG8_SA(0, 0), a2, voffA);
            PG8_BAR; PG8_WAIT_L(0); PG8_MMA(1, 0, At, B0); PG8_BAR; PG8_SCHED;
            PG8_STAGE(PG8_SB(0, 1), b2 + hstep, voffB);
            PG8_WAIT_V(6); PG8_BAR; PG8_MMA(1, 1, At, B1); PG8_BAR;
            PG8_LDB(B0, 1, 0); PG8_SCHED; PG8_LDA(At, 1, 0); PG8_STAGE(PG8_SA(0, 1), a2 + hstep, voffA);
            PG8_WAIT_L(8); PG8_BAR; PG8_WAIT_L(0); PG8_MMA(0, 0, At, B0); PG8_BAR; PG8_SCHED;
            PG8_LDB(B1, 1, 1); PG8_STAGE(PG8_SB(1, 0), b3, voffB);
            PG8_BAR; PG8_WAIT_L(0); PG8_MMA(0, 1, At, B1); PG8_BAR;
            PG8_LDA(At, 1, 1); PG8_STAGE(PG8_SA(1, 0), a3, voffA);
            PG8_BAR; PG8_WAIT_L(0); PG8_MMA(1, 0, At, B0); PG8_BAR; PG8_SCHED;
            PG8_STAGE(PG8_SB(1, 1), b3 + hstep, voffB);
            PG8_WAIT_V(6); PG8_BAR; PG8_MMA(1, 1, At, B1); PG8_BAR;
            }
        }
        if constexpr (ALIGN_EPI) { if (wr == 0) PG8_BAR; }
        if constexpr (!Epi::AFTER_DRAIN) { E(acc, cur, wr, wc, fr, fq); S.done(cur); }
        if (!has_next) break;
#pragma unroll
        for (int a = 0; a < 2; ++a)
#pragma unroll
            for (int b = 0; b < 2; ++b)
#pragma unroll
                for (int m = 0; m < 4; ++m)
#pragma unroll
                    for (int n = 0; n < 2; ++n) acc[a][b][m][n] = (f32x4){0.f, 0.f, 0.f, 0.f};
        cur = nxt; cA = nA; cB = nB; ++ui;
        if constexpr (ALIGN_EPI) { if (wr == 1) PG8_BAR; }
    }
    PG8_WAIT_V(0);
    if constexpr (!ALIGN_EPI) { if (wr == 0) PG8_BAR; }
    PG8_BAR;
    if constexpr (Epi::AFTER_DRAIN) { E.fused(acc, cur, wr, wc, fr, fq, lds, wid, lane); S.done(cur); }
#undef PG8_SA
#undef PG8_SB
#undef PG8_STAGE
#undef PG8_LDA
#undef PG8_LDB
#undef PG8_MMA
#undef PG8_WAIT_V
#undef PG8_WAIT_L
#undef PG8_BAR
#undef PG8_SCHED
}
}

constexpr int D = 1024, BATCH = 4, SEQ = 8192, MTOK = BATCH * SEQ, NCH = SEQ / 64, MEMLEN = 256;
constexpr int EIN = 3328, OIN = 4096;
constexpr float EPS = 1e-6f;
constexpr int C_AQ = 0, C_AK = 512, C_AV = 640, C_AG = 768, C_BQ = 1280, C_BK = 1792, C_BV = 2304, C_BG = 2816;
constexpr int NWAVES = 8, NTHR = 512;
constexpr size_t MiB = 1u << 20;
constexpr size_t WS_WEIN = 1 * MiB, WS_WEOUT = 8 * MiB, WS_WOIN = 10 * MiB, WS_WOOUT = 18 * MiB, WS_WQ = 20 * MiB, WS_WKV = 24 * MiB, WS_WO = 32 * MiB;
constexpr size_t WS_MEMN = 36 * MiB, WS_KV = 40 * MiB, WS_ROT = 48 * MiB, WS_SSP = 52 * MiB;
constexpr size_t WS_XB = 56 * MiB;
constexpr size_t WS_BIG = 120 * MiB;
constexpr size_t WS_BUFA = 376 * MiB;
constexpr size_t WS_BUFB = 440 * MiB;
constexpr size_t WS_BTO = 328 * MiB, WS_BTS = 344 * MiB;
constexpr size_t WS_END = 504 * MiB;
constexpr int LDS_BYTES = 147456;

#define LAS __attribute__((address_space(3)))
typedef unsigned short bf16;
typedef short bf16x8 __attribute__((ext_vector_type(8)));
typedef short s16x4 __attribute__((ext_vector_type(4)));
typedef float f32x2 __attribute__((ext_vector_type(2)));
typedef float f32x4 __attribute__((ext_vector_type(4)));
typedef float f32x16 __attribute__((ext_vector_type(16)));
typedef unsigned u32x2 __attribute__((ext_vector_type(2)));
typedef unsigned u32x4 __attribute__((ext_vector_type(4)));

__device__ __forceinline__ unsigned pk2(float lo, float hi) { return pg8::cvt_pk_bf16(lo, hi); }
__device__ __forceinline__ float bflo(unsigned w) { return __uint_as_float(w << 16); }
__device__ __forceinline__ float bfhi(unsigned w) { return __uint_as_float(w & 0xffff0000u); }
__device__ __forceinline__ int crow(int r, int hi) { return (r & 3) + 8 * (r >> 2) + 4 * hi; }
__device__ __forceinline__ float wave_sum(float v) {
#pragma unroll
    for (int o = 1; o < 64; o <<= 1) v += shx(v, o);
    return v;
}
__device__ __forceinline__ float silu(float x) { return x / (1.0f + __expf(-x)); }
__device__ __forceinline__ s16x4 trd(const LAS bf16* p) { return __builtin_bit_cast(s16x4, __builtin_amdgcn_ds_read_tr16_b64_v4i16((LAS s16x4*)p)); }
__device__ __forceinline__ bf16x8 tr_frag(const LAS bf16* T, int ld, int k0, int n0, int lane) {
    const int g4 = lane >> 4, li = lane & 15, q = li >> 2, p = li & 3, hi = g4 >> 1;
    const LAS bf16* a = T + (k0 + 4 * hi + q) * ld + n0 + 16 * (g4 & 1) + 4 * p;
    const s16x4 lo = trd(a), up = trd(a + 8 * ld);
    return (bf16x8){lo[0], lo[1], lo[2], lo[3], up[0], up[1], up[2], up[3]};
}
__device__ __forceinline__ bf16x8 pack8(float a0, float a1, float a2, float a3, float a4, float a5, float a6, float a7) {
    u32x4 w; w.x = pk2(a0, a1); w.y = pk2(a2, a3); w.z = pk2(a4, a5); w.w = pk2(a6, a7); return __builtin_bit_cast(bf16x8, w);
}
__device__ __forceinline__ int launder(int v) { asm volatile("" : "+v"(v)); return v; }
#define LBAR() asm volatile("s_waitcnt lgkmcnt(0)\n\ts_barrier" ::: "memory")
#define MFMA32(a, b, c) __builtin_amdgcn_mfma_f32_32x32x16_bf16((a), (b), (c), 0, 0, 0)

#define XB_TMO      128
#define XB_XCNT(j)  (256  + 64 * (j))
#define XB_XSUB(j)  (1280 + 64 * (j))
#define XB_XGEN(j)  (2304 + 64 * (j))
#define XB_TOP      3328
#define XB_TOPGEN   3392
#define XCD_BAR_WORDS 3456
#define XB_SPIN_CAP (1u << 18)

__device__ __forceinline__ unsigned xb_ld(unsigned* p)              { return __hip_atomic_load(p, __ATOMIC_RELAXED, __HIP_MEMORY_SCOPE_AGENT); }
__device__ __forceinline__ unsigned xb_add(unsigned* p, unsigned v) { return __hip_atomic_fetch_add(p, v, __ATOMIC_RELAXED, __HIP_MEMORY_SCOPE_AGENT); }
__device__ __forceinline__ unsigned xb_xcc_id() { return (unsigned)__builtin_amdgcn_s_getreg((3 << 11) | 20) & 0xFu; }
#define XB_SPIN(cond, bar) do { unsigned _sp = 0; while (cond) { __builtin_amdgcn_s_sleep(1); \
    if ((++_sp & 255u) == 0u) { if (xb_ld(&(bar)[XB_TMO])) break; if (_sp > XB_SPIN_CAP) { atomicAdd(&(bar)[XB_TMO], 1u); break; } } } } while (0)

struct XcdBarrier {
    unsigned* bar; unsigned x; int wv;
    volatile LAS unsigned* st;
};

__device__ __forceinline__ XcdBarrier xcd_barrier_post(unsigned* bar, volatile LAS unsigned* st, int wv) {
    XcdBarrier b; b.bar = bar; b.x = xb_xcc_id(); b.st = st; b.wv = wv;
    if (wv == 0 && mk_lane() == 0) (void)xb_add(&bar[XB_XCNT(b.x)], 1u);
    return b;
}
__device__ __forceinline__ void xcd_barrier_complete(unsigned* bar, unsigned x, unsigned& nloc, unsigned& nx) {
    const unsigned G = gridDim.x * gridDim.y * gridDim.z;
    unsigned sum, cnt, mine, sp = 0u;
    for (;;) {
        sum = 0u; cnt = 0u; mine = 0u;
#pragma unroll
        for (unsigned j = 0; j < 16; ++j) { const unsigned c = xb_ld(&bar[XB_XCNT(j)]); sum += c; cnt += (c > 0u) ? 1u : 0u; mine = (j == x) ? c : mine; }
        if (sum == G) break;
        __builtin_amdgcn_s_sleep(1);
        if ((++sp & 255u) == 0u) { if (xb_ld(&bar[XB_TMO])) break; if (sp > XB_SPIN_CAP) { atomicAdd(&bar[XB_TMO], 1u); break; } }
    }
    nloc = mine > 0u ? mine : 1u; nx = cnt > 0u ? cnt : 1u;
}

__device__ __forceinline__ void xcd_barrier(const XcdBarrier& b) {
    asm volatile("s_waitcnt vmcnt(0)" ::: "memory");
    __syncthreads();
    if (b.wv == 0 && mk_lane() == 0) {
        unsigned* bar = b.bar;
        __builtin_amdgcn_s_waitcnt(0);
        unsigned nloc = b.st[0], nx = b.st[1];
        if (nloc == 0u) { xcd_barrier_complete(bar, b.x, nloc, nx); b.st[0] = nloc; b.st[1] = nx; }
        const unsigned old = xb_add(&bar[XB_XSUB(b.x)], 1u);
        const unsigned gen = old / nloc;
        if (old + 1u == (gen + 1u) * nloc) {
            __builtin_amdgcn_fence(__ATOMIC_RELEASE, "agent");
            asm volatile("s_waitcnt vmcnt(0)" ::: "memory");
            const unsigned og = xb_add(&bar[XB_TOP], 1u);
            const unsigned tg = og / nx;
            if (og + 1u == (tg + 1u) * nx) xb_add(&bar[XB_TOPGEN], 1u);
            else XB_SPIN(xb_ld(&bar[XB_TOPGEN]) == tg, bar);
            __builtin_amdgcn_fence(__ATOMIC_ACQUIRE, "agent");
            xb_add(&bar[XB_XGEN(b.x)], 1u);
            asm volatile("s_waitcnt vmcnt(0)" ::: "memory");
        } else {
            XB_SPIN(xb_ld(&bar[XB_XGEN(b.x)]) == gen, bar);
            __builtin_amdgcn_fence(__ATOMIC_ACQUIRE, "agent");
            asm volatile("s_waitcnt vmcnt(0)" ::: "memory");
        }
    }
    __syncthreads();
}

constexpr int XB_WS_OFF = 4096, XB_LDS_OFF = 147200;
struct Args { const float* in[17]; float* out; unsigned char* ws; int ph_lo, ph_hi; };
struct Frame {
    LAS unsigned char* lds; int wave, G, bid;
    const Args* ap;
};

__device__ __forceinline__ int oin_src_col(int np) { const int t = np >> 8, j = np & 255, bj = j >> 7, wc = (j >> 5) & 3, r = j & 31, c = 64 * t + 32 * (wc & 1) + r;
    const int grp = (wc < 2) ? (bj ? 2 : 1) : (bj ? 3 : 0); return grp * 1024 + c; }
template <bool PERMC = false> __device__ __forceinline__ void p0_transpose_item(const float* W, const float* gain, int K, int N, bf16* WT, LAS float* scr, int item, int lane) {
    const int nblk = N / 32, kb = item / nblk, nb = item % nblk, k0 = 64 * kb, n0 = 32 * nb, ns0 = PERMC ? oin_src_col(n0) : n0;
    float wv[32];
#pragma unroll
    for (int i = 0; i < 32; ++i) wv[i] = W[(size_t)(k0 + 2 * i + (lane >> 5)) * N + ns0 + (lane & 31)];
    if (gain) {
#pragma unroll
        for (int i = 0; i < 32; ++i) wv[i] *= gain[k0 + 2 * i + (lane >> 5)]; }
#pragma unroll
    for (int i = 0; i < 32; ++i) scr[(2 * i + (lane >> 5)) * 33 + (lane & 31)] = wv[i];
    asm volatile("s_waitcnt lgkmcnt(0)" ::: "memory");
    const int c = lane & 7;
#pragma unroll
    for (int j = 0; j < 4; ++j) { const int n = (lane >> 3) + 8 * j; const LAS float* s = scr + (8 * c) * 33 + n;
        u32x4 o; o.x = pk2(s[0 * 33], s[1 * 33]); o.y = pk2(s[2 * 33], s[3 * 33]); o.z = pk2(s[4 * 33], s[5 * 33]); o.w = pk2(s[6 * 33], s[7 * 33]);
        *(u32x4*)(WT + (size_t)(n0 + n) * K + k0 + 8 * c) = o; }
    asm volatile("s_waitcnt lgkmcnt(0)" ::: "memory");
}
__device__ __forceinline__ void p0_prologue(Frame& F) {
    LAS float* scr = (LAS float*)(F.lds + F.wave * 16384);
    const int gw = F.bid * NWAVES + F.wave, NGW = F.G * NWAVES, lane = mk_lane();
    unsigned char* ws = F.ap->ws;
    constexpr int I_EIN = 16 * (EIN / 32), I_SQ = 16 * 32, I_OIN = 16 * (OIN / 32), I_KV = 16 * 64;
    constexpr int NITEMS = I_EIN + I_SQ + I_OIN + I_SQ + 2 * I_KV + 2 * I_SQ;
    for (int it = gw; it < NITEMS; it += NGW) {
        int r = it;
        if (r < I_EIN) { p0_transpose_item(F.ap->in[3], F.ap->in[2], D, EIN, (bf16*)(ws + WS_WEIN), scr, r, lane); continue; } r -= I_EIN;
        if (r < I_SQ) { p0_transpose_item(F.ap->in[5], nullptr, D, D, (bf16*)(ws + WS_WEOUT), scr, r, lane); continue; } r -= I_SQ;
        if (r < I_OIN) { p0_transpose_item<true>(F.ap->in[7], F.ap->in[6], D, OIN, (bf16*)(ws + WS_WOIN), scr, r, lane); continue; } r -= I_OIN;
        if (r < I_SQ) { p0_transpose_item(F.ap->in[10], nullptr, D, D, (bf16*)(ws + WS_WOOUT), scr, r, lane); continue; } r -= I_SQ;
        if (r < 2 * I_KV) { const int l = r / I_KV; p0_transpose_item(F.ap->in[14] + (size_t)l * D * 2 * D, nullptr, D, 2 * D, (bf16*)(ws + WS_WKV) + (size_t)l * 2 * D * D, scr, r % I_KV, lane); continue; } r -= 2 * I_KV;
        { const int lh = r / 128; p0_transpose_item(F.ap->in[15] + (size_t)lh * 256 * D, nullptr, 256, D, (bf16*)(ws + WS_WO) + (size_t)lh * 256 * D, scr, r % 128, lane); }
    }
    for (int e = F.bid * NTHR + launder(F.wave * 64 + mk_lane()); e < 2 * D * 4 * 32; e += F.G * NTHR) {
        const int ch = e & 31, h = (e >> 5) & 3, k = (e >> 7) & 1023, l = e >> 17;
        const float* src = F.ap->in[13] + ((size_t)l * D + k) * D + h * 256 + ch * 8; const float gk = F.ap->in[11][l * D + k];
        const f32x4 a = *(const f32x4*)src, b = *(const f32x4*)(src + 4);
        u32x4 w; w.x = pk2(a[0] * gk, a[1] * gk); w.y = pk2(a[2] * gk, a[3] * gk); w.z = pk2(b[0] * gk, b[1] * gk); w.w = pk2(b[2] * gk, b[3] * gk);
        *(u32x4*)((bf16*)(ws + WS_WQ) + ((size_t)(l * 4 + h) * D + k) * 256 + ch * 8) = w;
    }
    for (int it = gw; it < 2 * BATCH * MEMLEN; it += NGW) {
        const int l = it / (BATCH * MEMLEN), row = it % (BATCH * MEMLEN);
        const f32x4* xr = (const f32x4*)(F.ap->in[1] + (size_t)row * D) + lane; const f32x4* gr = (const f32x4*)(F.ap->in[12] + l * D) + lane;
        f32x4 v[4]; float s = 0.f;
#pragma unroll
        for (int j = 0; j < 4; ++j) { v[j] = xr[64 * j]; s += (v[j][0] * v[j][0] + v[j][1] * v[j][1]) + (v[j][2] * v[j][2] + v[j][3] * v[j][3]); }
        const float rs = 1.0f / sqrtf(wave_sum(s) * (1.0f / D) + EPS);
        u32x2* o8 = (u32x2*)((bf16*)(ws + WS_MEMN) + (size_t)it * D) + lane;
#pragma unroll
        for (int j = 0; j < 4; ++j) { const f32x4 g = gr[64 * j]; u32x2 w; w.x = pk2(v[j][0] * rs * g[0], v[j][1] * rs * g[1]); w.y = pk2(v[j][2] * rs * g[2], v[j][3] * rs * g[3]); o8[64 * j] = w; }
    }
    for (int row = 2 * gw; row < MTOK; row += 2 * NGW) {
        f32x4 v[2][4];
#pragma unroll
        for (int t = 0; t < 2; ++t) { const f32x4* xr = (const f32x4*)(F.ap->in[0] + (size_t)(row + t) * D) + lane;
#pragma unroll
            for (int j = 0; j < 4; ++j) v[t][j] = xr[64 * j]; }
#pragma unroll
        for (int t = 0; t < 2; ++t) { float s = 0.f;
#pragma unroll
            for (int j = 0; j < 4; ++j) s += (v[t][j][0] * v[t][j][0] + v[t][j][1] * v[t][j][1]) + (v[t][j][2] * v[t][j][2] + v[t][j][3] * v[t][j][3]);
            s = wave_sum(s);
            u32x2* o8 = (u32x2*)((bf16*)(ws + WS_XB) + (size_t)(row + t) * D) + lane;
#pragma unroll
            for (int j = 0; j < 4; ++j) { u32x2 w; w.x = pk2(v[t][j][0], v[t][j][1]); w.y = pk2(v[t][j][2], v[t][j][3]); o8[64 * j] = w; }
            if (lane < 16) ((float*)(ws + WS_SSP))[(size_t)(row + t) * 16 + lane] = (lane == 0) ? s : 0.f; }
    }
    for (int e = F.bid * NTHR + launder((F.wave * 64 + mk_lane())); e < SEQ * 64; e += F.G * NTHR) {
        const int pos = e >> 6, j = e & 63;
        const float inv = 1.0f / exp2f(((float)j / 63.0f) * 13.287712379549449f);
        const float ang = (float)pos * inv;
        const double a = (double)ang, kk = rint(a * 0.63661977236758134308);
        const float r = (float)fma(-kk, 1.57079632679489661923, a), r2 = r * r;
        const float sn = r + r * r2 * (-1.6666654611e-1f + r2 * (8.3321608736e-3f + r2 * (-1.9515295891e-4f)));
        const float cs = 1.0f - 0.5f * r2 + r2 * r2 * (4.166664568298827e-2f + r2 * (-1.388731625493765e-3f + r2 * 2.443315711809948e-5f));
        const int q = ((int)kk) & 3;
        f32x2 o; o.x = (q == 0) ? cs : (q == 1) ? -sn : (q == 2) ? -cs : sn; o.y = (q == 0) ? sn : (q == 1) ? cs : (q == 2) ? -sn : -cs;
        ((f32x2*)(ws + WS_ROT))[e] = o;
    }
}

constexpr int AKS = 72;
struct SwPre { u32x4 kx[3], vx[3]; bf16x8 qf[4]; };
__device__ __forceinline__ void swa_load(Frame& F, int item, SwPre& P) {
    const int kvh = item & 1, c = (item >> 1) & (NCH - 1), b = item >> 8;
    const int c0 = c >= 2 ? c - 2 : 0, nch = c - c0 + 1;
    const int tid = launder((F.wave * 64 + mk_lane())), lane = tid & 63, w = F.wave, r32 = lane & 31, hi = lane >> 5;
    const bf16* HC = (const bf16*)(F.ap->ws + WS_BIG);
    const size_t rowbase = (size_t)b * SEQ;
    const int qh = kvh * 4 + (w >> 1);
    const size_t tok = rowbase + c * 64 + (w & 1) * 32 + r32;
    const bf16* qp = HC + tok * EIN + C_AQ + qh * 64 + hi * 8;
#pragma unroll
    for (int i = 0; i < 3; ++i) if (i < nch) { const int p = tid + i * NTHR, r = p >> 3, ch = p & 7; const bf16* src = HC + (rowbase + c0 * 64 + r) * EIN + kvh * 64 + ch * 8;
        P.kx[i] = *(const u32x4*)(src + C_AK); P.vx[i] = *(const u32x4*)(src + C_AV); }
#pragma unroll
    for (int s = 0; s < 4; ++s) P.qf[s] = *(const bf16x8*)(qp + 16 * s);
}
__device__ __forceinline__ void swa_item(Frame& F, int item, SwPre& P, int next_item, int n_items) {
    const int kvh = item & 1, c = (item >> 1) & (NCH - 1), b = item >> 8;
    const int c0 = c >= 2 ? c - 2 : 0, nch = c - c0 + 1;
    const int tid = launder((F.wave * 64 + mk_lane())), lane = tid & 63, w = F.wave, r32 = lane & 31, hi = lane >> 5;
    LAS bf16* Ks = (LAS bf16*)F.lds; LAS bf16* Vs = Ks + 192 * AKS;
    const bf16* HC = (const bf16*)(F.ap->ws + WS_BIG);
    const size_t rowbase = (size_t)b * SEQ;
    const int qh = kvh * 4 + (w >> 1);
    const size_t tok = rowbase + c * 64 + (w & 1) * 32 + r32;
    const bf16* gp = HC + tok * EIN + C_AG + qh * 64;
#pragma unroll
    for (int i = 0; i < 3; ++i) if (i < nch) { const int p = tid + i * NTHR, r = p >> 3, ch = p & 7; *(LAS u32x4*)(Ks + r * AKS + ch * 8) = P.kx[i]; *(LAS u32x4*)(Vs + r * AKS + ch * 8) = P.vx[i]; }
    bf16x8 qf[4]; u32x2 gg[2][4];
#pragma unroll
    for (int s = 0; s < 4; ++s) qf[s] = P.qf[s];
    if (next_item < n_items) swa_load(F, next_item, P);
#pragma unroll
    for (int db = 0; db < 2; ++db)
#pragma unroll
        for (int gi = 0; gi < 4; ++gi) gg[db][gi] = *(const u32x2*)(gp + 32 * db + 8 * gi + 4 * hi);
    LBAR();
    const int nkb = 2 * nch;
    f32x16 st[6];
#pragma unroll
    for (int kb = 0; kb < 6; ++kb) { st[kb] = (f32x16){};
        if (kb < nkb) {
#pragma unroll
            for (int s = 0; s < 4; ++s) { const bf16x8 a = *(const LAS bf16x8*)(Ks + (32 * kb + r32) * AKS + 16 * s + 8 * hi); st[kb] = MFMA32(a, qf[s], st[kb]); } } }
    bf16x8 vpre[2][2][2];
#pragma unroll
    for (int kb = 0; kb < 2; ++kb)
#pragma unroll
        for (int s = 0; s < 2; ++s)
#pragma unroll
            for (int db = 0; db < 2; ++db) vpre[kb][s][db] = tr_frag(Vs, AKS, 32 * kb + 16 * s, 32 * db, lane);
    float mx = -3.0e38f;
#pragma unroll
    for (int kb = 0; kb < 6; ++kb) if (kb < nkb) {
#pragma unroll
        for (int i = 0; i < 16; ++i) mx = fmaxf(mx, st[kb][i]); }
    mx = fmaxf(mx, shx(mx, 32));
    const float sink = F.ap->in[4][qh];
    const float mref = fmaxf(mx * 0.125f, sink);
    const float L2E = 1.4426950408889634f;
    float sum = 0.f;
#pragma unroll
    for (int kb = 0; kb < 6; ++kb) if (kb < nkb) {
#pragma unroll
        for (int i = 0; i < 16; ++i) { const float p = exp2f((st[kb][i] * 0.125f - mref) * L2E); st[kb][i] = p; sum += p; } }
    sum += shx(sum, 32);
    const float inv = 1.0f / (sum + exp2f((sink - mref) * L2E));
    f32x16 o[2]; o[0] = (f32x16){}; o[1] = (f32x16){};
#pragma unroll
    for (int kb = 0; kb < 6; ++kb) if (kb < nkb) {
#pragma unroll
        for (int s = 0; s < 2; ++s) {
            const bf16x8 pf = pack8(st[kb][8 * s + 0] * inv, st[kb][8 * s + 1] * inv, st[kb][8 * s + 2] * inv, st[kb][8 * s + 3] * inv, st[kb][8 * s + 4] * inv, st[kb][8 * s + 5] * inv, st[kb][8 * s + 6] * inv, st[kb][8 * s + 7] * inv);
#pragma unroll
            for (int db = 0; db < 2; ++db) { const bf16x8 vf = (kb < 2) ? vpre[kb < 2 ? kb : 0][s][db] : tr_frag(Vs, AKS, 32 * kb + 16 * s, 32 * db, lane); o[db] = MFMA32(vf, pf, o[db]); } } }
    bf16* yp = (bf16*)(F.ap->ws + WS_BUFA) + tok * D + qh * 64;
#pragma unroll
    for (int db = 0; db < 2; ++db)
#pragma unroll
        for (int gi = 0; gi < 4; ++gi) { const int d0 = 32 * db + 8 * gi + 4 * hi; const u32x2 g = gg[db][gi];
            u32x2 y; y.x = pk2(o[db][4 * gi + 0] * silu(bflo(g.x)), o[db][4 * gi + 1] * silu(bfhi(g.x))); y.y = pk2(o[db][4 * gi + 2] * silu(bflo(g.y)), o[db][4 * gi + 3] * silu(bfhi(g.y)));
            *(u32x2*)(yp + d0) = y; }
    LBAR();
}

constexpr int RKS = 136;
__device__ __forceinline__ float head_lg2(int h) { return log2f(1.0f - exp2f(-5.0f - (float)h)); }
struct R1Pre { u32x4 q1, q2, k1, k2, v1, v2; f32x4 rt[4]; };
__device__ __forceinline__ void ret1_load(Frame& F, int item, R1Pre& P) {
    const int h = item & 3, c = (item >> 2) & (NCH - 1), b = item >> 9;
    const int tid = launder((F.wave * 64 + mk_lane())), j = tid >> 3, pc = tid & 7;
    const bf16* rowp = (const bf16*)(F.ap->ws + WS_BIG) + ((size_t)b * SEQ + (size_t)c * 64 + j) * EIN;
    P.q1 = *(const u32x4*)(rowp + C_BQ + h * 128 + 8 * pc); P.q2 = *(const u32x4*)(rowp + C_BQ + h * 128 + 64 + 8 * pc);
    P.k1 = *(const u32x4*)(rowp + C_BK + h * 128 + 8 * pc); P.k2 = *(const u32x4*)(rowp + C_BK + h * 128 + 64 + 8 * pc);
    P.v1 = *(const u32x4*)(rowp + C_BV + h * 128 + 16 * pc); P.v2 = *(const u32x4*)(rowp + C_BV + h * 128 + 16 * pc + 8);
    const f32x4* rt = (const f32x4*)((const f32x2*)(F.ap->ws + WS_ROT) + (size_t)(c * 64 + j) * 64 + 8 * pc);
#pragma unroll
    for (int e = 0; e < 4; ++e) P.rt[e] = rt[e];
}
__device__ __forceinline__ void ret1_item(Frame& F, int item, R1Pre& P, int next_item, int n_items) {
    const int h = item & 3, c = (item >> 2) & (NCH - 1), b = item >> 9;
    const int tid = launder((F.wave * 64 + mk_lane())), lane = tid & 63, w = F.wave, r32 = lane & 31, hi = lane >> 5;
    LAS bf16* Qr = (LAS bf16*)F.lds; LAS bf16* Kr = Qr + 64 * RKS; LAS bf16* Vs = Kr + 64 * RKS; LAS bf16* Vd = Vs + 64 * RKS;
    bf16* HC = (bf16*)(F.ap->ws + WS_BIG);
    const size_t rowbase = (size_t)b * SEQ + (size_t)c * 64;
    const float lg2 = head_lg2(h);
    {
        const int j = tid >> 3, pc = tid & 7;
        const u32x4 q1 = P.q1, q2 = P.q2, k1 = P.k1, k2 = P.k2, v1 = P.v1, v2 = P.v2;
        const f32x4* rt = P.rt;
        u32x4 qa, qb, ka, kb;
        const float ksc = 0.08838834764831845f;
#pragma unroll
        for (int e = 0; e < 4; ++e) { const f32x4 cs = rt[e];
            const float a0 = bflo(q1[e]), a1 = bfhi(q1[e]), b0 = bflo(q2[e]), b1 = bfhi(q2[e]);
            qa[e] = pk2(a0 * cs[0] - b0 * cs[1], a1 * cs[2] - b1 * cs[3]); qb[e] = pk2(a0 * cs[1] + b0 * cs[0], a1 * cs[3] + b1 * cs[2]);
            const float c0 = bflo(k1[e]), c1 = bfhi(k1[e]), d0 = bflo(k2[e]), d1 = bfhi(k2[e]);
            ka[e] = pk2((c0 * cs[0] - d0 * cs[1]) * ksc, (c1 * cs[2] - d1 * cs[3]) * ksc); kb[e] = pk2((c0 * cs[1] + d0 * cs[0]) * ksc, (c1 * cs[3] + d1 * cs[2]) * ksc); }
        *(LAS u32x4*)(Qr + j * RKS + 8 * pc) = qa; *(LAS u32x4*)(Qr + j * RKS + 64 + 8 * pc) = qb;
        *(LAS u32x4*)(Kr + j * RKS + 8 * pc) = ka; *(LAS u32x4*)(Kr + j * RKS + 64 + 8 * pc) = kb;
        { bf16* yq = (bf16*)(F.ap->ws + WS_BUFA) + (rowbase + j) * D + 512 + h * 128 + 8 * pc; *(u32x4*)yq = qa; *(u32x4*)(yq + 64) = qb; }
        *(LAS u32x4*)(Vs + j * RKS + 16 * pc) = v1; *(LAS u32x4*)(Vs + j * RKS + 16 * pc + 8) = v2;
        const float kd = exp2f(lg2 * (float)(63 - j));
        u32x4 w1, w2;
#pragma unroll
        for (int e = 0; e < 4; ++e) { w1[e] = pk2(bflo(v1[e]) * kd, bfhi(v1[e]) * kd); w2[e] = pk2(bflo(v2[e]) * kd, bfhi(v2[e]) * kd); }
        *(LAS u32x4*)(Vd + j * RKS + 16 * pc) = w1; *(LAS u32x4*)(Vd + j * RKS + 16 * pc + 8) = w2;
    }
    if (next_item < n_items) ret1_load(F, next_item, P);
    LBAR();
    const int ib = w & 1, db = w >> 1;
    f32x16 st[2];
    const int rb = w >> 1;
    bf16x8 qfr[8], vfr[4], afr[4], bfr[2][4];
#pragma unroll
    for (int s = 0; s < 8; ++s) qfr[s] = *(const LAS bf16x8*)(Qr + (32 * ib + r32) * RKS + 16 * s + 8 * hi);
#pragma unroll
    for (int jb = 0; jb < 2; ++jb) { bf16x8 afk[8];
#pragma unroll
        for (int s = 0; s < 8; ++s) afk[s] = *(const LAS bf16x8*)(Kr + (32 * jb + r32) * RKS + 16 * s + 8 * hi);
        if (jb == 1) {
#pragma unroll
            for (int s = 0; s < 4; ++s) { vfr[s] = tr_frag(Vs, RKS, 16 * s, 32 * db, lane); afr[s] = tr_frag(Kr, RKS, 16 * s, 32 * rb, lane);
                bfr[0][s] = tr_frag(Vd, RKS, 16 * s, 32 * (2 * (w & 1)), lane); bfr[1][s] = tr_frag(Vd, RKS, 16 * s, 32 * (2 * (w & 1) + 1), lane); } }
        st[jb] = (f32x16){};
#pragma unroll
        for (int s = 0; s < 8; ++s) st[jb] = MFMA32(afk[s], qfr[s], st[jb]); }
    const int iloc = 32 * ib + r32;
#pragma unroll
    for (int jb = 0; jb < 2; ++jb)
#pragma unroll
        for (int i = 0; i < 16; ++i) { const int j = 32 * jb + crow(i, hi); const int dd = iloc > j ? iloc - j : j - iloc; st[jb][i] *= exp2f(lg2 * (float)dd); }
    f32x16 o = (f32x16){};
#pragma unroll
    for (int jb = 0; jb < 2; ++jb)
#pragma unroll
        for (int s = 0; s < 2; ++s) {
            const bf16x8 pf = pack8(st[jb][8 * s + 0], st[jb][8 * s + 1], st[jb][8 * s + 2], st[jb][8 * s + 3], st[jb][8 * s + 4], st[jb][8 * s + 5], st[jb][8 * s + 6], st[jb][8 * s + 7]);
            o = MFMA32(vfr[2 * jb + s], pf, o); }
    {
        bf16* op = (bf16*)F.ap->out + (rowbase + iloc) * 512 + h * 128 + 32 * db + 4 * hi;
#pragma unroll
        for (int gi = 0; gi < 4; ++gi) { u32x2 y; y.x = pk2(o[4 * gi], o[4 * gi + 1]); y.y = pk2(o[4 * gi + 2], o[4 * gi + 3]); *(u32x2*)(op + 8 * gi) = y; }
    }
    f32x16 kv[2]; kv[0] = (f32x16){}; kv[1] = (f32x16){};
#pragma unroll
    for (int s = 0; s < 4; ++s)
#pragma unroll
        for (int t = 0; t < 2; ++t) kv[t] = MFMA32(afr[s], bfr[t][s], kv[t]);
    bf16* stp = (bf16*)(F.ap->ws + WS_BUFB) + ((size_t)(b * NCH + c) * 4 + h) * 16384;
#pragma unroll
    for (int t = 0; t < 2; ++t) { const int dv = 32 * (2 * (w & 1) + t) + r32;
#pragma unroll
        for (int gi = 0; gi < 4; ++gi) { const int dk = 32 * rb + 8 * gi + 4 * hi; u32x2 y; y.x = pk2(kv[t][4 * gi], kv[t][4 * gi + 1]); y.y = pk2(kv[t][4 * gi + 2], kv[t][4 * gi + 3]);
            *(u32x2*)(stp + dv * 128 + dk) = y; } }
    LBAR();
}

__device__ __forceinline__ void scan_phase(Frame& F) {
    u32x4* ST = (u32x4*)(F.ap->ws + WS_BUFB);
    const int tsc = launder(F.wave * 64 + mk_lane());
    if (tsc < 128)
    for (int e = F.bid * 128 + tsc; e < BATCH * 4 * 2048; e += F.G * 128) {
        const int idx = e & 2047, h = (e >> 11) & 3, b = e >> 13;
        const float dec = exp2f(head_lg2(h) * 64.0f);
        u32x4* p = ST + ((size_t)(b * NCH) * 4 + h) * 2048 + idx;
        float st[8];
#pragma unroll
        for (int i = 0; i < 8; ++i) st[i] = 0.f;
        u32x4 ka[16], kb[16];
#define SCAN_LD(dst, c0) do { _Pragma("unroll") for (int j = 0; j < 16; ++j) dst[j] = p[(size_t)((c0) + j) * 4 * 2048]; } while (0)
#define SCAN_UP(src, c0) do { _Pragma("unroll") for (int j = 0; j < 16; ++j) { u32x4 o; o.x = pk2(st[0], st[1]); o.y = pk2(st[2], st[3]); o.z = pk2(st[4], st[5]); o.w = pk2(st[6], st[7]); p[(size_t)((c0) + j) * 4 * 2048] = o; \
            _Pragma("unroll") for (int i = 0; i < 4; ++i) { st[2 * i] = st[2 * i] * dec + bflo(src[j][i]); st[2 * i + 1] = st[2 * i + 1] * dec + bfhi(src[j][i]); } } } while (0)
        SCAN_LD(ka, 0);
#pragma unroll 1
        for (int c0 = 0; c0 < NCH; c0 += 32) { SCAN_LD(kb, c0 + 16); SCAN_UP(ka, c0); if (c0 + 32 < NCH) SCAN_LD(ka, c0 + 32); SCAN_UP(kb, c0 + 16); }
#undef SCAN_LD
#undef SCAN_UP
    }
}

struct R2Pre { bf16x8 af[8], qv[8]; u32x2 oi[4]; u32x2 gg[4]; };
__device__ __forceinline__ void ret2_load(Frame& F, int item, R2Pre& P) {
    const int h = item & 3, c = (item >> 2) & (NCH - 1), b = item >> 9;
    const int lane = launder(mk_lane()), w = F.wave, r32 = lane & 31, hi = lane >> 5;
    const int ib = w & 1, db = w >> 1, iloc = 32 * ib + r32;
    const size_t tok = (size_t)b * SEQ + (size_t)c * 64 + iloc;
    const bf16* stp = (const bf16*)(F.ap->ws + WS_BUFB) + ((size_t)(b * NCH + c) * 4 + h) * 16384 + (size_t)(32 * db + r32) * 128 + 8 * hi;
    const bf16* qp = (const bf16*)(F.ap->ws + WS_BUFA) + tok * D + 512 + h * 128 + 8 * hi;
    const bf16* op = (const bf16*)F.ap->out + tok * 512 + h * 128 + 32 * db + 4 * hi;
    const bf16* gp = (const bf16*)(F.ap->ws + WS_BIG) + tok * EIN + C_BG + h * 128 + 32 * db + 4 * hi;
#pragma unroll
    for (int s = 0; s < 8; ++s) { P.af[s] = *(const bf16x8*)(stp + 16 * s); P.qv[s] = *(const bf16x8*)(qp + 16 * s); }
#pragma unroll
    for (int gi = 0; gi < 4; ++gi) { P.oi[gi] = *(const u32x2*)(op + 8 * gi); P.gg[gi] = *(const u32x2*)(gp + 8 * gi); }
}
__device__ __forceinline__ void ret2_item(Frame& F, int item, R2Pre& P, int next_item, int n_items) {
    const int h = item & 3, c = (item >> 2) & (NCH - 1), b = item >> 9;
    const int lane = launder(mk_lane()), w = F.wave, r32 = lane & 31, hi = lane >> 5;
    const int ib = w & 1, db = w >> 1, iloc = 32 * ib + r32;
    LAS float* part = (LAS float*)F.lds;
    const size_t tok = (size_t)b * SEQ + (size_t)c * 64 + iloc;
    f32x16 oc = (f32x16){};
#pragma unroll
    for (int s = 0; s < 8; ++s) oc = MFMA32(P.af[s], P.qv[s], oc);
    const float qdec = exp2f(head_lg2(h) * (float)(iloc + 1));
    float ss = 0.f;
#pragma unroll
    for (int gi = 0; gi < 4; ++gi) {
#pragma unroll
        for (int e = 0; e < 4; ++e) { const unsigned wq_ = (e < 2) ? P.oi[gi].x : P.oi[gi].y; const float v = ((e & 1) ? bfhi(wq_) : bflo(wq_)) + oc[4 * gi + e] * qdec; oc[4 * gi + e] = v; ss += v * v; } }
    u32x2 gg[4];
#pragma unroll
    for (int gi = 0; gi < 4; ++gi) gg[gi] = P.gg[gi];
    if (next_item < n_items) ret2_load(F, next_item, P);
    ss += shx(ss, 32);
    if (hi == 0) part[iloc * 4 + db] = ss;
    LBAR();
    const f32x4 pp = *(const LAS f32x4*)(part + iloc * 4);
    const float rs = 1.0f / sqrtf(((pp[0] + pp[1]) + (pp[2] + pp[3])) * (1.0f / 128.0f) + EPS);
    bf16* yp = (bf16*)(F.ap->ws + WS_BUFA) + tok * D + 512 + h * 128 + 32 * db + 4 * hi;
#pragma unroll
    for (int gi = 0; gi < 4; ++gi) { const u32x2 g = gg[gi];
        u32x2 y; y.x = pk2(oc[4 * gi + 0] * rs * silu(bflo(g.x)), oc[4 * gi + 1] * rs * silu(bfhi(g.x))); y.y = pk2(oc[4 * gi + 2] * rs * silu(bflo(g.y)), oc[4 * gi + 3] * rs * silu(bfhi(g.y)));
        *(u32x2*)(yp + 8 * gi) = y; }
    LBAR();
}

__device__ __forceinline__ void conv_phase(Frame& F) {
    const bf16* Z = (const bf16*)(F.ap->ws + WS_BIG); const bf16* G2 = Z + (size_t)MTOK * D; bf16* Y = (bf16*)(F.ap->ws + WS_BUFA);
    const float* cw = F.ap->in[8]; const float* cb = F.ap->in[9];
    for (int it = F.bid * NTHR + launder(F.wave * 64 + mk_lane()); it < (MTOK / 8) * 128; it += F.G * NTHR) {
        const int cgi = it & 127, tg = it >> 7, col = cgi * 8, t0 = tg * 8;
        const bool first = (t0 & (SEQ - 1)) == 0;
        u32x4 zr[10], gr[8];
#pragma unroll
        for (int i = 0; i < 10; ++i) { zr[i] = (u32x4){0u, 0u, 0u, 0u}; if (i >= 2 || !first) zr[i] = *(const u32x4*)(Z + (size_t)(t0 - 2 + i) * D + col); }
#pragma unroll
        for (int i = 0; i < 8; ++i) gr[i] = *(const u32x4*)(G2 + (size_t)(t0 + i) * D + col);
        float w0[8], w1[8], w2[8], bs[8];
#pragma unroll
        for (int e = 0; e < 8; ++e) { w0[e] = cw[col + e]; w1[e] = cw[D + col + e]; w2[e] = cw[2 * D + col + e]; bs[e] = cb[col + e]; }
#pragma unroll
        for (int tt = 0; tt < 8; ++tt) {
            float y[8];
#pragma unroll
            for (int e = 0; e < 4; ++e) {
                const float cv0 = bs[2 * e] + bflo(zr[tt][e]) * w0[2 * e] + bflo(zr[tt + 1][e]) * w1[2 * e] + bflo(zr[tt + 2][e]) * w2[2 * e];
                const float cv1 = bs[2 * e + 1] + bfhi(zr[tt][e]) * w0[2 * e + 1] + bfhi(zr[tt + 1][e]) * w1[2 * e + 1] + bfhi(zr[tt + 2][e]) * w2[2 * e + 1];
                y[2 * e] = bflo(gr[tt][e]) * cv0; y[2 * e + 1] = bfhi(gr[tt][e]) * cv1; }
            u32x4 o; o.x = pk2(y[0], y[1]); o.y = pk2(y[2], y[3]); o.z = pk2(y[4], y[5]); o.w = pk2(y[6], y[7]);
            *(u32x4*)(Y + (size_t)(t0 + tt) * D + col) = o;
        }
    }
}

__device__ __forceinline__ void final_phase(Frame& F) {
    const int gw = F.bid * NWAVES + F.wave, NGW = F.G * NWAVES, lane = mk_lane();
    const float* ssp = (const float*)(F.ap->ws + WS_SSP);
    const f32x4* gr = (const f32x4*)F.ap->in[16];
    f32x4 g[4];
#pragma unroll
    for (int j = 0; j < 2; ++j) { g[2 * j] = gr[128 * j + 2 * lane]; g[2 * j + 1] = gr[128 * j + 2 * lane + 1]; }
    for (int row = 2 * gw; row < MTOK; row += 2 * NGW) {
        f32x4 pv[2][4]; u32x4 xv[2][2];
#pragma unroll
        for (int t = 0; t < 2; ++t) { const f32x4* p = (const f32x4*)(ssp + (size_t)(row + t) * 16); const u32x4* xr = (const u32x4*)((const bf16*)(F.ap->ws + WS_XB) + (size_t)(row + t) * D) + lane;
#pragma unroll
            for (int j = 0; j < 4; ++j) pv[t][j] = p[j];
            xv[t][0] = xr[0]; xv[t][1] = xr[64]; }
#pragma unroll
        for (int t = 0; t < 2; ++t) {
            const float s = ((pv[t][0][0] + pv[t][0][1]) + (pv[t][0][2] + pv[t][0][3])) + ((pv[t][1][0] + pv[t][1][1]) + (pv[t][1][2] + pv[t][1][3])) + ((pv[t][2][0] + pv[t][2][1]) + (pv[t][2][2] + pv[t][2][3])) + ((pv[t][3][0] + pv[t][3][1]) + (pv[t][3][2] + pv[t][3][3]));
            const float rs = 1.0f / sqrtf(s * (1.0f / D) + EPS);
            f32x4* orow = (f32x4*)(F.ap->out + (size_t)(row + t) * D);
#pragma unroll
            for (int j = 0; j < 2; ++j) { const u32x4 w = xv[t][j];
                const f32x4 a = (f32x4){bflo(w.x), bfhi(w.x), bflo(w.y), bfhi(w.y)}, b = (f32x4){bflo(w.z), bfhi(w.z), bflo(w.w), bfhi(w.w)};
                orow[128 * j + 2 * lane] = a * rs * g[2 * j]; orow[128 * j + 2 * lane + 1] = b * rs * g[2 * j + 1]; } }
    }
}

#ifndef TS_PROBE
#define TS_PROBE 0
#endif
#define TS_A_HI 5
#define TS_A_LO 2
#define TS_B_HI 1
#define TS_B_LO 0
#ifndef DUP_MASK
#define DUP_MASK 0
#endif
__device__ __forceinline__ bool PHASE_ENTER_(Frame& F) { asm volatile("" : "+s"(F.bid), "+s"(F.G), "+s"(F.wave)); return true; }
#define REP(k) _Pragma("unroll 1") for (int rep_ = 0; rep_ < ((((DUP_MASK) >> (k)) & 1) + 1); ++rep_) if (PHASE_ENTER_(F))
#ifndef MK_SPLIT
#define MK_SPLIT 0
#endif
constexpr int NPHASE = 16;
__global__ void __launch_bounds__(NTHR, 2) fwd_megakernel(Args args) {
    extern __shared__ __attribute__((aligned(16))) unsigned char lds_raw[];
    cg::grid_group grid = cg::this_grid();
    Frame F;
    F.lds = (LAS unsigned char*)lds_raw; F.wave = __builtin_amdgcn_readfirstlane((int)threadIdx.x >> 6); F.G = gridDim.x; F.bid = blockIdx.x;
    F.ap = (const Args*)__builtin_amdgcn_kernarg_segment_ptr();
    if ((F.wave * 64 + mk_lane()) < 2) ((LAS unsigned*)(F.lds + XB_LDS_OFF))[(F.wave * 64 + mk_lane())] = 0u;
    __syncthreads();
    const XcdBarrier xbar = xcd_barrier_post((unsigned*)(args.ws + XB_WS_OFF), (volatile LAS unsigned*)(F.lds + XB_LDS_OFF), F.wave);
    const int lo = args.ph_lo, hi = args.ph_hi;
    if (hi > NPHASE) grid.sync();
#define PHASE_ENTER() do { asm volatile("" : "+s"(F.bid), "+s"(F.G), "+s"(F.wave)); } while (0)
#define IN(k) (lo <= (k) && (k) < hi)
#define SEAM(k) do { if (IN(k) && IN((k) + 1)) xcd_barrier(xbar); STAMP((k) + 1); } while (0)
    typedef pg8::EpiScaleBf16<true> EpiS; typedef pg8::EpiScaleBf16<false> EpiN;
#define ws (F.ap->ws)
#define XB ((bf16*)(ws + WS_XB))
#define SSP ((float*)(ws + WS_SSP))
#define BIG ((bf16*)(ws + WS_BIG))
#define BUFA ((bf16*)(ws + WS_BUFA))
#define BUFB ((bf16*)(ws + WS_BUFB))

#if TS_PROBE
#define STAMP(i) do { if (blockIdx.x == 0 && threadIdx.x == 0) ((unsigned long long*)ws)[i] = __builtin_amdgcn_s_memrealtime(); } while (0)
#else
#define STAMP(i) do { } while (0)
#endif
    STAMP(0);
    REP(0) {
    if (IN(0)) { p0_prologue(F); } SEAM(0); }
    REP(1) {
    if (IN(1)) {
        { pg8::Gemm g{XB, (const bf16*)(ws + WS_WEIN), MTOK, EIN, D}; pg8::StaticOrder S; S.init(MTOK, EIN, F.G, F.bid); pg8::rs_prepass((LAS float*)(F.lds + 131072), S, SSP, (F.wave * 64 + mk_lane())); EpiS E{BIG, EIN, (const LAS float*)(F.lds + 131072)};
          pg8::gemm_phase<EpiS, pg8::StaticOrder, true, true>(F.lds, g, S, E, F.wave); }
#pragma unroll 1
        for (int l = 0; l < 2; ++l) { pg8::Gemm g{(const bf16*)(ws + WS_MEMN) + (size_t)l * BATCH * MEMLEN * D, (const bf16*)(ws + WS_WKV) + (size_t)l * 2 * D * D, BATCH * MEMLEN, 2 * D, D};
          pg8::StaticOrder S; S.init(BATCH * MEMLEN, 2 * D, F.G, (F.bid + F.G - (F.G / 2 + 32 * l) % F.G) % F.G); pg8::EpiDense E{(bf16*)(ws + WS_KV) + (size_t)l * BATCH * MEMLEN * 2 * D, 8};
          pg8::gemm_phase<pg8::EpiDense, pg8::StaticOrder, true, true>(F.lds, g, S, E, F.wave); }
    } SEAM(1); }
    REP(2) {
    if (IN(2)) {
        { R1Pre P; if (F.bid < BATCH * NCH * 4) ret1_load(F, F.bid, P); __syncthreads();
          for (int it = F.bid; it < BATCH * NCH * 4; it += F.G) ret1_item(F, it, P, it + F.G, BATCH * NCH * 4); }
        { SwPre Q; if (F.bid < BATCH * NCH * 2) swa_load(F, F.bid, Q); __syncthreads();
          for (int it = F.bid; it < BATCH * NCH * 2; it += F.G) swa_item(F, it, Q, it + F.G, BATCH * NCH * 2); }
    } SEAM(2); }
    REP(3) {
    if (IN(3)) { scan_phase(F);
        if (F.bid < 128) { const int gi = F.bid >> 2, l = gi >> 4, b = (gi >> 2) & 3, h = gi & 3;
            pg8::Gemm g{(const bf16*)(ws + WS_WO) + (size_t)(l * 4 + h) * 256 * D, (const bf16*)(ws + WS_KV) + (size_t)((l * 4 + b) * 8 + 4 + h) * 65536, D, 256, 256};
            pg8::StaticOrder S; S.init(D, 256, 4, F.bid & 3); EpiN E{(bf16*)(ws + WS_BTO) + (size_t)(l * 4 + b) * D * D + h * 256, D, nullptr};
            pg8::gemm_phase<EpiN, pg8::StaticOrder, true, true>(F.lds, g, S, E, F.wave); }
        else if (F.bid < 256) { const int gi = (F.bid - 128) >> 2, l = gi >> 4, b = (gi >> 2) & 3, h = gi & 3;
            pg8::Gemm g{(const bf16*)(ws + WS_KV) + (size_t)((l * 4 + b) * 8 + h) * 65536, (const bf16*)(ws + WS_WQ) + (size_t)(l * 4 + h) * D * 256, 256, D, 256};
            pg8::StaticOrder S; S.init(256, D, 4, F.bid & 3); EpiN E{(bf16*)(ws + WS_BTS) + (size_t)(l * 4 + b) * D * D + (size_t)h * 256 * D, D, nullptr};
            pg8::gemm_phase<EpiN, pg8::StaticOrder, true, true>(F.lds, g, S, E, F.wave); }
    } SEAM(3); }
    REP(4) {
    if (IN(4)) { R2Pre P; if (F.bid < BATCH * NCH * 4) ret2_load(F, F.bid, P); __syncthreads();
        for (int it = F.bid; it < BATCH * NCH * 4; it += F.G) ret2_item(F, it, P, it + F.G, BATCH * NCH * 4); } SEAM(4); }
    REP(5) {
    if (IN(5)) {
        pg8::Gemm g{BUFA, (const bf16*)(ws + WS_WEOUT), MTOK, D, D}; pg8::StaticOrder S; S.init(MTOK, D, F.G, F.bid); typedef pg8::EpiResidual<false, false> EpiR0; EpiR0 E{XB, XB, SSP, D};
        pg8::gemm_phase<EpiR0, pg8::StaticOrder, true, true>(F.lds, g, S, E, F.wave);
    } SEAM(5); }
#pragma unroll
    for (int l = 0; l < 2; ++l) {
        const int pb = (l == 0) ? 6 : 12;
        REP(pb) {
        if (IN(pb)) {
            pg8::Gemm g{XB, (const bf16*)(ws + WS_BTS) + (size_t)l * 4 * D * D, MTOK, D, D, (size_t)D * D * 2, 5}; pg8::StaticOrder S; S.init(MTOK, D, F.G, F.bid);
            pg8::rs_prepass((LAS float*)(F.lds + 131072), S, SSP, (F.wave * 64 + mk_lane()));
            pg8::EpiSoftmax E{BUFA, (const LAS float*)(F.lds + 131072), (LAS float*)(F.lds + 135168), (LAS float*)(F.lds + 139264)};
            pg8::gemm_phase<pg8::EpiSoftmax, pg8::StaticOrder, true, true>(F.lds, g, S, E, F.wave);
        } SEAM(pb); }
        REP(pb + 2) {
        if (IN(pb + 2)) {
            pg8::Gemm g{BUFA, (const bf16*)(ws + WS_BTO) + (size_t)l * 4 * D * D, MTOK, D, D, (size_t)D * D * 2, 5};     pg8::StaticOrder S; S.init(MTOK, D, F.G, F.bid); { typedef pg8::EpiResidual<false, false> EpiR1; EpiR1 E{XB, XB, SSP, D}; pg8::gemm_phase<EpiR1, pg8::StaticOrder, true, true>(F.lds, g, S, E, F.wave); }
        } SEAM(pb + 2); }
        if (l == 0) {
            REP(9) {
            if (IN(9)) {
                pg8::Gemm g{XB, (const bf16*)(ws + WS_WOIN), MTOK, OIN, D}; pg8::StaticOrder S; S.init(MTOK, OIN, F.G, F.bid); pg8::rs_prepass((LAS float*)(F.lds + 131072), S, SSP, (F.wave * 64 + mk_lane()));
                pg8::EpiConv E{BIG, BIG + (size_t)MTOK * D, (const LAS float*)(F.lds + 131072)};
                pg8::gemm_phase<pg8::EpiConv, pg8::StaticOrder, true, true>(F.lds, g, S, E, F.wave);
            } SEAM(9); }
            REP(10) {
            if (IN(10)) { conv_phase(F); } SEAM(10); }
            REP(11) {
            if (IN(11)) {
                pg8::Gemm g{BUFA, (const bf16*)(ws + WS_WOOUT), MTOK, D, D}; pg8::StaticOrder S; S.init(MTOK, D, F.G, F.bid); typedef pg8::EpiResidual<false, false> EpiR1; EpiR1 E{XB, XB, SSP, D};
                pg8::gemm_phase<EpiR1, pg8::StaticOrder, true, true>(F.lds, g, S, E, F.wave);
            } SEAM(11); }
        }
    }
    if (IN(15)) { final_phase(F); }
#if TS_PROBE
    __syncthreads();
    if (blockIdx.x == 0 && threadIdx.x == 0) { const unsigned long long* ts = (const unsigned long long*)ws;
        const float ta = (float)(ts[TS_A_HI] - ts[TS_A_LO]) * 0.01f, tb = (float)(ts[TS_B_HI] - ts[TS_B_LO]) * 0.01f;
        F.ap->out[0] = ta; for (int i = 1; i <= 1000; ++i) F.ap->out[i] = tb; }
#endif
#undef IN
#undef SEAM
#undef ws
#undef XB
#undef SSP
#undef BIG
#undef BUFA
#undef BUFB
}

extern "C" void kernel_launch(void* const* d_in, const int* in_sizes, int n_in, void* d_out, int out_size, void* d_ws, size_t ws_size, hipStream_t stream) {
    static int grid = 0;
    if (grid == 0) {
        if (n_in != 17 || out_size != MTOK * D || ws_size < WS_END) { fprintf(stderr, "kernel_launch: unexpected shapes (n_in %d out %d ws %zu)\n", n_in, out_size, ws_size); grid = -1; return; }
        int dev = 0, cus = 0, per_cu = 0;
        hipGetDevice(&dev); hipDeviceGetAttribute(&cus, hipDeviceAttributeMultiprocessorCount, dev);
        if (hipFuncSetAttribute((const void*)fwd_megakernel, hipFuncAttributeMaxDynamicSharedMemorySize, LDS_BYTES) != hipSuccess) { fprintf(stderr, "kernel_launch: hipFuncSetAttribute failed\n"); grid = -1; return; }
        if (hipOccupancyMaxActiveBlocksPerMultiprocessor(&per_cu, (const void*)fwd_megakernel, NTHR, LDS_BYTES) != hipSuccess || per_cu < 1) { fprintf(stderr, "kernel_launch: occupancy query says %d\n", per_cu); per_cu = 1; }
        (void)hipGetLastError();
        grid = cus;
    }
    if (grid < 0) return;
    if (hipMemsetAsync(d_ws, 0, 65536, stream) != hipSuccess) { fprintf(stderr, "kernel_launch: hipMemsetAsync failed\n"); return; }
    Args a{};
    for (int i = 0; i < 17; ++i) a.in[i] = (const float*)d_in[i];
    a.out = (float*)d_out; a.ws = (unsigned char*)d_ws;
#if MK_SPLIT
    for (int p = 0; p < NPHASE; ++p) { a.ph_lo = p; a.ph_hi = p + 1; hipLaunchKernelGGL(fwd_megakernel, dim3(grid), dim3(NTHR), LDS_BYTES, stream, a); }
#else
    a.ph_lo = 0; a.ph_hi = NPHASE;
    void* kargs[] = {&a};
    hipError_t e = hipLaunchCooperativeKernel((const void*)fwd_megakernel, dim3(grid), dim3(NTHR), kargs, LDS_BYTES, stream);
    if (e != hipSuccess) fprintf(stderr, "kernel_launch: cooperative launch failed: %s (grid %d)\n", hipGetErrorString(e), grid);
#endif
}
```

```cpp
#include <hip/hip_runtime.h>
#include <hip/hip_cooperative_groups.h>
#include <cstdio>
#include <cstdint>
namespace cg = cooperative_groups;
__device__ __forceinline__ int mk_lane() { int l = (int)__builtin_amdgcn_mbcnt_hi(~0u, __builtin_amdgcn_mbcnt_lo(~0u, 0u)); asm volatile("" : "+v"(l)); return l; }
__device__ __forceinline__ float shx(float v, int mask) { return __int_as_float(__builtin_amdgcn_ds_bpermute((mk_lane() ^ mask) << 2, __float_as_int(v))); }
namespace pg8 {
#define PG8_LAS __attribute__((address_space(3)))
typedef unsigned short bf16_t;
typedef short bf16x8 __attribute__((ext_vector_type(8)));
typedef float f32x4 __attribute__((ext_vector_type(4)));
typedef unsigned u32x4 __attribute__((ext_vector_type(4)));
constexpr int BM = 256, BK = 64, HALF = 128, HTB = HALF * BK * 2  , STAGE_BYTES = 8 * HTB, NXCD = 8, WGM = 4;

__host__ __device__ __forceinline__ int lds_byte(int r, int c) { const int st = (r >> 4) * 2 + (c >> 5), rr = r & 15, cc = c & 31, ob = rr * 64 + cc * 2; return st * 1024 + (ob ^ (((ob >> 9) & 1) << 5)); }
__host__ __device__ __forceinline__ void stage_rc(int b, int& R, int& C) { const int st = b / 1024, sb = b % 1024, swz = sb ^ (((sb >> 9) & 1) << 5); R = (st >> 1) * 16 + swz / 64; C = (st & 1) * 32 + (swz % 64) / 2; }
__host__ __device__ __forceinline__ int perm32(int rho) { const int n = rho >> 4, i = rho & 15; return 8 * (i >> 2) + 4 * n + (i & 3); }

struct Unit { int pm, pn, idx; };
struct Gemm { const bf16_t* A; const bf16_t* Bt; int M, N, K; size_t bb_stride = 0; int bb_shift = 0; };

struct StaticOrder {
    int nM, nN, nwg, G, c;
    __host__ __device__ void init(int M, int N, int G_, int c_) { nM = M / BM; nN = N / BM; nwg = nM * nN; G = G_; c = c_; }
    __host__ __device__ bool next(int i, Unit& u) const {
        const long L = (long)i * G + c; if (L >= nwg) return false;
        int wgid = (int)L; { const int q = nwg / NXCD, r = nwg % NXCD, xcd = wgid % NXCD, off = wgid / NXCD; wgid = (xcd < r ? xcd * (q + 1) : r * (q + 1) + (xcd - r) * q) + off; }
        const int nig = WGM * nN, gid = wgid / nig, fm = gid * WGM, gsz = (nM - fm) < WGM ? (nM - fm) : WGM;
        u.pm = fm + ((wgid % nig) % gsz); u.pn = (wgid % nig) / gsz; u.idx = i; return true;
    }
    __device__ __forceinline__ void a_ready(const Unit&) const {}
    __device__ __forceinline__ void done(const Unit&) const {}
};

typedef float f32x2 __attribute__((ext_vector_type(2))); typedef __bf16 bf16x2_t __attribute__((ext_vector_type(2)));
__device__ __forceinline__ unsigned cvt_pk_bf16(float lo, float hi) { const f32x2 v = {lo, hi}; const bf16x2_t b = __builtin_convertvector(v, bf16x2_t); return __builtin_bit_cast(unsigned, b); }
template <bool SCALE> struct EpiScaleBf16 {
    static constexpr bool PERM = true, AFTER_DRAIN = false;
    bf16_t* O; int ldc; const PG8_LAS float* rs;
    __device__ __forceinline__ void operator()(const f32x4 (&acc)[2][2][4][2], const Unit& u, int wr, int wc, int fr, int fq) const {
        const int rl0 = wr * 64 + fr; const int col0 = u.pn * BM + wc * 32 + 8 * fq;
#pragma unroll
        for (int ai = 0; ai < 2; ++ai)
#pragma unroll
            for (int m = 0; m < 4; ++m) {
                const float sc = SCALE ? rs[256 * u.idx + rl0 + ai * HALF + m * 16] : 1.f;
                bf16_t* rowp = O + (size_t)(u.pm * BM + rl0 + ai * HALF + m * 16) * ldc + col0;
#pragma unroll
                for (int bj = 0; bj < 2; ++bj) { const f32x4 v0 = acc[ai][bj][m][0] * sc, v1 = acc[ai][bj][m][1] * sc;
                    u32x4 w; w.x = cvt_pk_bf16(v0[0], v0[1]); w.y = cvt_pk_bf16(v0[2], v0[3]); w.z = cvt_pk_bf16(v1[0], v1[1]); w.w = cvt_pk_bf16(v1[2], v1[3]);
                    *(u32x4*)(rowp + bj * HALF) = w; }
            }
    }
};
struct EpiDense {
    static constexpr bool PERM = true, AFTER_DRAIN = false;
    bf16_t* O; int nb;
    __device__ __forceinline__ void operator()(const f32x4 (&acc)[2][2][4][2], const Unit& u, int wr, int wc, int fr, int fq) const {
        bf16_t* base = O + (size_t)(u.pm * nb + u.pn) * 65536 + (wr * 64 + fr) * 256 + wc * 32 + 8 * fq;
#pragma unroll
        for (int ai = 0; ai < 2; ++ai)
#pragma unroll
            for (int m = 0; m < 4; ++m)
#pragma unroll
                for (int bj = 0; bj < 2; ++bj) { const f32x4 v0 = acc[ai][bj][m][0], v1 = acc[ai][bj][m][1];
                    u32x4 w; w.x = cvt_pk_bf16(v0[0], v0[1]); w.y = cvt_pk_bf16(v0[2], v0[3]); w.z = cvt_pk_bf16(v1[0], v1[1]); w.w = cvt_pk_bf16(v1[2], v1[3]);
                    *(u32x4*)(base + (ai * HALF + m * 16) * 256 + bj * HALF) = w; }
    }
};
struct EpiSoftmax {
    static constexpr bool PERM = true, AFTER_DRAIN = false;
    bf16_t* O; const PG8_LAS float* rs; PG8_LAS float* mxs; PG8_LAS float* sms;
    __device__ __forceinline__ void operator()(f32x4 (&acc)[2][2][4][2], const Unit& u, int wr, int wc, int fr, int fq) const {
        const int rl0 = wr * 64 + fr; const int col0 = u.pn * BM + wc * 32 + 8 * fq;
#pragma unroll
        for (int ai = 0; ai < 2; ++ai)
#pragma unroll
            for (int m = 0; m < 4; ++m) { const int rl = rl0 + ai * HALF + m * 16; const float sc = rs[256 * u.idx + rl] * (0.0625f * 1.4426950408889634f);
                float mx = -3.0e38f;
#pragma unroll
                for (int bj = 0; bj < 2; ++bj)
#pragma unroll
                    for (int n = 0; n < 2; ++n) { acc[ai][bj][m][n] = acc[ai][bj][m][n] * sc; const f32x4 v = acc[ai][bj][m][n]; mx = fmaxf(mx, fmaxf(fmaxf(v[0], v[1]), fmaxf(v[2], v[3]))); }
                mx = fmaxf(mx, shx(mx, 16)); mx = fmaxf(mx, shx(mx, 32));
                if (fq == 0) mxs[rl * 4 + wc] = mx; }
        asm volatile("s_waitcnt lgkmcnt(0)\n\ts_barrier" ::: "memory");
#pragma unroll
        for (int ai = 0; ai < 2; ++ai)
#pragma unroll
            for (int m = 0; m < 4; ++m) { const int rl = rl0 + ai * HALF + m * 16; const f32x4 pm4 = *(const PG8_LAS f32x4*)(mxs + rl * 4);
                const float mx = fmaxf(fmaxf(pm4[0], pm4[1]), fmaxf(pm4[2], pm4[3]));
                float sm = 0.f;
#pragma unroll
                for (int bj = 0; bj < 2; ++bj)
#pragma unroll
                    for (int n = 0; n < 2; ++n) { f32x4 v = acc[ai][bj][m][n];
                        v[0] = __builtin_amdgcn_exp2f(v[0] - mx); v[1] = __builtin_amdgcn_exp2f(v[1] - mx); v[2] = __builtin_amdgcn_exp2f(v[2] - mx); v[3] = __builtin_amdgcn_exp2f(v[3] - mx);
                        acc[ai][bj][m][n] = v; sm += (v[0] + v[1]) + (v[2] + v[3]); }
                sm += shx(sm, 16); sm += shx(sm, 32);
                if (fq == 0) sms[rl * 4 + wc] = sm; }
        asm volatile("s_waitcnt lgkmcnt(0)\n\ts_barrier" ::: "memory");
#pragma unroll
        for (int ai = 0; ai < 2; ++ai)
#pragma unroll
            for (int m = 0; m < 4; ++m) { const int rl = rl0 + ai * HALF + m * 16; const f32x4 ps4 = *(const PG8_LAS f32x4*)(sms + rl * 4);
                const float inv = 1.0f / ((ps4[0] + ps4[1]) + (ps4[2] + ps4[3]));
                bf16_t* rowp = O + (size_t)(u.pm * BM + rl) * 1024 + col0;
#pragma unroll
                for (int bj = 0; bj < 2; ++bj) { const f32x4 v0 = acc[ai][bj][m][0] * inv, v1 = acc[ai][bj][m][1] * inv;
                    u32x4 w; w.x = cvt_pk_bf16(v0[0], v0[1]); w.y = cvt_pk_bf16(v0[2], v0[3]); w.z = cvt_pk_bf16(v1[0], v1[1]); w.w = cvt_pk_bf16(v1[2], v1[3]);
                    *(u32x4*)(rowp + bj * HALF) = w; } }
        asm volatile("s_waitcnt lgkmcnt(0)\n\ts_barrier" ::: "memory");
    }
};
template <class Sched> __device__ __forceinline__ void rs_prepass(PG8_LAS float* rs, const Sched& S, const float* ssp, int tid) {
    const int row = tid >> 1, half = tid & 1;
    f32x4 v[8][2]; bool have[8];
#pragma unroll
    for (int i = 0; i < 8; ++i) { Unit u; have[i] = S.next(i, u);
        if (have[i]) { const f32x4* p = (const f32x4*)(ssp + (size_t)(u.pm * BM + row) * 16) + 2 * half; v[i][0] = p[0]; v[i][1] = p[1]; } }
#pragma unroll
    for (int i = 0; i < 8; ++i) if (have[i]) {
        float s = ((v[i][0][0] + v[i][0][1]) + (v[i][0][2] + v[i][0][3])) + ((v[i][1][0] + v[i][1][1]) + (v[i][1][2] + v[i][1][3]));
        s += shx(s, 1);
        if (half == 0) rs[256 * i + row] = 1.0f / sqrtf(s * (1.0f / 1024.0f) + 1e-6f); }
    __syncthreads();
}
struct EpiConv {
    static constexpr bool PERM = true, AFTER_DRAIN = false;
    bf16_t* Z; bf16_t* G2; const PG8_LAS float* rs;
    __device__ __forceinline__ void operator()(const f32x4 (&acc)[2][2][4][2], const Unit& u, int wr, int wc, int fr, int fq) const {
        const int rl0 = wr * 64 + fr; const int c = 64 * u.pn + 32 * (wc & 1) + 8 * fq;
        bf16_t* O = (wc < 2) ? Z : G2;
#pragma unroll
        for (int ai = 0; ai < 2; ++ai)
#pragma unroll
            for (int m = 0; m < 4; ++m) {
                const float sc = rs[256 * u.idx + rl0 + ai * HALF + m * 16];
                float v[8];
#pragma unroll
                for (int n = 0; n < 2; ++n)
#pragma unroll
                    for (int e = 0; e < 4; ++e) { const float a = acc[ai][0][m][n][e] * sc, b = acc[ai][1][m][n][e] * sc;
                        v[4 * n + e] = (wc < 2) ? a * b : a * (b / (1.0f + __expf(-b))); }
                u32x4 w; w.x = cvt_pk_bf16(v[0], v[1]); w.y = cvt_pk_bf16(v[2], v[3]); w.z = cvt_pk_bf16(v[4], v[5]); w.w = cvt_pk_bf16(v[6], v[7]);
                *(u32x4*)(O + (size_t)(u.pm * BM + rl0 + ai * HALF + m * 16) * 1024 + c) = w;
            }
    }
};
template <bool BASE_F32, bool OUT_F32> struct EpiResidual {
    static constexpr bool PERM = true, AFTER_DRAIN = false;
    const void* base; void* out; float* ssp; int ldc;
    __device__ __forceinline__ void operator()(const f32x4 (&acc)[2][2][4][2], const Unit& u, int wr, int wc, int fr, int fq) const {
        static_assert(!BASE_F32 && !OUT_F32, "bf16 residual stream only");
        const int row0 = u.pm * BM + wr * 64 + fr; const int col0 = u.pn * BM + wc * 32 + 8 * fq;
        u32x4 pb[2][4][2];
#pragma unroll
        for (int ai = 0; ai < 2; ++ai)
#pragma unroll
            for (int m = 0; m < 4; ++m)
#pragma unroll
                for (int bj = 0; bj < 2; ++bj) pb[ai][m][bj] = *(const u32x4*)((const bf16_t*)base + (size_t)(row0 + ai * HALF + m * 16) * ldc + col0 + bj * HALF);
#pragma unroll
        for (int ai = 0; ai < 2; ++ai)
#pragma unroll
            for (int m = 0; m < 4; ++m) {
                const int row = row0 + ai * HALF + m * 16;
                float ss = 0.f;
#pragma unroll
                for (int bj = 0; bj < 2; ++bj) { const size_t off = (size_t)row * ldc + col0 + bj * HALF;
                    const u32x4 w = pb[ai][m][bj];
                    const f32x4 b0 = (f32x4){__uint_as_float(w.x << 16), __uint_as_float(w.x & 0xffff0000u), __uint_as_float(w.y << 16), __uint_as_float(w.y & 0xffff0000u)};
                    const f32x4 b1 = (f32x4){__uint_as_float(w.z << 16), __uint_as_float(w.z & 0xffff0000u), __uint_as_float(w.w << 16), __uint_as_float(w.w & 0xffff0000u)};
                    const f32x4 o0 = b0 + acc[ai][bj][m][0], o1 = b1 + acc[ai][bj][m][1];
                    ss += ((o0[0] * o0[0] + o0[1] * o0[1]) + (o0[2] * o0[2] + o0[3] * o0[3])) + ((o1[0] * o1[0] + o1[1] * o1[1]) + (o1[2] * o1[2] + o1[3] * o1[3]));
                    u32x4 v; v.x = cvt_pk_bf16(o0[0], o0[1]); v.y = cvt_pk_bf16(o0[2], o0[3]); v.z = cvt_pk_bf16(o1[0], o1[1]); v.w = cvt_pk_bf16(o1[2], o1[3]);
                    *(u32x4*)((bf16_t*)out + off) = v; }
                ss += shx(ss, 16); ss += shx(ss, 32);
                if (fq == 0) ssp[(size_t)row * 16 + u.pn * 4 + wc] = ss;
            }
    }
};
template <class Epi, class Sched, bool ALIGN_EPI = false, bool SP2 = false>
__device__ __forceinline__ void gemm_phase(PG8_LAS unsigned char* lds, const Gemm g, const Sched& S, const Epi& E, const int wave_in) {
    int tid_ = wave_in * 64 + mk_lane(); asm volatile("" : "+v"(tid_));
    const int tid = tid_, wid = __builtin_amdgcn_readfirstlane(tid >> 6), lane = tid & 63, wr = wid >> 2, wc = wid & 3, fr = lane & 15, fq = lane >> 4;
    const int K = g.K, nt = K / BK;
    unsigned voffA[2], voffB[2];
#pragma unroll
    for (int i = 0; i < 2; ++i) { int R, C; stage_rc(tid * 16 + i * 8192, R, C); const int Rb = Epi::PERM ? ((R & ~31) + perm32(R & 31)) : R;
        voffA[i] = (unsigned)(R * K + C) * 2u; voffB[i] = (unsigned)(Rb * K + C) * 2u; }
    const size_t kstep = (size_t)(BK * 2);
    const size_t hstep = (size_t)HALF * K * 2;
    const size_t tstep = 2 * hstep;
    const unsigned ldsw = (unsigned)wid * 1024u;
    const int aoff = lds_byte(wr * 64 + fr, fq * 8), boff = lds_byte(wc * 32 + fr, fq * 8);
#define PG8_SA(b, h) (((b) * 2 + (h)) * HTB)
#define PG8_SB(b, h) ((4 + (b) * 2 + (h)) * HTB)
#define PG8_STAGE(bufoff, gbase, voff) do { _Pragma("unroll") for (int _i = 0; _i < 2; ++_i) \
        __builtin_amdgcn_global_load_lds((const unsigned*)((const char*)(gbase) + (voff)[_i]), (PG8_LAS unsigned*)(lds + (bufoff) + ldsw + _i * 8192), 16, 0, 0); } while (0)
#define PG8_LDA(dst, b, h) do { _Pragma("unroll") for (int m = 0; m < 4; ++m) _Pragma("unroll") for (int k = 0; k < 2; ++k) dst[m][k] = *(const PG8_LAS bf16x8*)(lds + PG8_SA(b, h) + aoff + m * 2048 + k * 1024); } while (0)
#define PG8_LDB(dst, b, h) do { _Pragma("unroll") for (int n = 0; n < 2; ++n) _Pragma("unroll") for (int k = 0; k < 2; ++k) dst[n][k] = *(const PG8_LAS bf16x8*)(lds + PG8_SB(b, h) + boff + n * 2048 + k * 1024); } while (0)
#define PG8_MMA(ai, bj, At, Bt) do { __builtin_amdgcn_s_setprio(1); _Pragma("unroll") for (int m = 0; m < 4; ++m) _Pragma("unroll") for (int n = 0; n < 2; ++n) _Pragma("unroll") for (int k = 0; k < 2; ++k) \
        acc[ai][bj][m][n] = __builtin_amdgcn_mfma_f32_16x16x32_bf16(Bt[n][k], At[m][k], acc[ai][bj][m][n], 0, 0, 0); __builtin_amdgcn_s_setprio(0); } while (0)
#define PG8_WAIT_V(n) asm volatile("s_waitcnt vmcnt(" #n ")" ::: "memory")
#define PG8_WAIT_L(n) asm volatile("s_waitcnt lgkmcnt(" #n ")" ::: "memory")
#define PG8_BAR __builtin_amdgcn_s_barrier()
#define PG8_SCHED __builtin_amdgcn_sched_barrier(0)
    Unit cur, nxt; int ui = 0;
    if (!S.next(0, cur)) return;
    f32x4 acc[2][2][4][2];
#pragma unroll
    for (int a = 0; a < 2; ++a)
#pragma unroll
        for (int b = 0; b < 2; ++b)
#pragma unroll
            for (int m = 0; m < 4; ++m)
#pragma unroll
                for (int n = 0; n < 2; ++n) acc[a][b][m][n] = (f32x4){0.f, 0.f, 0.f, 0.f};
    bf16x8 At[4][2], B0[2][2], B1[2][2];
    const char* cA = (const char*)g.A + (size_t)cur.pm * tstep; const char* cB = (const char*)g.Bt + (size_t)cur.pn * tstep + (size_t)(cur.pm >> g.bb_shift) * g.bb_stride;
    S.a_ready(cur);
    if constexpr (SP2) {
        PG8_STAGE(PG8_SB(0, 0), cB, voffB); PG8_STAGE(PG8_SB(0, 1), cB + hstep, voffB); PG8_STAGE(PG8_SA(0, 0), cA, voffA); PG8_STAGE(PG8_SA(0, 1), cA + hstep, voffA);
        if (wr == 1) PG8_BAR;
        PG8_WAIT_V(2); PG8_BAR;
        PG8_STAGE(PG8_SB(1, 0), cB + kstep, voffB); PG8_STAGE(PG8_SA(1, 0), cA + kstep, voffA); PG8_STAGE(PG8_SB(1, 1), cB + hstep + kstep, voffB);
        PG8_WAIT_V(6); PG8_BAR;
    } else {
        PG8_STAGE(PG8_SB(0, 0), cB, voffB); PG8_STAGE(PG8_SA(0, 0), cA, voffA); PG8_STAGE(PG8_SB(0, 1), cB + hstep, voffB); PG8_STAGE(PG8_SA(0, 1), cA + hstep, voffA);
        if (wr == 1) PG8_BAR;
        PG8_WAIT_V(4); PG8_BAR;
        PG8_STAGE(PG8_SB(1, 0), cB + kstep, voffB); PG8_STAGE(PG8_SA(1, 0), cA + kstep, voffA); PG8_STAGE(PG8_SB(1, 1), cB + hstep + kstep, voffB);
        PG8_WAIT_V(6); PG8_BAR;
    }
    for (;;) {
        const bool has_next = S.next(ui + 1, nxt);
        const char* nA = has_next ? (const char*)g.A + (size_t)nxt.pm * tstep : cA; const char* nB = has_next ? (const char*)g.Bt + (size_t)nxt.pn * tstep + (size_t)(nxt.pm >> g.bb_shift) * g.bb_stride : cB;
        for (int t = 0; t < nt; t += 2) {
            const bool last = (t == nt - 2);
            const char* a1 = cA + (size_t)(t + 1) * kstep;
            const char* a2 = last ? nA : cA + (size_t)(t + 2) * kstep; const char* b2 = last ? nB : cB + (size_t)(t + 2) * kstep;
            const char* a3 = a2 + kstep; const char* b3 = b2 + kstep;
            if (last && has_next) S.a_ready(nxt);
            if constexpr (SP2) {
            PG8_LDB(B0, 0, 0); PG8_LDB(B1, 0, 1); PG8_SCHED; PG8_LDA(At, 0, 0); PG8_STAGE(PG8_SA(1, 1), a1 + hstep, voffA);
            PG8_WAIT_V(8); PG8_WAIT_L(0); PG8_BAR; PG8_MMA(0, 0, At, B0); PG8_MMA(0, 1, At, B1); PG8_BAR; PG8_SCHED;
            PG8_LDA(At, 0, 1); PG8_STAGE(PG8_SB(0, 0), b2, voffB); PG8_STAGE(PG8_SB(0, 1), b2 + hstep, voffB); PG8_STAGE(PG8_SA(0, 0), a2, voffA);
            PG8_WAIT_V(8); PG8_WAIT_L(0); PG8_BAR; PG8_MMA(1, 0, At, B0); PG8_MMA(1, 1, At, B1); PG8_BAR; PG8_SCHED;
            PG8_LDB(B0, 1, 0); PG8_LDB(B1, 1, 1); PG8_SCHED; PG8_LDA(At, 1, 0); PG8_STAGE(PG8_SA(0, 1), a2 + hstep, voffA);
            PG8_WAIT_V(8); PG8_WAIT_L(0); PG8_BAR; PG8_MMA(0, 0, At, B0); PG8_MMA(0, 1, At, B1); PG8_BAR; PG8_SCHED;
            PG8_LDA(At, 1, 1); PG8_STAGE(PG8_SB(1, 0), b3, voffB); PG8_STAGE(PG8_SB(1, 1), b3 + hstep, voffB); PG8_STAGE(PG8_SA(1, 0), a3, voffA);
            PG8_WAIT_V(8); PG8_WAIT_L(0); PG8_BAR; PG8_MMA(1, 0, At, B0); PG8_MMA(1, 1, At, B1); PG8_BAR; PG8_SCHED;
            } else {
            PG8_LDB(B0, 0, 0); PG8_SCHED; PG8_LDA(At, 0, 0); PG8_STAGE(PG8_SA(1, 1), a1 + hstep, voffA);
            PG8_WAIT_L(8); PG8_BAR; PG8_WAIT_L(0); PG8_MMA(0, 0, At, B0); PG8_BAR; PG8_SCHED;
            PG8_LDB(B1, 0, 1); PG8_STAGE(PG8_SB(0, 0), b2, voffB);
            PG8_BAR; PG8_WAIT_L(0); PG8_MMA(0, 1, At, B1); PG8_BAR;
            PG8_LDA(At, 0, 1); PG8_STAGE(PG8_SA(0, 0), a2, voffA);
            PG8_BAR; PG8_WAIT_L(0); PG8_MMA(1, 0, At, B0); PG8_BAR; PG8_SCHED;
            PG8_STAGE(PG8_SB(0, 1), b2 + hstep, voffB);
            PG8_WAIT_V(6); PG8_BAR; PG8_MMA(1, 1, At, B1); PG8_BAR;
            PG8_LDB(B0, 1, 0); PG8_SCHED; PG8_LDA(At, 1, 0); PG8_STAGE(PG8_SA(0, 1), a2 + hstep, voffA);
            PG8_WAIT_L(8); PG8_BAR; PG8_WAIT_L(0); PG8_MMA(0, 0, At, B0); PG8_BAR; PG8_SCHED;
            PG8_LDB(B1, 1, 1); PG8_STAGE(PG8_SB(1, 0), b3, voffB);
            PG8_BAR; PG8_WAIT_L(0); PG8_MMA(0, 1, At, B1); PG8_BAR;
            PG8_LDA(At, 1, 1); PG8_STAGE(PG8_SA(1, 0), a3, voffA);
            PG8_BAR; PG8_WAIT_L(0); PG8_MMA(1, 0, At, B0); PG8_BAR; PG8_SCHED;
            PG8_STAGE(PG8_SB(1, 1), b3 + hstep, voffB);
            PG8_WAIT_V(6); PG8_BAR; PG8_MMA(1, 1, At, B1); PG8_BAR;
            }
        }
        if constexpr (ALIGN_EPI) { if (wr == 0) PG8_BAR; }
        if constexpr (!Epi::AFTER_DRAIN) { E(acc, cur, wr, wc, fr, fq); S.done(cur); }
        if (!has_next) break;
#pragma unroll
        for (int a = 0; a < 2; ++a)
#pragma unroll
            for (int b = 0; b < 2; ++b)
#pragma unroll
                for (int m = 0; m < 4; ++m)
#pragma unroll
                    for (int n = 0; n < 2; ++n) acc[a][b][m][n] = (f32x4){0.f, 0.f, 0.f, 0.f};
        cur = nxt; cA = nA; cB = nB; ++ui;
        if constexpr (ALIGN_EPI) { if (wr == 1) PG8_BAR; }
    }
    PG8_WAIT_V(0);
    if constexpr (!ALIGN_EPI) { if (wr == 0) PG8_BAR; }
    PG8_BAR;
    if constexpr (Epi::AFTER_DRAIN) { E.fused(acc, cur, wr, wc, fr, fq, lds, wid, lane); S.done(cur); }
#undef PG8_SA
#undef PG8_SB
#undef PG8_STAGE
#undef PG8_LDA
#undef PG8_LDB
#undef PG8_MMA
#undef PG8_WAIT_V
#undef PG8_WAIT_L
#undef PG8_BAR
#undef PG8_SCHED
}
}

constexpr int D = 1024, BATCH = 4, SEQ = 8192, MTOK = BATCH * SEQ, NCH = SEQ / 64, MEMLEN = 256;
constexpr int EIN = 3328, OIN = 4096;
constexpr float EPS = 1e-6f;
constexpr int C_AQ = 0, C_AK = 512, C_AV = 640, C_AG = 768, C_BQ = 1280, C_BK = 1792, C_BV = 2304, C_BG = 2816;
constexpr int NWAVES = 8, NTHR = 512;
constexpr size_t MiB = 1u << 20;
constexpr size_t WS_WEIN = 1 * MiB, WS_WEOUT = 8 * MiB, WS_WOIN = 10 * MiB, WS_WOOUT = 18 * MiB, WS_WQ = 20 * MiB, WS_WKV = 24 * MiB, WS_WO = 32 * MiB;
constexpr size_t WS_MEMN = 36 * MiB, WS_KV = 40 * MiB, WS_ROT = 48 * MiB, WS_SSP = 52 * MiB;
constexpr size_t WS_XB = 56 * MiB;
constexpr size_t WS_BIG = 120 * MiB;
constexpr size_t WS_BUFA = 376 * MiB;
constexpr size_t WS_BUFB = 440 * MiB;
constexpr size_t WS_BTO = 328 * MiB, WS_BTS = 344 * MiB;
constexpr size_t WS_END = 504 * MiB;
constexpr int LDS_BYTES = 147456;

#define LAS __attribute__((address_space(3)))
typedef unsigned short bf16;
typedef short bf16x8 __attribute__((ext_vector_type(8)));
typedef short s16x4 __attribute__((ext_vector_type(4)));
typedef float f32x2 __attribute__((ext_vector_type(2)));
typedef float f32x4 __attribute__((ext_vector_type(4)));
typedef float f32x16 __attribute__((ext_vector_type(16)));
typedef unsigned u32x2 __attribute__((ext_vector_type(2)));
typedef unsigned u32x4 __attribute__((ext_vector_type(4)));

__device__ __forceinline__ unsigned pk2(float lo, float hi) { return pg8::cvt_pk_bf16(lo, hi); }
__device__ __forceinline__ float bflo(unsigned w) { return __uint_as_float(w << 16); }
__device__ __forceinline__ float bfhi(unsigned w) { return __uint_as_float(w & 0xffff0000u); }
__device__ __forceinline__ int crow(int r, int hi) { return (r & 3) + 8 * (r >> 2) + 4 * hi; }
__device__ __forceinline__ float wave_sum(float v) {
#pragma unroll
    for (int o = 1; o < 64; o <<= 1) v += shx(v, o);
    return v;
}
__device__ __forceinline__ float silu(float x) { return x / (1.0f + __expf(-x)); }
__device__ __forceinline__ s16x4 trd(const LAS bf16* p) { return __builtin_bit_cast(s16x4, __builtin_amdgcn_ds_read_tr16_b64_v4i16((LAS s16x4*)p)); }
__device__ __forceinline__ bf16x8 tr_frag(const LAS bf16* T, int ld, int k0, int n0, int lane) {
    const int g4 = lane >> 4, li = lane & 15, q = li >> 2, p = li & 3, hi = g4 >> 1;
    const LAS bf16* a = T + (k0 + 4 * hi + q) * ld + n0 + 16 * (g4 & 1) + 4 * p;
    const s16x4 lo = trd(a), up = trd(a + 8 * ld);
    return (bf16x8){lo[0], lo[1], lo[2], lo[3], up[0], up[1], up[2], up[3]};
}
__device__ __forceinline__ bf16x8 pack8(float a0, float a1, float a2, float a3, float a4, float a5, float a6, float a7) {
    u32x4 w; w.x = pk2(a0, a1); w.y = pk2(a2, a3); w.z = pk2(a4, a5); w.w = pk2(a6, a7); return __builtin_bit_cast(bf16x8, w);
}
__device__ __forceinline__ int launder(int v) { asm volatile("" : "+v"(v)); return v; }
#define LBAR() asm volatile("s_waitcnt lgkmcnt(0)\n\ts_barrier" ::: "memory")
#define MFMA32(a, b, c) __builtin_amdgcn_mfma_f32_32x32x16_bf16((a), (b), (c), 0, 0, 0)

#define XB_TMO      128
#define XB_XCNT(j)  (256  + 64 * (j))
#define XB_XSUB(j)  (1280 + 64 * (j))
#define XB_XGEN(j)  (2304 + 64 * (j))
#define XB_TOP      3328
#define XB_TOPGEN   3392
#define XCD_BAR_WORDS 3456
#define XB_SPIN_CAP (1u << 18)

__device__ __forceinline__ unsigned xb_ld(unsigned* p)              { return __hip_atomic_load(p, __ATOMIC_RELAXED, __HIP_MEMORY_SCOPE_AGENT); }
__device__ __forceinline__ unsigned xb_add(unsigned* p, unsigned v) { return __hip_atomic_fetch_add(p, v, __ATOMIC_RELAXED, __HIP_MEMORY_SCOPE_AGENT); }
__device__ __forceinline__ unsigned xb_xcc_id() { return (unsigned)__builtin_amdgcn_s_getreg((3 << 11) | 20) & 0xFu; }
#define XB_SPIN(cond, bar) do { unsigned _sp = 0; while (cond) { __builtin_amdgcn_s_sleep(1); \
    if ((++_sp & 255u) == 0u) { if (xb_ld(&(bar)[XB_TMO])) break; if (_sp > XB_SPIN_CAP) { atomicAdd(&(bar)[XB_TMO], 1u); break; } } } } while (0)

struct XcdBarrier {
    unsigned* bar; unsigned x; int wv;
    volatile LAS unsigned* st;
};

__device__ __forceinline__ XcdBarrier xcd_barrier_post(unsigned* bar, volatile LAS unsigned* st, int wv) {
    XcdBarrier b; b.bar = bar; b.x = xb_xcc_id(); b.st = st; b.wv = wv;
    if (wv == 0 && mk_lane() == 0) (void)xb_add(&bar[XB_XCNT(b.x)], 1u);
    return b;
}
__device__ __forceinline__ void xcd_barrier_complete(unsigned* bar, unsigned x, unsigned& nloc, unsigned& nx) {
    const unsigned G = gridDim.x * gridDim.y * gridDim.z;
    unsigned sum, cnt, mine, sp = 0u;
    for (;;) {
        sum = 0u; cnt = 0u; mine = 0u;
#pragma unroll
        for (unsigned j = 0; j < 16; ++j) { const unsigned c = xb_ld(&bar[XB_XCNT(j)]); sum += c; cnt += (c > 0u) ? 1u : 0u; mine = (j == x) ? c : mine; }
        if (sum == G) break;
        __builtin_amdgcn_s_sleep(1);
        if ((++sp & 255u) == 0u) { if (xb_ld(&bar[XB_TMO])) break; if (sp > XB_SPIN_CAP) { atomicAdd(&bar[XB_TMO], 1u); break; } }
    }
    nloc = mine > 0u ? mine : 1u; nx = cnt > 0u ? cnt : 1u;
}

__device__ __forceinline__ void xcd_barrier(const XcdBarrier& b) {
    asm volatile("s_waitcnt vmcnt(0)" ::: "memory");
    __syncthreads();
    if (b.wv == 0 && mk_lane() == 0) {
        unsigned* bar = b.bar;
        __builtin_amdgcn_s_waitcnt(0);
        unsigned nloc = b.st[0], nx = b.st[1];
        if (nloc == 0u) { xcd_barrier_complete(bar, b.x, nloc, nx); b.st[0] = nloc; b.st[1] = nx; }
        const unsigned old = xb_add(&bar[XB_XSUB(b.x)], 1u);
        const unsigned gen = old / nloc;
        if (old + 1u == (gen + 1u) * nloc) {
            __builtin_amdgcn_fence(__ATOMIC_RELEASE, "agent");
            asm volatile("s_waitcnt vmcnt(0)" ::: "memory");
            const unsigned og = xb_add(&bar[XB_TOP], 1u);
            const unsigned tg = og / nx;
            if (og + 1u == (tg + 1u) * nx) xb_add(&bar[XB_TOPGEN], 1u);
            else XB_SPIN(xb_ld(&bar[XB_TOPGEN]) == tg, bar);
            __builtin_amdgcn_fence(__ATOMIC_ACQUIRE, "agent");
            xb_add(&bar[XB_XGEN(b.x)], 1u);
            asm volatile("s_waitcnt vmcnt(0)" ::: "memory");
        } else {
            XB_SPIN(xb_ld(&bar[XB_XGEN(b.x)]) == gen, bar);
            __builtin_amdgcn_fence(__ATOMIC_ACQUIRE, "agent");
            asm volatile("s_waitcnt vmcnt(0)" ::: "memory");
        }
    }
    __syncthreads();
}

constexpr int XB_WS_OFF = 4096, XB_LDS_OFF = 147200;
struct Args { const float* in[17]; float* out; unsigned char* ws; int ph_lo, ph_hi; };
struct Frame {
    LAS unsigned char* lds; int wave, G, bid;
    const Args* ap;
};

__device__ __forceinline__ int oin_src_col(int np) { const int t = np >> 8, j = np & 255, bj = j >> 7, wc = (j >> 5) & 3, r = j & 31, c = 64 * t + 32 * (wc & 1) + r;
    const int grp = (wc < 2) ? (bj ? 2 : 1) : (bj ? 3 : 0); return grp * 1024 + c; }
template <bool PERMC = false> __device__ __forceinline__ void p0_transpose_item(const float* W, const float* gain, int K, int N, bf16* WT, LAS float* scr, int item, int lane) {
    const int nblk = N / 32, kb = item / nblk, nb = item % nblk, k0 = 64 * kb, n0 = 32 * nb, ns0 = PERMC ? oin_src_col(n0) : n0;
    float wv[32];
#pragma unroll
    for (int i = 0; i < 32; ++i) wv[i] = W[(size_t)(k0 + 2 * i + (lane >> 5)) * N + ns0 + (lane & 31)];
    if (gain) {
#pragma unroll
        for (int i = 0; i < 32; ++i) wv[i] *= gain[k0 + 2 * i + (lane >> 5)]; }
#pragma unroll
    for (int i = 0; i < 32; ++i) scr[(2 * i + (lane >> 5)) * 33 + (lane & 31)] = wv[i];
    asm volatile("s_waitcnt lgkmcnt(0)" ::: "memory");
    const int c = lane & 7;
#pragma unroll
    for (int j = 0; j < 4; ++j) { const int n = (lane >> 3) + 8 * j; const LAS float* s = scr + (8 * c) * 33 + n;
        u32x4 o; o.x = pk2(s[0 * 33], s[1 * 33]); o.y = pk2(s[2 * 33], s[3 * 33]); o.z = pk2(s[4 * 33], s[5 * 33]); o.w = pk2(s[6 * 33], s[7 * 33]);
        *(u32x4*)(WT + (size_t)(n0 + n) * K + k0 + 8 * c) = o; }
    asm volatile("s_waitcnt lgkmcnt(0)" ::: "memory");
}
__device__ __forceinline__ void p0_prologue(Frame& F) {
    LAS float* scr = (LAS float*)(F.lds + F.wave * 16384);
    const int gw = F.bid * NWAVES + F.wave, NGW = F.G * NWAVES, lane = mk_lane();
    unsigned char* ws = F.ap->ws;
    constexpr int I_EIN = 16 * (EIN / 32), I_SQ = 16 * 32, I_OIN = 16 * (OIN / 32), I_KV = 16 * 64;
    constexpr int NITEMS = I_EIN + I_SQ + I_OIN + I_SQ + 2 * I_KV + 2 * I_SQ;
    for (int it = gw; it < NITEMS; it += NGW) {
        int r = it;
        if (r < I_EIN) { p0_transpose_item(F.ap->in[3], F.ap->in[2], D, EIN, (bf16*)(ws + WS_WEIN), scr, r, lane); continue; } r -= I_EIN;
        if (r < I_SQ) { p0_transpose_item(F.ap->in[5], nullptr, D, D, (bf16*)(ws + WS_WEOUT), scr, r, lane); continue; } r -= I_SQ;
        if (r < I_OIN) { p0_transpose_item<true>(F.ap->in[7], F.ap->in[6], D, OIN, (bf16*)(ws + WS_WOIN), scr, r, lane); continue; } r -= I_OIN;
        if (r < I_SQ) { p0_transpose_item(F.ap->in[10], nullptr, D, D, (bf16*)(ws + WS_WOOUT), scr, r, lane); continue; } r -= I_SQ;
        if (r < 2 * I_KV) { const int l = r / I_KV; p0_transpose_item(F.ap->in[14] + (size_t)l * D * 2 * D, nullptr, D, 2 * D, (bf16*)(ws + WS_WKV) + (size_t)l * 2 * D * D, scr, r % I_KV, lane); continue; } r -= 2 * I_KV;
        { const int lh = r / 128; p0_transpose_item(F.ap->in[15] + (size_t)lh * 256 * D, nullptr, 256, D, (bf16*)(ws + WS_WO) + (size_t)lh * 256 * D, scr, r % 128, lane); }
    }
    for (int e = F.bid * NTHR + launder(F.wave * 64 + mk_lane()); e < 2 * D * 4 * 32; e += F.G * NTHR) {
        const int ch = e & 31, h = (e >> 5) & 3, k = (e >> 7) & 1023, l = e >> 17;
        const float* src = F.ap->in[13] + ((size_t)l * D + k) * D + h * 256 + ch * 8; const float gk = F.ap->in[11][l * D + k];
        const f32x4 a = *(const f32x4*)src, b = *(const f32x4*)(src + 4);
        u32x4 w; w.x = pk2(a[0] * gk, a[1] * gk); w.y = pk2(a[2] * gk, a[3] * gk); w.z = pk2(b[0] * gk, b[1] * gk); w.w = pk2(b[2] * gk, b[3] * gk);
        *(u32x4*)((bf16*)(ws + WS_WQ) + ((size_t)(l * 4 + h) * D + k) * 256 + ch * 8) = w;
    }
    for (int it = gw; it < 2 * BATCH * MEMLEN; it += NGW) {
        const int l = it / (BATCH * MEMLEN), row = it % (BATCH * MEMLEN);
        const f32x4* xr = (const f32x4*)(F.ap->in[1] + (size_t)row * D) + lane; const f32x4* gr = (const f32x4*)(F.ap->in[12] + l * D) + lane;
        f32x4 v[4]; float s = 0.f;
#pragma unroll
        for (int j = 0; j < 4; ++j) { v[j] = xr[64 * j]; s += (v[j][0] * v[j][0] + v[j][1] * v[j][1]) + (v[j][2] * v[j][2] + v[j][3] * v[j][3]); }
        const float rs = 1.0f / sqrtf(wave_sum(s) * (1.0f / D) + EPS);
        u32x2* o8 = (u32x2*)((bf16*)(ws + WS_MEMN) + (size_t)it * D) + lane;
#pragma unroll
        for (int j = 0; j < 4; ++j) { const f32x4 g = gr[64 * j]; u32x2 w; w.x = pk2(v[j][0] * rs * g[0], v[j][1] * rs * g[1]); w.y = pk2(v[j][2] * rs * g[2], v[j][3] * rs * g[3]); o8[64 * j] = w; }
    }
    for (int row = 2 * gw; row < MTOK; row += 2 * NGW) {
        f32x4 v[2][4];
#pragma unroll
        for (int t = 0; t < 2; ++t) { const f32x4* xr = (const f32x4*)(F.ap->in[0] + (size_t)(row + t) * D) + lane;
#pragma unroll
            for (int j = 0; j < 4; ++j) v[t][j] = xr[64 * j]; }
#pragma unroll
        for (int t = 0; t < 2; ++t) { float s = 0.f;
#pragma unroll
            for (int j = 0; j < 4; ++j) s += (v[t][j][0] * v[t][j][0] + v[t][j][1] * v[t][j][1]) + (v[t][j][2] * v[t][j][2] + v[t][j][3] * v[t][j][3]);
            s = wave_sum(s);
            u32x2* o8 = (u32x2*)((bf16*)(ws + WS_XB) + (size_t)(row + t) * D) + lane;
#pragma unroll
            for (int j = 0; j < 4; ++j) { u32x2 w; w.x = pk2(v[t][j][0], v[t][j][1]); w.y = pk2(v[t][j][2], v[t][j][3]); o8[64 * j] = w; }
            if (lane < 16) ((float*)(ws + WS_SSP))[(size_t)(row + t) * 16 + lane] = (lane == 0) ? s : 0.f; }
    }
    for (int e = F.bid * NTHR + launder((F.wave * 64 + mk_lane())); e < SEQ * 64; e += F.G * NTHR) {
        const int pos = e >> 6, j = e & 63;
        const float inv = 1.0f / exp2f(((float)j / 63.0f) * 13.287712379549449f);
        const float ang = (float)pos * inv;
        const double a = (double)ang, kk = rint(a * 0.63661977236758134308);
        const float r = (float)fma(-kk, 1.57079632679489661923, a), r2 = r * r;
        const float sn = r + r * r2 * (-1.6666654611e-1f + r2 * (8.3321608736e-3f + r2 * (-1.9515295891e-4f)));
        const float cs = 1.0f - 0.5f * r2 + r2 * r2 * (4.166664568298827e-2f + r2 * (-1.388731625493765e-3f + r2 * 2.443315711809948e-5f));
        const int q = ((int)kk) & 3;
        f32x2 o; o.x = (q == 0) ? cs : (q == 1) ? -sn : (q == 2) ? -cs : sn; o.y = (q == 0) ? sn : (q == 1) ? cs : (q == 2) ? -sn : -cs;
        ((f32x2*)(ws + WS_ROT))[e] = o;
    }
}

constexpr int AKS = 72;
struct SwPre { u32x4 kx[3], vx[3]; bf16x8 qf[4]; };
__device__ __forceinline__ void swa_load(Frame& F, int item, SwPre& P) {
    const int kvh = item & 1, c = (item >> 1) & (NCH - 1), b = item >> 8;
    const int c0 = c >= 2 ? c - 2 : 0, nch = c - c0 + 1;
    const int tid = launder((F.wave * 64 + mk_lane())), lane = tid & 63, w = F.wave, r32 = lane & 31, hi = lane >> 5;
    const bf16* HC = (const bf16*)(F.ap->ws + WS_BIG);
    const size_t rowbase = (size_t)b * SEQ;
    const int qh = kvh * 4 + (w >> 1);
    const size_t tok = rowbase + c * 64 + (w & 1) * 32 + r32;
    const bf16* qp = HC + tok * EIN + C_AQ + qh * 64 + hi * 8;
#pragma unroll
    for (int i = 0; i < 3; ++i) if (i < nch) { const int p = tid + i * NTHR, r = p >> 3, ch = p & 7; const bf16* src = HC + (rowbase + c0 * 64 + r) * EIN + kvh * 64 + ch * 8;
        P.kx[i] = *(const u32x4*)(src + C_AK); P.vx[i] = *(const u32x4*)(src + C_AV); }
#pragma unroll
    for (int s = 0; s < 4; ++s) P.qf[s] = *(const bf16x8*)(qp + 16 * s);
}
__device__ __forceinline__ void swa_item(Frame& F, int item, SwPre& P, int next_item, int n_items) {
    const int kvh = item & 1, c = (item >> 1) & (NCH - 1), b = item >> 8;
    const int c0 = c >= 2 ? c - 2 : 0, nch = c - c0 + 1;
    const int tid = launder((F.wave * 64 + mk_lane())), lane = tid & 63, w = F.wave, r32 = lane & 31, hi = lane >> 5;
    LAS bf16* Ks = (LAS bf16*)F.lds; LAS bf16* Vs = Ks + 192 * AKS;
    const bf16* HC = (const bf16*)(F.ap->ws + WS_BIG);
    const size_t rowbase = (size_t)b * SEQ;
    const int qh = kvh * 4 + (w >> 1);
    const size_t tok = rowbase + c * 64 + (w & 1) * 32 + r32;
    const bf16* gp = HC + tok * EIN + C_AG + qh * 64;
#pragma unroll
    for (int i = 0; i < 3; ++i) if (i < nch) { const int p = tid + i * NTHR, r = p >> 3, ch = p & 7; *(LAS u32x4*)(Ks + r * AKS + ch * 8) = P.kx[i]; *(LAS u32x4*)(Vs + r * AKS + ch * 8) = P.vx[i]; }
    bf16x8 qf[4]; u32x2 gg[2][4];
#pragma unroll
    for (int s = 0; s < 4; ++s) qf[s] = P.qf[s];
    if (next_item < n_items) swa_load(F, next_item, P);
#pragma unroll
    for (int db = 0; db < 2; ++db)
#pragma unroll
        for (int gi = 0; gi < 4; ++gi) gg[db][gi] = *(const u32x2*)(gp + 32 * db + 8 * gi + 4 * hi);
    LBAR();
    const int nkb = 2 * nch;
    f32x16 st[6];
#pragma unroll
    for (int kb = 0; kb < 6; ++kb) { st[kb] = (f32x16){};
        if (kb < nkb) {
#pragma unroll
            for (int s = 0; s < 4; ++s) { const bf16x8 a = *(const LAS bf16x8*)(Ks + (32 * kb + r32) * AKS + 16 * s + 8 * hi); st[kb] = MFMA32(a, qf[s], st[kb]); } } }
    bf16x8 vpre[2][2][2];
#pragma unroll
    for (int kb = 0; kb < 2; ++kb)
#pragma unroll
        for (int s = 0; s < 2; ++s)
#pragma unroll
            for (int db = 0; db < 2; ++db) vpre[kb][s][db] = tr_frag(Vs, AKS, 32 * kb + 16 * s, 32 * db, lane);
    float mx = -3.0e38f;
#pragma unroll
    for (int kb = 0; kb < 6; ++kb) if (kb < nkb) {
#pragma unroll
        for (int i = 0; i < 16; ++i) mx = fmaxf(mx, st[kb][i]); }
    mx = fmaxf(mx, shx(mx, 32));
    const float sink = F.ap->in[4][qh];
    const float mref = fmaxf(mx * 0.125f, sink);
    const float L2E = 1.4426950408889634f;
    float sum = 0.f;
#pragma unroll
    for (int kb = 0; kb < 6; ++kb) if (kb < nkb) {
#pragma unroll
        for (int i = 0; i < 16; ++i) { const float p = exp2f((st[kb][i] * 0.125f - mref) * L2E); st[kb][i] = p; sum += p; } }
    sum += shx(sum, 32);
    const float inv = 1.0f / (sum + exp2f((sink - mref) * L2E));
    f32x16 o[2]; o[0] = (f32x16){}; o[1] = (f32x16){};
#pragma unroll
    for (int kb = 0; kb < 6; ++kb) if (kb < nkb) {
#pragma unroll
        for (int s = 0; s < 2; ++s) {
            const bf16x8 pf = pack8(st[kb][8 * s + 0] * inv, st[kb][8 * s + 1] * inv, st[kb][8 * s + 2] * inv, st[kb][8 * s + 3] * inv, st[kb][8 * s + 4] * inv, st[kb][8 * s + 5] * inv, st[kb][8 * s + 6] * inv, st[kb][8 * s + 7] * inv);
#pragma unroll
            for (int db = 0; db < 2; ++db) { const bf16x8 vf = (kb < 2) ? vpre[kb < 2 ? kb : 0][s][db] : tr_frag(Vs, AKS, 32 * kb + 16 * s, 32 * db, lane); o[db] = MFMA32(vf, pf, o[db]); } } }
    bf16* yp = (bf16*)(F.ap->ws + WS_BUFA) + tok * D + qh * 64;
#pragma unroll
    for (int db = 0; db < 2; ++db)
#pragma unroll
        for (int gi = 0; gi < 4; ++gi) { const int d0 = 32 * db + 8 * gi + 4 * hi; const u32x2 g = gg[db][gi];
            u32x2 y; y.x = pk2(o[db][4 * gi + 0] * silu(bflo(g.x)), o[db][4 * gi + 1] * silu(bfhi(g.x))); y.y = pk2(o[db][4 * gi + 2] * silu(bflo(g.y)), o[db][4 * gi + 3] * silu(bfhi(g.y)));
            *(u32x2*)(yp + d0) = y; }
    LBAR();
}

constexpr int RKS = 136;
__device__ __forceinline__ float head_lg2(int h) { return log2f(1.0f - exp2f(-5.0f - (float)h)); }
struct R1Pre { u32x4 q1, q2, k1, k2, v1, v2; f32x4 rt[4]; };
__device__ __forceinline__ void ret1_load(Frame& F, int item, R1Pre& P) {
    const int h = item & 3, c = (item >> 2) & (NCH - 1), b = item >> 9;
    const int tid = launder((F.wave * 64 + mk_lane())), j = tid >> 3, pc = tid & 7;
    const bf16* rowp = (const bf16*)(F.ap->ws + WS_BIG) + ((size_t)b * SEQ + (size_t)c * 64 + j) * EIN;
    P.q1 = *(const u32x4*)(rowp + C_BQ + h * 128 + 8 * pc); P.q2 = *(const u32x4*)(rowp + C_BQ + h * 128 + 64 + 8 * pc);
    P.k1 = *(const u32x4*)(rowp + C_BK + h * 128 + 8 * pc); P.k2 = *(const u32x4*)(rowp + C_BK + h * 128 + 64 + 8 * pc);
    P.v1 = *(const u32x4*)(rowp + C_BV + h * 128 + 16 * pc); P.v2 = *(const u32x4*)(rowp + C_BV + h * 128 + 16 * pc + 8);
    const f32x4* rt = (const f32x4*)((const f32x2*)(F.ap->ws + WS_ROT) + (size_t)(c * 64 + j) * 64 + 8 * pc);
#pragma unroll
    for (int e = 0; e < 4; ++e) P.rt[e] = rt[e];
}
__device__ __forceinline__ void ret1_item(Frame& F, int item, R1Pre& P, int next_item, int n_items) {
    const int h = item & 3, c = (item >> 2) & (NCH - 1), b = item >> 9;
    const int tid = launder((F.wave * 64 + mk_lane())), lane = tid & 63, w = F.wave, r32 = lane & 31, hi = lane >> 5;
    LAS bf16* Qr = (LAS bf16*)F.lds; LAS bf16* Kr = Qr + 64 * RKS; LAS bf16* Vs = Kr + 64 * RKS; LAS bf16* Vd = Vs + 64 * RKS;
    bf16* HC = (bf16*)(F.ap->ws + WS_BIG);
    const size_t rowbase = (size_t)b * SEQ + (size_t)c * 64;
    const float lg2 = head_lg2(h);
    {
        const int j = tid >> 3, pc = tid & 7;
        const u32x4 q1 = P.q1, q2 = P.q2, k1 = P.k1, k2 = P.k2, v1 = P.v1, v2 = P.v2;
        const f32x4* rt = P.rt;
        u32x4 qa, qb, ka, kb;
        const float ksc = 0.08838834764831845f;
#pragma unroll
        for (int e = 0; e < 4; ++e) { const f32x4 cs = rt[e];
            const float a0 = bflo(q1[e]), a1 = bfhi(q1[e]), b0 = bflo(q2[e]), b1 = bfhi(q2[e]);
            qa[e] = pk2(a0 * cs[0] - b0 * cs[1], a1 * cs[2] - b1 * cs[3]); qb[e] = pk2(a0 * cs[1] + b0 * cs[0], a1 * cs[3] + b1 * cs[2]);
            const float c0 = bflo(k1[e]), c1 = bfhi(k1[e]), d0 = bflo(k2[e]), d1 = bfhi(k2[e]);
            ka[e] = pk2((c0 * cs[0] - d0 * cs[1]) * ksc, (c1 * cs[2] - d1 * cs[3]) * ksc); kb[e] = pk2((c0 * cs[1] + d0 * cs[0]) * ksc, (c1 * cs[3] + d1 * cs[2]) * ksc); }
        *(LAS u32x4*)(Qr + j * RKS + 8 * pc) = qa; *(LAS u32x4*)(Qr + j * RKS + 64 + 8 * pc) = qb;
        *(LAS u32x4*)(Kr + j * RKS + 8 * pc) = ka; *(LAS u32x4*)(Kr + j * RKS + 64 + 8 * pc) = kb;
        { bf16* yq = (bf16*)(F.ap->ws + WS_BUFA) + (rowbase + j) * D + 512 + h * 128 + 8 * pc; *(u32x4*)yq = qa; *(u32x4*)(yq + 64) = qb; }
        *(LAS u32x4*)(Vs + j * RKS + 16 * pc) = v1; *(LAS u32x4*)(Vs + j * RKS + 16 * pc + 8) = v2;
        const float kd = exp2f(lg2 * (float)(63 - j));
        u32x4 w1, w2;
#pragma unroll
        for (int e = 0; e < 4; ++e) { w1[e] = pk2(bflo(v1[e]) * kd, bfhi(v1[e]) * kd); w2[e] = pk2(bflo(v2[e]) * kd, bfhi(v2[e]) * kd); }
        *(LAS u32x4*)(Vd + j * RKS + 16 * pc) = w1; *(LAS u32x4*)(Vd + j * RKS + 16 * pc + 8) = w2;
    }
    if (next_item < n_items) ret1_load(F, next_item, P);
    LBAR();
    const int ib = w & 1, db = w >> 1;
    f32x16 st[2];
    const int rb = w >> 1;
    bf16x8 qfr[8], vfr[4], afr[4], bfr[2][4];
#pragma unroll
    for (int s = 0; s < 8; ++s) qfr[s] = *(const LAS bf16x8*)(Qr + (32 * ib + r32) * RKS + 16 * s + 8 * hi);
#pragma unroll
    for (int jb = 0; jb < 2; ++jb) { bf16x8 afk[8];
#pragma unroll
        for (int s = 0; s < 8; ++s) afk[s] = *(const LAS bf16x8*)(Kr + (32 * jb + r32) * RKS + 16 * s + 8 * hi);
        if (jb == 1) {
#pragma unroll
            for (int s = 0; s < 4; ++s) { vfr[s] = tr_frag(Vs, RKS, 16 * s, 32 * db, lane); afr[s] = tr_frag(Kr, RKS, 16 * s, 32 * rb, lane);
                bfr[0][s] = tr_frag(Vd, RKS, 16 * s, 32 * (2 * (w & 1)), lane); bfr[1][s] = tr_frag(Vd, RKS, 16 * s, 32 * (2 * (w & 1) + 1), lane); } }
        st[jb] = (f32x16){};
#pragma unroll
        for (int s = 0; s < 8; ++s) st[jb] = MFMA32(afk[s], qfr[s], st[jb]); }
    const int iloc = 32 * ib + r32;
#pragma unroll
    for (int jb = 0; jb < 2; ++jb)
#pragma unroll
        for (int i = 0; i < 16; ++i) { const int j = 32 * jb + crow(i, hi); const int dd = iloc > j ? iloc - j : j - iloc; st[jb][i] *= exp2f(lg2 * (float)dd); }
    f32x16 o = (f32x16){};
#pragma unroll
    for (int jb = 0; jb < 2; ++jb)
#pragma unroll
        for (int s = 0; s < 2; ++s) {
            const bf16x8 pf = pack8(st[jb][8 * s + 0], st[jb][8 * s + 1], st[jb][8 * s + 2], st[jb][8 * s + 3], st[jb][8 * s + 4], st[jb][8 * s + 5], st[jb][8 * s + 6], st[jb][8 * s + 7]);
            o = MFMA32(vfr[2 * jb + s], pf, o); }
    {
        bf16* op = (bf16*)F.ap->out + (rowbase + iloc) * 512 + h * 128 + 32 * db + 4 * hi;
#pragma unroll
        for (int gi = 0; gi < 4; ++gi) { u32x2 y; y.x = pk2(o[4 * gi], o[4 * gi + 1]); y.y = pk2(o[4 * gi + 2], o[4 * gi + 3]); *(u32x2*)(op + 8 * gi) = y; }
    }
    f32x16 kv[2]; kv[0] = (f32x16){}; kv[1] = (f32x16){};
#pragma unroll
    for (int s = 0; s < 4; ++s)
#pragma unroll
        for (int t = 0; t < 2; ++t) kv[t] = MFMA32(afr[s], bfr[t][s], kv[t]);
    bf16* stp = (bf16*)(F.ap->ws + WS_BUFB) + ((size_t)(b * NCH + c) * 4 + h) * 16384;
#pragma unroll
    for (int t = 0; t < 2; ++t) { const int dv = 32 * (2 * (w & 1) + t) + r32;
#pragma unroll
        for (int gi = 0; gi < 4; ++gi) { const int dk = 32 * rb + 8 * gi + 4 * hi; u32x2 y; y.x = pk2(kv[t][4 * gi], kv[t][4 * gi + 1]); y.y = pk2(kv[t][4 * gi + 2], kv[t][4 * gi + 3]);
            *(u32x2*)(stp + dv * 128 + dk) = y; } }
    LBAR();
}

__device__ __forceinline__ void scan_phase(Frame& F) {
    u32x4* ST = (u32x4*)(F.ap->ws + WS_BUFB);
    const int tsc = launder(F.wave * 64 + mk_lane());
    if (tsc < 128)
    for (int e = F.bid * 128 + tsc; e < BATCH * 4 * 2048; e += F.G * 128) {
        const int idx = e & 2047, h = (e >> 11) & 3, b = e >> 13;
        const float dec = exp2f(head_lg2(h) * 64.0f);
        u32x4* p = ST + ((size_t)(b * NCH) * 4 + h) * 2048 + idx;
        float st[8];
#pragma unroll
        for (int i = 0; i < 8; ++i) st[i] = 0.f;
        u32x4 ka[16], kb[16];
#define SCAN_LD(dst, c0) do { _Pragma("unroll") for (int j = 0; j < 16; ++j) dst[j] = p[(size_t)((c0) + j) * 4 * 2048]; } while (0)
#define SCAN_UP(src, c0) do { _Pragma("unroll") for (int j = 0; j < 16; ++j) { u32x4 o; o.x = pk2(st[0], st[1]); o.y = pk2(st[2], st[3]); o.z = pk2(st[4], st[5]); o.w = pk2(st[6], st[7]); p[(size_t)((c0) + j) * 4 * 2048] = o; \
            _Pragma("unroll") for (int i = 0; i < 4; ++i) { st[2 * i] = st[2 * i] * dec + bflo(src[j][i]); st[2 * i + 1] = st[2 * i + 1] * dec + bfhi(src[j][i]); } } } while (0)
        SCAN_LD(ka, 0);
#pragma unroll 1
        for (int c0 = 0; c0 < NCH; c0 += 32) { SCAN_LD(kb, c0 + 16); SCAN_UP(ka, c0); if (c0 + 32 < NCH) SCAN_LD(ka, c0 + 32); SCAN_UP(kb, c0 + 16); }
#undef SCAN_LD
#undef SCAN_UP
    }
}

struct R2Pre { bf16x8 af[8], qv[8]; u32x2 oi[4]; u32x2 gg[4]; };
__device__ __forceinline__ void ret2_load(Frame& F, int item, R2Pre& P) {
    const int h = item & 3, c = (item >> 2) & (NCH - 1), b = item >> 9;
    const int lane = launder(mk_lane()), w = F.wave, r32 = lane & 31, hi = lane >> 5;
    const int ib = w & 1, db = w >> 1, iloc = 32 * ib + r32;
    const size_t tok = (size_t)b * SEQ + (size_t)c * 64 + iloc;
    const bf16* stp = (const bf16*)(F.ap->ws + WS_BUFB) + ((size_t)(b * NCH + c) * 4 + h) * 16384 + (size_t)(32 * db + r32) * 128 + 8 * hi;
    const bf16* qp = (const bf16*)(F.ap->ws + WS_BUFA) + tok * D + 512 + h * 128 + 8 * hi;
    const bf16* op = (const bf16*)F.ap->out + tok * 512 + h * 128 + 32 * db + 4 * hi;
    const bf16* gp = (const bf16*)(F.ap->ws + WS_BIG) + tok * EIN + C_BG + h * 128 + 32 * db + 4 * hi;
#pragma unroll
    for (int s = 0; s < 8; ++s) { P.af[s] = *(const bf16x8*)(stp + 16 * s); P.qv[s] = *(const bf16x8*)(qp + 16 * s); }
#pragma unroll
    for (int gi = 0; gi < 4; ++gi) { P.oi[gi] = *(const u32x2*)(op + 8 * gi); P.gg[gi] = *(const u32x2*)(gp + 8 * gi); }
}
__device__ __forceinline__ void ret2_item(Frame& F, int item, R2Pre& P, int next_item, int n_items) {
    const int h = item & 3, c = (item >> 2) & (NCH - 1), b = item >> 9;
    const int lane = launder(mk_lane()), w = F.wave, r32 = lane & 31, hi = lane >> 5;
    const int ib = w & 1, db = w >> 1, iloc = 32 * ib + r32;
    LAS float* part = (LAS float*)F.lds;
    const size_t tok = (size_t)b * SEQ + (size_t)c * 64 + iloc;
    f32x16 oc = (f32x16){};
#pragma unroll
    for (int s = 0; s < 8; ++s) oc = MFMA32(P.af[s], P.qv[s], oc);
    const float qdec = exp2f(head_lg2(h) * (float)(iloc + 1));
    float ss = 0.f;
#pragma unroll
    for (int gi = 0; gi < 4; ++gi) {
#pragma unroll
        for (int e = 0; e < 4; ++e) { const unsigned wq_ = (e < 2) ? P.oi[gi].x : P.oi[gi].y; const float v = ((e & 1) ? bfhi(wq_) : bflo(wq_)) + oc[4 * gi + e] * qdec; oc[4 * gi + e] = v; ss += v * v; } }
    u32x2 gg[4];
#pragma unroll
    for (int gi = 0; gi < 4; ++gi) gg[gi] = P.gg[gi];
    if (next_item < n_items) ret2_load(F, next_item, P);
    ss += shx(ss, 32);
    if (hi == 0) part[iloc * 4 + db] = ss;
    LBAR();
    const f32x4 pp = *(const LAS f32x4*)(part + iloc * 4);
    const float rs = 1.0f / sqrtf(((pp[0] + pp[1]) + (pp[2] + pp[3])) * (1.0f / 128.0f) + EPS);
    bf16* yp = (bf16*)(F.ap->ws + WS_BUFA) + tok * D + 512 + h * 128 + 32 * db + 4 * hi;
#pragma unroll
    for (int gi = 0; gi < 4; ++gi) { const u32x2 g = gg[gi];
        u32x2 y; y.x = pk2(oc[4 * gi + 0] * rs * silu(bflo(g.x)), oc[4 * gi + 1] * rs * silu(bfhi(g.x))); y.y = pk2(oc[4 * gi + 2] * rs * silu(bflo(g.y)), oc[4 * gi + 3] * rs * silu(bfhi(g.y)));
        *(u32x2*)(yp + 8 * gi) = y; }
    LBAR();
}

__device__ __forceinline__ void conv_phase(Frame& F) {
    const bf16* Z = (const bf16*)(F.ap->ws + WS_BIG); const bf16* G2 = Z + (size_t)MTOK * D; bf16* Y = (bf16*)(F.ap->ws + WS_BUFA);
    const float* cw = F.ap->in[8]; const float* cb = F.ap->in[9];
    for (int it = F.bid * NTHR + launder(F.wave * 64 + mk_lane()); it < (MTOK / 8) * 128; it += F.G * NTHR) {
        const int cgi = it & 127, tg = it >> 7, col = cgi * 8, t0 = tg * 8;
        const bool first = (t0 & (SEQ - 1)) == 0;
        u32x4 zr[10], gr[8];
#pragma unroll
        for (int i = 0; i < 10; ++i) { zr[i] = (u32x4){0u, 0u, 0u, 0u}; if (i >= 2 || !first) zr[i] = *(const u32x4*)(Z + (size_t)(t0 - 2 + i) * D + col); }
#pragma unroll
        for (int i = 0; i < 8; ++i) gr[i] = *(const u32x4*)(G2 + (size_t)(t0 + i) * D + col);
        float w0[8], w1[8], w2[8], bs[8];
#pragma unroll
        for (int e = 0; e < 8; ++e) { w0[e] = cw[col + e]; w1[e] = cw[D + col + e]; w2[e] = cw[2 * D + col + e]; bs[e] = cb[col + e]; }
#pragma unroll
        for (int tt = 0; tt < 8; ++tt) {
            float y[8];
#pragma unroll
            for (int e = 0; e < 4; ++e) {
                const float cv0 = bs[2 * e] + bflo(zr[tt][e]) * w0[2 * e] + bflo(zr[tt + 1][e]) * w1[2 * e] + bflo(zr[tt + 2][e]) * w2[2 * e];
                const float cv1 = bs[2 * e + 1] + bfhi(zr[tt][e]) * w0[2 * e + 1] + bfhi(zr[tt + 1][e]) * w1[2 * e + 1] + bfhi(zr[tt + 2][e]) * w2[2 * e + 1];
                y[2 * e] = bflo(gr[tt][e]) * cv0; y[2 * e + 1] = bfhi(gr[tt][e]) * cv1; }
            u32x4 o; o.x = pk2(y[0], y[1]); o.y = pk2(y[2], y[3]); o.z = pk2(y[4], y[5]); o.w = pk2(y[6], y[7]);
            *(u32x4*)(Y + (size_t)(t0 + tt) * D + col) = o;
        }
    }
}

__device__ __forceinline__ void final_phase(Frame& F) {
    const int gw = F.bid * NWAVES + F.wave, NGW = F.G * NWAVES, lane = mk_lane();
    const float* ssp = (const float*)(F.ap->ws + WS_SSP);
    const f32x4* gr = (const f32x4*)F.ap->in[16];
    f32x4 g[4];
#pragma unroll
    for (int j = 0; j < 2; ++j) { g[2 * j] = gr[128 * j + 2 * lane]; g[2 * j + 1] = gr[128 * j + 2 * lane + 1]; }
    for (int row = 2 * gw; row < MTOK; row += 2 * NGW) {
        f32x4 pv[2][4]; u32x4 xv[2][2];
#pragma unroll
        for (int t = 0; t < 2; ++t) { const f32x4* p = (const f32x4*)(ssp + (size_t)(row + t) * 16); const u32x4* xr = (const u32x4*)((const bf16*)(F.ap->ws + WS_XB) + (size_t)(row + t) * D) + lane;
#pragma unroll
            for (int j = 0; j < 4; ++j) pv[t][j] = p[j];
            xv[t][0] = xr[0]; xv[t][1] = xr[64]; }
#pragma unroll
        for (int t = 0; t < 2; ++t) {
            const float s = ((pv[t][0][0] + pv[t][0][1]) + (pv[t][0][2] + pv[t][0][3])) + ((pv[t][1][0] + pv[t][1][1]) + (pv[t][1][2] + pv[t][1][3])) + ((pv[t][2][0] + pv[t][2][1]) + (pv[t][2][2] + pv[t][2][3])) + ((pv[t][3][0] + pv[t][3][1]) + (pv[t][3][2] + pv[t][3][3]));
            const float rs = 1.0f / sqrtf(s * (1.0f / D) + EPS);
            f32x4* orow = (f32x4*)(F.ap->out + (size_t)(row + t) * D);
#pragma unroll
            for (int j = 0; j < 2; ++j) { const u32x4 w = xv[t][j];
                const f32x4 a = (f32x4){bflo(w.x), bfhi(w.x), bflo(w.y), bfhi(w.y)}, b = (f32x4){bflo(w.z), bfhi(w.z), bflo(w.w), bfhi(w.w)};
                orow[128 * j + 2 * lane] = a * rs * g[2 * j]; orow[128 * j + 2 * lane + 1] = b * rs * g[2 * j + 1]; } }
    }
}

#ifndef TS_PROBE
#define TS_PROBE 0
#endif
#define TS_A_HI 5
#define TS_A_LO 2
#define TS_B_HI 1
#define TS_B_LO 0
#ifndef DUP_MASK
#define DUP_MASK 0
#endif
__device__ __forceinline__ bool PHASE_ENTER_(Frame& F) { asm volatile("" : "+s"(F.bid), "+s"(F.G), "+s"(F.wave)); return true; }
#define REP(k) _Pragma("unroll 1") for (int rep_ = 0; rep_ < ((((DUP_MASK) >> (k)) & 1) + 1); ++rep_) if (PHASE_ENTER_(F))
#ifndef MK_SPLIT
#define MK_SPLIT 0
#endif
constexpr int NPHASE = 16;
__global__ void __launch_bounds__(NTHR, 2) fwd_megakernel(Args args) {
    extern __shared__ __attribute__((aligned(16))) unsigned char lds_raw[];
    cg::grid_group grid = cg::this_grid();
    Frame F;
    F.lds = (LAS unsigned char*)lds_raw; F.wave = __builtin_amdgcn_readfirstlane((int)threadIdx.x >> 6); F.G = gridDim.x; F.bid = blockIdx.x;
    F.ap = (const Args*)__builtin_amdgcn_kernarg_segment_ptr();
    if ((F.wave * 64 + mk_lane()) < 2) ((LAS unsigned*)(F.lds + XB_LDS_OFF))[(F.wave * 64 + mk_lane())] = 0u;
    __syncthreads();
    const XcdBarrier xbar = xcd_barrier_post((unsigned*)(args.ws + XB_WS_OFF), (volatile LAS unsigned*)(F.lds + XB_LDS_OFF), F.wave);
    const int lo = args.ph_lo, hi = args.ph_hi;
    if (hi > NPHASE) grid.sync();
#define PHASE_ENTER() do { asm volatile("" : "+s"(F.bid), "+s"(F.G), "+s"(F.wave)); } while (0)
#define IN(k) (lo <= (k) && (k) < hi)
#define SEAM(k) do { if (IN(k) && IN((k) + 1)) xcd_barrier(xbar); STAMP((k) + 1); } while (0)
    typedef pg8::EpiScaleBf16<true> EpiS; typedef pg8::EpiScaleBf16<false> EpiN;
#define ws (F.ap->ws)
#define XB ((bf16*)(ws + WS_XB))
#define SSP ((float*)(ws + WS_SSP))
#define BIG ((bf16*)(ws + WS_BIG))
#define BUFA ((bf16*)(ws + WS_BUFA))
#define BUFB ((bf16*)(ws + WS_BUFB))

#if TS_PROBE
#define STAMP(i) do { if (blockIdx.x == 0 && threadIdx.x == 0) ((unsigned long long*)ws)[i] = __builtin_amdgcn_s_memrealtime(); } while (0)
#else
#define STAMP(i) do { } while (0)
#endif
    STAMP(0);
    REP(0) {
    if (IN(0)) { p0_prologue(F); } SEAM(0); }
    REP(1) {
    if (IN(1)) {
        { pg8::Gemm g{XB, (const bf16*)(ws + WS_WEIN), MTOK, EIN, D}; pg8::StaticOrder S; S.init(MTOK, EIN, F.G, F.bid); pg8::rs_prepass((LAS float*)(F.lds + 131072), S, SSP, (F.wave * 64 + mk_lane())); EpiS E{BIG, EIN, (const LAS float*)(F.lds + 131072)};
          pg8::gemm_phase<EpiS, pg8::StaticOrder, true, true>(F.lds, g, S, E, F.wave); }
#pragma unroll 1
        for (int l = 0; l < 2; ++l) { pg8::Gemm g{(const bf16*)(ws + WS_MEMN) + (size_t)l * BATCH * MEMLEN * D, (const bf16*)(ws + WS_WKV) + (size_t)l * 2 * D * D, BATCH * MEMLEN, 2 * D, D};
          pg8::StaticOrder S; S.init(BATCH * MEMLEN, 2 * D, F.G, (F.bid + F.G - (F.G / 2 + 32 * l) % F.G) % F.G); pg8::EpiDense E{(bf16*)(ws + WS_KV) + (size_t)l * BATCH * MEMLEN * 2 * D, 8};
          pg8::gemm_phase<pg8::EpiDense, pg8::StaticOrder, true, true>(F.lds, g, S, E, F.wave); }
    } SEAM(1); }
    REP(2) {
    if (IN(2)) {
        { R1Pre P; if (F.bid < BATCH * NCH * 4) ret1_load(F, F.bid, P); __syncthreads();
          for (int it = F.bid; it < BATCH * NCH * 4; it += F.G) ret1_item(F, it, P, it + F.G, BATCH * NCH * 4); }
        { SwPre Q; if (F.bid < BATCH * NCH * 2) swa_load(F, F.bid, Q); __syncthreads();
          for (int it = F.bid; it < BATCH * NCH * 2; it += F.G) swa_item(F, it, Q, it + F.G, BATCH * NCH * 2); }
    } SEAM(2); }
    REP(3) {
    if (IN(3)) { scan_phase(F);
        if (F.bid < 128) { const int gi = F.bid >> 2, l = gi >> 4, b = (gi >> 2) & 3, h = gi & 3;
            pg8::Gemm g{(const bf16*)(ws + WS_WO) + (size_t)(l * 4 + h) * 256 * D, (const bf16*)(ws + WS_KV) + (size_t)((l * 4 + b) * 8 + 4 + h) * 65536, D, 256, 256};
            pg8::StaticOrder S; S.init(D, 256, 4, F.bid & 3); EpiN E{(bf16*)(ws + WS_BTO) + (size_t)(l * 4 + b) * D * D + h * 256, D, nullptr};
            pg8::gemm_phase<EpiN, pg8::StaticOrder, true, true>(F.lds, g, S, E, F.wave); }
        else if (F.bid < 256) { const int gi = (F.bid - 128) >> 2, l = gi >> 4, b = (gi >> 2) & 3, h = gi & 3;
            pg8::Gemm g{(const bf16*)(ws + WS_KV) + (size_t)((l * 4 + b) * 8 + h) * 65536, (const bf16*)(ws + WS_WQ) + (size_t)(l * 4 + h) * D * 256, 256, D, 256};
            pg8::StaticOrder S; S.init(256, D, 4, F.bid & 3); EpiN E{(bf16*)(ws + WS_BTS) + (size_t)(l * 4 + b) * D * D + (size_t)h * 256 * D, D, nullptr};
            pg8::gemm_phase<EpiN, pg8::StaticOrder, true, true>(F.lds, g, S, E, F.wave); }
    } SEAM(3); }
    REP(4) {
    if (IN(4)) { R2Pre P; if (F.bid < BATCH * NCH * 4) ret2_load(F, F.bid, P); __syncthreads();
        for (int it = F.bid; it < BATCH * NCH * 4; it += F.G) ret2_item(F, it, P, it + F.G, BATCH * NCH * 4); } SEAM(4); }
    REP(5) {
    if (IN(5)) {
        pg8::Gemm g{BUFA, (const bf16*)(ws + WS_WEOUT), MTOK, D, D}; pg8::StaticOrder S; S.init(MTOK, D, F.G, F.bid); typedef pg8::EpiResidual<false, false> EpiR0; EpiR0 E{XB, XB, SSP, D};
        pg8::gemm_phase<EpiR0, pg8::StaticOrder, true, true>(F.lds, g, S, E, F.wave);
    } SEAM(5); }
#pragma unroll
    for (int l = 0; l < 2; ++l) {
        const int pb = (l == 0) ? 6 : 12;
        REP(pb) {
        if (IN(pb)) {
            pg8::Gemm g{XB, (const bf16*)(ws + WS_BTS) + (size_t)l * 4 * D * D, MTOK, D, D, (size_t)D * D * 2, 5}; pg8::StaticOrder S; S.init(MTOK, D, F.G, F.bid);
            pg8::rs_prepass((LAS float*)(F.lds + 131072), S, SSP, (F.wave * 64 + mk_lane()));
            pg8::EpiSoftmax E{BUFA, (const LAS float*)(F.lds + 131072), (LAS float*)(F.lds + 135168), (LAS float*)(F.lds + 139264)};
            pg8::gemm_phase<pg8::EpiSoftmax, pg8::StaticOrder, true, true>(F.lds, g, S, E, F.wave);
        } SEAM(pb); }
        REP(pb + 2) {
        if (IN(pb + 2)) {
            pg8::Gemm g{BUFA, (const bf16*)(ws + WS_BTO) + (size_t)l * 4 * D * D, MTOK, D, D, (size_t)D * D * 2, 5};     pg8::StaticOrder S; S.init(MTOK, D, F.G, F.bid); { typedef pg8::EpiResidual<false, false> EpiR1; EpiR1 E{XB, XB, SSP, D}; pg8::gemm_phase<EpiR1, pg8::StaticOrder, true, true>(F.lds, g, S, E, F.wave); }
        } SEAM(pb + 2); }
        if (l == 0) {
            REP(9) {
            if (IN(9)) {
                pg8::Gemm g{XB, (const bf16*)(ws + WS_WOIN), MTOK, OIN, D}; pg8::StaticOrder S; S.init(MTOK, OIN, F.G, F.bid); pg8::rs_prepass((LAS float*)(F.lds + 131072), S, SSP, (F.wave * 64 + mk_lane()));
                pg8::EpiConv E{BIG, BIG + (size_t)MTOK * D, (const LAS float*)(F.lds + 131072)};
                pg8::gemm_phase<pg8::EpiConv, pg8::StaticOrder, true, true>(F.lds, g, S, E, F.wave);
            } SEAM(9); }
            REP(10) {
            if (IN(10)) { conv_phase(F); } SEAM(10); }
            REP(11) {
            if (IN(11)) {
                pg8::Gemm g{BUFA, (const bf16*)(ws + WS_WOOUT), MTOK, D, D}; pg8::StaticOrder S; S.init(MTOK, D, F.G, F.bid); typedef pg8::EpiResidual<false, false> EpiR1; EpiR1 E{XB, XB, SSP, D};
                pg8::gemm_phase<EpiR1, pg8::StaticOrder, true, true>(F.lds, g, S, E, F.wave);
            } SEAM(11); }
        }
    }
    if (IN(15)) { final_phase(F); }
#if TS_PROBE
    __syncthreads();
    if (blockIdx.x == 0 && threadIdx.x == 0) { const unsigned long long* ts = (const unsigned long long*)ws;
        const float ta = (float)(ts[TS_A_HI] - ts[TS_A_LO]) * 0.01f, tb = (float)(ts[TS_B_HI] - ts[TS_B_LO]) * 0.01f;
        F.ap->out[0] = ta; for (int i = 1; i <= 1000; ++i) F.ap->out[i] = tb; }
#endif
#undef IN
#undef SEAM
#undef ws
#undef XB
#undef SSP
#undef BIG
#undef BUFA
#undef BUFB
}

extern "C" void kernel_launch(void* const* d_in, const int* in_sizes, int n_in, void* d_out, int out_size, void* d_ws, size_t ws_size, hipStream_t stream) {
    static int grid = 0;
    if (grid == 0) {
        if (n_in != 17 || out_size != MTOK * D || ws_size < WS_END) { fprintf(stderr, "kernel_launch: unexpected shapes (n_in %d out %d ws %zu)\n", n_in, out_size, ws_size); grid = -1; return; }
        int dev = 0, cus = 0, per_cu = 0;
        hipGetDevice(&dev); hipDeviceGetAttribute(&cus, hipDeviceAttributeMultiprocessorCount, dev);
        if (hipFuncSetAttribute((const void*)fwd_megakernel, hipFuncAttributeMaxDynamicSharedMemorySize, LDS_BYTES) != hipSuccess) { fprintf(stderr, "kernel_launch: hipFuncSetAttribute failed\n"); grid = -1; return; }
        if (hipOccupancyMaxActiveBlocksPerMultiprocessor(&per_cu, (const void*)fwd_megakernel, NTHR, LDS_BYTES) != hipSuccess || per_cu < 1) { fprintf(stderr, "kernel_launch: occupancy query says %d\n", per_cu); per_cu = 1; }
        (void)hipGetLastError();
        grid = cus;
    }
    if (grid < 0) return;
    if (hipMemsetAsync(d_ws, 0, 65536, stream) != hipSuccess) { fprintf(stderr, "kernel_launch: hipMemsetAsync failed\n"); return; }
    Args a{};
    for (int i = 0; i < 17; ++i) a.in[i] = (const float*)d_in[i];
    a.out = (float*)d_out; a.ws = (unsigned char*)d_ws;
#if MK_SPLIT
    for (int p = 0; p < NPHASE; ++p) { a.ph_lo = p; a.ph_hi = p + 1; hipLaunchKernelGGL(fwd_megakernel, dim3(grid), dim3(NTHR), LDS_BYTES, stream, a); }
#else
    a.ph_lo = 0; a.ph_hi = NPHASE;
    void* kargs[] = {&a};
    hipError_t e = hipLaunchCooperativeKernel((const void*)fwd_megakernel, dim3(grid), dim3(NTHR), kargs, LDS_BYTES, stream);
    if (e != hipSuccess) fprintf(stderr, "kernel_launch: cooperative launch failed: %s (grid %d)\n", hipGetErrorString(e), grid);
#endif
}
```
